# Optimizing an MI355X kernel written in HIP

```python
import jax, jax.numpy as jnp
from jax import lax
import numpy as np

D_MODEL = 1024
BATCH = 2
SEQ = 8192
DEPTH = 1

ATTN_GROUPS = ((128, 1), (512, 4), (2048, 16))
ATTN_HEADS_PER_GROUP = 8
ATTN_HEAD_DIM = 64
ATTN_BLOCK = 128
N_ATTN_HEADS = len(ATTN_GROUPS) * ATTN_HEADS_PER_GROUP
ATTN_QKV_WIDTH = 3 * N_ATTN_HEADS * ATTN_HEAD_DIM
ATTN_OUT = ATTN_HEADS_PER_GROUP * ATTN_HEAD_DIM

GLA_HEADS = 4
GLA_DK = D_MODEL // 2
GLA_DV = D_MODEL
GLA_HK = GLA_DK // GLA_HEADS
GLA_HV = GLA_DV // GLA_HEADS
GLA_GATE_RANK = 16
GLA_TAU = 16.0
GLA_CHUNK = 64

D_FF = 4 * D_MODEL

N_BRANCHES = 2
EPS = 1e-6

_IN_SIZES = (ATTN_QKV_WIDTH, GLA_DK, GLA_DK, GLA_DV, GLA_DV, GLA_GATE_RANK, N_BRANCHES * D_MODEL)
D_IN = sum(_IN_SIZES)
_IN_OFFSETS = tuple(int(v) for v in np.cumsum(_IN_SIZES)[:-1])

kernel_name = 'hybrid_dilated_attn_gla_gated_block'


def rms_norm(x, g):
    xf = x.astype(jnp.float32)
    y = xf * lax.rsqrt(jnp.mean(jnp.square(xf), axis=-1, keepdims=True) + EPS)
    return (y * g.astype(jnp.float32)).astype(x.dtype)


def _dilated_group(q, k, v, window, dilation):
    b, s, h, e = q.shape
    n_back = window // dilation
    blk = ATTN_BLOCK
    assert n_back <= blk
    seg = dilation * blk
    s_pad = -(-s // seg) * seg
    L = s_pad // dilation
    nb = L // blk

    def to_blocks(t):
        t = jnp.pad(t, ((0, 0), (0, s_pad - s), (0, 0), (0, 0)))
        t = t.reshape(b, L, dilation, h, e).transpose(0, 2, 3, 1, 4)
        return t.reshape(b, dilation, h, nb, blk, e)

    def with_prev(t):
        prev = jnp.pad(t[:, :, :, :-1], ((0, 0), (0, 0), (0, 0), (1, 0), (0, 0), (0, 0)))
        return jnp.concatenate([prev, t], axis=4)

    qb, kb, vb = to_blocks(q), to_blocks(k), to_blocks(v)
    kw, vw = with_prev(kb), with_prev(vb)
    scores = jnp.einsum('bdhnqe,bdhnke->bdhnqk', qb, kw).astype(jnp.float32) * (e ** -0.5)
    qi = jnp.arange(blk)[:, None]
    ki = jnp.arange(2 * blk)[None, :]
    dist = blk + qi - ki
    first = (jnp.arange(nb) == 0)[:, None, None]
    valid = (dist >= 0) & (dist <= n_back) & ~(first & (ki < blk))
    scores = jnp.where(valid, scores, -jnp.inf)
    mx = jnp.max(scores, axis=-1, keepdims=True)
    p = jnp.exp(scores - mx)
    den = jnp.sum(p, axis=-1, keepdims=True)
    o = jnp.einsum('bdhnqk,bdhnke->bdhnqe', p, vw.astype(jnp.float32)) / den
    lse = (mx + jnp.log(den))[..., 0]
    o = o.reshape(b, dilation, h, L, e).transpose(0, 3, 1, 2, 4).reshape(b, s_pad, h, e)[:, :s]
    lse = lse.reshape(b, dilation, h, L).transpose(0, 3, 1, 2).reshape(b, s_pad, h)[:, :s]
    return o, lse


def dilated_attention(q, k, v, gq, gk):
    b, s = q.shape[:2]
    q = rms_norm(q, gq)
    k = rms_norm(k, gk)
    outs, lses = [], []
    for gi, (window, dilation) in enumerate(ATTN_GROUPS):
        sl = slice(gi * ATTN_HEADS_PER_GROUP, (gi + 1) * ATTN_HEADS_PER_GROUP)
        o, l = _dilated_group(q[:, :, sl], k[:, :, sl], v[:, :, sl], window, dilation)
        outs.append(o)
        lses.append(l)
    wts = jax.nn.softmax(jnp.stack(lses, axis=0), axis=0)
    o = jnp.sum(wts[..., None] * jnp.stack(outs, axis=0), axis=0)
    return o.reshape(b, s, ATTN_OUT).astype(v.dtype)


def gated_linear_attention(q, k, v, log_a):
    b, s, h, dk = q.shape
    dv = v.shape[-1]
    c = GLA_CHUNK
    n = s // c

    def chunks(t):
        return t.reshape(b, n, c, h, t.shape[-1]).transpose(1, 0, 3, 2, 4).astype(jnp.float32)

    qc = chunks(q) * (dk ** -0.5)
    kc, vc, ac = chunks(k), chunks(v), chunks(log_a)
    causal = jnp.tril(jnp.ones((c, c), dtype=bool))[:, :, None]

    def step(state, inp):
        qt, kt, vt, at = inp
        bcum = jnp.cumsum(at, axis=2)
        o_inter = jnp.einsum('bhtk,bhkv->bhtv', qt * jnp.exp(bcum), state)
        diff = bcum[:, :, :, None, :] - bcum[:, :, None, :, :]
        decay = jnp.exp(jnp.where(causal, diff, -jnp.inf))
        attn = jnp.einsum('bhtk,bhsk,bhtsk->bhts', qt, kt, decay)
        o_intra = jnp.einsum('bhts,bhsv->bhtv', attn, vt)
        blast = bcum[:, :, -1:, :]
        state = (jnp.exp(blast[:, :, 0, :])[..., None] * state
                 + jnp.einsum('bhsk,bhsv->bhkv', kt * jnp.exp(blast - bcum), vt))
        return state, o_inter + o_intra

    state0 = jnp.zeros((b, h, dk, dv), jnp.float32)
    _, o = lax.scan(step, state0, (qc, kc, vc, ac))
    return o.transpose(1, 0, 3, 2, 4).reshape(b, s, h, dv).astype(v.dtype)


def setup_inputs(seed: int = 0) -> dict:
    key = jax.random.key(seed)
    ks = jax.random.split(key, 16)
    f32 = jnp.float32

    def dense(k, fan_in, fan_out):
        return jax.random.normal(k, (DEPTH, fan_in, fan_out), f32) * fan_in ** -0.5

    def gain(k, n):
        return 1.0 + 0.02 * jax.random.normal(k, (DEPTH, n), f32)

    return {
        'x': jax.random.normal(ks[0], (BATCH, SEQ, D_MODEL), f32),
        'norm1_g': gain(ks[1], D_MODEL),
        'w_in': dense(ks[2], D_MODEL, D_IN),
        'attn_q_norm_g': gain(ks[3], ATTN_HEAD_DIM),
        'attn_k_norm_g': gain(ks[4], ATTN_HEAD_DIM),
        'gla_gate_up': dense(ks[5], GLA_GATE_RANK, GLA_DK),
        'gla_gate_bias': 0.1 * jax.random.normal(ks[6], (DEPTH, GLA_DK), f32),
        'gla_out_norm_g': gain(ks[7], GLA_HV),
        'branch_gate_bias': 0.1 * jax.random.normal(ks[8], (DEPTH, N_BRANCHES * D_MODEL), f32),
        'w_attn_branch': dense(ks[9], ATTN_OUT, D_MODEL),
        'w_gla_branch': dense(ks[10], GLA_DV, D_MODEL),
        'w_out': dense(ks[11], D_MODEL, D_MODEL),
        'norm2_g': gain(ks[12], D_MODEL),
        'w_ff_up': dense(ks[13], D_MODEL, D_FF),
        'w_ff_down': dense(ks[14], D_FF, D_MODEL),
    }


def reference(x, norm1_g, w_in, attn_q_norm_g, attn_k_norm_g, gla_gate_up, gla_gate_bias,
              gla_out_norm_g, branch_gate_bias, w_attn_branch, w_gla_branch, w_out,
              norm2_g, w_ff_up, w_ff_down):
    b, s, _ = x.shape
    for l in range(DEPTH):
        h = rms_norm(x, norm1_g[l])
        proj = jnp.einsum('bsd,de->bse', h, w_in[l])
        p_attn, p_q, p_k, p_v, p_r, p_a, p_gate = jnp.split(proj, _IN_OFFSETS, axis=-1)

        qkv = p_attn.reshape(b, s, 3, N_ATTN_HEADS, ATTN_HEAD_DIM)
        o_attn = dilated_attention(qkv[:, :, 0], qkv[:, :, 1], qkv[:, :, 2],
                                   attn_q_norm_g[l], attn_k_norm_g[l])

        gate_logits = (p_a @ gla_gate_up[l] + gla_gate_bias[l]).astype(jnp.float32)
        log_a = jax.nn.log_sigmoid(gate_logits) / GLA_TAU
        o_gla = gated_linear_attention(
            p_q.reshape(b, s, GLA_HEADS, GLA_HK),
            p_k.reshape(b, s, GLA_HEADS, GLA_HK),
            p_v.reshape(b, s, GLA_HEADS, GLA_HV),
            log_a.reshape(b, s, GLA_HEADS, GLA_HK))
        o_gla = rms_norm(o_gla, gla_out_norm_g[l]).reshape(b, s, GLA_DV) * jax.nn.silu(p_r)

        gates = jax.nn.sigmoid(p_gate + branch_gate_bias[l]).reshape(b, s, N_BRANCHES, D_MODEL)
        mixed = (gates[:, :, 0] * (o_attn @ w_attn_branch[l])
                 + gates[:, :, 1] * (o_gla @ w_gla_branch[l]))
        x = x + mixed @ w_out[l]

        h2 = rms_norm(x, norm2_g[l])
        x = x + jnp.square(jax.nn.relu(h2 @ w_ff_up[l])) @ w_ff_down[l]
    return x
```

```cpp
#include <hip/hip_runtime.h>
#include <hip/hip_cooperative_groups.h>
#include <cstdio>
#include <cstdint>
#include <cmath>
namespace cg = cooperative_groups;
namespace pg8 {
#define PG8_LAS __attribute__((address_space(3)))
typedef unsigned short bf16_t;
typedef short bf16x8 __attribute__((ext_vector_type(8)));
typedef float f32x4 __attribute__((ext_vector_type(4)));
typedef unsigned u32x4 __attribute__((ext_vector_type(4)));
constexpr int BM = 256, BK = 64, HALF = 128, HTB = HALF * BK * 2  , STAGE_BYTES = 8 * HTB, NXCD = 8, WGM = 8;

__host__ __device__ __forceinline__ int lds_byte(int r, int c) { const int st = (r >> 4) * 2 + (c >> 5), rr = r & 15, cc = c & 31, ob = rr * 64 + cc * 2; return st * 1024 + (ob ^ (((ob >> 9) & 1) << 5)); }
__host__ __device__ __forceinline__ void stage_rc(int b, int& R, int& C) { const int st = b / 1024, sb = b % 1024, swz = sb ^ (((sb >> 9) & 1) << 5); R = (st >> 1) * 16 + swz / 64; C = (st & 1) * 32 + (swz % 64) / 2; }
__host__ __device__ __forceinline__ int perm32(int rho) { const int n = rho >> 4, i = rho & 15; return 8 * (i >> 2) + 4 * n + (i & 3); }

struct Unit { int pm, pn; };
struct Gemm { const bf16_t* A; const bf16_t* Bt; int M, N, K; };

struct StaticOrder {
    int nM, nN, nwg, G, c;
    __host__ __device__ void init(int M, int N, int G_, int c_) { nM = M / BM; nN = N / BM; nwg = nM * nN; G = G_; c = c_; }
    __host__ __device__ bool next(int i, Unit& u) const {
        const long L = (long)i * G + c; if (L >= nwg) return false;
        int wgid = (int)L; { const int q = nwg / NXCD, r = nwg % NXCD, xcd = wgid % NXCD, off = wgid / NXCD; wgid = (xcd < r ? xcd * (q + 1) : r * (q + 1) + (xcd - r) * q) + off; }
        const int nig = WGM * nN, gid = wgid / nig, fm = gid * WGM, gsz = (nM - fm) < WGM ? (nM - fm) : WGM;
        u.pm = fm + ((wgid % nig) % gsz); u.pn = (wgid % nig) / gsz; return true;
    }
    __device__ __forceinline__ void a_ready(const Unit&) const {}
    __device__ __forceinline__ void done(const Unit&) const {}
};
__device__ __forceinline__ unsigned cvt_pk_bf16(float lo, float hi) { unsigned r; asm volatile("v_cvt_pk_bf16_f32 %0, %1, %2" : "=v"(r) : "v"(lo), "v"(hi)); return r; }
typedef float f32x2 __attribute__((ext_vector_type(2)));
__device__ __forceinline__ float bflo(unsigned w) { return __uint_as_float(w << 16); }
__device__ __forceinline__ float bfhi(unsigned w) { return __uint_as_float(w & 0xffff0000u); }
__device__ __forceinline__ void unpack8(const u32x4 w, float (&f)[8]) { f[0] = bflo(w.x); f[1] = bfhi(w.x); f[2] = bflo(w.y); f[3] = bfhi(w.y); f[4] = bflo(w.z); f[5] = bfhi(w.z); f[6] = bflo(w.w); f[7] = bfhi(w.w); }
__device__ __forceinline__ u32x4 pack8(const float (&v)[8]) { u32x4 w; w.x = cvt_pk_bf16(v[0], v[1]); w.y = cvt_pk_bf16(v[2], v[3]); w.z = cvt_pk_bf16(v[4], v[5]); w.w = cvt_pk_bf16(v[6], v[7]); return w; }
__device__ __forceinline__ float fsigmoid(float x) { return 1.0f / (1.0f + __expf(-x)); }

struct EpiProj {
    static constexpr bool PERM = true, AFTER_DRAIN = false;
    bf16_t* proj; bf16_t* vt; bf16_t* gates; const float* r1; const float* gbias;
    __device__ __forceinline__ void operator()(const f32x4 (&acc)[2][2][4][2], const Unit& u, int wr, int wc, int fr_in, int fq_in) const {
        int fr = fr_in, fq = fq_in; asm volatile("" : "+v"(fr), "+v"(fq));
        const int ct = u.pn; const int row0 = u.pm * BM + wr * 64 + fr; const int cl = wc * 32 + 8 * fq;
#pragma unroll
        for (int ai = 0; ai < 2; ++ai)
#pragma unroll
            for (int m = 0; m < 4; ++m) {
                const int row = row0 + ai * HALF + m * 16; const float rs = r1[row];
#pragma unroll
                for (int bj = 0; bj < 2; ++bj) {
                    const f32x4 v0 = acc[ai][bj][m][0] * rs, v1 = acc[ai][bj][m][1] * rs;
                    float v[8] = {v0[0], v0[1], v0[2], v0[3], v1[0], v1[1], v1[2], v1[3]};
                    const int c = cl + bj * HALF;
                    if (ct < 22) { *(u32x4*)(proj + (size_t)row * 6656 + ct * 256 + c) = pack8(v); }
                    else if (ct < 26) { const u32x4 w = pack8(v); bf16_t* p = vt + (size_t)((ct - 22) * 256 + c) * 8192 + row;
                        p[0] = (bf16_t)(w.x & 0xffffu); p[8192] = (bf16_t)(w.x >> 16); p[2 * 8192] = (bf16_t)(w.y & 0xffffu); p[3 * 8192] = (bf16_t)(w.y >> 16);
                        p[4 * 8192] = (bf16_t)(w.z & 0xffffu); p[5 * 8192] = (bf16_t)(w.z >> 16); p[6 * 8192] = (bf16_t)(w.w & 0xffffu); p[7 * 8192] = (bf16_t)(w.w >> 16); }
                    else if (ct < 30) {
#pragma unroll
                        for (int i = 0; i < 8; ++i) v[i] = v[i] * fsigmoid(v[i]);
                        *(u32x4*)(proj + (size_t)row * 6656 + (ct - 4) * 256 + c) = pack8(v); }
                    else { const int gc = (ct - 30) * 256 + c; const f32x4 b0 = *(const f32x4*)(gbias + gc), b1 = *(const f32x4*)(gbias + gc + 4);
                        const float bb[8] = {b0[0], b0[1], b0[2], b0[3], b1[0], b1[1], b1[2], b1[3]};
#pragma unroll
                        for (int i = 0; i < 8; ++i) v[i] = fsigmoid(v[i] + bb[i]);
                        *(u32x4*)(gates + (size_t)row * 2048 + gc) = pack8(v); }
                }
            }
    }
};
struct EpiBranch {
    static constexpr bool PERM = true, AFTER_DRAIN = false;
    bf16_t* mixed; const bf16_t* gates; int goff; int add;
    __device__ __forceinline__ void operator()(const f32x4 (&acc)[2][2][4][2], const Unit& u, int wr, int wc, int fr_in, int fq_in) const {
        int fr = fr_in, fq = fq_in; asm volatile("" : "+v"(fr), "+v"(fq));
        const int row0 = u.pm * BM + wr * 64 + fr; const int cl = u.pn * BM + wc * 32 + 8 * fq;
#pragma unroll
        for (int ai = 0; ai < 2; ++ai)
#pragma unroll
            for (int m = 0; m < 4; ++m) {
                const int row = row0 + ai * HALF + m * 16;
#pragma unroll
                for (int bj = 0; bj < 2; ++bj) {
                    const int c = cl + bj * HALF; float g[8], v[8];
                    unpack8(*(const u32x4*)(gates + (size_t)row * 2048 + goff + c), g);
                    const f32x4 v0 = acc[ai][bj][m][0], v1 = acc[ai][bj][m][1];
                    v[0] = v0[0] * g[0]; v[1] = v0[1] * g[1]; v[2] = v0[2] * g[2]; v[3] = v0[3] * g[3]; v[4] = v1[0] * g[4]; v[5] = v1[1] * g[5]; v[6] = v1[2] * g[6]; v[7] = v1[3] * g[7];
                    if (add) { float t[8]; unpack8(*(const u32x4*)(mixed + (size_t)row * 1024 + c), t);
#pragma unroll
                        for (int i = 0; i < 8; ++i) v[i] += t[i]; }
                    *(u32x4*)(mixed + (size_t)row * 1024 + c) = pack8(v);
                }
            }
    }
};
struct EpiOut1 {
    static constexpr bool PERM = true, AFTER_DRAIN = false;
    const float* x; float* out; bf16_t* x1b; float* ss2;
    __device__ __forceinline__ void operator()(const f32x4 (&acc)[2][2][4][2], const Unit& u, int wr, int wc, int fr_in, int fq_in) const {
        int fr = fr_in, fq = fq_in; asm volatile("" : "+v"(fr), "+v"(fq));
        const int row0 = u.pm * BM + wr * 64 + fr; const int cl = u.pn * BM + wc * 32 + 8 * fq;
#pragma unroll
        for (int ai = 0; ai < 2; ++ai)
#pragma unroll
            for (int m = 0; m < 4; ++m) {
                const int row = row0 + ai * HALF + m * 16; float ssq = 0.f;
#pragma unroll
                for (int bj = 0; bj < 2; ++bj) {
                    const size_t off = (size_t)row * 1024 + cl + bj * HALF;
                    const f32x4 o0 = *(const f32x4*)(x + off) + acc[ai][bj][m][0], o1 = *(const f32x4*)(x + off + 4) + acc[ai][bj][m][1];
                    *(f32x4*)(out + off) = o0; *(f32x4*)(out + off + 4) = o1;
                    const float v[8] = {o0[0], o0[1], o0[2], o0[3], o1[0], o1[1], o1[2], o1[3]};
                    *(u32x4*)(x1b + off) = pack8(v);
#pragma unroll
                    for (int i = 0; i < 8; ++i) ssq += v[i] * v[i];
                }
                ssq += __shfl_xor(ssq, 16); ssq += __shfl_xor(ssq, 32);
                if (fq == 0) ss2[(size_t)row * 16 + u.pn * 4 + wc] = ssq;
            }
    }
};
struct EpiUp {
    static constexpr bool PERM = true, AFTER_DRAIN = false;
    bf16_t* U; const float* ss2;
    __device__ __forceinline__ void operator()(const f32x4 (&acc)[2][2][4][2], const Unit& u, int wr, int wc, int fr_in, int fq_in) const {
        int fr = fr_in, fq = fq_in; asm volatile("" : "+v"(fr), "+v"(fq));
        const int row0 = u.pm * BM + wr * 64 + fr; const int cl = u.pn * BM + wc * 32 + 8 * fq;
#pragma unroll
        for (int ai = 0; ai < 2; ++ai)
#pragma unroll
            for (int m = 0; m < 4; ++m) {
                const int row = row0 + ai * HALF + m * 16;
                const f32x4* sp = (const f32x4*)(ss2 + (size_t)row * 16); const f32x4 s0 = sp[0], s1 = sp[1], s2 = sp[2], s3 = sp[3];
                const float s = ((s0[0] + s0[1]) + (s0[2] + s0[3])) + ((s1[0] + s1[1]) + (s1[2] + s1[3])) + ((s2[0] + s2[1]) + (s2[2] + s2[3])) + ((s3[0] + s3[1]) + (s3[2] + s3[3]));
                const float rs = 1.0f / sqrtf(s * (1.0f / 1024.0f) + 1e-6f);
#pragma unroll
                for (int bj = 0; bj < 2; ++bj) {
                    const f32x4 v0 = acc[ai][bj][m][0] * rs, v1 = acc[ai][bj][m][1] * rs;
                    float v[8] = {v0[0], v0[1], v0[2], v0[3], v1[0], v1[1], v1[2], v1[3]};
#pragma unroll
                    for (int i = 0; i < 8; ++i) { const float r = fmaxf(v[i], 0.f); v[i] = r * r; }
                    *(u32x4*)(U + (size_t)row * 4096 + cl + bj * HALF) = pack8(v);
                }
            }
    }
};
struct EpiDown {
    static constexpr bool PERM = true, AFTER_DRAIN = false;
    float* out;
    __device__ __forceinline__ void operator()(const f32x4 (&acc)[2][2][4][2], const Unit& u, int wr, int wc, int fr_in, int fq_in) const {
        int fr = fr_in, fq = fq_in; asm volatile("" : "+v"(fr), "+v"(fq));
        const int row0 = u.pm * BM + wr * 64 + fr; const int cl = u.pn * BM + wc * 32 + 8 * fq;
#pragma unroll
        for (int ai = 0; ai < 2; ++ai)
#pragma unroll
            for (int m = 0; m < 4; ++m) {
                const int row = row0 + ai * HALF + m * 16;
#pragma unroll
                for (int bj = 0; bj < 2; ++bj) {
                    const size_t off = (size_t)row * 1024 + cl + bj * HALF;
                    const f32x4 o0 = *(const f32x4*)(out + off) + acc[ai][bj][m][0], o1 = *(const f32x4*)(out + off + 4) + acc[ai][bj][m][1];
                    *(f32x4*)(out + off) = o0; *(f32x4*)(out + off + 4) = o1;
                }
            }
    }
};
template <class Epi, class Sched, bool ALIGN_EPI = false, bool SP2 = false>
__device__ __forceinline__ void gemm_phase(PG8_LAS unsigned char* lds, const Gemm g, const Sched& S, const Epi& E) {
    int tid_l = threadIdx.x; asm volatile("" : "+v"(tid_l));
    const int tid = tid_l, wid = __builtin_amdgcn_readfirstlane(tid >> 6), lane = tid & 63, wr = wid >> 2, wc = wid & 3, fr = lane & 15, fq = lane >> 4;
    const int K = g.K, nt = K / BK;
    unsigned voffA[2], voffB[2];
#pragma unroll
    for (int i = 0; i < 2; ++i) { int R, C; stage_rc(tid * 16 + i * 8192, R, C); const int Rb = Epi::PERM ? ((R & ~31) + perm32(R & 31)) : R;
        voffA[i] = (unsigned)(R * K + C) * 2u; voffB[i] = (unsigned)(Rb * K + C) * 2u; }
    const size_t kstep = (size_t)(BK * 2);
    const size_t hstep = (size_t)HALF * K * 2;
    const size_t tstep = 2 * hstep;
    const unsigned ldsw = (unsigned)wid * 1024u;
    const int aoff = lds_byte(wr * 64 + fr, fq * 8), boff = lds_byte(wc * 32 + fr, fq * 8);
#define PG8_SA(b, h) (((b) * 2 + (h)) * HTB)
#define PG8_SB(b, h) ((4 + (b) * 2 + (h)) * HTB)
#define PG8_STAGE(bufoff, gbase, voff) do { _Pragma("unroll") for (int _i = 0; _i < 2; ++_i) \
        __builtin_amdgcn_global_load_lds((const unsigned*)((const char*)(gbase) + (voff)[_i]), (PG8_LAS unsigned*)(lds + (bufoff) + ldsw + _i * 8192), 16, 0, 0); } while (0)
#define PG8_LDA(dst, b, h) do { _Pragma("unroll") for (int m = 0; m < 4; ++m) _Pragma("unroll") for (int k = 0; k < 2; ++k) dst[m][k] = *(const PG8_LAS bf16x8*)(lds + PG8_SA(b, h) + aoff + m * 2048 + k * 1024); } while (0)
#define PG8_LDB(dst, b, h) do { _Pragma("unroll") for (int n = 0; n < 2; ++n) _Pragma("unroll") for (int k = 0; k < 2; ++k) dst[n][k] = *(const PG8_LAS bf16x8*)(lds + PG8_SB(b, h) + boff + n * 2048 + k * 1024); } while (0)
#define PG8_MMA(ai, bj, At, Bt) do { __builtin_amdgcn_s_setprio(1); _Pragma("unroll") for (int m = 0; m < 4; ++m) _Pragma("unroll") for (int n = 0; n < 2; ++n) _Pragma("unroll") for (int k = 0; k < 2; ++k) \
        acc[ai][bj][m][n] = __builtin_amdgcn_mfma_f32_16x16x32_bf16(Bt[n][k], At[m][k], acc[ai][bj][m][n], 0, 0, 0); __builtin_amdgcn_s_setprio(0); } while (0)
#define PG8_WAIT_V(n) asm volatile("s_waitcnt vmcnt(" #n ")" ::: "memory")
#define PG8_WAIT_L(n) asm volatile("s_waitcnt lgkmcnt(" #n ")" ::: "memory")
#define PG8_BAR __builtin_amdgcn_s_barrier()
#define PG8_SCHED __builtin_amdgcn_sched_barrier(0)
    Unit cur, nxt; int ui = 0;
    if (!S.next(0, cur)) return;
    f32x4 acc[2][2][4][2];
#pragma unroll
    for (int a = 0; a < 2; ++a)
#pragma unroll
        for (int b = 0; b < 2; ++b)
#pragma unroll
            for (int m = 0; m < 4; ++m)
#pragma unroll
                for (int n = 0; n < 2; ++n) acc[a][b][m][n] = (f32x4){0.f, 0.f, 0.f, 0.f};
    bf16x8 At[4][2], B0[2][2], B1[2][2];
    const char* cA = (const char*)g.A + (size_t)cur.pm * tstep; const char* cB = (const char*)g.Bt + (size_t)cur.pn * tstep;
    S.a_ready(cur);
    if constexpr (SP2) {
        PG8_STAGE(PG8_SB(0, 0), cB, voffB); PG8_STAGE(PG8_SB(0, 1), cB + hstep, voffB); PG8_STAGE(PG8_SA(0, 0), cA, voffA); PG8_STAGE(PG8_SA(0, 1), cA + hstep, voffA);
        if (wr == 1) PG8_BAR;
        PG8_WAIT_V(2); PG8_BAR;
        PG8_STAGE(PG8_SB(1, 0), cB + kstep, voffB); PG8_STAGE(PG8_SA(1, 0), cA + kstep, voffA); PG8_STAGE(PG8_SB(1, 1), cB + hstep + kstep, voffB);
        PG8_WAIT_V(6); PG8_BAR;
    } else {
        PG8_STAGE(PG8_SB(0, 0), cB, voffB); PG8_STAGE(PG8_SA(0, 0), cA, voffA); PG8_STAGE(PG8_SB(0, 1), cB + hstep, voffB); PG8_STAGE(PG8_SA(0, 1), cA + hstep, voffA);
        if (wr == 1) PG8_BAR;
        PG8_WAIT_V(4); PG8_BAR;
        PG8_STAGE(PG8_SB(1, 0), cB + kstep, voffB); PG8_STAGE(PG8_SA(1, 0), cA + kstep, voffA); PG8_STAGE(PG8_SB(1, 1), cB + hstep + kstep, voffB);
        PG8_WAIT_V(6); PG8_BAR;
    }
    for (;;) {
        const bool has_next = S.next(ui + 1, nxt);
        const char* nA = has_next ? (const char*)g.A + (size_t)nxt.pm * tstep : cA; const char* nB = has_next ? (const char*)g.Bt + (size_t)nxt.pn * tstep : cB;
        for (int t = 0; t < nt; t += 2) {
            const bool last = (t == nt - 2);
            const char* a1 = cA + (size_t)(t + 1) * kstep;
            const char* a2 = last ? nA : cA + (size_t)(t + 2) * kstep; const char* b2 = last ? nB : cB + (size_t)(t + 2) * kstep;
            const char* a3 = a2 + kstep; const char* b3 = b2 + kstep;
            if (last && has_next) S.a_ready(nxt);
            if constexpr (SP2) {
            PG8_LDB(B0, 0, 0); PG8_LDB(B1, 0, 1); PG8_SCHED; PG8_LDA(At, 0, 0); PG8_STAGE(PG8_SA(1, 1), a1 + hstep, voffA);
            PG8_WAIT_V(8); PG8_WAIT_L(0); PG8_BAR; PG8_MMA(0, 0, At, B0); PG8_MMA(0, 1, At, B1); PG8_BAR; PG8_SCHED;
            PG8_LDA(At, 0, 1); PG8_STAGE(PG8_SB(0, 0), b2, voffB); PG8_STAGE(PG8_SB(0, 1), b2 + hstep, voffB); PG8_STAGE(PG8_SA(0, 0), a2, voffA);
            PG8_WAIT_V(8); PG8_WAIT_L(0); PG8_BAR; PG8_MMA(1, 0, At, B0); PG8_MMA(1, 1, At, B1); PG8_BAR; PG8_SCHED;
            PG8_LDB(B0, 1, 0); PG8_LDB(B1, 1, 1); PG8_SCHED; PG8_LDA(At, 1, 0); PG8_STAGE(PG8_SA(0, 1), a2 + hstep, voffA);
            PG8_WAIT_V(8); PG8_WAIT_L(0); PG8_BAR; PG8_MMA(0, 0, At, B0); PG8_MMA(0, 1, At, B1); PG8_BAR; PG8_SCHED;
            PG8_LDA(At, 1, 1); PG8_STAGE(PG8_SB(1, 0), b3, voffB); PG8_STAGE(PG8_SB(1, 1), b3 + hstep, voffB); PG8_STAGE(PG8_SA(1, 0), a3, voffA);
            PG8_WAIT_V(8); PG8_WAIT_L(0); PG8_BAR; PG8_MMA(1, 0, At, B0); PG8_MMA(1, 1, At, B1); PG8_BAR; PG8_SCHED;
            } else {
            PG8_LDB(B0, 0, 0); PG8_SCHED; PG8_LDA(At, 0, 0); PG8_STAGE(PG8_SA(1, 1), a1 + hstep, voffA);
            PG8_WAIT_L(8); PG8_BAR; PG8_WAIT_L(0); PG8_MMA(0, 0, At, B0); PG8_BAR; PG8_SCHED;
            PG8_LDB(B1, 0, 1); PG8_STAGE(PG8_SB(0, 0), b2, voffB);
            PG8_BAR; PG8_WAIT_L(0); PG8_MMA(0, 1, At, B1); PG8_BAR;
            PG8_LDA(At, 0, 1); PG8_STAGE(PG8_SA(0, 0), a2, voffA);
            PG8_BAR; PG8_WAIT_L(0); PG8_MMA(1, 0, At, B0); PG8_BAR; PG8_SCHED;
            PG8_STAGE(PG8_SB(0, 1), b2 + hstep, voffB);
            PG8_WAIT_V(6); PG8_BAR; PG8_MMA(1, 1, At, B1); PG8_BAR;
            PG8_LDB(B0, 1, 0); PG8_SCHED; PG8_LDA(At, 1, 0); PG8_STAGE(PG8_SA(0, 1), a2 + hstep, voffA);
            PG8_WAIT_L(8); PG8_BAR; PG8_WAIT_L(0); PG8_MMA(0, 0, At, B0); PG8_BAR; PG8_SCHED;
            PG8_LDB(B1, 1, 1); PG8_STAGE(PG8_SB(1, 0), b3, voffB);
            PG8_BAR; PG8_WAIT_L(0); PG8_MMA(0, 1, At, B1); PG8_BAR;
            PG8_LDA(At, 1, 1); PG8_STAGE(PG8_SA(1, 0), a3, voffA);
            PG8_BAR; PG8_WAIT_L(0); PG8_MMA(1, 0, At, B0); PG8_BAR; PG8_SCHED;
            PG8_STAGE(PG8_SB(1, 1), b3 + hstep, voffB);
            PG8_WAIT_V(6); PG8_BAR; PG8_MMA(1, 1, At, B1); PG8_BAR;
            }
        }
        if constexpr (ALIGN_EPI) { if (wr == 0) PG8_BAR; }
        if constexpr (!Epi::AFTER_DRAIN) { E(acc, cur, wr, wc, fr, fq); S.done(cur); }
        if (!has_next) break;
#pragma unroll
        for (int a = 0; a < 2; ++a)
#pragma unroll
            for (int b = 0; b < 2; ++b)
#pragma unroll
                for (int m = 0; m < 4; ++m)
#pragma unroll
                    for (int n = 0; n < 2; ++n) acc[a][b][m][n] = (f32x4){0.f, 0.f, 0.f, 0.f};
        cur = nxt; cA = nA; cB = nB; ++ui;
        if constexpr (ALIGN_EPI) { if (wr == 1) PG8_BAR; }
    }
    PG8_WAIT_V(0);
    if constexpr (!ALIGN_EPI) { if (wr == 0) PG8_BAR; }
    PG8_BAR;
    if constexpr (Epi::AFTER_DRAIN) { E.fused(acc, cur, wr, wc, fr, fq, lds, wid, lane); S.done(cur); }
#undef PG8_SA
#undef PG8_SB
#undef PG8_STAGE
#undef PG8_LDA
#undef PG8_LDB
#undef PG8_MMA
#undef PG8_WAIT_V
#undef PG8_WAIT_L
#undef PG8_BAR
#undef PG8_SCHED
}
}
#define LAS __attribute__((address_space(3)))
typedef unsigned short bf16;
typedef unsigned v4u __attribute__((ext_vector_type(4)));
typedef float f32x4 __attribute__((ext_vector_type(4)));
constexpr int NWAVES = 8, NTHREADS = 512;
constexpr int SEQ = 8192, DM = 1024, MTOK = 16384, DIN = 9744, N1 = 9728, PLD = 6656, FF = 4096;
constexpr float EPS = 1e-6f;
constexpr size_t MiB = 1u << 20;
constexpr size_t WS_WIN = 1 * MiB, WS_WA = 20 * MiB, WS_WB = 21 * MiB, WS_WO = 23 * MiB, WS_WUP = 25 * MiB, WS_WDN = 33 * MiB;
constexpr size_t WS_XB = 41 * MiB, WS_PROJ = 73 * MiB, WS_VT = 177 * MiB, WS_A1 = 193 * MiB, WS_A2 = 209 * MiB;
constexpr size_t WS_R1 = 241 * MiB, WS_PA = 242 * MiB, WS_SS2 = 243 * MiB, WS_MISC = 244 * MiB;
constexpr size_t WS_MIXED = 73 * MiB, WS_U = 73 * MiB, WS_END = 256 * MiB;
constexpr int LDS_BYTES = 155648;

__device__ __forceinline__ float bf2f(bf16 h) { return __uint_as_float(((unsigned)h) << 16); }
__device__ __forceinline__ unsigned f2bf(float f) { unsigned u = __builtin_bit_cast(unsigned, f); return (u + 0x7fffu + ((u >> 16) & 1u)) >> 16; }
__device__ __forceinline__ unsigned pk2(float lo, float hi) { return f2bf(lo) | (f2bf(hi) << 16); }
__device__ __forceinline__ float wave_sum(float v) {
#pragma unroll
    for (int o = 1; o < 64; o <<= 1) v += __shfl_xor(v, o);
    return v;
}
__device__ __forceinline__ float log_sigmoid(float x) { return fminf(x, 0.f) - log1pf(__expf(-fabsf(x))); }

struct Args { const float* in[15]; float* out; unsigned char* ws; int ph_lo, ph_hi; };

__device__ __forceinline__ void p0_transpose_item(const float* W, int ldw, int srccol0, const float* kscale, int kmask, float cscale,
                                                  bf16* WT, int K, int dstrow0, int k0, LAS float* scr, int lane) {
#pragma unroll 8
    for (int i = 0; i < 32; ++i) { const int kk = 2 * i + (lane >> 5); const float ks = kscale ? kscale[(k0 + kk) & kmask] * cscale : cscale;
        scr[kk * 33 + (lane & 31)] = W[(size_t)(k0 + kk) * ldw + srccol0 + (lane & 31)] * ks; }
    asm volatile("s_waitcnt lgkmcnt(0)" ::: "memory");
    const int c = lane & 7;
#pragma unroll
    for (int j = 0; j < 4; ++j) { const int n = (lane >> 3) + 8 * j; const LAS float* s = scr + (8 * c) * 33 + n;
        v4u o; o.x = pk2(s[0 * 33], s[1 * 33]); o.y = pk2(s[2 * 33], s[3 * 33]); o.z = pk2(s[4 * 33], s[5 * 33]); o.w = pk2(s[6 * 33], s[7 * 33]);
        *(v4u*)(WT + (size_t)(dstrow0 + n) * K + k0 + 8 * c) = o; }
    asm volatile("s_waitcnt lgkmcnt(0)" ::: "memory");
}

__global__ void __launch_bounds__(NTHREADS, 2) fwd_kernel(Args a) {
    extern __shared__ __attribute__((aligned(16))) unsigned char lds_raw[];
    LAS unsigned char* lds = (LAS unsigned char*)lds_raw;
    cg::grid_group grid = cg::this_grid();
    const int tid = threadIdx.x, lane = tid & 63, wave = __builtin_amdgcn_readfirstlane(tid >> 6);
    const int G = gridDim.x, bx = blockIdx.x;
    const int gw = bx * NWAVES + wave, NGW = G * NWAVES;
    unsigned char* ws = a.ws;
    const float* x = a.in[0]; const float* g1 = a.in[1]; const float* w_in = a.in[2]; const float* gq = a.in[3]; const float* gk = a.in[4];
    const float* gate_up = a.in[5]; const float* gate_bias = a.in[6]; const float* gla_g = a.in[7]; const float* bgate_bias = a.in[8];
    const float* w_ab = a.in[9]; const float* w_gb = a.in[10]; const float* w_out = a.in[11]; const float* g2 = a.in[12]; const float* w_up = a.in[13]; const float* w_dn = a.in[14];
    bf16* WIN = (bf16*)(ws + WS_WIN); bf16* WA = (bf16*)(ws + WS_WA); bf16* WB = (bf16*)(ws + WS_WB); bf16* WO = (bf16*)(ws + WS_WO);
    bf16* WUP = (bf16*)(ws + WS_WUP); bf16* WDN = (bf16*)(ws + WS_WDN); bf16* XB = (bf16*)(ws + WS_XB); bf16* PROJ = (bf16*)(ws + WS_PROJ);
    bf16* VT = (bf16*)(ws + WS_VT); bf16* A1 = (bf16*)(ws + WS_A1); bf16* A2 = (bf16*)(ws + WS_A2);
    float* R1 = (float*)(ws + WS_R1); float* PA = (float*)(ws + WS_PA); float* SS2 = (float*)(ws + WS_SS2);
    bf16* MIXED = (bf16*)(ws + WS_MIXED); bf16* UB = (bf16*)(ws + WS_U); bf16* GATES = (bf16*)a.out;
    const int lo = a.ph_lo, hi = a.ph_hi;
#define IN(k) (lo <= (k) && (k) < hi)
#define LAUNDER(p) asm volatile("" : "+s"(p))
#define SYNC(k) do { if (IN(k) && IN((k) + 1)) grid.sync(); } while (0)

    if (IN(0)) {
        LAS float* scr = (LAS float*)(lds + 81920 + wave * 8448);
        constexpr int I_IN = 16 * 304, I_A = 8 * 32, I_B = 16 * 32, I_O = 16 * 32, I_UP = 16 * 128, I_DN = 64 * 32;
        constexpr int NITEMS = I_IN + I_A + I_B + I_O + I_UP + I_DN;
        for (int it = gw; it < NITEMS; it += NGW) {
            int r = it;
            if (r < I_IN) { const int kb = r / 304, nb = r % 304; const int n0 = nb * 32; const int src = n0 < 7680 ? n0 : n0 + 16;
                const float cs = (n0 >= 4608 && n0 < 5120) ? 0.08838834764831845f : 1.0f;
                p0_transpose_item(w_in, DIN, src, g1, 1023, cs, WIN, 1024, n0, kb * 64, scr, lane); continue; } r -= I_IN;
            if (r < I_A) { const int kb = r / 32, nb = r % 32; p0_transpose_item(w_ab, 1024, nb * 32, nullptr, 0, 1.0f, WA, 512, nb * 32, kb * 64, scr, lane); continue; } r -= I_A;
            if (r < I_B) { const int kb = r / 32, nb = r % 32; p0_transpose_item(w_gb, 1024, nb * 32, gla_g, 255, 1.0f, WB, 1024, nb * 32, kb * 64, scr, lane); continue; } r -= I_B;
            if (r < I_O) { const int kb = r / 32, nb = r % 32; p0_transpose_item(w_out, 1024, nb * 32, nullptr, 0, 1.0f, WO, 1024, nb * 32, kb * 64, scr, lane); continue; } r -= I_O;
            if (r < I_UP) { const int kb = r / 128, nb = r % 128; p0_transpose_item(w_up, 4096, nb * 32, g2, 1023, 1.0f, WUP, 1024, nb * 32, kb * 64, scr, lane); continue; } r -= I_UP;
            { const int kb = r / 32, nb = r % 32; p0_transpose_item(w_dn, 1024, nb * 32, nullptr, 0, 1.0f, WDN, 4096, nb * 32, kb * 64, scr, lane); }
        }
        LAS float* WAl = (LAS float*)lds;
        for (int idx = tid; idx < 1024 * 16; idx += NTHREADS) { const int k = idx >> 4, r = idx & 15; const int rho = ((k >> 8) * 4 + (k & 3)) * 64 + ((k >> 2) & 63);
            WAl[rho * 20 + r] = w_in[(size_t)k * DIN + 7680 + r] * g1[k]; }
        __syncthreads();
        for (int row = gw; row < MTOK; row += NGW) {
            asm volatile("" ::: "memory");
            const f32x4* xr = (const f32x4*)(x + (size_t)row * DM) + lane;
            f32x4 v[4]; float ss = 0.f;
#pragma unroll
            for (int j = 0; j < 4; ++j) { v[j] = xr[64 * j]; ss += (v[j][0] * v[j][0] + v[j][1] * v[j][1]) + (v[j][2] * v[j][2] + v[j][3] * v[j][3]); }
            ss = wave_sum(ss); const float r1 = 1.0f / sqrtf(ss * (1.0f / 1024.0f) + EPS);
            float pa[16];
#pragma unroll
            for (int r = 0; r < 16; ++r) pa[r] = 0.f;
#pragma unroll
            for (int j = 0; j < 4; ++j)
#pragma unroll
                for (int c = 0; c < 4; ++c) { const float xv = v[j][c]; const LAS f32x4* wp = (const LAS f32x4*)(WAl + ((j * 4 + c) * 64 + lane) * 20);
#pragma unroll
                    for (int q = 0; q < 4; ++q) { const f32x4 w = wp[q]; pa[4 * q] += xv * w[0]; pa[4 * q + 1] += xv * w[1]; pa[4 * q + 2] += xv * w[2]; pa[4 * q + 3] += xv * w[3]; } }
            float mine = 0.f;
#pragma unroll
            for (int r = 0; r < 16; ++r) { const float s = wave_sum(pa[r]); mine = (lane == r) ? s : mine; }
            if (lane < 16) PA[(size_t)row * 16 + lane] = mine * r1;
            if (lane == 0) R1[row] = r1;
            unsigned long long* o8 = (unsigned long long*)(XB + (size_t)row * DM) + lane;
#pragma unroll
            for (int j = 0; j < 4; ++j) o8[64 * j] = (unsigned long long)pk2(v[j][0], v[j][1]) | ((unsigned long long)pk2(v[j][2], v[j][3]) << 32);
        }
        __syncthreads();
    }
    SYNC(0);

    for (int bq = 0; bq < 2; ++bq) {
        int b = bq; LAUNDER(b);
        const int p1 = 1 + 3 * b;
        if (IN(p1)) {
            pg8::Gemm g{XB + (size_t)b * SEQ * DM, WIN, SEQ, N1, DM}; pg8::StaticOrder S; S.init(SEQ, N1, G, bx);
            pg8::EpiProj E{PROJ, VT, GATES + (size_t)b * SEQ * 2048, R1 + b * SEQ, bgate_bias};
            pg8::gemm_phase<pg8::EpiProj, pg8::StaticOrder, true, true>(lds, g, S, E);
        }
        SYNC(p1);
        int tid_ = threadIdx.x; asm volatile("" : "+v"(tid_)); const int lane_ = tid_ & 63; const int wave_ = __builtin_amdgcn_readfirstlane(tid_ >> 6); int bx_ = bx; LAUNDER(bx_); const int gw_ = bx_ * NWAVES + wave_;
        if (IN(p1 + 1)) {
            const float* gate_up_ = gate_up; const float* gate_bias_ = gate_bias; const float* PA_ = PA; const bf16* PROJ_ = PROJ; const bf16* VT_ = VT; bf16* A1_ = A1; bf16* A2_ = A2; const float* gq_ = gq; const float* gk_ = gk;
            LAUNDER(gate_up_); LAUNDER(gate_bias_); LAUNDER(PA_); LAUNDER(PROJ_); LAUNDER(VT_); LAUNDER(A1_); LAUNDER(A2_); LAUNDER(gq_); LAUNDER(gk_);
            if (bx_ < 4) {
                const int h = bx_; LAS float* qs = (LAS float*)lds; LAS float* ks = qs + 128; LAS float* as = ks + 128; LAS float* opart = as + 128;
                const int col = tid_ & 255, kh = tid_ >> 8;
                float st[64];
#pragma unroll
                for (int i = 0; i < 64; ++i) st[i] = 0.f;
                float upr[16]; float bk = 0.f;
                if (tid_ < 128) {
#pragma unroll
                    for (int r = 0; r < 16; ++r) upr[r] = gate_up_[r * 512 + h * 128 + tid_];
                    bk = gate_bias_[h * 128 + tid_]; }
                const bf16* vtp = VT_ + (size_t)(h * 256 + col) * SEQ;
                for (int t = 0; t < SEQ; ++t) {
                    if (tid_ < 128) { const float* pa = PA_ + (size_t)(b * SEQ + t) * 16; float lg = bk;
#pragma unroll
                        for (int r = 0; r < 16; ++r) lg += pa[r] * upr[r];
                        as[tid_] = __expf(log_sigmoid(lg) * (1.0f / 16.0f));
                        qs[tid_] = bf2f(PROJ_[(size_t)t * PLD + 4608 + h * 128 + tid_]); ks[tid_] = bf2f(PROJ_[(size_t)t * PLD + 5120 + h * 128 + tid_]); }
                    __syncthreads();
                    const float v = bf2f(vtp[t]); float o = 0.f;
#pragma unroll
                    for (int i = 0; i < 64; ++i) { const int k = kh * 64 + i; st[i] = as[k] * st[i] + ks[k] * v; o += qs[k] * st[i]; }
                    opart[tid_] = o;
                    __syncthreads();
                    if (tid_ < 256) A2_[(size_t)(b * SEQ + t) * DM + h * 256 + col] = (bf16)f2bf(opart[tid_] + opart[tid_ + 256]);
                }
            } else {
                const int agw = (bx_ - 4) * NWAVES + wave_, ANGW = (G - 4) * NWAVES;
                const float gql = gq_[lane_] * 0.125f, gkl = gk_[lane_];
                for (int item = agw; item < SEQ * 8; item += ANGW) {
                    const int t = item >> 3, slot = item & 7;
                    float mx = -INFINITY, den = 0.f, acc = 0.f;
                    for (int gi = 0; gi < 3; ++gi) {
                        const int d = gi == 0 ? 1 : (gi == 1 ? 4 : 16); const int hd = gi * 8 + slot;
                        const float q = bf2f(PROJ_[(size_t)t * PLD + hd * 64 + lane_]);
                        const float qn = q * (1.0f / sqrtf(wave_sum(q * q) * (1.0f / 64.0f) + EPS)) * gql;
                        for (int j = 0; j <= 128; ++j) { const int tk = t - j * d; if (tk < 0) break;
                            const float kx = bf2f(PROJ_[(size_t)tk * PLD + 1536 + hd * 64 + lane_]);
                            const float kn = kx * (1.0f / sqrtf(wave_sum(kx * kx) * (1.0f / 64.0f) + EPS)) * gkl;
                            const float s = wave_sum(qn * kn);
                            const float vv = bf2f(PROJ_[(size_t)tk * PLD + 3072 + hd * 64 + lane_]);
                            const float mn = fmaxf(mx, s); const float corr = __expf(mx - mn), p = __expf(s - mn);
                            den = den * corr + p; acc = acc * corr + p * vv; mx = mn; }
                    }
                    A1_[(size_t)(b * SEQ + t) * 512 + slot * 64 + lane_] = (bf16)f2bf(acc / den);
                }
            }
        }
        SYNC(p1 + 1);
        if (IN(p1 + 2)) {
            bf16* A2_ = A2; const bf16* PROJ_ = PROJ; LAUNDER(A2_); LAUNDER(PROJ_);
            for (int item = gw_; item < SEQ * 4; item += NGW) {
                const int t = item >> 2, h = item & 3;
                unsigned long long* ap = (unsigned long long*)(A2_ + (size_t)(b * SEQ + t) * DM + h * 256) + lane_;
                const unsigned long long w = *ap; const unsigned long long rr = *((const unsigned long long*)(PROJ_ + (size_t)t * PLD + 5632 + h * 256) + lane_);
                const float o0 = bf2f((bf16)(w & 0xffff)), o1 = bf2f((bf16)((w >> 16) & 0xffff)), o2 = bf2f((bf16)((w >> 32) & 0xffff)), o3 = bf2f((bf16)(w >> 48));
                const float r0 = bf2f((bf16)(rr & 0xffff)), r1_ = bf2f((bf16)((rr >> 16) & 0xffff)), r2 = bf2f((bf16)((rr >> 32) & 0xffff)), r3 = bf2f((bf16)(rr >> 48));
                const float ss = wave_sum((o0 * o0 + o1 * o1) + (o2 * o2 + o3 * o3)); const float rs = 1.0f / sqrtf(ss * (1.0f / 256.0f) + EPS);
                *ap = (unsigned long long)pk2(o0 * rs * r0, o1 * rs * r1_) | ((unsigned long long)pk2(o2 * rs * r2, o3 * rs * r3) << 32);
            }
        }
        SYNC(p1 + 2);
    }
    if (IN(7)) {
        { pg8::Gemm g{A1, WA, MTOK, DM, 512}; pg8::StaticOrder S; S.init(MTOK, DM, G, bx); pg8::EpiBranch E{MIXED, GATES, 0, 0};
          pg8::gemm_phase<pg8::EpiBranch, pg8::StaticOrder, true, true>(lds, g, S, E); }
        __syncthreads();
        { pg8::Gemm g{A2, WB, MTOK, DM, 1024}; pg8::StaticOrder S; S.init(MTOK, DM, G, bx); pg8::EpiBranch E{MIXED, GATES, 1024, 1};
          pg8::gemm_phase<pg8::EpiBranch, pg8::StaticOrder, true, true>(lds, g, S, E); }
    }
    SYNC(7);
    if (IN(8)) { pg8::Gemm g{MIXED, WO, MTOK, DM, 1024}; pg8::StaticOrder S; S.init(MTOK, DM, G, bx); pg8::EpiOut1 E{x, a.out, XB, SS2};
        pg8::gemm_phase<pg8::EpiOut1, pg8::StaticOrder, true, true>(lds, g, S, E); }
    SYNC(8);
    if (IN(9)) { pg8::Gemm g{XB, WUP, MTOK, FF, 1024}; pg8::StaticOrder S; S.init(MTOK, FF, G, bx); pg8::EpiUp E{UB, SS2};
        pg8::gemm_phase<pg8::EpiUp, pg8::StaticOrder, true, true>(lds, g, S, E); }
    SYNC(9);
    if (IN(10)) { pg8::Gemm g{UB, WDN, MTOK, DM, FF}; pg8::StaticOrder S; S.init(MTOK, DM, G, bx); pg8::EpiDown E{a.out};
        pg8::gemm_phase<pg8::EpiDown, pg8::StaticOrder, true, true>(lds, g, S, E); }
#undef IN
#undef SYNC
}

extern "C" void kernel_launch(void* const* d_in, const int* in_sizes, int n_in, void* d_out, int out_size, void* d_ws, size_t ws_size, hipStream_t stream) {
    static int grid = 0;
    if (grid == 0) {
        if (n_in != 15 || out_size != MTOK * DM || ws_size < WS_END) { fprintf(stderr, "kernel_launch: unexpected shapes (n_in %d, out %d, ws %zu)\n", n_in, out_size, ws_size); grid = -1; return; }
        int dev = 0, cus = 0, per_cu = 0;
        hipGetDevice(&dev); hipDeviceGetAttribute(&cus, hipDeviceAttributeMultiprocessorCount, dev);
        if (hipFuncSetAttribute((const void*)fwd_kernel, hipFuncAttributeMaxDynamicSharedMemorySize, LDS_BYTES) != hipSuccess) { fprintf(stderr, "kernel_launch: hipFuncSetAttribute failed\n"); grid = -1; return; }
        if (hipOccupancyMaxActiveBlocksPerMultiprocessor(&per_cu, (const void*)fwd_kernel, NTHREADS, LDS_BYTES) != hipSuccess || per_cu < 1) per_cu = 1;
        (void)hipGetLastError();
        grid = cus * per_cu;
        fprintf(stderr, "kernel_launch: grid %d (cus %d x %d)\n", grid, cus, per_cu);
    }
    if (grid < 0) return;
    Args a{};
    for (int i = 0; i < 15; ++i) a.in[i] = (const float*)d_in[i];
    a.out = (float*)d_out; a.ws = (unsigned char*)d_ws; a.ph_lo = 0; a.ph_hi = 11;
    void* args[] = {&a};
    hipError_t e = hipLaunchCooperativeKernel((const void*)fwd_kernel, dim3(grid), dim3(NTHREADS), args, LDS_BYTES, stream);
    if (e != hipSuccess) fprintf(stderr, "cooperative launch failed: %s (grid %d)\n", hipGetErrorString(e), grid);
}
```

```cpp
#include <hip/hip_runtime.h>
#include <hip/hip_cooperative_groups.h>
#include <cstdio>
#include <cstdint>
#include <cmath>
namespace cg = cooperative_groups;
namespace pg8 {
#define PG8_LAS __attribute__((address_space(3)))
typedef unsigned short bf16_t;
typedef short bf16x8 __attribute__((ext_vector_type(8)));
typedef float f32x4 __attribute__((ext_vector_type(4)));
typedef unsigned u32x4 __attribute__((ext_vector_type(4)));
constexpr int BM = 256, BK = 64, HALF = 128, HTB = HALF * BK * 2  , STAGE_BYTES = 8 * HTB, NXCD = 8, WGM = 8;

__host__ __device__ __forceinline__ int lds_byte(int r, int c) { const int st = (r >> 4) * 2 + (c >> 5), rr = r & 15, cc = c & 31, ob = rr * 64 + cc * 2; return st * 1024 + (ob ^ (((ob >> 9) & 1) << 5)); }
__host__ __device__ __forceinline__ void stage_rc(int b, int& R, int& C) { const int st = b / 1024, sb = b % 1024, swz = sb ^ (((sb >> 9) & 1) << 5); R = (st >> 1) * 16 + swz / 64; C = (st & 1) * 32 + (swz % 64) / 2; }
__host__ __device__ __forceinline__ int perm32(int rho) { const int n = rho >> 4, i = rho & 15; return 8 * (i >> 2) + 4 * n + (i & 3); }

struct Unit { int pm, pn; };
struct Gemm { const bf16_t* A; const bf16_t* Bt; int M, N, K; };

struct StaticOrder {
    int nM, nN, nwg, G, c;
    __host__ __device__ void init(int M, int N, int G_, int c_) { nM = M / BM; nN = N / BM; nwg = nM * nN; G = G_; c = c_; }
    __host__ __device__ bool next(int i, Unit& u) const {
        const long L = (long)i * G + c; if (L >= nwg) return false;
        int wgid = (int)L; { const int q = nwg / NXCD, r = nwg % NXCD, xcd = wgid % NXCD, off = wgid / NXCD; wgid = (xcd < r ? xcd * (q + 1) : r * (q + 1) + (xcd - r) * q) + off; }
        const int nig = WGM * nN, gid = wgid / nig, fm = gid * WGM, gsz = (nM - fm) < WGM ? (nM - fm) : WGM;
        u.pm = fm + ((wgid % nig) % gsz); u.pn = (wgid % nig) / gsz; return true;
    }
    __device__ __forceinline__ void a_ready(const Unit&) const {}
    __device__ __forceinline__ void done(const Unit&) const {}
};
typedef float f32x2 __attribute__((ext_vector_type(2)));
typedef __bf16 bf16x2_cv __attribute__((ext_vector_type(2)));
__device__ __forceinline__ unsigned cvt_pk_bf16(float lo, float hi) { const f32x2 v = {lo, hi}; const bf16x2_cv b = __builtin_convertvector(v, bf16x2_cv); return __builtin_bit_cast(unsigned, b); }
__device__ __forceinline__ float bflo(unsigned w) { return __uint_as_float(w << 16); }
__device__ __forceinline__ float bfhi(unsigned w) { return __uint_as_float(w & 0xffff0000u); }
__device__ __forceinline__ void unpack8(const u32x4 w, float (&f)[8]) { f[0] = bflo(w.x); f[1] = bfhi(w.x); f[2] = bflo(w.y); f[3] = bfhi(w.y); f[4] = bflo(w.z); f[5] = bfhi(w.z); f[6] = bflo(w.w); f[7] = bfhi(w.w); }
__device__ __forceinline__ u32x4 pack8(const float (&v)[8]) { u32x4 w; w.x = cvt_pk_bf16(v[0], v[1]); w.y = cvt_pk_bf16(v[2], v[3]); w.z = cvt_pk_bf16(v[4], v[5]); w.w = cvt_pk_bf16(v[6], v[7]); return w; }
__device__ __forceinline__ float fsigmoid(float x) { return 1.0f / (1.0f + __expf(-x)); }

struct EpiProj {
    static constexpr bool PERM = true, AFTER_DRAIN = false;
    bf16_t* proj; bf16_t* vt; bf16_t* gates; const float* r1; const float* gbias;
    __device__ __forceinline__ void operator()(const f32x4 (&acc)[2][2][4][2], const Unit& u, int wr, int wc, int fr_in, int fq_in) const {
        int fr = fr_in, fq = fq_in; asm volatile("" : "+v"(fr), "+v"(fq));
        const int ct = u.pn; const int row0 = u.pm * BM + wr * 64 + fr; const int cl = wc * 32 + 8 * fq;
#pragma unroll
        for (int ai = 0; ai < 2; ++ai)
#pragma unroll
            for (int m = 0; m < 4; ++m) {
                const int row = row0 + ai * HALF + m * 16; const float rs = r1[row];
#pragma unroll
                for (int bj = 0; bj < 2; ++bj) {
                    const f32x4 v0 = acc[ai][bj][m][0] * rs, v1 = acc[ai][bj][m][1] * rs;
                    float v[8] = {v0[0], v0[1], v0[2], v0[3], v1[0], v1[1], v1[2], v1[3]};
                    const int c = cl + bj * HALF;
                    if (ct < 22) { *(u32x4*)(proj + (size_t)row * 6656 + ct * 256 + c) = pack8(v); }
                    else if (ct < 26) { const u32x4 w = pack8(v); bf16_t* p = vt + (size_t)((ct - 22) * 256 + c) * 8192 + row;
                        p[0] = (bf16_t)(w.x & 0xffffu); p[8192] = (bf16_t)(w.x >> 16); p[2 * 8192] = (bf16_t)(w.y & 0xffffu); p[3 * 8192] = (bf16_t)(w.y >> 16);
                        p[4 * 8192] = (bf16_t)(w.z & 0xffffu); p[5 * 8192] = (bf16_t)(w.z >> 16); p[6 * 8192] = (bf16_t)(w.w & 0xffffu); p[7 * 8192] = (bf16_t)(w.w >> 16); }
                    else if (ct < 30) {
#pragma unroll
                        for (int i = 0; i < 8; ++i) v[i] = v[i] * fsigmoid(v[i]);
                        *(u32x4*)(proj + (size_t)row * 6656 + (ct - 4) * 256 + c) = pack8(v); }
                    else { const int gc = (ct - 30) * 256 + c; const f32x4 b0 = *(const f32x4*)(gbias + gc), b1 = *(const f32x4*)(gbias + gc + 4);
                        const float bb[8] = {b0[0], b0[1], b0[2], b0[3], b1[0], b1[1], b1[2], b1[3]};
#pragma unroll
                        for (int i = 0; i < 8; ++i) v[i] = fsigmoid(v[i] + bb[i]);
                        *(u32x4*)(gates + (size_t)row * 2048 + gc) = pack8(v); }
                }
            }
    }
};
struct EpiBranch {
    static constexpr bool PERM = true, AFTER_DRAIN = false;
    bf16_t* mixed; const bf16_t* gates; int goff; int add;
    __device__ __forceinline__ void operator()(const f32x4 (&acc)[2][2][4][2], const Unit& u, int wr, int wc, int fr_in, int fq_in) const {
        int fr = fr_in, fq = fq_in; asm volatile("" : "+v"(fr), "+v"(fq));
        const int row0 = u.pm * BM + wr * 64 + fr; const int cl = u.pn * BM + wc * 32 + 8 * fq;
#pragma unroll
        for (int ai = 0; ai < 2; ++ai)
#pragma unroll
            for (int m = 0; m < 4; ++m) {
                const int row = row0 + ai * HALF + m * 16;
#pragma unroll
                for (int bj = 0; bj < 2; ++bj) {
                    const int c = cl + bj * HALF; float g[8], v[8];
                    unpack8(*(const u32x4*)(gates + (size_t)row * 2048 + goff + c), g);
                    const f32x4 v0 = acc[ai][bj][m][0], v1 = acc[ai][bj][m][1];
                    v[0] = v0[0] * g[0]; v[1] = v0[1] * g[1]; v[2] = v0[2] * g[2]; v[3] = v0[3] * g[3]; v[4] = v1[0] * g[4]; v[5] = v1[1] * g[5]; v[6] = v1[2] * g[6]; v[7] = v1[3] * g[7];
                    if (add) { float t[8]; unpack8(*(const u32x4*)(mixed + (size_t)row * 1024 + c), t);
#pragma unroll
                        for (int i = 0; i < 8; ++i) v[i] += t[i]; }
                    *(u32x4*)(mixed + (size_t)row * 1024 + c) = pack8(v);
                }
            }
    }
};
struct EpiOut1 {
    static constexpr bool PERM = true, AFTER_DRAIN = false;
    const float* x; float* out; bf16_t* x1b; float* ss2;
    __device__ __forceinline__ void operator()(const f32x4 (&acc)[2][2][4][2], const Unit& u, int wr, int wc, int fr_in, int fq_in) const {
        int fr = fr_in, fq = fq_in; asm volatile("" : "+v"(fr), "+v"(fq));
        const int row0 = u.pm * BM + wr * 64 + fr; const int cl = u.pn * BM + wc * 32 + 8 * fq;
#pragma unroll
        for (int ai = 0; ai < 2; ++ai)
#pragma unroll
            for (int m = 0; m < 4; ++m) {
                const int row = row0 + ai * HALF + m * 16; float ssq = 0.f;
#pragma unroll
                for (int bj = 0; bj < 2; ++bj) {
                    const size_t off = (size_t)row * 1024 + cl + bj * HALF;
                    const f32x4 o0 = *(const f32x4*)(x + off) + acc[ai][bj][m][0], o1 = *(const f32x4*)(x + off + 4) + acc[ai][bj][m][1];
                    *(f32x4*)(out + off) = o0; *(f32x4*)(out + off + 4) = o1;
                    const float v[8] = {o0[0], o0[1], o0[2], o0[3], o1[0], o1[1], o1[2], o1[3]};
                    *(u32x4*)(x1b + off) = pack8(v);
#pragma unroll
                    for (int i = 0; i < 8; ++i) ssq += v[i] * v[i];
                }
                ssq += __shfl_xor(ssq, 16); ssq += __shfl_xor(ssq, 32);
                if (fq == 0) ss2[(size_t)row * 16 + u.pn * 4 + wc] = ssq;
            }
    }
};
struct EpiUp {
    static constexpr bool PERM = true, AFTER_DRAIN = false;
    bf16_t* U; const float* ss2;
    __device__ __forceinline__ void operator()(const f32x4 (&acc)[2][2][4][2], const Unit& u, int wr, int wc, int fr_in, int fq_in) const {
        int fr = fr_in, fq = fq_in; asm volatile("" : "+v"(fr), "+v"(fq));
        const int row0 = u.pm * BM + wr * 64 + fr; const int cl = u.pn * BM + wc * 32 + 8 * fq;
#pragma unroll
        for (int ai = 0; ai < 2; ++ai)
#pragma unroll
            for (int m = 0; m < 4; ++m) {
                const int row = row0 + ai * HALF + m * 16;
                const f32x4* sp = (const f32x4*)(ss2 + (size_t)row * 16); const f32x4 s0 = sp[0], s1 = sp[1], s2 = sp[2], s3 = sp[3];
                const float s = ((s0[0] + s0[1]) + (s0[2] + s0[3])) + ((s1[0] + s1[1]) + (s1[2] + s1[3])) + ((s2[0] + s2[1]) + (s2[2] + s2[3])) + ((s3[0] + s3[1]) + (s3[2] + s3[3]));
                const float rs = 1.0f / sqrtf(s * (1.0f / 1024.0f) + 1e-6f);
#pragma unroll
                for (int bj = 0; bj < 2; ++bj) {
                    const f32x4 v0 = acc[ai][bj][m][0] * rs, v1 = acc[ai][bj][m][1] * rs;
                    float v[8] = {v0[0], v0[1], v0[2], v0[3], v1[0], v1[1], v1[2], v1[3]};
#pragma unroll
                    for (int i = 0; i < 8; ++i) { const float r = fmaxf(v[i], 0.f); v[i] = r * r; }
                    *(u32x4*)(U + (size_t)row * 4096 + cl + bj * HALF) = pack8(v);
                }
            }
    }
};
struct EpiDown {
    static constexpr bool PERM = true, AFTER_DRAIN = false;
    float* out;
    __device__ __forceinline__ void operator()(const f32x4 (&acc)[2][2][4][2], const Unit& u, int wr, int wc, int fr_in, int fq_in) const {
        int fr = fr_in, fq = fq_in; asm volatile("" : "+v"(fr), "+v"(fq));
        const int row0 = u.pm * BM + wr * 64 + fr; const int cl = u.pn * BM + wc * 32 + 8 * fq;
#pragma unroll
        for (int ai = 0; ai < 2; ++ai)
#pragma unroll
            for (int m = 0; m < 4; ++m) {
                const int row = row0 + ai * HALF + m * 16;
#pragma unroll
                for (int bj = 0; bj < 2; ++bj) {
                    const size_t off = (size_t)row * 1024 + cl + bj * HALF;
                    const f32x4 o0 = *(const f32x4*)(out + off) + acc[ai][bj][m][0], o1 = *(const f32x4*)(out + off + 4) + acc[ai][bj][m][1];
                    *(f32x4*)(out + off) = o0; *(f32x4*)(out + off + 4) = o1;
                }
            }
    }
};
template <class Epi, class Sched, bool ALIGN_EPI = false, bool SP2 = false>
__device__ __forceinline__ void gemm_phase(PG8_LAS unsigned char* lds, const Gemm g, const Sched& S, const Epi& E) {
    int tid_l = threadIdx.x; asm volatile("" : "+v"(tid_l));
    const int tid = tid_l, wid = __builtin_amdgcn_readfirstlane(tid >> 6), lane = tid & 63, wr = wid >> 2, wc = wid & 3, fr = lane & 15, fq = lane >> 4;
    const int K = g.K, nt = K / BK;
    unsigned voffA[2], voffB[2];
#pragma unroll
    for (int i = 0; i < 2; ++i) { int R, C; stage_rc(tid * 16 + i * 8192, R, C); const int Rb = Epi::PERM ? ((R & ~31) + perm32(R & 31)) : R;
        voffA[i] = (unsigned)(R * K + C) * 2u; voffB[i] = (unsigned)(Rb * K + C) * 2u; }
    const size_t kstep = (size_t)(BK * 2);
    const size_t hstep = (size_t)HALF * K * 2;
    const size_t tstep = 2 * hstep;
    const unsigned ldsw = (unsigned)wid * 1024u;
    const int aoff = lds_byte(wr * 64 + fr, fq * 8), boff = lds_byte(wc * 32 + fr, fq * 8);
#define PG8_SA(b, h) (((b) * 2 + (h)) * HTB)
#define PG8_SB(b, h) ((4 + (b) * 2 + (h)) * HTB)
#define PG8_STAGE(bufoff, gbase, voff) do { _Pragma("unroll") for (int _i = 0; _i < 2; ++_i) \
        __builtin_amdgcn_global_load_lds((const unsigned*)((const char*)(gbase) + (voff)[_i]), (PG8_LAS unsigned*)(lds + (bufoff) + ldsw + _i * 8192), 16, 0, 0); } while (0)
#define PG8_LDA(dst, b, h) do { _Pragma("unroll") for (int m = 0; m < 4; ++m) _Pragma("unroll") for (int k = 0; k < 2; ++k) dst[m][k] = *(const PG8_LAS bf16x8*)(lds + PG8_SA(b, h) + aoff + m * 2048 + k * 1024); } while (0)
#define PG8_LDB(dst, b, h) do { _Pragma("unroll") for (int n = 0; n < 2; ++n) _Pragma("unroll") for (int k = 0; k < 2; ++k) dst[n][k] = *(const PG8_LAS bf16x8*)(lds + PG8_SB(b, h) + boff + n * 2048 + k * 1024); } while (0)
#define PG8_MMA(ai, bj, At, Bt) do { __builtin_amdgcn_s_setprio(1); _Pragma("unroll") for (int m = 0; m < 4; ++m) _Pragma("unroll") for (int n = 0; n < 2; ++n) _Pragma("unroll") for (int k = 0; k < 2; ++k) \
        acc[ai][bj][m][n] = __builtin_amdgcn_mfma_f32_16x16x32_bf16(Bt[n][k], At[m][k], acc[ai][bj][m][n], 0, 0, 0); __builtin_amdgcn_s_setprio(0); } while (0)
#define PG8_WAIT_V(n) asm volatile("s_waitcnt vmcnt(" #n ")" ::: "memory")
#define PG8_WAIT_L(n) asm volatile("s_waitcnt lgkmcnt(" #n ")" ::: "memory")
#define PG8_BAR __builtin_amdgcn_s_barrier()
#define PG8_SCHED __builtin_amdgcn_sched_barrier(0)
    Unit cur, nxt; int ui = 0;
    if (!S.next(0, cur)) return;
    f32x4 acc[2][2][4][2];
#pragma unroll
    for (int a = 0; a < 2; ++a)
#pragma unroll
        for (int b = 0; b < 2; ++b)
#pragma unroll
            for (int m = 0; m < 4; ++m)
#pragma unroll
                for (int n = 0; n < 2; ++n) acc[a][b][m][n] = (f32x4){0.f, 0.f, 0.f, 0.f};
    bf16x8 At[4][2], B0[2][2], B1[2][2];
    const char* cA = (const char*)g.A + (size_t)cur.pm * tstep; const char* cB = (const char*)g.Bt + (size_t)cur.pn * tstep;
    S.a_ready(cur);
    if constexpr (SP2) {
        PG8_STAGE(PG8_SB(0, 0), cB, voffB); PG8_STAGE(PG8_SB(0, 1), cB + hstep, voffB); PG8_STAGE(PG8_SA(0, 0), cA, voffA); PG8_STAGE(PG8_SA(0, 1), cA + hstep, voffA);
        if (wr == 1) PG8_BAR;
        PG8_WAIT_V(2); PG8_BAR;
        PG8_STAGE(PG8_SB(1, 0), cB + kstep, voffB); PG8_STAGE(PG8_SA(1, 0), cA + kstep, voffA); PG8_STAGE(PG8_SB(1, 1), cB + hstep + kstep, voffB);
        PG8_WAIT_V(6); PG8_BAR;
    } else {
        PG8_STAGE(PG8_SB(0, 0), cB, voffB); PG8_STAGE(PG8_SA(0, 0), cA, voffA); PG8_STAGE(PG8_SB(0, 1), cB + hstep, voffB); PG8_STAGE(PG8_SA(0, 1), cA + hstep, voffA);
        if (wr == 1) PG8_BAR;
        PG8_WAIT_V(4); PG8_BAR;
        PG8_STAGE(PG8_SB(1, 0), cB + kstep, voffB); PG8_STAGE(PG8_SA(1, 0), cA + kstep, voffA); PG8_STAGE(PG8_SB(1, 1), cB + hstep + kstep, voffB);
        PG8_WAIT_V(6); PG8_BAR;
    }
    for (;;) {
        const bool has_next = S.next(ui + 1, nxt);
        const char* nA = has_next ? (const char*)g.A + (size_t)nxt.pm * tstep : cA; const char* nB = has_next ? (const char*)g.Bt + (size_t)nxt.pn * tstep : cB;
        for (int t = 0; t < nt; t += 2) {
            const bool last = (t == nt - 2);
            const char* a1 = cA + (size_t)(t + 1) * kstep;
            const char* a2 = last ? nA : cA + (size_t)(t + 2) * kstep; const char* b2 = last ? nB : cB + (size_t)(t + 2) * kstep;
            const char* a3 = a2 + kstep; const char* b3 = b2 + kstep;
            if (last && has_next) S.a_ready(nxt);
            if constexpr (SP2) {
            PG8_LDB(B0, 0, 0); PG8_LDB(B1, 0, 1); PG8_SCHED; PG8_LDA(At, 0, 0); PG8_STAGE(PG8_SA(1, 1), a1 + hstep, voffA);
            PG8_WAIT_V(8); PG8_WAIT_L(0); PG8_BAR; PG8_MMA(0, 0, At, B0); PG8_MMA(0, 1, At, B1); PG8_BAR; PG8_SCHED;
            PG8_LDA(At, 0, 1); PG8_STAGE(PG8_SB(0, 0), b2, voffB); PG8_STAGE(PG8_SB(0, 1), b2 + hstep, voffB); PG8_STAGE(PG8_SA(0, 0), a2, voffA);
            PG8_WAIT_V(8); PG8_WAIT_L(0); PG8_BAR; PG8_MMA(1, 0, At, B0); PG8_MMA(1, 1, At, B1); PG8_BAR; PG8_SCHED;
            PG8_LDB(B0, 1, 0); PG8_LDB(B1, 1, 1); PG8_SCHED; PG8_LDA(At, 1, 0); PG8_STAGE(PG8_SA(0, 1), a2 + hstep, voffA);
            PG8_WAIT_V(8); PG8_WAIT_L(0); PG8_BAR; PG8_MMA(0, 0, At, B0); PG8_MMA(0, 1, At, B1); PG8_BAR; PG8_SCHED;
            PG8_LDA(At, 1, 1); PG8_STAGE(PG8_SB(1, 0), b3, voffB); PG8_STAGE(PG8_SB(1, 1), b3 + hstep, voffB); PG8_STAGE(PG8_SA(1, 0), a3, voffA);
            PG8_WAIT_V(8); PG8_WAIT_L(0); PG8_BAR; PG8_MMA(1, 0, At, B0); PG8_MMA(1, 1, At, B1); PG8_BAR; PG8_SCHED;
            } else {
            PG8_LDB(B0, 0, 0); PG8_SCHED; PG8_LDA(At, 0, 0); PG8_STAGE(PG8_SA(1, 1), a1 + hstep, voffA);
            PG8_WAIT_L(8); PG8_BAR; PG8_WAIT_L(0); PG8_MMA(0, 0, At, B0); PG8_BAR; PG8_SCHED;
            PG8_LDB(B1, 0, 1); PG8_STAGE(PG8_SB(0, 0), b2, voffB);
            PG8_BAR; PG8_WAIT_L(0); PG8_MMA(0, 1, At, B1); PG8_BAR;
            PG8_LDA(At, 0, 1); PG8_STAGE(PG8_SA(0, 0), a2, voffA);
            PG8_BAR; PG8_WAIT_L(0); PG8_MMA(1, 0, At, B0); PG8_BAR; PG8_SCHED;
            PG8_STAGE(PG8_SB(0, 1), b2 + hstep, voffB);
            PG8_WAIT_V(6); PG8_BAR; PG8_MMA(1, 1, At, B1); PG8_BAR;
            PG8_LDB(B0, 1, 0); PG8_SCHED; PG8_LDA(At, 1, 0); PG8_STAGE(PG8_SA(0, 1), a2 + hstep, voffA);
            PG8_WAIT_L(8); PG8_BAR; PG8_WAIT_L(0); PG8_MMA(0, 0, At, B0); PG8_BAR; PG8_SCHED;
            PG8_LDB(B1, 1, 1); PG8_STAGE(PG8_SB(1, 0), b3, voffB);
            PG8_BAR; PG8_WAIT_L(0); PG8_MMA(0, 1, At, B1); PG8_BAR;
            PG8_LDA(At, 1, 1); PG8_STAGE(PG8_SA(1, 0), a3, voffA);
            PG8_BAR; PG8_WAIT_L(0); PG8_MMA(1, 0, At, B0); PG8_BAR; PG8_SCHED;
            PG8_STAGE(PG8_SB(1, 1), b3 + hstep, voffB);
            PG8_WAIT_V(6); PG8_BAR; PG8_MMA(1, 1, At, B1); PG8_BAR;
            }
        }
        if constexpr (ALIGN_EPI) { if (wr == 0) PG8_BAR; }
        if constexpr (!Epi::AFTER_DRAIN) { E(acc, cur, wr, wc, fr, fq); S.done(cur); }
        if (!has_next) break;
#pragma unroll
        for (int a = 0; a < 2; ++a)
#pragma unroll
            for (int b = 0; b < 2; ++b)
#pragma unroll
                for (int m = 0; m < 4; ++m)
#pragma unroll
                    for (int n = 0; n < 2; ++n) acc[a][b][m][n] = (f32x4){0.f, 0.f, 0.f, 0.f};
        cur = nxt; cA = nA; cB = nB; ++ui;
        if constexpr (ALIGN_EPI) { if (wr == 1) PG8_BAR; }
    }
    PG8_WAIT_V(0);
    if constexpr (!ALIGN_EPI) { if (wr == 0) PG8_BAR; }
    PG8_BAR;
    if constexpr (Epi::AFTER_DRAIN) { E.fused(acc, cur, wr, wc, fr, fq, lds, wid, lane); S.done(cur); }
#undef PG8_SA
#undef PG8_SB
#undef PG8_STAGE
#undef PG8_LDA
#undef PG8_LDB
#undef PG8_MMA
#undef PG8_WAIT_V
#undef PG8_WAIT_L
#undef PG8_BAR
#undef PG8_SCHED
}
}
#define LAS __attribute__((address_space(3)))
#define GAS __attribute__((address_space(1)))
typedef unsigned short bf16;
typedef unsigned v4u __attribute__((ext_vector_type(4)));
typedef float f32x4 __attribute__((ext_vector_type(4)));
constexpr int NWAVES = 8, NTHREADS = 512;
constexpr int SEQ = 8192, DM = 1024, MTOK = 16384, DIN = 9744, N1 = 9728, PLD = 6656, FF = 4096;
constexpr float EPS = 1e-6f;
constexpr size_t MiB = 1u << 20;
constexpr size_t WS_WIN = 1 * MiB, WS_WA = 20 * MiB, WS_WB = 21 * MiB, WS_WO = 23 * MiB, WS_WUP = 25 * MiB, WS_WDN = 33 * MiB;
constexpr size_t WS_XB = 41 * MiB, WS_PROJ = 73 * MiB, WS_VT = 177 * MiB, WS_A1 = 193 * MiB, WS_A2 = 209 * MiB;
constexpr size_t WS_R1 = 241 * MiB, WS_PA = 242 * MiB, WS_SS2 = 243 * MiB, WS_MISC = 244 * MiB;
constexpr size_t WS_MIXED = 73 * MiB, WS_U = 73 * MiB, WS_END = 256 * MiB;
constexpr int LDS_BYTES = 155648;

__device__ __forceinline__ float bf2f(bf16 h) { return __uint_as_float(((unsigned)h) << 16); }
__device__ __forceinline__ unsigned f2bf(float f) { unsigned u = __builtin_bit_cast(unsigned, f); return (u + 0x7fffu + ((u >> 16) & 1u)) >> 16; }
__device__ __forceinline__ unsigned pk2(float lo, float hi) { return f2bf(lo) | (f2bf(hi) << 16); }
__device__ __forceinline__ float wave_sum(float v) {
#pragma unroll
    for (int o = 1; o < 64; o <<= 1) v += __shfl_xor(v, o);
    return v;
}
__device__ __forceinline__ float log_sigmoid(float x) { return fminf(x, 0.f) - log1pf(__expf(-fabsf(x))); }

struct Args { const float* in[15]; float* out; unsigned char* ws; int ph_lo, ph_hi; };

__device__ __forceinline__ void p0_transpose_item(const float* W, int ldw, int srccol0, const float* kscale, int kmask, float cscale,
                                                  bf16* WT, int K, int dstrow0, int k0, LAS float* scr, int lane) {
#pragma unroll 8
    for (int i = 0; i < 32; ++i) { const int kk = 2 * i + (lane >> 5); const float ks = kscale ? kscale[(k0 + kk) & kmask] * cscale : cscale;
        scr[kk * 33 + (lane & 31)] = W[(size_t)(k0 + kk) * ldw + srccol0 + (lane & 31)] * ks; }
    asm volatile("s_waitcnt lgkmcnt(0)" ::: "memory");
    const int c = lane & 7;
#pragma unroll
    for (int j = 0; j < 4; ++j) { const int n = (lane >> 3) + 8 * j; const LAS float* s = scr + (8 * c) * 33 + n;
        v4u o; o.x = pk2(s[0 * 33], s[1 * 33]); o.y = pk2(s[2 * 33], s[3 * 33]); o.z = pk2(s[4 * 33], s[5 * 33]); o.w = pk2(s[6 * 33], s[7 * 33]);
        *(v4u*)(WT + (size_t)(dstrow0 + n) * K + k0 + 8 * c) = o; }
    asm volatile("s_waitcnt lgkmcnt(0)" ::: "memory");
}


typedef short bf16x8_t __attribute__((ext_vector_type(8)));
typedef short s16x4_t __attribute__((ext_vector_type(4)));
constexpr int AT_PITCH = 144;
constexpr int AT_KL = 0, AT_VL = 256 * AT_PITCH;
constexpr int N_ATT_ITEMS = 1536;
struct AttnRegs { v4u k[4], v[4], q[2]; };
__device__ __forceinline__ void attn_decode(int it, int& g, int& slot, int& d, int& r, int& n) {
    g = it >> 9; const int rem = it & 511; slot = rem & 7; const int rest = rem >> 3; const int sh = 2 * g; d = 1 << sh; r = rest >> (6 - sh); n = rest & ((64 >> sh) - 1);
}
__device__ __forceinline__ void attn_prefetch(AttnRegs& R, const bf16* PROJ_, int it, int tid, int wave, int lane) {
    int g, slot, d, r, n; attn_decode(it, g, slot, d, r, n); const int hd = g * 8 + slot; const int c = tid & 7;
#pragma unroll
    for (int p = 0; p < 4; ++p) { const int row = p * 64 + (tid >> 3); const int sp = (n - 1) * 128 + row;
        if (n > 0 || p >= 2) { const GAS bf16* base = (const GAS bf16*)PROJ_ + (size_t)(sp * d + r) * PLD + hd * 64 + c * 8; R.k[p] = *(const GAS v4u*)(base + 1536); R.v[p] = *(const GAS v4u*)(base + 3072); }
        else { R.k[p] = (v4u){0u, 0u, 0u, 0u}; R.v[p] = (v4u){0u, 0u, 0u, 0u}; } }
    const int fr = lane & 15, fq = lane >> 4; const GAS bf16* qb = (const GAS bf16*)PROJ_ + (size_t)((n * 128 + 16 * wave + fr) * d + r) * PLD + hd * 64 + 8 * fq;
    R.q[0] = *(const GAS v4u*)(qb); R.q[1] = *(const GAS v4u*)(qb + 32);
}
__device__ __forceinline__ void attn_stage(const AttnRegs& R, LAS unsigned char* lds, const float (&gkr)[8], int tid) {
    const int c = tid & 7;
#pragma unroll
    for (int p = 0; p < 4; ++p) { const int row = p * 64 + (tid >> 3); float f[8]; pg8::unpack8(R.k[p], f); float ss = 0.f;
#pragma unroll
        for (int i = 0; i < 8; ++i) ss += f[i] * f[i];
        ss += __shfl_xor(ss, 1); ss += __shfl_xor(ss, 2); ss += __shfl_xor(ss, 4);
        const float rs = 1.0f / sqrtf(ss * (1.0f / 64.0f) + EPS);
#pragma unroll
        for (int i = 0; i < 8; ++i) f[i] = f[i] * rs * gkr[i];
        *(LAS v4u*)(lds + AT_KL + row * AT_PITCH + c * 16) = pg8::pack8(f);
        *(LAS v4u*)(lds + AT_VL + row * AT_PITCH + c * 16) = R.v[p]; }
}
__device__ __forceinline__ void attn_compute(const AttnRegs& R, LAS unsigned char* lds, bf16* PROJ_, float* ML_, const float (&gqr)[16], int it, int wave, int lane) {
    int g, slot, d, r, n; attn_decode(it, g, slot, d, r, n); const int hd = g * 8 + slot;
    const int fr = lane & 15, fq = lane >> 4, w = wave;
    float qf[16]; { float t0[8], t1[8]; pg8::unpack8(R.q[0], t0); pg8::unpack8(R.q[1], t1);
#pragma unroll
        for (int i = 0; i < 8; ++i) { qf[i] = t0[i]; qf[8 + i] = t1[i]; } }
    float ss = 0.f;
#pragma unroll
    for (int i = 0; i < 16; ++i) ss += qf[i] * qf[i];
    ss += __shfl_xor(ss, 16); ss += __shfl_xor(ss, 32);
    const float qs = (1.0f / sqrtf(ss * (1.0f / 64.0f) + EPS)) * (0.125f * 1.4426950408889634f);
    bf16x8_t qa[2];
    { float t0[8], t1[8];
#pragma unroll
      for (int i = 0; i < 8; ++i) { t0[i] = qf[i] * qs * gqr[i]; t1[i] = qf[8 + i] * qs * gqr[8 + i]; }
      qa[0] = __builtin_bit_cast(bf16x8_t, pg8::pack8(t0)); qa[1] = __builtin_bit_cast(bf16x8_t, pg8::pack8(t1)); }
    f32x4 sc[9];
#pragma unroll
    for (int kti = 0; kti < 9; ++kti) { f32x4 acc = (f32x4){0.f, 0.f, 0.f, 0.f}; const LAS unsigned char* kp = lds + AT_KL + ((w + kti) * 16 + fr) * AT_PITCH + fq * 16;
#pragma unroll
        for (int ks = 0; ks < 2; ++ks) { const bf16x8_t kf = *(const LAS bf16x8_t*)(kp + ks * 64); acc = __builtin_amdgcn_mfma_f32_16x16x32_bf16(kf, qa[ks], acc, 0, 0, 0); }
        sc[kti] = acc; if (kti % 3 == 2) __builtin_amdgcn_sched_barrier(0); }
    float mx = -INFINITY;
#pragma unroll
    for (int j = 0; j < 4; ++j) { if (4 * fq + j < fr) sc[0][j] = -INFINITY; if (4 * fq + j > fr) sc[8][j] = -INFINITY; }
#pragma unroll
    for (int kti = 0; kti < 9; ++kti) { if (n == 0 && w + kti < 8) sc[kti] = (f32x4){-INFINITY, -INFINITY, -INFINITY, -INFINITY};
#pragma unroll
        for (int j = 0; j < 4; ++j) mx = fmaxf(mx, sc[kti][j]); }
    mx = fmaxf(mx, __shfl_xor(mx, 16)); mx = fmaxf(mx, __shfl_xor(mx, 32));
    float den = 0.f;
#pragma unroll
    for (int kti = 0; kti < 9; ++kti)
#pragma unroll
        for (int j = 0; j < 4; ++j) { const float pv = __builtin_amdgcn_exp2f(sc[kti][j] - mx); sc[kti][j] = pv; den += pv; }
    den += __shfl_xor(den, 16); den += __shfl_xor(den, 32);
    __builtin_amdgcn_sched_barrier(0);
    f32x4 o[4];
#pragma unroll
    for (int et = 0; et < 4; ++et) o[et] = (f32x4){0.f, 0.f, 0.f, 0.f};
    const int q_ = (lane >> 2) & 3, p_ = lane & 3;
#pragma unroll
    for (int kk = 0; kk < 5; ++kk) { const int kt0 = w + 2 * kk, kt1 = (kk < 4) ? kt0 + 1 : kt0;
        v4u aw; aw.x = pg8::cvt_pk_bf16(sc[2 * kk][0], sc[2 * kk][1]); aw.y = pg8::cvt_pk_bf16(sc[2 * kk][2], sc[2 * kk][3]);
        if (kk < 4) { aw.z = pg8::cvt_pk_bf16(sc[(kk < 4) ? 2 * kk + 1 : 0][0], sc[(kk < 4) ? 2 * kk + 1 : 0][1]); aw.w = pg8::cvt_pk_bf16(sc[(kk < 4) ? 2 * kk + 1 : 0][2], sc[(kk < 4) ? 2 * kk + 1 : 0][3]); } else { aw.z = 0u; aw.w = 0u; }
        const bf16x8_t af = __builtin_bit_cast(bf16x8_t, aw);
        const LAS unsigned char* v0 = lds + AT_VL + (kt0 * 16 + 4 * fq + q_) * AT_PITCH + p_ * 8; const LAS unsigned char* v1 = lds + AT_VL + (kt1 * 16 + 4 * fq + q_) * AT_PITCH + p_ * 8;
#pragma unroll
        for (int et = 0; et < 4; ++et) {
            const s16x4_t lo = __builtin_bit_cast(s16x4_t, __builtin_amdgcn_ds_read_tr16_b64_v4i16((LAS s16x4_t*)(v0 + et * 32)));
            const s16x4_t hi = __builtin_bit_cast(s16x4_t, __builtin_amdgcn_ds_read_tr16_b64_v4i16((LAS s16x4_t*)(v1 + et * 32)));
            const bf16x8_t bfr = (bf16x8_t){lo[0], lo[1], lo[2], lo[3], hi[0], hi[1], hi[2], hi[3]};
            o[et] = __builtin_amdgcn_mfma_f32_16x16x32_bf16(af, bfr, o[et], 0, 0, 0); }
        __builtin_amdgcn_sched_barrier(0); }
#pragma unroll
    for (int j = 0; j < 4; ++j) { GAS bf16* op = (GAS bf16*)PROJ_ + (size_t)((n * 128 + 16 * w + 4 * fq + j) * d + r) * PLD + hd * 64 + fr;
#pragma unroll
        for (int et = 0; et < 4; ++et) op[et * 16] = (bf16)f2bf(o[et][j]); }
    if (fq == 0) { GAS float* mp = (GAS float*)ML_ + (size_t)((n * 128 + 16 * w + fr) * d + r) * 48 + (g * 8 + slot) * 2; mp[0] = mx; mp[1] = den; }
}


constexpr int GL_QG = 0, GL_KG = 17408, GL_KDT = 34816, GL_VTL = 53248, GL_PL = 90112, GL_EB = 99328, GL_PAL = 99840, GL_GT = 103936, GL_SSQ = 105984, GL_RS = 108032;
typedef unsigned u32x2_t __attribute__((ext_vector_type(2)));
template <bool FULL>
__device__ __forceinline__ void gla_item(LAS unsigned char* lds, int b, int item, const bf16* PROJ_, const bf16* VT_, const float* PA_, const float* gate_up_, const float* gate_bias_,
                                         float* SBUF_, float* DBUF_, bf16* A2_, int tid, int wave, int lane) {
    const int h = item >> 5, seg = item & 31;
    const int kd = tid & 127, tq = tid >> 7, fr = lane & 15, fq = lane >> 4, w = wave;
    float upr[16];
#pragma unroll
    for (int r = 0; r < 16; ++r) upr[r] = gate_up_[r * 512 + h * 128 + kd];
    const float bk = gate_bias_[h * 128 + kd];
    f32x4 S[8][2];
#pragma unroll
    for (int mtk = 0; mtk < 8; ++mtk)
#pragma unroll
        for (int nt = 0; nt < 2; ++nt)
#pragma unroll
            for (int j = 0; j < 4; ++j) S[mtk][nt][j] = FULL ? ((const GAS float*)SBUF_)[((size_t)item * 64 + (mtk * 2 + nt) * 4 + j) * 512 + tid] : 0.f;
    float segsum = 0.f;
    for (int c = 0; c < 4; ++c) {
        const int tok0 = seg * 256 + c * 64;
        { const GAS float* pap = (const GAS float*)PA_ + (size_t)(b * SEQ + tok0) * 16; LAS float* PAL = (LAS float*)(lds + GL_PAL); PAL[tid] = pap[tid]; PAL[tid + 512] = pap[tid + 512];
#pragma unroll
          for (int i = 0; i < 4; ++i) { const int piece = tid + 512 * i, v = piece >> 3, cc = piece & 7;
              *(LAS v4u*)(lds + GL_VTL + v * 144 + cc * 16) = *(const GAS v4u*)((const GAS bf16*)VT_ + (size_t)(h * 256 + v) * SEQ + tok0 + cc * 8); } }
        unsigned short kraw[16], qraw[16];
#pragma unroll
        for (int i = 0; i < 16; ++i) { const GAS bf16* rp = (const GAS bf16*)PROJ_ + (size_t)(tok0 + 16 * tq + i) * PLD + h * 128 + kd; kraw[i] = rp[5120]; qraw[i] = FULL ? rp[4608] : (unsigned short)0; }
        __syncthreads();
        float cb[16];
        { const LAS f32x4* pl = (const LAS f32x4*)(lds + GL_PAL); float run = 0.f;
#pragma unroll
          for (int i = 0; i < 16; ++i) { const int t = 16 * tq + i; float lg = bk;
#pragma unroll
              for (int q4 = 0; q4 < 4; ++q4) { const f32x4 pv = pl[t * 4 + q4]; lg += pv[0] * upr[4 * q4] + pv[1] * upr[4 * q4 + 1] + pv[2] * upr[4 * q4 + 2] + pv[3] * upr[4 * q4 + 3]; }
              run += log_sigmoid(lg) * (1.0f / 16.0f); cb[i] = run; } }
        { LAS float* GT = (LAS float*)(lds + GL_GT); GT[tq * 128 + kd] = cb[15]; }
        __syncthreads();
        float off = 0.f, tot = 0.f;
        { const LAS float* GT = (const LAS float*)(lds + GL_GT);
#pragma unroll
          for (int q = 0; q < 4; ++q) { const float gv = GT[q * 128 + kd]; tot += gv; off += (q < tq) ? gv : 0.f; } }
        { float kdv[16];
#pragma unroll
          for (int i = 0; i < 16; ++i) { const float bc = cb[i] + off; const float kf = bf2f(kraw[i]); kdv[i] = kf * __expf(tot - bc);
              if (FULL) { const int t = 16 * tq + i;
                  *(LAS unsigned short*)(lds + GL_QG + t * 272 + kd * 2) = (unsigned short)f2bf(bf2f(qraw[i]) * __expf(bc));
                  *(LAS unsigned short*)(lds + GL_KG + t * 272 + kd * 2) = (unsigned short)f2bf(kf * __expf(-bc)); } }
          float lo8[8], hi8[8];
#pragma unroll
          for (int i = 0; i < 8; ++i) { lo8[i] = kdv[i]; hi8[i] = kdv[8 + i]; }
          *(LAS v4u*)(lds + GL_KDT + kd * 144 + tq * 32) = pg8::pack8(lo8); *(LAS v4u*)(lds + GL_KDT + kd * 144 + tq * 32 + 16) = pg8::pack8(hi8); }
        if (tq == 0) ((LAS float*)(lds + GL_EB))[kd] = __expf(tot);
        segsum += tot;
        __syncthreads();
        if (FULL) {
            const int mt = w >> 1;
#pragma unroll
            for (int sti = 0; sti < 2; ++sti) { const int st = 2 * (w & 1) + sti; f32x4 acc = (f32x4){0.f, 0.f, 0.f, 0.f};
                if (st <= mt) {
#pragma unroll
                    for (int ks = 0; ks < 4; ++ks) { const bf16x8_t kf = *(const LAS bf16x8_t*)(lds + GL_KG + (16 * st + fr) * 272 + (32 * ks + 8 * fq) * 2);
                        const bf16x8_t qf = *(const LAS bf16x8_t*)(lds + GL_QG + (16 * mt + fr) * 272 + (32 * ks + 8 * fq) * 2);
                        acc = __builtin_amdgcn_mfma_f32_16x16x32_bf16(kf, qf, acc, 0, 0, 0); }
                    if (st == mt) {
#pragma unroll
                        for (int j = 0; j < 4; ++j) if (4 * fq + j > fr) acc[j] = 0.f; } }
                u32x2_t wv; wv.x = pg8::cvt_pk_bf16(acc[0], acc[1]); wv.y = pg8::cvt_pk_bf16(acc[2], acc[3]);
                *(LAS u32x2_t*)(lds + GL_PL + (16 * mt + fr) * 144 + (16 * st + 4 * fq) * 2) = wv; }
            __syncthreads();
        }
        bf16x8_t vf[2][2];
#pragma unroll
        for (int ks2 = 0; ks2 < 2; ++ks2)
#pragma unroll
            for (int nt = 0; nt < 2; ++nt) vf[ks2][nt] = *(const LAS bf16x8_t*)(lds + GL_VTL + (32 * w + 16 * nt + fr) * 144 + (32 * ks2 + 8 * fq) * 2);
        f32x4 o[4][2];
        if (FULL) {
#pragma unroll
            for (int mt = 0; mt < 4; ++mt) { o[mt][0] = (f32x4){0.f, 0.f, 0.f, 0.f}; o[mt][1] = (f32x4){0.f, 0.f, 0.f, 0.f}; }
#pragma unroll
            for (int ks = 0; ks < 4; ++ks) { bf16x8_t bfr[2];
#pragma unroll
                for (int nt = 0; nt < 2; ++nt) { v4u wv; wv.x = pg8::cvt_pk_bf16(S[2 * ks][nt][0], S[2 * ks][nt][1]); wv.y = pg8::cvt_pk_bf16(S[2 * ks][nt][2], S[2 * ks][nt][3]);
                    wv.z = pg8::cvt_pk_bf16(S[2 * ks + 1][nt][0], S[2 * ks + 1][nt][1]); wv.w = pg8::cvt_pk_bf16(S[2 * ks + 1][nt][2], S[2 * ks + 1][nt][3]); bfr[nt] = __builtin_bit_cast(bf16x8_t, wv); }
#pragma unroll
                for (int mt = 0; mt < 4; ++mt) { const u32x2_t a0 = *(const LAS u32x2_t*)(lds + GL_QG + (16 * mt + fr) * 272 + (32 * ks + 4 * fq) * 2), a1 = *(const LAS u32x2_t*)(lds + GL_QG + (16 * mt + fr) * 272 + (32 * ks + 16 + 4 * fq) * 2);
                    const v4u aw = (v4u){a0.x, a0.y, a1.x, a1.y}; const bf16x8_t af = __builtin_bit_cast(bf16x8_t, aw);
                    o[mt][0] = __builtin_amdgcn_mfma_f32_16x16x32_bf16(af, bfr[0], o[mt][0], 0, 0, 0); o[mt][1] = __builtin_amdgcn_mfma_f32_16x16x32_bf16(af, bfr[1], o[mt][1], 0, 0, 0); } }
#pragma unroll
            for (int ks2 = 0; ks2 < 2; ++ks2)
#pragma unroll
                for (int mt = 0; mt < 4; ++mt) { const bf16x8_t pf = *(const LAS bf16x8_t*)(lds + GL_PL + (16 * mt + fr) * 144 + (32 * ks2 + 8 * fq) * 2);
                    o[mt][0] = __builtin_amdgcn_mfma_f32_16x16x32_bf16(pf, vf[ks2][0], o[mt][0], 0, 0, 0); o[mt][1] = __builtin_amdgcn_mfma_f32_16x16x32_bf16(pf, vf[ks2][1], o[mt][1], 0, 0, 0); }
        }
#pragma unroll
        for (int mtk = 0; mtk < 8; ++mtk) { const f32x4 eb = *(const LAS f32x4*)(lds + GL_EB + (16 * mtk + 4 * fq) * 4);
            S[mtk][0] = S[mtk][0] * eb; S[mtk][1] = S[mtk][1] * eb;
#pragma unroll
            for (int ks2 = 0; ks2 < 2; ++ks2) { const bf16x8_t kf = *(const LAS bf16x8_t*)(lds + GL_KDT + (16 * mtk + fr) * 144 + (32 * ks2 + 8 * fq) * 2);
                S[mtk][0] = __builtin_amdgcn_mfma_f32_16x16x32_bf16(kf, vf[ks2][0], S[mtk][0], 0, 0, 0); S[mtk][1] = __builtin_amdgcn_mfma_f32_16x16x32_bf16(kf, vf[ks2][1], S[mtk][1], 0, 0, 0); } }
        if (FULL) {
#pragma unroll
            for (int mt = 0; mt < 4; ++mt)
#pragma unroll
                for (int j = 0; j < 4; ++j) { float sq = o[mt][0][j] * o[mt][0][j] + o[mt][1][j] * o[mt][1][j];
                    sq += __shfl_xor(sq, 1); sq += __shfl_xor(sq, 2); sq += __shfl_xor(sq, 4); sq += __shfl_xor(sq, 8);
                    if (fr == 0) ((LAS float*)(lds + GL_SSQ))[w * 64 + 16 * mt + 4 * fq + j] = sq; }
            __syncthreads();
            if (tid < 64) { const LAS float* sp = (const LAS float*)(lds + GL_SSQ); float tsum = 0.f;
#pragma unroll
                for (int q = 0; q < 8; ++q) tsum += sp[q * 64 + tid];
                ((LAS float*)(lds + GL_RS))[tid] = 1.0f / sqrtf(tsum * (1.0f / 256.0f) + EPS); }
            __syncthreads();
#pragma unroll
            for (int mt = 0; mt < 4; ++mt) { const f32x4 rs = *(const LAS f32x4*)(lds + GL_RS + (16 * mt + 4 * fq) * 4);
#pragma unroll
                for (int j = 0; j < 4; ++j)
#pragma unroll
                    for (int nt = 0; nt < 2; ++nt) *(LAS unsigned short*)(lds + (16 * mt + 4 * fq + j) * 528 + (32 * w + 16 * nt + fr) * 2) = (unsigned short)f2bf(o[mt][nt][j] * rs[j]); }
            __syncthreads();
#pragma unroll
            for (int i = 0; i < 4; ++i) { const int piece = tid + 512 * i, t = piece >> 5, c8 = piece & 31; float ov[8], rv[8];
                pg8::unpack8(*(const LAS v4u*)(lds + t * 528 + c8 * 16), ov);
                pg8::unpack8(*(const GAS v4u*)((const GAS bf16*)PROJ_ + (size_t)(tok0 + t) * PLD + 5632 + h * 256 + c8 * 8), rv);
#pragma unroll
                for (int e = 0; e < 8; ++e) ov[e] *= rv[e];
                *(GAS v4u*)((GAS bf16*)A2_ + (size_t)(b * SEQ + tok0 + t) * DM + h * 256 + c8 * 8) = pg8::pack8(ov); }
        } else {
            __syncthreads();
        }
    }
    if (!FULL) {
#pragma unroll
        for (int mtk = 0; mtk < 8; ++mtk)
#pragma unroll
            for (int nt = 0; nt < 2; ++nt)
#pragma unroll
                for (int j = 0; j < 4; ++j) ((GAS float*)SBUF_)[((size_t)item * 64 + (mtk * 2 + nt) * 4 + j) * 512 + tid] = S[mtk][nt][j];
        if (tq == 0) ((GAS float*)DBUF_)[item * 128 + kd] = __expf(segsum);
    }
}

__global__ void __launch_bounds__(NTHREADS, 2) fwd_kernel(Args a) {
    extern __shared__ __attribute__((aligned(16))) unsigned char lds_raw[];
    LAS unsigned char* lds = (LAS unsigned char*)lds_raw;
    cg::grid_group grid = cg::this_grid();
    const int tid = threadIdx.x, lane = tid & 63, wave = __builtin_amdgcn_readfirstlane(tid >> 6);
    const int G = gridDim.x, bx = blockIdx.x;
    const int gw = bx * NWAVES + wave, NGW = G * NWAVES;
    unsigned char* ws = a.ws;
    const float* x = a.in[0]; const float* g1 = a.in[1]; const float* w_in = a.in[2]; const float* gq = a.in[3]; const float* gk = a.in[4];
    const float* gate_up = a.in[5]; const float* gate_bias = a.in[6]; const float* gla_g = a.in[7]; const float* bgate_bias = a.in[8];
    const float* w_ab = a.in[9]; const float* w_gb = a.in[10]; const float* w_out = a.in[11]; const float* g2 = a.in[12]; const float* w_up = a.in[13]; const float* w_dn = a.in[14];
    bf16* WIN = (bf16*)(ws + WS_WIN); bf16* WA = (bf16*)(ws + WS_WA); bf16* WB = (bf16*)(ws + WS_WB); bf16* WO = (bf16*)(ws + WS_WO);
    bf16* WUP = (bf16*)(ws + WS_WUP); bf16* WDN = (bf16*)(ws + WS_WDN); bf16* XB = (bf16*)(ws + WS_XB); bf16* PROJ = (bf16*)(ws + WS_PROJ);
    bf16* VT = (bf16*)(ws + WS_VT); bf16* A1 = (bf16*)(ws + WS_A1); bf16* A2 = (bf16*)(ws + WS_A2);
    float* R1 = (float*)(ws + WS_R1); float* PA = (float*)(ws + WS_PA); float* SS2 = (float*)(ws + WS_SS2);
    bf16* MIXED = (bf16*)(ws + WS_MIXED); bf16* UB = (bf16*)(ws + WS_U); bf16* GATES = (bf16*)a.out;
    const int lo = a.ph_lo, hi = a.ph_hi;
#define IN(k) (lo <= (k) && (k) < hi)
#define LAUNDER(p) asm volatile("" : "+s"(p))
#define SYNC(k) do { if (IN(k) && IN((k) + 1)) { asm volatile("s_waitcnt vmcnt(0) lgkmcnt(0)" ::: "memory"); grid.sync(); } } while (0)

    if (IN(0)) {
        LAS float* scr = (LAS float*)(lds + 81920 + wave * 8448);
        constexpr int I_IN = 16 * 304, I_A = 8 * 32, I_B = 16 * 32, I_O = 16 * 32, I_UP = 16 * 128, I_DN = 64 * 32;
        constexpr int NITEMS = I_IN + I_A + I_B + I_O + I_UP + I_DN;
        for (int it = gw; it < NITEMS; it += NGW) {
            int r = it;
            if (r < I_IN) { const int kb = r / 304, nb = r % 304; const int n0 = nb * 32; const int src = n0 < 7680 ? n0 : n0 + 16;
                const float cs = (n0 >= 4608 && n0 < 5120) ? 0.08838834764831845f : 1.0f;
                p0_transpose_item(w_in, DIN, src, g1, 1023, cs, WIN, 1024, n0, kb * 64, scr, lane); continue; } r -= I_IN;
            if (r < I_A) { const int kb = r / 32, nb = r % 32; p0_transpose_item(w_ab, 1024, nb * 32, nullptr, 0, 1.0f, WA, 512, nb * 32, kb * 64, scr, lane); continue; } r -= I_A;
            if (r < I_B) { const int kb = r / 32, nb = r % 32; p0_transpose_item(w_gb, 1024, nb * 32, gla_g, 255, 1.0f, WB, 1024, nb * 32, kb * 64, scr, lane); continue; } r -= I_B;
            if (r < I_O) { const int kb = r / 32, nb = r % 32; p0_transpose_item(w_out, 1024, nb * 32, nullptr, 0, 1.0f, WO, 1024, nb * 32, kb * 64, scr, lane); continue; } r -= I_O;
            if (r < I_UP) { const int kb = r / 128, nb = r % 128; p0_transpose_item(w_up, 4096, nb * 32, g2, 1023, 1.0f, WUP, 1024, nb * 32, kb * 64, scr, lane); continue; } r -= I_UP;
            { const int kb = r / 32, nb = r % 32; p0_transpose_item(w_dn, 1024, nb * 32, nullptr, 0, 1.0f, WDN, 4096, nb * 32, kb * 64, scr, lane); }
        }
        LAS float* WAl = (LAS float*)lds;
        for (int idx = tid; idx < 1024 * 16; idx += NTHREADS) { const int k = idx >> 4, r = idx & 15; const int rho = ((k >> 8) * 4 + (k & 3)) * 64 + ((k >> 2) & 63);
            WAl[rho * 20 + r] = w_in[(size_t)k * DIN + 7680 + r] * g1[k]; }
        __syncthreads();
        for (int row = gw; row < MTOK; row += NGW) {
            asm volatile("" ::: "memory");
            const f32x4* xr = (const f32x4*)(x + (size_t)row * DM) + lane;
            f32x4 v[4]; float ss = 0.f;
#pragma unroll
            for (int j = 0; j < 4; ++j) { v[j] = xr[64 * j]; ss += (v[j][0] * v[j][0] + v[j][1] * v[j][1]) + (v[j][2] * v[j][2] + v[j][3] * v[j][3]); }
            ss = wave_sum(ss); const float r1 = 1.0f / sqrtf(ss * (1.0f / 1024.0f) + EPS);
            float pa[16];
#pragma unroll
            for (int r = 0; r < 16; ++r) pa[r] = 0.f;
#pragma unroll
            for (int j = 0; j < 4; ++j)
#pragma unroll
                for (int c = 0; c < 4; ++c) { const float xv = v[j][c]; const LAS f32x4* wp = (const LAS f32x4*)(WAl + ((j * 4 + c) * 64 + lane) * 20);
#pragma unroll
                    for (int q = 0; q < 4; ++q) { const f32x4 w = wp[q]; pa[4 * q] += xv * w[0]; pa[4 * q + 1] += xv * w[1]; pa[4 * q + 2] += xv * w[2]; pa[4 * q + 3] += xv * w[3]; } }
            float mine = 0.f;
#pragma unroll
            for (int r = 0; r < 16; ++r) { const float s = wave_sum(pa[r]); mine = (lane == r) ? s : mine; }
            if (lane < 16) PA[(size_t)row * 16 + lane] = mine * r1;
            if (lane == 0) R1[row] = r1;
            unsigned long long* o8 = (unsigned long long*)(XB + (size_t)row * DM) + lane;
#pragma unroll
            for (int j = 0; j < 4; ++j) o8[64 * j] = (unsigned long long)pk2(v[j][0], v[j][1]) | ((unsigned long long)pk2(v[j][2], v[j][3]) << 32);
        }
        __syncthreads();
    }
    SYNC(0);

    for (int bq = 0; bq < 2; ++bq) {
        int b = bq; LAUNDER(b);
        const int p1 = 1 + 4 * b;
        if (IN(p1)) {
            pg8::Gemm g{XB + (size_t)b * SEQ * DM, WIN, SEQ, N1, DM}; pg8::StaticOrder S; S.init(SEQ, N1, G, bx);
            pg8::EpiProj E{PROJ, VT, GATES + (size_t)b * SEQ * 2048, R1 + b * SEQ, bgate_bias};
            pg8::gemm_phase<pg8::EpiProj, pg8::StaticOrder, true, true>(lds, g, S, E);
        }
        SYNC(p1);
        int tid_ = threadIdx.x; asm volatile("" : "+v"(tid_)); const int lane_ = tid_ & 63; const int wave_ = __builtin_amdgcn_readfirstlane(tid_ >> 6); int bx_ = bx; LAUNDER(bx_);
        const float* gate_up_ = gate_up; const float* gate_bias_ = gate_bias; const float* PA_ = PA; const bf16* PROJ_ = PROJ; const bf16* VT_ = VT; bf16* A1_ = A1; bf16* A2_ = A2; const float* gq_ = gq; const float* gk_ = gk;
        float* SBUF_ = (float*)(ws + WS_XB); float* DBUF_ = (float*)(ws + WS_MISC + 2 * MiB); float* ML_ = (float*)(ws + WS_MISC);
        LAUNDER(gate_up_); LAUNDER(gate_bias_); LAUNDER(PA_); LAUNDER(PROJ_); LAUNDER(VT_); LAUNDER(A1_); LAUNDER(A2_); LAUNDER(gq_); LAUNDER(gk_); LAUNDER(SBUF_); LAUNDER(DBUF_); LAUNDER(ML_);
        if (IN(p1 + 1)) {
            if (bx_ < 128) { gla_item<false>(lds, b, bx_, PROJ_, VT_, PA_, gate_up_, gate_bias_, SBUF_, DBUF_, A2_, tid_, wave_, lane_); }
            {
                float gkr[8], gqr[16];
#pragma unroll
                for (int i = 0; i < 8; ++i) gkr[i] = gk_[(tid_ & 7) * 8 + i];
#pragma unroll
                for (int i = 0; i < 8; ++i) { gqr[i] = gq_[8 * (lane_ >> 4) + i]; gqr[8 + i] = gq_[32 + 8 * (lane_ >> 4) + i]; }
                bf16* PROJW = (bf16*)PROJ_;
                const int first = bx_ < 128 ? bx_ : 640 + (bx_ - 128), cnt = bx_ < 128 ? 5 : 7;
                for (int k = 0; k < cnt; ++k) { const int it = first + 128 * k;
                    AttnRegs R; attn_prefetch(R, PROJ_, it, tid_, wave_, lane_);
                    __syncthreads();
                    attn_stage(R, lds, gkr, tid_);
                    __syncthreads();
                    attn_compute(R, lds, PROJW, ML_, gqr, it, wave_, lane_);
                }
            }
        }
        SYNC(p1 + 1);
        if (IN(p1 + 2)) {
            { const int gid = bx_ * NTHREADS + tid_;
              if (gid < 4 * 64 * 512) { const int h = gid >> 15, r = (gid >> 9) & 63, tl = gid & 511; const int kdr = 16 * (r >> 3) + 4 * ((tl & 63) >> 4) + (r & 3);
                float cur = 0.f;
                for (int sg = 0; sg < 32; ++sg) { GAS float* sp = (GAS float*)SBUF_ + ((size_t)(h * 32 + sg) * 64 + r) * 512 + tl; const float loc = *sp; *sp = cur;
                    cur = ((const GAS float*)DBUF_)[(h * 32 + sg) * 128 + kdr] * cur + loc; } } }
            {
                for (int idx = bx_ * NTHREADS + tid_; idx < SEQ * 64; idx += G * NTHREADS) {
                    const int t = idx >> 6, slot = (idx >> 3) & 7, c8 = idx & 7;
                    float m[3], dn[3];
#pragma unroll
                    for (int g = 0; g < 3; ++g) { const GAS float* mp = (const GAS float*)ML_ + (size_t)t * 48 + (g * 8 + slot) * 2; m[g] = mp[0]; dn[g] = mp[1]; }
                    const float M = fmaxf(m[0], fmaxf(m[1], m[2])); float D = 0.f; float acc[8];
#pragma unroll
                    for (int i = 0; i < 8; ++i) acc[i] = 0.f;
#pragma unroll
                    for (int g = 0; g < 3; ++g) { const float wg = __builtin_amdgcn_exp2f(m[g] - M); D += wg * dn[g]; float f[8];
                        pg8::unpack8(*(const GAS v4u*)((const GAS bf16*)PROJ_ + (size_t)t * PLD + (g * 8 + slot) * 64 + c8 * 8), f);
#pragma unroll
                        for (int i = 0; i < 8; ++i) acc[i] += wg * f[i]; }
                    const float inv = 1.0f / D;
#pragma unroll
                    for (int i = 0; i < 8; ++i) acc[i] *= inv;
                    *(GAS v4u*)((GAS bf16*)A1_ + (size_t)(b * SEQ + t) * 512 + slot * 64 + c8 * 8) = pg8::pack8(acc);
                }
            }
        }
        SYNC(p1 + 2);
        if (IN(p1 + 3)) {
            if (bx_ < 128) { gla_item<true>(lds, b, bx_, PROJ_, VT_, PA_, gate_up_, gate_bias_, SBUF_, DBUF_, A2_, tid_, wave_, lane_); }
        }
        SYNC(p1 + 3);
    }
    if (IN(9)) {
        { pg8::Gemm g{A1, WA, MTOK, DM, 512}; pg8::StaticOrder S; S.init(MTOK, DM, G, bx); pg8::EpiBranch E{MIXED, GATES, 0, 0};
          pg8::gemm_phase<pg8::EpiBranch, pg8::StaticOrder, true, true>(lds, g, S, E); }
        __syncthreads();
        { pg8::Gemm g{A2, WB, MTOK, DM, 1024}; pg8::StaticOrder S; S.init(MTOK, DM, G, bx); pg8::EpiBranch E{MIXED, GATES, 1024, 1};
          pg8::gemm_phase<pg8::EpiBranch, pg8::StaticOrder, true, true>(lds, g, S, E); }
    }
    SYNC(9);
    if (IN(10)) { pg8::Gemm g{MIXED, WO, MTOK, DM, 1024}; pg8::StaticOrder S; S.init(MTOK, DM, G, bx); pg8::EpiOut1 E{x, a.out, XB, SS2};
        pg8::gemm_phase<pg8::EpiOut1, pg8::StaticOrder, true, true>(lds, g, S, E); }
    SYNC(10);
    if (IN(11)) { pg8::Gemm g{XB, WUP, MTOK, FF, 1024}; pg8::StaticOrder S; S.init(MTOK, FF, G, bx); pg8::EpiUp E{UB, SS2};
        pg8::gemm_phase<pg8::EpiUp, pg8::StaticOrder, true, true>(lds, g, S, E); }
    SYNC(11);
    if (IN(12)) { pg8::Gemm g{UB, WDN, MTOK, DM, FF}; pg8::StaticOrder S; S.init(MTOK, DM, G, bx); pg8::EpiDown E{a.out};
        pg8::gemm_phase<pg8::EpiDown, pg8::StaticOrder, true, true>(lds, g, S, E); }
#undef IN
#undef SYNC
}

extern "C" void kernel_launch(void* const* d_in, const int* in_sizes, int n_in, void* d_out, int out_size, void* d_ws, size_t ws_size, hipStream_t stream) {
    static int grid = 0;
    if (grid == 0) {
        if (n_in != 15 || out_size != MTOK * DM || ws_size < WS_END) { fprintf(stderr, "kernel_launch: unexpected shapes (n_in %d, out %d, ws %zu)\n", n_in, out_size, ws_size); grid = -1; return; }
        int dev = 0, cus = 0, per_cu = 0;
        hipGetDevice(&dev); hipDeviceGetAttribute(&cus, hipDeviceAttributeMultiprocessorCount, dev);
        if (hipFuncSetAttribute((const void*)fwd_kernel, hipFuncAttributeMaxDynamicSharedMemorySize, LDS_BYTES) != hipSuccess) { fprintf(stderr, "kernel_launch: hipFuncSetAttribute failed\n"); grid = -1; return; }
        if (hipOccupancyMaxActiveBlocksPerMultiprocessor(&per_cu, (const void*)fwd_kernel, NTHREADS, LDS_BYTES) != hipSuccess || per_cu < 1) per_cu = 1;
        (void)hipGetLastError();
        grid = cus * per_cu;
        fprintf(stderr, "kernel_launch: grid %d (cus %d x %d)\n", grid, cus, per_cu);
    }
    if (grid < 0) return;
    Args a{};
    for (int i = 0; i < 15; ++i) a.in[i] = (const float*)d_in[i];
    a.out = (float*)d_out; a.ws = (unsigned char*)d_ws; a.ph_lo = 0; a.ph_hi = 13;
    void* args[] = {&a};
    hipError_t e = hipLaunchCooperativeKernel((const void*)fwd_kernel, dim3(grid), dim3(NTHREADS), args, LDS_BYTES, stream);
    if (e != hipSuccess) fprintf(stderr, "cooperative launch failed: %s (grid %d)\n", hipGetErrorString(e), grid);
}
```

```cpp
#include <hip/hip_runtime.h>
#include <hip/hip_cooperative_groups.h>
#include <cstdio>
#include <cstdint>
#include <cmath>
namespace cg = cooperative_groups;
namespace pg8 {
#define PG8_LAS __attribute__((address_space(3)))
typedef unsigned short bf16_t;
typedef short bf16x8 __attribute__((ext_vector_type(8)));
typedef float f32x4 __attribute__((ext_vector_type(4)));
typedef unsigned u32x4 __attribute__((ext_vector_type(4)));
constexpr int BM = 256, BK = 64, HALF = 128, HTB = HALF * BK * 2  , STAGE_BYTES = 8 * HTB, NXCD = 8, WGM = 8;

__host__ __device__ __forceinline__ int lds_byte(int r, int c) { const int st = (r >> 4) * 2 + (c >> 5), rr = r & 15, cc = c & 31, ob = rr * 64 + cc * 2; return st * 1024 + (ob ^ (((ob >> 9) & 1) << 5)); }
__host__ __device__ __forceinline__ void stage_rc(int b, int& R, int& C) { const int st = b / 1024, sb = b % 1024, swz = sb ^ (((sb >> 9) & 1) << 5); R = (st >> 1) * 16 + swz / 64; C = (st & 1) * 32 + (swz % 64) / 2; }
__host__ __device__ __forceinline__ int perm32(int rho) { const int n = rho >> 4, i = rho & 15; return 8 * (i >> 2) + 4 * n + (i & 3); }

struct Unit { int pm, pn; };
struct Gemm { const bf16_t* A; const bf16_t* Bt; int M, N, K; };

struct StaticOrder {
    int nM, nN, nwg, G, c;
    __host__ __device__ void init(int M, int N, int G_, int c_) { nM = M / BM; nN = N / BM; nwg = nM * nN; G = G_; c = c_; }
    __host__ __device__ bool next(int i, Unit& u) const {
        const long L = (long)i * G + c; if (L >= nwg) return false;
        int wgid = (int)L; { const int q = nwg / NXCD, r = nwg % NXCD, xcd = wgid % NXCD, off = wgid / NXCD; wgid = (xcd < r ? xcd * (q + 1) : r * (q + 1) + (xcd - r) * q) + off; }
        const int nig = WGM * nN, gid = wgid / nig, fm = gid * WGM, gsz = (nM - fm) < WGM ? (nM - fm) : WGM;
        u.pm = fm + ((wgid % nig) % gsz); u.pn = (wgid % nig) / gsz; return true;
    }
    __device__ __forceinline__ void a_ready(const Unit&) const {}
    __device__ __forceinline__ void done(const Unit&) const {}
};
typedef float f32x2 __attribute__((ext_vector_type(2)));
typedef __bf16 bf16x2_cv __attribute__((ext_vector_type(2)));
__device__ __forceinline__ unsigned cvt_pk_bf16(float lo, float hi) { const f32x2 v = {lo, hi}; const bf16x2_cv b = __builtin_convertvector(v, bf16x2_cv); return __builtin_bit_cast(unsigned, b); }
__device__ __forceinline__ float bflo(unsigned w) { return __uint_as_float(w << 16); }
__device__ __forceinline__ float bfhi(unsigned w) { return __uint_as_float(w & 0xffff0000u); }
__device__ __forceinline__ void unpack8(const u32x4 w, float (&f)[8]) { f[0] = bflo(w.x); f[1] = bfhi(w.x); f[2] = bflo(w.y); f[3] = bfhi(w.y); f[4] = bflo(w.z); f[5] = bfhi(w.z); f[6] = bflo(w.w); f[7] = bfhi(w.w); }
__device__ __forceinline__ u32x4 pack8(const float (&v)[8]) { u32x4 w; w.x = cvt_pk_bf16(v[0], v[1]); w.y = cvt_pk_bf16(v[2], v[3]); w.z = cvt_pk_bf16(v[4], v[5]); w.w = cvt_pk_bf16(v[6], v[7]); return w; }
__device__ __forceinline__ float fsigmoid(float x) { return 1.0f / (1.0f + __expf(-x)); }

struct EpiProj {
    static constexpr bool PERM = true, AFTER_DRAIN = false;
    bf16_t* proj; bf16_t* vt; bf16_t* gates; const float* r1; const float* gbias;
    __device__ __forceinline__ void operator()(const f32x4 (&acc)[2][2][4][2], const Unit& u, int wr, int wc, int fr_in, int fq_in) const {
        int fr = fr_in, fq = fq_in; asm volatile("" : "+v"(fr), "+v"(fq));
        const int ct = u.pn; const int row0 = u.pm * BM + wr * 64 + fr; const int cl = wc * 32 + 8 * fq;
#pragma unroll
        for (int ai = 0; ai < 2; ++ai)
#pragma unroll
            for (int m = 0; m < 4; ++m) {
                const int row = row0 + ai * HALF + m * 16; const float rs = r1[row];
#pragma unroll
                for (int bj = 0; bj < 2; ++bj) {
                    const f32x4 v0 = acc[ai][bj][m][0] * rs, v1 = acc[ai][bj][m][1] * rs;
                    float v[8] = {v0[0], v0[1], v0[2], v0[3], v1[0], v1[1], v1[2], v1[3]};
                    const int c = cl + bj * HALF;
                    if (ct < 22) { *(u32x4*)(proj + (size_t)row * 6656 + ct * 256 + c) = pack8(v); }
                    else if (ct < 26) { const u32x4 w = pack8(v); bf16_t* p = vt + (size_t)((ct - 22) * 256 + c) * 8192 + row;
                        p[0] = (bf16_t)(w.x & 0xffffu); p[8192] = (bf16_t)(w.x >> 16); p[2 * 8192] = (bf16_t)(w.y & 0xffffu); p[3 * 8192] = (bf16_t)(w.y >> 16);
                        p[4 * 8192] = (bf16_t)(w.z & 0xffffu); p[5 * 8192] = (bf16_t)(w.z >> 16); p[6 * 8192] = (bf16_t)(w.w & 0xffffu); p[7 * 8192] = (bf16_t)(w.w >> 16); }
                    else if (ct < 30) {
#pragma unroll
                        for (int i = 0; i < 8; ++i) v[i] = v[i] * fsigmoid(v[i]);
                        *(u32x4*)(proj + (size_t)row * 6656 + (ct - 4) * 256 + c) = pack8(v); }
                    else { const int gc = (ct - 30) * 256 + c; const f32x4 b0 = *(const f32x4*)(gbias + gc), b1 = *(const f32x4*)(gbias + gc + 4);
                        const float bb[8] = {b0[0], b0[1], b0[2], b0[3], b1[0], b1[1], b1[2], b1[3]};
#pragma unroll
                        for (int i = 0; i < 8; ++i) v[i] = fsigmoid(v[i] + bb[i]);
                        *(u32x4*)(gates + (size_t)row * 2048 + gc) = pack8(v); }
                }
            }
    }
};
struct EpiBranch {
    static constexpr bool PERM = true, AFTER_DRAIN = false;
    bf16_t* mixed; const bf16_t* gates; int goff; int add;
    __device__ __forceinline__ void operator()(const f32x4 (&acc)[2][2][4][2], const Unit& u, int wr, int wc, int fr_in, int fq_in) const {
        int fr = fr_in, fq = fq_in; asm volatile("" : "+v"(fr), "+v"(fq));
        const int row0 = u.pm * BM + wr * 64 + fr; const int cl = u.pn * BM + wc * 32 + 8 * fq;
#pragma unroll
        for (int ai = 0; ai < 2; ++ai)
#pragma unroll
            for (int m = 0; m < 4; ++m) {
                const int row = row0 + ai * HALF + m * 16;
#pragma unroll
                for (int bj = 0; bj < 2; ++bj) {
                    const int c = cl + bj * HALF; float g[8], v[8];
                    unpack8(*(const u32x4*)(gates + (size_t)row * 2048 + goff + c), g);
                    const f32x4 v0 = acc[ai][bj][m][0], v1 = acc[ai][bj][m][1];
                    v[0] = v0[0] * g[0]; v[1] = v0[1] * g[1]; v[2] = v0[2] * g[2]; v[3] = v0[3] * g[3]; v[4] = v1[0] * g[4]; v[5] = v1[1] * g[5]; v[6] = v1[2] * g[6]; v[7] = v1[3] * g[7];
                    if (add) { float t[8]; unpack8(*(const u32x4*)(mixed + (size_t)row * 1024 + c), t);
#pragma unroll
                        for (int i = 0; i < 8; ++i) v[i] += t[i]; }
                    *(u32x4*)(mixed + (size_t)row * 1024 + c) = pack8(v);
                }
            }
    }
};
struct EpiOut1 {
    static constexpr bool PERM = true, AFTER_DRAIN = false;
    const float* x; float* out; bf16_t* x1b; float* ss2;
    __device__ __forceinline__ void operator()(const f32x4 (&acc)[2][2][4][2], const Unit& u, int wr, int wc, int fr_in, int fq_in) const {
        int fr = fr_in, fq = fq_in; asm volatile("" : "+v"(fr), "+v"(fq));
        const int row0 = u.pm * BM + wr * 64 + fr; const int cl = u.pn * BM + wc * 32 + 8 * fq;
#pragma unroll
        for (int ai = 0; ai < 2; ++ai)
#pragma unroll
            for (int m = 0; m < 4; ++m) {
                const int row = row0 + ai * HALF + m * 16; float ssq = 0.f;
#pragma unroll
                for (int bj = 0; bj < 2; ++bj) {
                    const size_t off = (size_t)row * 1024 + cl + bj * HALF;
                    const f32x4 o0 = *(const f32x4*)(x + off) + acc[ai][bj][m][0], o1 = *(const f32x4*)(x + off + 4) + acc[ai][bj][m][1];
                    *(f32x4*)(out + off) = o0; *(f32x4*)(out + off + 4) = o1;
                    const float v[8] = {o0[0], o0[1], o0[2], o0[3], o1[0], o1[1], o1[2], o1[3]};
                    *(u32x4*)(x1b + off) = pack8(v);
#pragma unroll
                    for (int i = 0; i < 8; ++i) ssq += v[i] * v[i];
                }
                ssq += __shfl_xor(ssq, 16); ssq += __shfl_xor(ssq, 32);
                if (fq == 0) ss2[(size_t)row * 16 + u.pn * 4 + wc] = ssq;
            }
    }
};
struct EpiUp {
    static constexpr bool PERM = true, AFTER_DRAIN = false;
    bf16_t* U; const float* ss2;
    __device__ __forceinline__ void operator()(const f32x4 (&acc)[2][2][4][2], const Unit& u, int wr, int wc, int fr_in, int fq_in) const {
        int fr = fr_in, fq = fq_in; asm volatile("" : "+v"(fr), "+v"(fq));
        const int row0 = u.pm * BM + wr * 64 + fr; const int cl = u.pn * BM + wc * 32 + 8 * fq;
#pragma unroll
        for (int ai = 0; ai < 2; ++ai)
#pragma unroll
            for (int m = 0; m < 4; ++m) {
                const int row = row0 + ai * HALF + m * 16;
                const f32x4* sp = (const f32x4*)(ss2 + (size_t)row * 16); const f32x4 s0 = sp[0], s1 = sp[1], s2 = sp[2], s3 = sp[3];
                const float s = ((s0[0] + s0[1]) + (s0[2] + s0[3])) + ((s1[0] + s1[1]) + (s1[2] + s1[3])) + ((s2[0] + s2[1]) + (s2[2] + s2[3])) + ((s3[0] + s3[1]) + (s3[2] + s3[3]));
                const float rs = 1.0f / sqrtf(s * (1.0f / 1024.0f) + 1e-6f);
#pragma unroll
                for (int bj = 0; bj < 2; ++bj) {
                    const f32x4 v0 = acc[ai][bj][m][0] * rs, v1 = acc[ai][bj][m][1] * rs;
                    float v[8] = {v0[0], v0[1], v0[2], v0[3], v1[0], v1[1], v1[2], v1[3]};
#pragma unroll
                    for (int i = 0; i < 8; ++i) { const float r = fmaxf(v[i], 0.f); v[i] = r * r; }
                    *(u32x4*)(U + (size_t)row * 4096 + cl + bj * HALF) = pack8(v);
                }
            }
    }
};
struct EpiDown {
    static constexpr bool PERM = true, AFTER_DRAIN = false;
    float* out;
    __device__ __forceinline__ void operator()(const f32x4 (&acc)[2][2][4][2], const Unit& u, int wr, int wc, int fr_in, int fq_in) const {
        int fr = fr_in, fq = fq_in; asm volatile("" : "+v"(fr), "+v"(fq));
        const int row0 = u.pm * BM + wr * 64 + fr; const int cl = u.pn * BM + wc * 32 + 8 * fq;
#pragma unroll
        for (int ai = 0; ai < 2; ++ai)
#pragma unroll
            for (int m = 0; m < 4; ++m) {
                const int row = row0 + ai * HALF + m * 16;
#pragma unroll
                for (int bj = 0; bj < 2; ++bj) {
                    const size_t off = (size_t)row * 1024 + cl + bj * HALF;
                    const f32x4 o0 = *(const f32x4*)(out + off) + acc[ai][bj][m][0], o1 = *(const f32x4*)(out + off + 4) + acc[ai][bj][m][1];
                    *(f32x4*)(out + off) = o0; *(f32x4*)(out + off + 4) = o1;
                }
            }
    }
};
template <class Epi, class Sched, bool ALIGN_EPI = false, bool SP2 = false>
__device__ __forceinline__ void gemm_phase(PG8_LAS unsigned char* lds, const Gemm g, const Sched& S, const Epi& E) {
    int tid_l = threadIdx.x; asm volatile("" : "+v"(tid_l));
    const int tid = tid_l, wid = __builtin_amdgcn_readfirstlane(tid >> 6), lane = tid & 63, wr = wid >> 2, wc = wid & 3, fr = lane & 15, fq = lane >> 4;
    const int K = g.K, nt = K / BK;
    unsigned voffA[2], voffB[2];
#pragma unroll
    for (int i = 0; i < 2; ++i) { int R, C; stage_rc(tid * 16 + i * 8192, R, C); const int Rb = Epi::PERM ? ((R & ~31) + perm32(R & 31)) : R;
        voffA[i] = (unsigned)(R * K + C) * 2u; voffB[i] = (unsigned)(Rb * K + C) * 2u; }
    const size_t kstep = (size_t)(BK * 2);
    const size_t hstep = (size_t)HALF * K * 2;
    const size_t tstep = 2 * hstep;
    const unsigned ldsw = (unsigned)wid * 1024u;
    const int aoff = lds_byte(wr * 64 + fr, fq * 8), boff = lds_byte(wc * 32 + fr, fq * 8);
#define PG8_SA(b, h) (((b) * 2 + (h)) * HTB)
#define PG8_SB(b, h) ((4 + (b) * 2 + (h)) * HTB)
#define PG8_STAGE(bufoff, gbase, voff) do { _Pragma("unroll") for (int _i = 0; _i < 2; ++_i) \
        __builtin_amdgcn_global_load_lds((const unsigned*)((const char*)(gbase) + (voff)[_i]), (PG8_LAS unsigned*)(lds + (bufoff) + ldsw + _i * 8192), 16, 0, 0); } while (0)
#define PG8_LDA(dst, b, h) do { _Pragma("unroll") for (int m = 0; m < 4; ++m) _Pragma("unroll") for (int k = 0; k < 2; ++k) dst[m][k] = *(const PG8_LAS bf16x8*)(lds + PG8_SA(b, h) + aoff + m * 2048 + k * 1024); } while (0)
#define PG8_LDB(dst, b, h) do { _Pragma("unroll") for (int n = 0; n < 2; ++n) _Pragma("unroll") for (int k = 0; k < 2; ++k) dst[n][k] = *(const PG8_LAS bf16x8*)(lds + PG8_SB(b, h) + boff + n * 2048 + k * 1024); } while (0)
#define PG8_MMA(ai, bj, At, Bt) do { __builtin_amdgcn_s_setprio(1); _Pragma("unroll") for (int m = 0; m < 4; ++m) _Pragma("unroll") for (int n = 0; n < 2; ++n) _Pragma("unroll") for (int k = 0; k < 2; ++k) \
        acc[ai][bj][m][n] = __builtin_amdgcn_mfma_f32_16x16x32_bf16(Bt[n][k], At[m][k], acc[ai][bj][m][n], 0, 0, 0); __builtin_amdgcn_s_setprio(0); } while (0)
#define PG8_WAIT_V(n) asm volatile("s_waitcnt vmcnt(" #n ")" ::: "memory")
#define PG8_WAIT_L(n) asm volatile("s_waitcnt lgkmcnt(" #n ")" ::: "memory")
#define PG8_BAR __builtin_amdgcn_s_barrier()
#define PG8_SCHED __builtin_amdgcn_sched_barrier(0)
    Unit cur, nxt; int ui = 0;
    if (!S.next(0, cur)) return;
    f32x4 acc[2][2][4][2];
#pragma unroll
    for (int a = 0; a < 2; ++a)
#pragma unroll
        for (int b = 0; b < 2; ++b)
#pragma unroll
            for (int m = 0; m < 4; ++m)
#pragma unroll
                for (int n = 0; n < 2; ++n) acc[a][b][m][n] = (f32x4){0.f, 0.f, 0.f, 0.f};
    bf16x8 At[4][2], B0[2][2], B1[2][2];
    const char* cA = (const char*)g.A + (size_t)cur.pm * tstep; const char* cB = (const char*)g.Bt + (size_t)cur.pn * tstep;
    S.a_ready(cur);
    if constexpr (SP2) {
        PG8_STAGE(PG8_SB(0, 0), cB, voffB); PG8_STAGE(PG8_SB(0, 1), cB + hstep, voffB); PG8_STAGE(PG8_SA(0, 0), cA, voffA); PG8_STAGE(PG8_SA(0, 1), cA + hstep, voffA);
        if (wr == 1) PG8_BAR;
        PG8_WAIT_V(2); PG8_BAR;
        PG8_STAGE(PG8_SB(1, 0), cB + kstep, voffB); PG8_STAGE(PG8_SA(1, 0), cA + kstep, voffA); PG8_STAGE(PG8_SB(1, 1), cB + hstep + kstep, voffB);
        PG8_WAIT_V(6); PG8_BAR;
    } else {
        PG8_STAGE(PG8_SB(0, 0), cB, voffB); PG8_STAGE(PG8_SA(0, 0), cA, voffA); PG8_STAGE(PG8_SB(0, 1), cB + hstep, voffB); PG8_STAGE(PG8_SA(0, 1), cA + hstep, voffA);
        if (wr == 1) PG8_BAR;
        PG8_WAIT_V(4); PG8_BAR;
        PG8_STAGE(PG8_SB(1, 0), cB + kstep, voffB); PG8_STAGE(PG8_SA(1, 0), cA + kstep, voffA); PG8_STAGE(PG8_SB(1, 1), cB + hstep + kstep, voffB);
        PG8_WAIT_V(6); PG8_BAR;
    }
    for (;;) {
        const bool has_next = S.next(ui + 1, nxt);
        const char* nA = has_next ? (const char*)g.A + (size_t)nxt.pm * tstep : cA; const char* nB = has_next ? (const char*)g.Bt + (size_t)nxt.pn * tstep : cB;
        for (int t = 0; t < nt; t += 2) {
            const bool last = (t == nt - 2);
            const char* a1 = cA + (size_t)(t + 1) * kstep;
            const char* a2 = last ? nA : cA + (size_t)(t + 2) * kstep; const char* b2 = last ? nB : cB + (size_t)(t + 2) * kstep;
            const char* a3 = a2 + kstep; const char* b3 = b2 + kstep;
            if (last && has_next) S.a_ready(nxt);
            if constexpr (SP2) {
            PG8_LDB(B0, 0, 0); PG8_LDB(B1, 0, 1); PG8_SCHED; PG8_LDA(At, 0, 0); PG8_STAGE(PG8_SA(1, 1), a1 + hstep, voffA);
            PG8_WAIT_V(8); PG8_WAIT_L(0); PG8_BAR; PG8_MMA(0, 0, At, B0); PG8_MMA(0, 1, At, B1); PG8_BAR; PG8_SCHED;
            PG8_LDA(At, 0, 1); PG8_STAGE(PG8_SB(0, 0), b2, voffB); PG8_STAGE(PG8_SB(0, 1), b2 + hstep, voffB); PG8_STAGE(PG8_SA(0, 0), a2, voffA);
            PG8_WAIT_V(8); PG8_WAIT_L(0); PG8_BAR; PG8_MMA(1, 0, At, B0); PG8_MMA(1, 1, At, B1); PG8_BAR; PG8_SCHED;
            PG8_LDB(B0, 1, 0); PG8_LDB(B1, 1, 1); PG8_SCHED; PG8_LDA(At, 1, 0); PG8_STAGE(PG8_SA(0, 1), a2 + hstep, voffA);
            PG8_WAIT_V(8); PG8_WAIT_L(0); PG8_BAR; PG8_MMA(0, 0, At, B0); PG8_MMA(0, 1, At, B1); PG8_BAR; PG8_SCHED;
            PG8_LDA(At, 1, 1); PG8_STAGE(PG8_SB(1, 0), b3, voffB); PG8_STAGE(PG8_SB(1, 1), b3 + hstep, voffB); PG8_STAGE(PG8_SA(1, 0), a3, voffA);
            PG8_WAIT_V(8); PG8_WAIT_L(0); PG8_BAR; PG8_MMA(1, 0, At, B0); PG8_MMA(1, 1, At, B1); PG8_BAR; PG8_SCHED;
            } else {
            PG8_LDB(B0, 0, 0); PG8_SCHED; PG8_LDA(At, 0, 0); PG8_STAGE(PG8_SA(1, 1), a1 + hstep, voffA);
            PG8_WAIT_L(8); PG8_BAR; PG8_WAIT_L(0); PG8_MMA(0, 0, At, B0); PG8_BAR; PG8_SCHED;
            PG8_LDB(B1, 0, 1); PG8_STAGE(PG8_SB(0, 0), b2, voffB);
            PG8_BAR; PG8_WAIT_L(0); PG8_MMA(0, 1, At, B1); PG8_BAR;
            PG8_LDA(At, 0, 1); PG8_STAGE(PG8_SA(0, 0), a2, voffA);
            PG8_BAR; PG8_WAIT_L(0); PG8_MMA(1, 0, At, B0); PG8_BAR; PG8_SCHED;
            PG8_STAGE(PG8_SB(0, 1), b2 + hstep, voffB);
            PG8_WAIT_V(6); PG8_BAR; PG8_MMA(1, 1, At, B1); PG8_BAR;
            PG8_LDB(B0, 1, 0); PG8_SCHED; PG8_LDA(At, 1, 0); PG8_STAGE(PG8_SA(0, 1), a2 + hstep, voffA);
            PG8_WAIT_L(8); PG8_BAR; PG8_WAIT_L(0); PG8_MMA(0, 0, At, B0); PG8_BAR; PG8_SCHED;
            PG8_LDB(B1, 1, 1); PG8_STAGE(PG8_SB(1, 0), b3, voffB);
            PG8_BAR; PG8_WAIT_L(0); PG8_MMA(0, 1, At, B1); PG8_BAR;
            PG8_LDA(At, 1, 1); PG8_STAGE(PG8_SA(1, 0), a3, voffA);
            PG8_BAR; PG8_WAIT_L(0); PG8_MMA(1, 0, At, B0); PG8_BAR; PG8_SCHED;
            PG8_STAGE(PG8_SB(1, 1), b3 + hstep, voffB);
            PG8_WAIT_V(6); PG8_BAR; PG8_MMA(1, 1, At, B1); PG8_BAR;
            }
        }
        if constexpr (ALIGN_EPI) { if (wr == 0) PG8_BAR; }
        if constexpr (!Epi::AFTER_DRAIN) { E(acc, cur, wr, wc, fr, fq); S.done(cur); }
        if (!has_next) break;
#pragma unroll
        for (int a = 0; a < 2; ++a)
#pragma unroll
            for (int b = 0; b < 2; ++b)
#pragma unroll
                for (int m = 0; m < 4; ++m)
#pragma unroll
                    for (int n = 0; n < 2; ++n) acc[a][b][m][n] = (f32x4){0.f, 0.f, 0.f, 0.f};
        cur = nxt; cA = nA; cB = nB; ++ui;
        if constexpr (ALIGN_EPI) { if (wr == 1) PG8_BAR; }
    }
    PG8_WAIT_V(0);
    if constexpr (!ALIGN_EPI) { if (wr == 0) PG8_BAR; }
    PG8_BAR;
    if constexpr (Epi::AFTER_DRAIN) { E.fused(acc, cur, wr, wc, fr, fq, lds, wid, lane); S.done(cur); }
#undef PG8_SA
#undef PG8_SB
#undef PG8_STAGE
#undef PG8_LDA
#undef PG8_LDB
#undef PG8_MMA
#undef PG8_WAIT_V
#undef PG8_WAIT_L
#undef PG8_BAR
#undef PG8_SCHED
}
}
#define LAS __attribute__((address_space(3)))
#define GAS __attribute__((address_space(1)))
typedef unsigned short bf16;
typedef unsigned v4u __attribute__((ext_vector_type(4)));
typedef float f32x4 __attribute__((ext_vector_type(4)));
constexpr int NWAVES = 8, NTHREADS = 512;
constexpr int SEQ = 8192, DM = 1024, MTOK = 16384, DIN = 9744, N1 = 9728, PLD = 6656, FF = 4096;
constexpr float EPS = 1e-6f;
constexpr size_t MiB = 1u << 20;
constexpr size_t WS_WIN = 1 * MiB, WS_WA = 20 * MiB, WS_WB = 21 * MiB, WS_WO = 23 * MiB, WS_WUP = 25 * MiB, WS_WDN = 33 * MiB;
constexpr size_t WS_XB = 41 * MiB, WS_PROJ = 73 * MiB, WS_VT = 177 * MiB, WS_A1 = 193 * MiB, WS_A2 = 209 * MiB;
constexpr size_t WS_R1 = 241 * MiB, WS_PA = 242 * MiB, WS_SS2 = 243 * MiB, WS_MISC = 244 * MiB;
constexpr size_t WS_MIXED = 73 * MiB, WS_U = 73 * MiB, WS_END = 256 * MiB;
constexpr int LDS_BYTES = 155648, LDS_BARST = 155584;
constexpr size_t WS_BAR = 0;

__device__ __forceinline__ float bf2f(bf16 h) { return __uint_as_float(((unsigned)h) << 16); }
__device__ __forceinline__ unsigned f2bf(float f) { unsigned u = __builtin_bit_cast(unsigned, f); return (u + 0x7fffu + ((u >> 16) & 1u)) >> 16; }
__device__ __forceinline__ unsigned pk2(float lo, float hi) { return f2bf(lo) | (f2bf(hi) << 16); }
__device__ __forceinline__ float wave_sum(float v) {
#pragma unroll
    for (int o = 1; o < 64; o <<= 1) v += __shfl_xor(v, o);
    return v;
}
__device__ __forceinline__ float log_sigmoid(float x) { return fminf(x, 0.f) - log1pf(__expf(-fabsf(x))); }

#ifndef REPMASK
#define REPMASK 0
#endif
struct Args { const float* in[15]; float* out; unsigned char* ws; int ph_lo, ph_hi, rep, pad; };

__device__ __forceinline__ void p0_transpose_item(const float* W, int ldw, int srccol0, const float* kscale, int kmask, float cscale,
                                                  bf16* WT, int K, int dstrow0, int k0, LAS float* scr, int lane) {
#pragma unroll 8
    for (int i = 0; i < 32; ++i) { const int kk = 2 * i + (lane >> 5); const float ks = kscale ? kscale[(k0 + kk) & kmask] * cscale : cscale;
        scr[kk * 33 + (lane & 31)] = W[(size_t)(k0 + kk) * ldw + srccol0 + (lane & 31)] * ks; }
    asm volatile("s_waitcnt lgkmcnt(0)" ::: "memory");
    const int c = lane & 7;
#pragma unroll
    for (int j = 0; j < 4; ++j) { const int n = (lane >> 3) + 8 * j; const LAS float* s = scr + (8 * c) * 33 + n;
        v4u o; o.x = pk2(s[0 * 33], s[1 * 33]); o.y = pk2(s[2 * 33], s[3 * 33]); o.z = pk2(s[4 * 33], s[5 * 33]); o.w = pk2(s[6 * 33], s[7 * 33]);
        *(v4u*)(WT + (size_t)(dstrow0 + n) * K + k0 + 8 * c) = o; }
    asm volatile("s_waitcnt lgkmcnt(0)" ::: "memory");
}


#define XB_TMO      128
#define XB_XCNT(j)  (256  + 64 * (j))
#define XB_XSUB(j)  (1280 + 64 * (j))
#define XB_XGEN(j)  (2304 + 64 * (j))
#define XB_TOP      3328
#define XB_TOPGEN   3392
#define XCD_BAR_WORDS 3456
#define XB_SPIN_CAP (1u << 18)

__device__ __forceinline__ unsigned xb_ld(unsigned* p)              { return __hip_atomic_load(p, __ATOMIC_RELAXED, __HIP_MEMORY_SCOPE_AGENT); }
__device__ __forceinline__ unsigned xb_add(unsigned* p, unsigned v) { return __hip_atomic_fetch_add(p, v, __ATOMIC_RELAXED, __HIP_MEMORY_SCOPE_AGENT); }
__device__ __forceinline__ unsigned xb_xcc_id() { return (unsigned)__builtin_amdgcn_s_getreg((3 << 11) | 20) & 0xFu; }
#define XB_SPIN(cond, bar) do { unsigned _sp = 0; while (cond) { __builtin_amdgcn_s_sleep(1); \
    if ((++_sp & 255u) == 0u) { if (xb_ld(&(bar)[XB_TMO])) break; if (_sp > XB_SPIN_CAP) { atomicAdd(&(bar)[XB_TMO], 1u); break; } } } } while (0)

struct XcdBarrier {
    unsigned* bar; unsigned x;
    volatile LAS unsigned* st;
};

__device__ __forceinline__ XcdBarrier xcd_barrier_post(unsigned* bar, volatile LAS unsigned* st) {
    XcdBarrier b; b.bar = bar; b.x = xb_xcc_id(); b.st = st;
    if (threadIdx.x == 0) (void)xb_add(&bar[XB_XCNT(b.x)], 1u);
    return b;
}
__device__ __forceinline__ void xcd_barrier_complete(unsigned* bar, unsigned x, unsigned& nloc, unsigned& nx) {
    const unsigned G = gridDim.x * gridDim.y * gridDim.z;
    unsigned sum, cnt, mine, sp = 0u;
    for (;;) {
        sum = 0u; cnt = 0u; mine = 0u;
#pragma unroll
        for (unsigned j = 0; j < 16; ++j) { const unsigned c = xb_ld(&bar[XB_XCNT(j)]); sum += c; cnt += (c > 0u) ? 1u : 0u; mine = (j == x) ? c : mine; }
        if (sum == G) break;
        __builtin_amdgcn_s_sleep(1);
        if ((++sp & 255u) == 0u) { if (xb_ld(&bar[XB_TMO])) break; if (sp > XB_SPIN_CAP) { atomicAdd(&bar[XB_TMO], 1u); break; } }
    }
    nloc = mine > 0u ? mine : 1u; nx = cnt > 0u ? cnt : 1u;
}

__device__ __forceinline__ void xcd_barrier(const XcdBarrier& b) {
    asm volatile("s_waitcnt vmcnt(0)" ::: "memory");
    __syncthreads();
    if (threadIdx.x == 0) {
        unsigned* bar = b.bar;
        __builtin_amdgcn_s_waitcnt(0);
        unsigned nloc = b.st[0], nx = b.st[1];
        if (nloc == 0u) { xcd_barrier_complete(bar, b.x, nloc, nx); b.st[0] = nloc; b.st[1] = nx; }
        const unsigned old = xb_add(&bar[XB_XSUB(b.x)], 1u);
        const unsigned gen = old / nloc;
        if (old + 1u == (gen + 1u) * nloc) {
            __builtin_amdgcn_fence(__ATOMIC_RELEASE, "agent");
            asm volatile("s_waitcnt vmcnt(0)" ::: "memory");
            const unsigned og = xb_add(&bar[XB_TOP], 1u);
            const unsigned tg = og / nx;
            if (og + 1u == (tg + 1u) * nx) xb_add(&bar[XB_TOPGEN], 1u);
            else XB_SPIN(xb_ld(&bar[XB_TOPGEN]) == tg, bar);
            __builtin_amdgcn_fence(__ATOMIC_ACQUIRE, "agent");
            xb_add(&bar[XB_XGEN(b.x)], 1u);
            asm volatile("s_waitcnt vmcnt(0)" ::: "memory");
        } else {
            XB_SPIN(xb_ld(&bar[XB_XGEN(b.x)]) == gen, bar);
            __builtin_amdgcn_fence(__ATOMIC_ACQUIRE, "agent");
            asm volatile("s_waitcnt vmcnt(0)" ::: "memory");
        }
    }
    __syncthreads();
}

typedef short bf16x8_t __attribute__((ext_vector_type(8)));
typedef short s16x4_t __attribute__((ext_vector_type(4)));
constexpr int AT_PITCH = 144;
constexpr int AT_KL = 0, AT_VL = 256 * AT_PITCH;
constexpr int N_ATT_ITEMS = 1536;
struct AttnRegs { v4u k[4], v[4], q[2]; };
__device__ __forceinline__ void attn_decode(int it, int& g, int& slot, int& d, int& r, int& n) {
    g = it >> 9; const int rem = it & 511; slot = rem & 7; const int rest = rem >> 3; const int sh = 2 * g; d = 1 << sh; r = rest >> (6 - sh); n = rest & ((64 >> sh) - 1);
}
__device__ __forceinline__ void attn_prefetch(AttnRegs& R, const bf16* PROJ_, int it, int tid, int wave, int lane) {
    int g, slot, d, r, n; attn_decode(it, g, slot, d, r, n); const int hd = g * 8 + slot; const int c = tid & 7;
#pragma unroll
    for (int p = 0; p < 4; ++p) { const int row = p * 64 + (tid >> 3); const int sp = (n - 1) * 128 + row;
        if (n > 0 || p >= 2) { const GAS bf16* base = (const GAS bf16*)PROJ_ + (size_t)(sp * d + r) * PLD + hd * 64 + c * 8; R.k[p] = *(const GAS v4u*)(base + 1536); R.v[p] = *(const GAS v4u*)(base + 3072); }
        else { R.k[p] = (v4u){0u, 0u, 0u, 0u}; R.v[p] = (v4u){0u, 0u, 0u, 0u}; } }
    const int fr = lane & 15, fq = lane >> 4; const GAS bf16* qb = (const GAS bf16*)PROJ_ + (size_t)((n * 128 + 16 * wave + fr) * d + r) * PLD + hd * 64 + 8 * fq;
    R.q[0] = *(const GAS v4u*)(qb); R.q[1] = *(const GAS v4u*)(qb + 32);
}
__device__ __forceinline__ void attn_stage(const AttnRegs& R, LAS unsigned char* lds, const float (&gkr)[8], int tid) {
    const int c = tid & 7;
#pragma unroll
    for (int p = 0; p < 4; ++p) { const int row = p * 64 + (tid >> 3); float f[8]; pg8::unpack8(R.k[p], f); float ss = 0.f;
#pragma unroll
        for (int i = 0; i < 8; ++i) ss += f[i] * f[i];
        ss += __shfl_xor(ss, 1); ss += __shfl_xor(ss, 2); ss += __shfl_xor(ss, 4);
        const float rs = 1.0f / sqrtf(ss * (1.0f / 64.0f) + EPS);
#pragma unroll
        for (int i = 0; i < 8; ++i) f[i] = f[i] * rs * gkr[i];
        *(LAS v4u*)(lds + AT_KL + row * AT_PITCH + c * 16) = pg8::pack8(f);
        *(LAS v4u*)(lds + AT_VL + row * AT_PITCH + c * 16) = R.v[p]; }
}
__device__ __forceinline__ void attn_compute(const AttnRegs& R, LAS unsigned char* lds, bf16* PROJ_, float* ML_, const float (&gqr)[16], int it, int wave, int lane, bool do_store) {
    int g, slot, d, r, n; attn_decode(it, g, slot, d, r, n); const int hd = g * 8 + slot;
    const int fr = lane & 15, fq = lane >> 4, w = wave;
    float qf[16]; { float t0[8], t1[8]; pg8::unpack8(R.q[0], t0); pg8::unpack8(R.q[1], t1);
#pragma unroll
        for (int i = 0; i < 8; ++i) { qf[i] = t0[i]; qf[8 + i] = t1[i]; } }
    float ss = 0.f;
#pragma unroll
    for (int i = 0; i < 16; ++i) ss += qf[i] * qf[i];
    ss += __shfl_xor(ss, 16); ss += __shfl_xor(ss, 32);
    const float qs = (1.0f / sqrtf(ss * (1.0f / 64.0f) + EPS)) * (0.125f * 1.4426950408889634f);
    bf16x8_t qa[2];
    { float t0[8], t1[8];
#pragma unroll
      for (int i = 0; i < 8; ++i) { t0[i] = qf[i] * qs * gqr[i]; t1[i] = qf[8 + i] * qs * gqr[8 + i]; }
      qa[0] = __builtin_bit_cast(bf16x8_t, pg8::pack8(t0)); qa[1] = __builtin_bit_cast(bf16x8_t, pg8::pack8(t1)); }
    f32x4 sc[9];
#pragma unroll
    for (int kti = 0; kti < 9; ++kti) { f32x4 acc = (f32x4){0.f, 0.f, 0.f, 0.f}; const LAS unsigned char* kp = lds + AT_KL + ((w + kti) * 16 + fr) * AT_PITCH + fq * 16;
#pragma unroll
        for (int ks = 0; ks < 2; ++ks) { const bf16x8_t kf = *(const LAS bf16x8_t*)(kp + ks * 64); acc = __builtin_amdgcn_mfma_f32_16x16x32_bf16(kf, qa[ks], acc, 0, 0, 0); }
        sc[kti] = acc; if (kti % 3 == 2) __builtin_amdgcn_sched_barrier(0); }
    float mx = -INFINITY;
#pragma unroll
    for (int j = 0; j < 4; ++j) { if (4 * fq + j < fr) sc[0][j] = -INFINITY; if (4 * fq + j > fr) sc[8][j] = -INFINITY; }
#pragma unroll
    for (int kti = 0; kti < 9; ++kti) { if (n == 0 && w + kti < 8) sc[kti] = (f32x4){-INFINITY, -INFINITY, -INFINITY, -INFINITY};
#pragma unroll
        for (int j = 0; j < 4; ++j) mx = fmaxf(mx, sc[kti][j]); }
    mx = fmaxf(mx, __shfl_xor(mx, 16)); mx = fmaxf(mx, __shfl_xor(mx, 32));
    float den = 0.f;
#pragma unroll
    for (int kti = 0; kti < 9; ++kti)
#pragma unroll
        for (int j = 0; j < 4; ++j) { const float pv = __builtin_amdgcn_exp2f(sc[kti][j] - mx); sc[kti][j] = pv; den += pv; }
    den += __shfl_xor(den, 16); den += __shfl_xor(den, 32);
    __builtin_amdgcn_sched_barrier(0);
    f32x4 o[4];
#pragma unroll
    for (int et = 0; et < 4; ++et) o[et] = (f32x4){0.f, 0.f, 0.f, 0.f};
    const int q_ = (lane >> 2) & 3, p_ = lane & 3;
#pragma unroll
    for (int kk = 0; kk < 5; ++kk) { const int kt0 = w + 2 * kk, kt1 = (kk < 4) ? kt0 + 1 : kt0;
        v4u aw; aw.x = pg8::cvt_pk_bf16(sc[2 * kk][0], sc[2 * kk][1]); aw.y = pg8::cvt_pk_bf16(sc[2 * kk][2], sc[2 * kk][3]);
        if (kk < 4) { aw.z = pg8::cvt_pk_bf16(sc[(kk < 4) ? 2 * kk + 1 : 0][0], sc[(kk < 4) ? 2 * kk + 1 : 0][1]); aw.w = pg8::cvt_pk_bf16(sc[(kk < 4) ? 2 * kk + 1 : 0][2], sc[(kk < 4) ? 2 * kk + 1 : 0][3]); } else { aw.z = 0u; aw.w = 0u; }
        const bf16x8_t af = __builtin_bit_cast(bf16x8_t, aw);
        const LAS unsigned char* v0 = lds + AT_VL + (kt0 * 16 + 4 * fq + q_) * AT_PITCH + p_ * 8; const LAS unsigned char* v1 = lds + AT_VL + (kt1 * 16 + 4 * fq + q_) * AT_PITCH + p_ * 8;
#pragma unroll
        for (int et = 0; et < 4; ++et) {
            const s16x4_t lo = __builtin_bit_cast(s16x4_t, __builtin_amdgcn_ds_read_tr16_b64_v4i16((LAS s16x4_t*)(v0 + et * 32)));
            const s16x4_t hi = __builtin_bit_cast(s16x4_t, __builtin_amdgcn_ds_read_tr16_b64_v4i16((LAS s16x4_t*)(v1 + et * 32)));
            const bf16x8_t bfr = (bf16x8_t){lo[0], lo[1], lo[2], lo[3], hi[0], hi[1], hi[2], hi[3]};
            o[et] = __builtin_amdgcn_mfma_f32_16x16x32_bf16(af, bfr, o[et], 0, 0, 0); }
        __builtin_amdgcn_sched_barrier(0); }
    if (do_store)
#pragma unroll
    for (int j = 0; j < 4; ++j) { GAS bf16* op = (GAS bf16*)PROJ_ + (size_t)((n * 128 + 16 * w + 4 * fq + j) * d + r) * PLD + hd * 64 + fr;
#pragma unroll
        for (int et = 0; et < 4; ++et) op[et * 16] = (bf16)f2bf(o[et][j]); }
    if (fq == 0) { GAS float* mp = (GAS float*)ML_ + (size_t)((n * 128 + 16 * w + fr) * d + r) * 48 + (g * 8 + slot) * 2; mp[0] = mx; mp[1] = den; }
}


constexpr int GL_QG = 0, GL_KG = 17408, GL_KDT = 34816, GL_VTL = 53248, GL_PL = 90112, GL_EB = 99328, GL_PAL = 99840, GL_GT = 103936, GL_SSQ = 105984, GL_RS = 108032;
typedef unsigned u32x2_t __attribute__((ext_vector_type(2)));
template <bool FULL>
__device__ __forceinline__ void gla_item(LAS unsigned char* lds, int b, int item, const bf16* PROJ_, const bf16* VT_, const float* PA_, const float* gate_up_, const float* gate_bias_,
                                         float* SBUF_, float* DBUF_, bf16* A2_, int tid_in, int wave, int lane_in) {
    int tid = tid_in, lane = lane_in; asm volatile("" : "+v"(tid), "+v"(lane));
    const int h = item >> 5, seg = item & 31;
    const int kd = tid & 127, tq = tid >> 7, fr = lane & 15, fq = lane >> 4, w = wave;
    float upr[16];
#pragma unroll
    for (int r = 0; r < 16; ++r) upr[r] = gate_up_[r * 512 + h * 128 + kd];
    const float bk = gate_bias_[h * 128 + kd];
    f32x4 S[8][2];
#pragma unroll
    for (int mtk = 0; mtk < 8; ++mtk)
#pragma unroll
        for (int nt = 0; nt < 2; ++nt)
#pragma unroll
            for (int j = 0; j < 4; ++j) S[mtk][nt][j] = FULL ? ((const GAS float*)SBUF_)[((size_t)item * 64 + (mtk * 2 + nt) * 4 + j) * 512 + tid] : 0.f;
    float segsum = 0.f;
    for (int c = 0; c < 4; ++c) {
        const int tok0 = seg * 256 + c * 64;
        { const GAS float* pap = (const GAS float*)PA_ + (size_t)(b * SEQ + tok0) * 16; LAS float* PAL = (LAS float*)(lds + GL_PAL); PAL[tid] = pap[tid]; PAL[tid + 512] = pap[tid + 512];
#pragma unroll
          for (int i = 0; i < 4; ++i) { const int piece = tid + 512 * i, v = piece >> 3, cc = piece & 7;
              *(LAS v4u*)(lds + GL_VTL + v * 144 + cc * 16) = *(const GAS v4u*)((const GAS bf16*)VT_ + (size_t)(h * 256 + v) * SEQ + tok0 + cc * 8); } }
        unsigned short kraw[16], qraw[16];
#pragma unroll
        for (int i = 0; i < 16; ++i) { const GAS bf16* rp = (const GAS bf16*)PROJ_ + (size_t)(tok0 + 16 * tq + i) * PLD + h * 128 + kd; kraw[i] = rp[5120]; qraw[i] = FULL ? rp[4608] : (unsigned short)0; }
        __syncthreads();
        float cb[16];
        { const LAS f32x4* pl = (const LAS f32x4*)(lds + GL_PAL); float run = 0.f;
#pragma unroll
          for (int i = 0; i < 16; ++i) { const int t = 16 * tq + i; float lg = bk;
#pragma unroll
              for (int q4 = 0; q4 < 4; ++q4) { const f32x4 pv = pl[t * 4 + q4]; lg += pv[0] * upr[4 * q4] + pv[1] * upr[4 * q4 + 1] + pv[2] * upr[4 * q4 + 2] + pv[3] * upr[4 * q4 + 3]; }
              run += log_sigmoid(lg) * (1.0f / 16.0f); cb[i] = run; } }
        { LAS float* GT = (LAS float*)(lds + GL_GT); GT[tq * 128 + kd] = cb[15]; }
        __syncthreads();
        float off = 0.f, tot = 0.f;
        { const LAS float* GT = (const LAS float*)(lds + GL_GT);
#pragma unroll
          for (int q = 0; q < 4; ++q) { const float gv = GT[q * 128 + kd]; tot += gv; off += (q < tq) ? gv : 0.f; } }
        { float kdv[16];
#pragma unroll
          for (int i = 0; i < 16; ++i) { const float bc = cb[i] + off; const float kf = bf2f(kraw[i]); kdv[i] = kf * __expf(tot - bc);
              if (FULL) { const int t = 16 * tq + i;
                  *(LAS unsigned short*)(lds + GL_QG + t * 272 + kd * 2) = (unsigned short)f2bf(bf2f(qraw[i]) * __expf(bc));
                  *(LAS unsigned short*)(lds + GL_KG + t * 272 + kd * 2) = (unsigned short)f2bf(kf * __expf(-bc)); } }
          float lo8[8], hi8[8];
#pragma unroll
          for (int i = 0; i < 8; ++i) { lo8[i] = kdv[i]; hi8[i] = kdv[8 + i]; }
          *(LAS v4u*)(lds + GL_KDT + kd * 144 + tq * 32) = pg8::pack8(lo8); *(LAS v4u*)(lds + GL_KDT + kd * 144 + tq * 32 + 16) = pg8::pack8(hi8); }
        if (tq == 0) ((LAS float*)(lds + GL_EB))[kd] = __expf(tot);
        segsum += tot;
        __syncthreads();
        if (FULL) {
            const int mt = w >> 1;
#pragma unroll
            for (int sti = 0; sti < 2; ++sti) { const int st = 2 * (w & 1) + sti; f32x4 acc = (f32x4){0.f, 0.f, 0.f, 0.f};
                if (st <= mt) {
#pragma unroll
                    for (int ks = 0; ks < 4; ++ks) { const bf16x8_t kf = *(const LAS bf16x8_t*)(lds + GL_KG + (16 * st + fr) * 272 + (32 * ks + 8 * fq) * 2);
                        const bf16x8_t qf = *(const LAS bf16x8_t*)(lds + GL_QG + (16 * mt + fr) * 272 + (32 * ks + 8 * fq) * 2);
                        acc = __builtin_amdgcn_mfma_f32_16x16x32_bf16(kf, qf, acc, 0, 0, 0); }
                    if (st == mt) {
#pragma unroll
                        for (int j = 0; j < 4; ++j) if (4 * fq + j > fr) acc[j] = 0.f; } }
                u32x2_t wv; wv.x = pg8::cvt_pk_bf16(acc[0], acc[1]); wv.y = pg8::cvt_pk_bf16(acc[2], acc[3]);
                *(LAS u32x2_t*)(lds + GL_PL + (16 * mt + fr) * 144 + (16 * st + 4 * fq) * 2) = wv; }
            __syncthreads();
        }
        bf16x8_t vf[2][2];
#pragma unroll
        for (int ks2 = 0; ks2 < 2; ++ks2)
#pragma unroll
            for (int nt = 0; nt < 2; ++nt) vf[ks2][nt] = *(const LAS bf16x8_t*)(lds + GL_VTL + (32 * w + 16 * nt + fr) * 144 + (32 * ks2 + 8 * fq) * 2);
        f32x4 o[4][2];
        if (FULL) {
#pragma unroll
            for (int mt = 0; mt < 4; ++mt) { o[mt][0] = (f32x4){0.f, 0.f, 0.f, 0.f}; o[mt][1] = (f32x4){0.f, 0.f, 0.f, 0.f}; }
#pragma unroll
            for (int ks = 0; ks < 4; ++ks) { bf16x8_t bfr[2];
#pragma unroll
                for (int nt = 0; nt < 2; ++nt) { v4u wv; wv.x = pg8::cvt_pk_bf16(S[2 * ks][nt][0], S[2 * ks][nt][1]); wv.y = pg8::cvt_pk_bf16(S[2 * ks][nt][2], S[2 * ks][nt][3]);
                    wv.z = pg8::cvt_pk_bf16(S[2 * ks + 1][nt][0], S[2 * ks + 1][nt][1]); wv.w = pg8::cvt_pk_bf16(S[2 * ks + 1][nt][2], S[2 * ks + 1][nt][3]); bfr[nt] = __builtin_bit_cast(bf16x8_t, wv); }
#pragma unroll
                for (int mt = 0; mt < 4; ++mt) { const u32x2_t a0 = *(const LAS u32x2_t*)(lds + GL_QG + (16 * mt + fr) * 272 + (32 * ks + 4 * fq) * 2), a1 = *(const LAS u32x2_t*)(lds + GL_QG + (16 * mt + fr) * 272 + (32 * ks + 16 + 4 * fq) * 2);
                    const v4u aw = (v4u){a0.x, a0.y, a1.x, a1.y}; const bf16x8_t af = __builtin_bit_cast(bf16x8_t, aw);
                    o[mt][0] = __builtin_amdgcn_mfma_f32_16x16x32_bf16(af, bfr[0], o[mt][0], 0, 0, 0); o[mt][1] = __builtin_amdgcn_mfma_f32_16x16x32_bf16(af, bfr[1], o[mt][1], 0, 0, 0); } }
#pragma unroll
            for (int ks2 = 0; ks2 < 2; ++ks2)
#pragma unroll
                for (int mt = 0; mt < 4; ++mt) { const bf16x8_t pf = *(const LAS bf16x8_t*)(lds + GL_PL + (16 * mt + fr) * 144 + (32 * ks2 + 8 * fq) * 2);
                    o[mt][0] = __builtin_amdgcn_mfma_f32_16x16x32_bf16(pf, vf[ks2][0], o[mt][0], 0, 0, 0); o[mt][1] = __builtin_amdgcn_mfma_f32_16x16x32_bf16(pf, vf[ks2][1], o[mt][1], 0, 0, 0); }
        }
#pragma unroll
        for (int mtk = 0; mtk < 8; ++mtk) { const f32x4 eb = *(const LAS f32x4*)(lds + GL_EB + (16 * mtk + 4 * fq) * 4);
            S[mtk][0] = S[mtk][0] * eb; S[mtk][1] = S[mtk][1] * eb;
#pragma unroll
            for (int ks2 = 0; ks2 < 2; ++ks2) { const bf16x8_t kf = *(const LAS bf16x8_t*)(lds + GL_KDT + (16 * mtk + fr) * 144 + (32 * ks2 + 8 * fq) * 2);
                S[mtk][0] = __builtin_amdgcn_mfma_f32_16x16x32_bf16(kf, vf[ks2][0], S[mtk][0], 0, 0, 0); S[mtk][1] = __builtin_amdgcn_mfma_f32_16x16x32_bf16(kf, vf[ks2][1], S[mtk][1], 0, 0, 0); } }
        if (FULL) {
#pragma unroll
            for (int mt = 0; mt < 4; ++mt)
#pragma unroll
                for (int j = 0; j < 4; ++j) { float sq = o[mt][0][j] * o[mt][0][j] + o[mt][1][j] * o[mt][1][j];
                    sq += __shfl_xor(sq, 1); sq += __shfl_xor(sq, 2); sq += __shfl_xor(sq, 4); sq += __shfl_xor(sq, 8);
                    if (fr == 0) ((LAS float*)(lds + GL_SSQ))[w * 64 + 16 * mt + 4 * fq + j] = sq; }
            __syncthreads();
            if (tid < 64) { const LAS float* sp = (const LAS float*)(lds + GL_SSQ); float tsum = 0.f;
#pragma unroll
                for (int q = 0; q < 8; ++q) tsum += sp[q * 64 + tid];
                ((LAS float*)(lds + GL_RS))[tid] = 1.0f / sqrtf(tsum * (1.0f / 256.0f) + EPS); }
            __syncthreads();
#pragma unroll
            for (int mt = 0; mt < 4; ++mt) { const f32x4 rs = *(const LAS f32x4*)(lds + GL_RS + (16 * mt + 4 * fq) * 4);
#pragma unroll
                for (int j = 0; j < 4; ++j)
#pragma unroll
                    for (int nt = 0; nt < 2; ++nt) *(LAS unsigned short*)(lds + (16 * mt + 4 * fq + j) * 528 + (32 * w + 16 * nt + fr) * 2) = (unsigned short)f2bf(o[mt][nt][j] * rs[j]); }
            __syncthreads();
#pragma unroll
            for (int i = 0; i < 4; ++i) { const int piece = tid + 512 * i, t = piece >> 5, c8 = piece & 31; float ov[8], rv[8];
                pg8::unpack8(*(const LAS v4u*)(lds + t * 528 + c8 * 16), ov);
                pg8::unpack8(*(const GAS v4u*)((const GAS bf16*)PROJ_ + (size_t)(tok0 + t) * PLD + 5632 + h * 256 + c8 * 8), rv);
#pragma unroll
                for (int e = 0; e < 8; ++e) ov[e] *= rv[e];
                *(GAS v4u*)((GAS bf16*)A2_ + (size_t)(b * SEQ + tok0 + t) * DM + h * 256 + c8 * 8) = pg8::pack8(ov); }
        } else {
            __syncthreads();
        }
    }
    if (!FULL) {
#pragma unroll
        for (int mtk = 0; mtk < 8; ++mtk)
#pragma unroll
            for (int nt = 0; nt < 2; ++nt)
#pragma unroll
                for (int j = 0; j < 4; ++j) ((GAS float*)SBUF_)[((size_t)item * 64 + (mtk * 2 + nt) * 4 + j) * 512 + tid] = S[mtk][nt][j];
        if (tq == 0) ((GAS float*)DBUF_)[item * 128 + kd] = __expf(segsum);
    }
}

__global__ void __launch_bounds__(NTHREADS, 2) fwd_kernel(Args a) {
    extern __shared__ __attribute__((aligned(16))) unsigned char lds_raw[];
    LAS unsigned char* lds = (LAS unsigned char*)lds_raw;
    cg::grid_group grid = cg::this_grid();
    const int tid = threadIdx.x, lane = tid & 63, wave = __builtin_amdgcn_readfirstlane(tid >> 6);
    const int G = gridDim.x, bx = blockIdx.x;
    const int gw = bx * NWAVES + wave, NGW = G * NWAVES;
    unsigned char* ws = a.ws;
    const float* x = a.in[0]; const float* g1 = a.in[1]; const float* w_in = a.in[2]; const float* gq = a.in[3]; const float* gk = a.in[4];
    const float* gate_up = a.in[5]; const float* gate_bias = a.in[6]; const float* gla_g = a.in[7]; const float* bgate_bias = a.in[8];
    const float* w_ab = a.in[9]; const float* w_gb = a.in[10]; const float* w_out = a.in[11]; const float* g2 = a.in[12]; const float* w_up = a.in[13]; const float* w_dn = a.in[14];
    bf16* WIN = (bf16*)(ws + WS_WIN); bf16* WA = (bf16*)(ws + WS_WA); bf16* WB = (bf16*)(ws + WS_WB); bf16* WO = (bf16*)(ws + WS_WO);
    bf16* WUP = (bf16*)(ws + WS_WUP); bf16* WDN = (bf16*)(ws + WS_WDN); bf16* XB = (bf16*)(ws + WS_XB); bf16* PROJ = (bf16*)(ws + WS_PROJ);
    bf16* VT = (bf16*)(ws + WS_VT); bf16* A1 = (bf16*)(ws + WS_A1); bf16* A2 = (bf16*)(ws + WS_A2);
    float* R1 = (float*)(ws + WS_R1); float* PA = (float*)(ws + WS_PA); float* SS2 = (float*)(ws + WS_SS2);
    bf16* MIXED = (bf16*)(ws + WS_MIXED); bf16* UB = (bf16*)(ws + WS_U); bf16* GATES = (bf16*)a.out;
    const int lo = a.ph_lo, hi = a.ph_hi; const int repm = a.rep;
    if (tid < 16) ((LAS unsigned*)(lds + LDS_BARST))[tid] = 0u;
    if (bx == 0 && a.ph_lo == 0) for (int i = tid; i < XCD_BAR_WORDS; i += NTHREADS) ((unsigned*)(ws + WS_BAR))[i] = 0u;
    __syncthreads();
#define NREP(bit) (((repm >> (bit)) & 1) + 1)
#define IN(k) (lo <= (k) && (k) < hi)
#define LAUNDER(p) asm volatile("" : "+s"(p))
#define XBAR_OBJ(bb) XcdBarrier bb; bb.bar = (unsigned*)(ws + WS_BAR); bb.x = xb_xcc_id(); bb.st = (volatile LAS unsigned*)(lds + LDS_BARST)
#define SYNC(k) do { if (IN(k) && IN((k) + 1)) { asm volatile("s_waitcnt vmcnt(0) lgkmcnt(0)" ::: "memory"); \
        if ((k) == 0) { grid.sync(); if (threadIdx.x == 0) (void)xb_add((unsigned*)(ws + WS_BAR) + XB_XCNT(xb_xcc_id()), 1u); } \
        else { XBAR_OBJ(bb_); xcd_barrier(bb_); } } } while (0)

    if (IN(0)) for (int rep_ = 0; rep_ < NREP(0); ++rep_) {
        LAS float* scr = (LAS float*)(lds + 81920 + wave * 8448);
        constexpr int I_IN = 16 * 304, I_A = 8 * 32, I_B = 16 * 32, I_O = 16 * 32, I_UP = 16 * 128, I_DN = 64 * 32;
        constexpr int NITEMS = I_IN + I_A + I_B + I_O + I_UP + I_DN;
        for (int it = gw; it < NITEMS; it += NGW) {
            int r = it;
            if (r < I_IN) { const int kb = r / 304, nb = r % 304; const int n0 = nb * 32; const int src = n0 < 7680 ? n0 : n0 + 16;
                const float cs = (n0 >= 4608 && n0 < 5120) ? 0.08838834764831845f : 1.0f;
                p0_transpose_item(w_in, DIN, src, g1, 1023, cs, WIN, 1024, n0, kb * 64, scr, lane); continue; } r -= I_IN;
            if (r < I_A) { const int kb = r / 32, nb = r % 32; p0_transpose_item(w_ab, 1024, nb * 32, nullptr, 0, 1.0f, WA, 512, nb * 32, kb * 64, scr, lane); continue; } r -= I_A;
            if (r < I_B) { const int kb = r / 32, nb = r % 32; p0_transpose_item(w_gb, 1024, nb * 32, gla_g, 255, 1.0f, WB, 1024, nb * 32, kb * 64, scr, lane); continue; } r -= I_B;
            if (r < I_O) { const int kb = r / 32, nb = r % 32; p0_transpose_item(w_out, 1024, nb * 32, nullptr, 0, 1.0f, WO, 1024, nb * 32, kb * 64, scr, lane); continue; } r -= I_O;
            if (r < I_UP) { const int kb = r / 128, nb = r % 128; p0_transpose_item(w_up, 4096, nb * 32, g2, 1023, 1.0f, WUP, 1024, nb * 32, kb * 64, scr, lane); continue; } r -= I_UP;
            { const int kb = r / 32, nb = r % 32; p0_transpose_item(w_dn, 1024, nb * 32, nullptr, 0, 1.0f, WDN, 4096, nb * 32, kb * 64, scr, lane); }
        }
        LAS float* WAl = (LAS float*)lds;
        for (int idx = tid; idx < 1024 * 16; idx += NTHREADS) { const int k = idx >> 4, r = idx & 15; const int rho = ((k >> 8) * 4 + (k & 3)) * 64 + ((k >> 2) & 63);
            WAl[rho * 20 + r] = w_in[(size_t)k * DIN + 7680 + r] * g1[k]; }
        __syncthreads();
        for (int row = gw; row < MTOK; row += NGW) {
            asm volatile("" ::: "memory");
            const f32x4* xr = (const f32x4*)(x + (size_t)row * DM) + lane;
            f32x4 v[4]; float ss = 0.f;
#pragma unroll
            for (int j = 0; j < 4; ++j) { v[j] = xr[64 * j]; ss += (v[j][0] * v[j][0] + v[j][1] * v[j][1]) + (v[j][2] * v[j][2] + v[j][3] * v[j][3]); }
            ss = wave_sum(ss); const float r1 = 1.0f / sqrtf(ss * (1.0f / 1024.0f) + EPS);
            float pa[16];
#pragma unroll
            for (int r = 0; r < 16; ++r) pa[r] = 0.f;
#pragma unroll
            for (int j = 0; j < 4; ++j)
#pragma unroll
                for (int c = 0; c < 4; ++c) { const float xv = v[j][c]; const LAS f32x4* wp = (const LAS f32x4*)(WAl + ((j * 4 + c) * 64 + lane) * 20);
#pragma unroll
                    for (int q = 0; q < 4; ++q) { const f32x4 w = wp[q]; pa[4 * q] += xv * w[0]; pa[4 * q + 1] += xv * w[1]; pa[4 * q + 2] += xv * w[2]; pa[4 * q + 3] += xv * w[3]; } }
            float mine = 0.f;
#pragma unroll
            for (int r = 0; r < 16; ++r) { const float s = wave_sum(pa[r]); mine = (lane == r) ? s : mine; }
            if (lane < 16) PA[(size_t)row * 16 + lane] = mine * r1;
            if (lane == 0) R1[row] = r1;
            unsigned long long* o8 = (unsigned long long*)(XB + (size_t)row * DM) + lane;
#pragma unroll
            for (int j = 0; j < 4; ++j) o8[64 * j] = (unsigned long long)pk2(v[j][0], v[j][1]) | ((unsigned long long)pk2(v[j][2], v[j][3]) << 32);
        }
        __syncthreads();
    }
    SYNC(0);

    for (int bq = 0; bq < 2; ++bq) {
        int b = bq; LAUNDER(b);
        const int p1 = 1 + 4 * b;
        if (IN(p1)) for (int rep_ = 0; rep_ < NREP(1); ++rep_) {
            pg8::Gemm g{XB + (size_t)b * SEQ * DM, WIN, SEQ, N1, DM}; pg8::StaticOrder S; S.init(SEQ, N1, G, bx);
            pg8::EpiProj E{PROJ, VT, GATES + (size_t)b * SEQ * 2048, R1 + b * SEQ, bgate_bias};
            pg8::gemm_phase<pg8::EpiProj, pg8::StaticOrder, true, true>(lds, g, S, E);
        }
        SYNC(p1);
        int tid_ = threadIdx.x; asm volatile("" : "+v"(tid_)); const int lane_ = tid_ & 63; const int wave_ = __builtin_amdgcn_readfirstlane(tid_ >> 6); int bx_ = bx; LAUNDER(bx_);
        const float* gate_up_ = gate_up; const float* gate_bias_ = gate_bias; const float* PA_ = PA; const bf16* PROJ_ = PROJ; const bf16* VT_ = VT; bf16* A1_ = A1; bf16* A2_ = A2; const float* gq_ = gq; const float* gk_ = gk;
        float* SBUF_ = (float*)(ws + WS_XB); float* DBUF_ = (float*)(ws + WS_MISC + 2 * MiB); float* ML_ = (float*)(ws + WS_MISC);
        LAUNDER(gate_up_); LAUNDER(gate_bias_); LAUNDER(PA_); LAUNDER(PROJ_); LAUNDER(VT_); LAUNDER(A1_); LAUNDER(A2_); LAUNDER(gq_); LAUNDER(gk_); LAUNDER(SBUF_); LAUNDER(DBUF_); LAUNDER(ML_);
        if (IN(p1 + 1)) {
            if (bx_ < 128) for (int rep_ = 0; rep_ < NREP(2); ++rep_) { gla_item<false>(lds, b, bx_, PROJ_, VT_, PA_, gate_up_, gate_bias_, SBUF_, DBUF_, A2_, tid_, wave_, lane_); }
            {
                float gkr[8], gqr[16];
#pragma unroll
                for (int i = 0; i < 8; ++i) gkr[i] = gk_[(tid_ & 7) * 8 + i];
#pragma unroll
                for (int i = 0; i < 8; ++i) { gqr[i] = gq_[8 * (lane_ >> 4) + i]; gqr[8 + i] = gq_[32 + 8 * (lane_ >> 4) + i]; }
                bf16* PROJW = (bf16*)PROJ_;
                const int first = bx_ < 128 ? bx_ : 640 + (bx_ - 128), cnt = bx_ < 128 ? 5 : 7;
                const int nrep_ = NREP(7);
                for (int rep_ = 0; rep_ < nrep_; ++rep_)
                for (int k = 0; k < cnt; ++k) { const int it = first + 128 * k;
                    AttnRegs R; attn_prefetch(R, PROJ_, it, tid_, wave_, lane_);
                    __syncthreads();
                    attn_stage(R, lds, gkr, tid_);
                    __syncthreads();
                    attn_compute(R, lds, PROJW, ML_, gqr, it, wave_, lane_, rep_ == nrep_ - 1);
                }
            }
        }
        SYNC(p1 + 1);
        if (IN(p1 + 2)) {
            { const int gid = bx_ * NTHREADS + tid_;
              if (gid < 4 * 64 * 512) { const int h = gid >> 15, r = (gid >> 9) & 63, tl = gid & 511; const int kdr = 16 * (r >> 3) + 4 * ((tl & 63) >> 4) + (r & 3);
                float loc[32], dec[32];
#pragma unroll
                for (int sg = 0; sg < 32; ++sg) { loc[sg] = ((const GAS float*)SBUF_)[((size_t)(h * 32 + sg) * 64 + r) * 512 + tl]; dec[sg] = ((const GAS float*)DBUF_)[(h * 32 + sg) * 128 + kdr]; }
                float cur = 0.f;
#pragma unroll
                for (int sg = 0; sg < 32; ++sg) { ((GAS float*)SBUF_)[((size_t)(h * 32 + sg) * 64 + r) * 512 + tl] = cur; cur = dec[sg] * cur + loc[sg]; } } }
            {
                for (int idx = bx_ * NTHREADS + tid_; idx < SEQ * 64; idx += G * NTHREADS) {
                    const int t = idx >> 6, slot = (idx >> 3) & 7, c8 = idx & 7;
                    float m[3], dn[3];
#pragma unroll
                    for (int g = 0; g < 3; ++g) { const GAS float* mp = (const GAS float*)ML_ + (size_t)t * 48 + (g * 8 + slot) * 2; m[g] = mp[0]; dn[g] = mp[1]; }
                    const float M = fmaxf(m[0], fmaxf(m[1], m[2])); float D = 0.f; float acc[8];
#pragma unroll
                    for (int i = 0; i < 8; ++i) acc[i] = 0.f;
#pragma unroll
                    for (int g = 0; g < 3; ++g) { const float wg = __builtin_amdgcn_exp2f(m[g] - M); D += wg * dn[g]; float f[8];
                        pg8::unpack8(*(const GAS v4u*)((const GAS bf16*)PROJ_ + (size_t)t * PLD + (g * 8 + slot) * 64 + c8 * 8), f);
#pragma unroll
                        for (int i = 0; i < 8; ++i) acc[i] += wg * f[i]; }
                    const float inv = 1.0f / D;
#pragma unroll
                    for (int i = 0; i < 8; ++i) acc[i] *= inv;
                    *(GAS v4u*)((GAS bf16*)A1_ + (size_t)(b * SEQ + t) * 512 + slot * 64 + c8 * 8) = pg8::pack8(acc);
                }
            }
        }
        SYNC(p1 + 2);
        if (IN(p1 + 3)) {
            if (bx_ < 128) for (int rep_ = 0; rep_ < NREP(3); ++rep_) { gla_item<true>(lds, b, bx_, PROJ_, VT_, PA_, gate_up_, gate_bias_, SBUF_, DBUF_, A2_, tid_, wave_, lane_); __syncthreads(); }
        }
        SYNC(p1 + 3);
    }
    if (IN(9)) for (int rep_ = 0; rep_ < NREP(4); ++rep_) {
        { pg8::Gemm g{A1, WA, MTOK, DM, 512}; pg8::StaticOrder S; S.init(MTOK, DM, G, bx); pg8::EpiBranch E{MIXED, GATES, 0, 0};
          pg8::gemm_phase<pg8::EpiBranch, pg8::StaticOrder, true, true>(lds, g, S, E); }
        __syncthreads();
        { pg8::Gemm g{A2, WB, MTOK, DM, 1024}; pg8::StaticOrder S; S.init(MTOK, DM, G, bx); pg8::EpiBranch E{MIXED, GATES, 1024, 1};
          pg8::gemm_phase<pg8::EpiBranch, pg8::StaticOrder, true, true>(lds, g, S, E); }
    }
    SYNC(9);
    if (IN(10)) for (int rep_ = 0; rep_ < NREP(5); ++rep_) { pg8::Gemm g{MIXED, WO, MTOK, DM, 1024}; pg8::StaticOrder S; S.init(MTOK, DM, G, bx); pg8::EpiOut1 E{x, a.out, XB, SS2};
        pg8::gemm_phase<pg8::EpiOut1, pg8::StaticOrder, true, true>(lds, g, S, E); }
    SYNC(10);
    if (IN(11)) for (int rep_ = 0; rep_ < NREP(6); ++rep_) { pg8::Gemm g{XB, WUP, MTOK, FF, 1024}; pg8::StaticOrder S; S.init(MTOK, FF, G, bx); pg8::EpiUp E{UB, SS2};
        pg8::gemm_phase<pg8::EpiUp, pg8::StaticOrder, true, true>(lds, g, S, E); }
    SYNC(11);
    if (IN(12)) { pg8::Gemm g{UB, WDN, MTOK, DM, FF}; pg8::StaticOrder S; S.init(MTOK, DM, G, bx); pg8::EpiDown E{a.out};
        pg8::gemm_phase<pg8::EpiDown, pg8::StaticOrder, true, true>(lds, g, S, E); }
#undef IN
#undef SYNC
}

extern "C" void kernel_launch(void* const* d_in, const int* in_sizes, int n_in, void* d_out, int out_size, void* d_ws, size_t ws_size, hipStream_t stream) {
    static int grid = 0;
    if (grid == 0) {
        if (n_in != 15 || out_size != MTOK * DM || ws_size < WS_END) { fprintf(stderr, "kernel_launch: unexpected shapes (n_in %d, out %d, ws %zu)\n", n_in, out_size, ws_size); grid = -1; return; }
        int dev = 0, cus = 0, per_cu = 0;
        hipGetDevice(&dev); hipDeviceGetAttribute(&cus, hipDeviceAttributeMultiprocessorCount, dev);
        if (hipFuncSetAttribute((const void*)fwd_kernel, hipFuncAttributeMaxDynamicSharedMemorySize, LDS_BYTES) != hipSuccess) { fprintf(stderr, "kernel_launch: hipFuncSetAttribute failed\n"); grid = -1; return; }
        if (hipOccupancyMaxActiveBlocksPerMultiprocessor(&per_cu, (const void*)fwd_kernel, NTHREADS, LDS_BYTES) != hipSuccess || per_cu < 1) per_cu = 1;
        (void)hipGetLastError();
        grid = cus * per_cu;
        fprintf(stderr, "kernel_launch: grid %d (cus %d x %d)\n", grid, cus, per_cu);
    }
    if (grid < 0) return;
    Args a{};
    for (int i = 0; i < 15; ++i) a.in[i] = (const float*)d_in[i];
    a.out = (float*)d_out; a.ws = (unsigned char*)d_ws; a.ph_lo = 0; a.ph_hi = 13; a.rep = REPMASK; a.pad = 0;
    void* args[] = {&a};
    hipError_t e = hipLaunchCooperativeKernel((const void*)fwd_kernel, dim3(grid), dim3(NTHREADS), args, LDS_BYTES, stream);
    if (e != hipSuccess) fprintf(stderr, "cooperative launch failed: %s (grid %d)\n", hipGetErrorString(e), grid);
}
```

```cpp
#include <hip/hip_runtime.h>
#include <hip/hip_cooperative_groups.h>
#include <cstdio>
#include <cstdint>
#include <cmath>
namespace cg = cooperative_groups;
namespace pg8 {
#define PG8_LAS __attribute__((address_space(3)))
typedef unsigned short bf16_t;
typedef short bf16x8 __attribute__((ext_vector_type(8)));
typedef float f32x4 __attribute__((ext_vector_type(4)));
typedef unsigned u32x4 __attribute__((ext_vector_type(4)));
constexpr int BM = 256, BK = 64, HALF = 128, HTB = HALF * BK * 2  , STAGE_BYTES = 8 * HTB, NXCD = 8, WGM = 8;

__host__ __device__ __forceinline__ int lds_byte(int r, int c) { const int st = (r >> 4) * 2 + (c >> 5), rr = r & 15, cc = c & 31, ob = rr * 64 + cc * 2; return st * 1024 + (ob ^ (((ob >> 9) & 1) << 5)); }
__host__ __device__ __forceinline__ void stage_rc(int b, int& R, int& C) { const int st = b / 1024, sb = b % 1024, swz = sb ^ (((sb >> 9) & 1) << 5); R = (st >> 1) * 16 + swz / 64; C = (st & 1) * 32 + (swz % 64) / 2; }
__host__ __device__ __forceinline__ int perm32(int rho) { const int n = rho >> 4, i = rho & 15; return 8 * (i >> 2) + 4 * n + (i & 3); }

struct Unit { int pm, pn; };
struct Gemm { const bf16_t* A; const bf16_t* Bt; int M, N, K; };

struct StaticOrder {
    int nM, nN, nwg, G, c;
    __host__ __device__ void init(int M, int N, int G_, int c_) { nM = M / BM; nN = N / BM; nwg = nM * nN; G = G_; c = c_; }
    __host__ __device__ bool next(int i, Unit& u) const {
        const long L = (long)i * G + c; if (L >= nwg) return false;
        int wgid = (int)L; { const int q = nwg / NXCD, r = nwg % NXCD, xcd = wgid % NXCD, off = wgid / NXCD; wgid = (xcd < r ? xcd * (q + 1) : r * (q + 1) + (xcd - r) * q) + off; }
        const int nig = WGM * nN, gid = wgid / nig, fm = gid * WGM, gsz = (nM - fm) < WGM ? (nM - fm) : WGM;
        u.pm = fm + ((wgid % nig) % gsz); u.pn = (wgid % nig) / gsz; return true;
    }
    __device__ __forceinline__ void a_ready(const Unit&) const {}
    __device__ __forceinline__ void done(const Unit&) const {}
};
typedef float f32x2 __attribute__((ext_vector_type(2)));
typedef __bf16 bf16x2_cv __attribute__((ext_vector_type(2)));
__device__ __forceinline__ unsigned cvt_pk_bf16(float lo, float hi) { const f32x2 v = {lo, hi}; const bf16x2_cv b = __builtin_convertvector(v, bf16x2_cv); return __builtin_bit_cast(unsigned, b); }
__device__ __forceinline__ float bflo(unsigned w) { return __uint_as_float(w << 16); }
__device__ __forceinline__ float bfhi(unsigned w) { return __uint_as_float(w & 0xffff0000u); }
__device__ __forceinline__ void unpack8(const u32x4 w, float (&f)[8]) { f[0] = bflo(w.x); f[1] = bfhi(w.x); f[2] = bflo(w.y); f[3] = bfhi(w.y); f[4] = bflo(w.z); f[5] = bfhi(w.z); f[6] = bflo(w.w); f[7] = bfhi(w.w); }
__device__ __forceinline__ u32x4 pack8(const float (&v)[8]) { u32x4 w; w.x = cvt_pk_bf16(v[0], v[1]); w.y = cvt_pk_bf16(v[2], v[3]); w.z = cvt_pk_bf16(v[4], v[5]); w.w = cvt_pk_bf16(v[6], v[7]); return w; }
__device__ __forceinline__ float fsigmoid(float x) { return 1.0f / (1.0f + __expf(-x)); }

struct EpiProj {
    static constexpr bool PERM = true, AFTER_DRAIN = false;
    bf16_t* proj; bf16_t* vt; bf16_t* gates; const float* r1; const float* gbias;
    __device__ __forceinline__ void operator()(const f32x4 (&acc)[2][2][4][2], const Unit& u, int wr, int wc, int fr_in, int fq_in) const {
        int fr = fr_in, fq = fq_in; asm volatile("" : "+v"(fr), "+v"(fq));
        const int ct = u.pn; const int row0 = u.pm * BM + wr * 64 + fr; const int cl = wc * 32 + 8 * fq;
#pragma unroll
        for (int ai = 0; ai < 2; ++ai)
#pragma unroll
            for (int m = 0; m < 4; ++m) {
                const int row = row0 + ai * HALF + m * 16; const float rs = r1[row];
#pragma unroll
                for (int bj = 0; bj < 2; ++bj) {
                    const f32x4 v0 = acc[ai][bj][m][0] * rs, v1 = acc[ai][bj][m][1] * rs;
                    float v[8] = {v0[0], v0[1], v0[2], v0[3], v1[0], v1[1], v1[2], v1[3]};
                    const int c = cl + bj * HALF;
                    if (ct < 22) { *(u32x4*)(proj + (size_t)row * 6656 + ct * 256 + c) = pack8(v); }
                    else if (ct < 26) { const u32x4 w = pack8(v); bf16_t* p = vt + (size_t)((ct - 22) * 256 + c) * 8192 + row;
                        p[0] = (bf16_t)(w.x & 0xffffu); p[8192] = (bf16_t)(w.x >> 16); p[2 * 8192] = (bf16_t)(w.y & 0xffffu); p[3 * 8192] = (bf16_t)(w.y >> 16);
                        p[4 * 8192] = (bf16_t)(w.z & 0xffffu); p[5 * 8192] = (bf16_t)(w.z >> 16); p[6 * 8192] = (bf16_t)(w.w & 0xffffu); p[7 * 8192] = (bf16_t)(w.w >> 16); }
                    else if (ct < 30) {
#pragma unroll
                        for (int i = 0; i < 8; ++i) v[i] = v[i] * fsigmoid(v[i]);
                        *(u32x4*)(proj + (size_t)row * 6656 + (ct - 4) * 256 + c) = pack8(v); }
                    else { const int gc = (ct - 30) * 256 + c; const f32x4 b0 = *(const f32x4*)(gbias + gc), b1 = *(const f32x4*)(gbias + gc + 4);
                        const float bb[8] = {b0[0], b0[1], b0[2], b0[3], b1[0], b1[1], b1[2], b1[3]};
#pragma unroll
                        for (int i = 0; i < 8; ++i) v[i] = fsigmoid(v[i] + bb[i]);
                        *(u32x4*)(gates + (size_t)row * 2048 + gc) = pack8(v); }
                }
            }
    }
};
struct EpiBranch {
    static constexpr bool PERM = true, AFTER_DRAIN = false;
    bf16_t* mixed; const bf16_t* gates; int goff; int add;
    __device__ __forceinline__ void operator()(const f32x4 (&acc)[2][2][4][2], const Unit& u, int wr, int wc, int fr_in, int fq_in) const {
        int fr = fr_in, fq = fq_in; asm volatile("" : "+v"(fr), "+v"(fq));
        const int row0 = u.pm * BM + wr * 64 + fr; const int cl = u.pn * BM + wc * 32 + 8 * fq;
#pragma unroll
        for (int ai = 0; ai < 2; ++ai)
#pragma unroll
            for (int m = 0; m < 4; ++m) {
                const int row = row0 + ai * HALF + m * 16;
#pragma unroll
                for (int bj = 0; bj < 2; ++bj) {
                    const int c = cl + bj * HALF; float g[8], v[8];
                    unpack8(*(const u32x4*)(gates + (size_t)row * 2048 + goff + c), g);
                    const f32x4 v0 = acc[ai][bj][m][0], v1 = acc[ai][bj][m][1];
                    v[0] = v0[0] * g[0]; v[1] = v0[1] * g[1]; v[2] = v0[2] * g[2]; v[3] = v0[3] * g[3]; v[4] = v1[0] * g[4]; v[5] = v1[1] * g[5]; v[6] = v1[2] * g[6]; v[7] = v1[3] * g[7];
                    if (add) { float t[8]; unpack8(*(const u32x4*)(mixed + (size_t)row * 1024 + c), t);
#pragma unroll
                        for (int i = 0; i < 8; ++i) v[i] += t[i]; }
                    *(u32x4*)(mixed + (size_t)row * 1024 + c) = pack8(v);
                }
            }
    }
};
struct EpiOut1 {
    static constexpr bool PERM = true, AFTER_DRAIN = false;
    const float* x; float* out; bf16_t* x1b; float* ss2;
    __device__ __forceinline__ void operator()(const f32x4 (&acc)[2][2][4][2], const Unit& u, int wr, int wc, int fr_in, int fq_in) const {
        int fr = fr_in, fq = fq_in; asm volatile("" : "+v"(fr), "+v"(fq));
        const int row0 = u.pm * BM + wr * 64 + fr; const int cl = u.pn * BM + wc * 32 + 8 * fq;
#pragma unroll
        for (int ai = 0; ai < 2; ++ai)
#pragma unroll
            for (int m = 0; m < 4; ++m) {
                const int row = row0 + ai * HALF + m * 16; float ssq = 0.f;
#pragma unroll
                for (int bj = 0; bj < 2; ++bj) {
                    const size_t off = (size_t)row * 1024 + cl + bj * HALF;
                    const f32x4 o0 = *(const f32x4*)(x + off) + acc[ai][bj][m][0], o1 = *(const f32x4*)(x + off + 4) + acc[ai][bj][m][1];
                    *(f32x4*)(out + off) = o0; *(f32x4*)(out + off + 4) = o1;
                    const float v[8] = {o0[0], o0[1], o0[2], o0[3], o1[0], o1[1], o1[2], o1[3]};
                    *(u32x4*)(x1b + off) = pack8(v);
#pragma unroll
                    for (int i = 0; i < 8; ++i) ssq += v[i] * v[i];
                }
                ssq += __shfl_xor(ssq, 16); ssq += __shfl_xor(ssq, 32);
                if (fq == 0) ss2[(size_t)row * 16 + u.pn * 4 + wc] = ssq;
            }
    }
};
struct EpiUp {
    static constexpr bool PERM = true, AFTER_DRAIN = false;
    bf16_t* U; const float* ss2;
    __device__ __forceinline__ void operator()(const f32x4 (&acc)[2][2][4][2], const Unit& u, int wr, int wc, int fr_in, int fq_in) const {
        int fr = fr_in, fq = fq_in; asm volatile("" : "+v"(fr), "+v"(fq));
        const int row0 = u.pm * BM + wr * 64 + fr; const int cl = u.pn * BM + wc * 32 + 8 * fq;
#pragma unroll
        for (int ai = 0; ai < 2; ++ai)
#pragma unroll
            for (int m = 0; m < 4; ++m) {
                const int row = row0 + ai * HALF + m * 16;
                const f32x4* sp = (const f32x4*)(ss2 + (size_t)row * 16); const f32x4 s0 = sp[0], s1 = sp[1], s2 = sp[2], s3 = sp[3];
                const float s = ((s0[0] + s0[1]) + (s0[2] + s0[3])) + ((s1[0] + s1[1]) + (s1[2] + s1[3])) + ((s2[0] + s2[1]) + (s2[2] + s2[3])) + ((s3[0] + s3[1]) + (s3[2] + s3[3]));
                const float rs = 1.0f / sqrtf(s * (1.0f / 1024.0f) + 1e-6f);
#pragma unroll
                for (int bj = 0; bj < 2; ++bj) {
                    const f32x4 v0 = acc[ai][bj][m][0] * rs, v1 = acc[ai][bj][m][1] * rs;
                    float v[8] = {v0[0], v0[1], v0[2], v0[3], v1[0], v1[1], v1[2], v1[3]};
#pragma unroll
                    for (int i = 0; i < 8; ++i) { const float r = fmaxf(v[i], 0.f); v[i] = r * r; }
                    *(u32x4*)(U + (size_t)row * 4096 + cl + bj * HALF) = pack8(v);
                }
            }
    }
};
struct EpiDown {
    static constexpr bool PERM = true, AFTER_DRAIN = false;
    float* out;
    __device__ __forceinline__ void operator()(const f32x4 (&acc)[2][2][4][2], const Unit& u, int wr, int wc, int fr_in, int fq_in) const {
        int fr = fr_in, fq = fq_in; asm volatile("" : "+v"(fr), "+v"(fq));
        const int row0 = u.pm * BM + wr * 64 + fr; const int cl = u.pn * BM + wc * 32 + 8 * fq;
#pragma unroll
        for (int ai = 0; ai < 2; ++ai)
#pragma unroll
            for (int m = 0; m < 4; ++m) {
                const int row = row0 + ai * HALF + m * 16;
#pragma unroll
                for (int bj = 0; bj < 2; ++bj) {
                    const size_t off = (size_t)row * 1024 + cl + bj * HALF;
                    const f32x4 o0 = *(const f32x4*)(out + off) + acc[ai][bj][m][0], o1 = *(const f32x4*)(out + off + 4) + acc[ai][bj][m][1];
                    *(f32x4*)(out + off) = o0; *(f32x4*)(out + off + 4) = o1;
                }
            }
    }
};
template <class Epi, class Sched, bool ALIGN_EPI = false, bool SP2 = false>
__device__ __forceinline__ void gemm_phase(PG8_LAS unsigned char* lds, const Gemm g, const Sched& S, const Epi& E) {
    int tid_l = threadIdx.x; asm volatile("" : "+v"(tid_l));
    const int tid = tid_l, wid = __builtin_amdgcn_readfirstlane(tid >> 6), lane = tid & 63, wr = wid >> 2, wc = wid & 3, fr = lane & 15, fq = lane >> 4;
    const int K = g.K, nt = K / BK;
    unsigned voffA[2], voffB[2];
#pragma unroll
    for (int i = 0; i < 2; ++i) { int R, C; stage_rc(tid * 16 + i * 8192, R, C); const int Rb = Epi::PERM ? ((R & ~31) + perm32(R & 31)) : R;
        voffA[i] = (unsigned)(R * K + C) * 2u; voffB[i] = (unsigned)(Rb * K + C) * 2u; }
    const size_t kstep = (size_t)(BK * 2);
    const size_t hstep = (size_t)HALF * K * 2;
    const size_t tstep = 2 * hstep;
    const unsigned ldsw = (unsigned)wid * 1024u;
    const int aoff = lds_byte(wr * 64 + fr, fq * 8), boff = lds_byte(wc * 32 + fr, fq * 8);
#define PG8_SA(b, h) (((b) * 2 + (h)) * HTB)
#define PG8_SB(b, h) ((4 + (b) * 2 + (h)) * HTB)
#define PG8_STAGE(bufoff, gbase, voff) do { _Pragma("unroll") for (int _i = 0; _i < 2; ++_i) \
        __builtin_amdgcn_global_load_lds((const unsigned*)((const char*)(gbase) + (voff)[_i]), (PG8_LAS unsigned*)(lds + (bufoff) + ldsw + _i * 8192), 16, 0, 0); } while (0)
#define PG8_LDA(dst, b, h) do { _Pragma("unroll") for (int m = 0; m < 4; ++m) _Pragma("unroll") for (int k = 0; k < 2; ++k) dst[m][k] = *(const PG8_LAS bf16x8*)(lds + PG8_SA(b, h) + aoff + m * 2048 + k * 1024); } while (0)
#define PG8_LDB(dst, b, h) do { _Pragma("unroll") for (int n = 0; n < 2; ++n) _Pragma("unroll") for (int k = 0; k < 2; ++k) dst[n][k] = *(const PG8_LAS bf16x8*)(lds + PG8_SB(b, h) + boff + n * 2048 + k * 1024); } while (0)
#define PG8_MMA(ai, bj, At, Bt) do { __builtin_amdgcn_s_setprio(1); _Pragma("unroll") for (int m = 0; m < 4; ++m) _Pragma("unroll") for (int n = 0; n < 2; ++n) _Pragma("unroll") for (int k = 0; k < 2; ++k) \
        acc[ai][bj][m][n] = __builtin_amdgcn_mfma_f32_16x16x32_bf16(Bt[n][k], At[m][k], acc[ai][bj][m][n], 0, 0, 0); __builtin_amdgcn_s_setprio(0); } while (0)
#define PG8_WAIT_V(n) asm volatile("s_waitcnt vmcnt(" #n ")" ::: "memory")
#define PG8_WAIT_L(n) asm volatile("s_waitcnt lgkmcnt(" #n ")" ::: "memory")
#define PG8_BAR __builtin_amdgcn_s_barrier()
#define PG8_SCHED __builtin_amdgcn_sched_barrier(0)
    Unit cur, nxt; int ui = 0;
    if (!S.next(0, cur)) return;
    f32x4 acc[2][2][4][2];
#pragma unroll
    for (int a = 0; a < 2; ++a)
#pragma unroll
        for (int b = 0; b < 2; ++b)
#pragma unroll
            for (int m = 0; m < 4; ++m)
#pragma unroll
                for (int n = 0; n < 2; ++n) acc[a][b][m][n] = (f32x4){0.f, 0.f, 0.f, 0.f};
    bf16x8 At[4][2], B0[2][2], B1[2][2];
    const char* cA = (const char*)g.A + (size_t)cur.pm * tstep; const char* cB = (const char*)g.Bt + (size_t)cur.pn * tstep;
    S.a_ready(cur);
    if constexpr (SP2) {
        PG8_STAGE(PG8_SB(0, 0), cB, voffB); PG8_STAGE(PG8_SB(0, 1), cB + hstep, voffB); PG8_STAGE(PG8_SA(0, 0), cA, voffA); PG8_STAGE(PG8_SA(0, 1), cA + hstep, voffA);
        if (wr == 1) PG8_BAR;
        PG8_WAIT_V(2); PG8_BAR;
        PG8_STAGE(PG8_SB(1, 0), cB + kstep, voffB); PG8_STAGE(PG8_SA(1, 0), cA + kstep, voffA); PG8_STAGE(PG8_SB(1, 1), cB + hstep + kstep, voffB);
        PG8_WAIT_V(6); PG8_BAR;
    } else {
        PG8_STAGE(PG8_SB(0, 0), cB, voffB); PG8_STAGE(PG8_SA(0, 0), cA, voffA); PG8_STAGE(PG8_SB(0, 1), cB + hstep, voffB); PG8_STAGE(PG8_SA(0, 1), cA + hstep, voffA);
        if (wr == 1) PG8_BAR;
        PG8_WAIT_V(4); PG8_BAR;
        PG8_STAGE(PG8_SB(1, 0), cB + kstep, voffB); PG8_STAGE(PG8_SA(1, 0), cA + kstep, voffA); PG8_STAGE(PG8_SB(1, 1), cB + hstep + kstep, voffB);
        PG8_WAIT_V(6); PG8_BAR;
    }
    for (;;) {
        const bool has_next = S.next(ui + 1, nxt);
        const char* nA = has_next ? (const char*)g.A + (size_t)nxt.pm * tstep : cA; const char* nB = has_next ? (const char*)g.Bt + (size_t)nxt.pn * tstep : cB;
        for (int t = 0; t < nt; t += 2) {
            const bool last = (t == nt - 2);
            const char* a1 = cA + (size_t)(t + 1) * kstep;
            const char* a2 = last ? nA : cA + (size_t)(t + 2) * kstep; const char* b2 = last ? nB : cB + (size_t)(t + 2) * kstep;
            const char* a3 = a2 + kstep; const char* b3 = b2 + kstep;
            if (last && has_next) S.a_ready(nxt);
            if constexpr (SP2) {
            PG8_LDB(B0, 0, 0); PG8_LDB(B1, 0, 1); PG8_SCHED; PG8_LDA(At, 0, 0); PG8_STAGE(PG8_SA(1, 1), a1 + hstep, voffA);
            PG8_WAIT_V(8); PG8_WAIT_L(0); PG8_BAR; PG8_MMA(0, 0, At, B0); PG8_MMA(0, 1, At, B1); PG8_BAR; PG8_SCHED;
            PG8_LDA(At, 0, 1); PG8_STAGE(PG8_SB(0, 0), b2, voffB); PG8_STAGE(PG8_SB(0, 1), b2 + hstep, voffB); PG8_STAGE(PG8_SA(0, 0), a2, voffA);
            PG8_WAIT_V(8); PG8_WAIT_L(0); PG8_BAR; PG8_MMA(1, 0, At, B0); PG8_MMA(1, 1, At, B1); PG8_BAR; PG8_SCHED;
            PG8_LDB(B0, 1, 0); PG8_LDB(B1, 1, 1); PG8_SCHED; PG8_LDA(At, 1, 0); PG8_STAGE(PG8_SA(0, 1), a2 + hstep, voffA);
            PG8_WAIT_V(8); PG8_WAIT_L(0); PG8_BAR; PG8_MMA(0, 0, At, B0); PG8_MMA(0, 1, At, B1); PG8_BAR; PG8_SCHED;
            PG8_LDA(At, 1, 1); PG8_STAGE(PG8_SB(1, 0), b3, voffB); PG8_STAGE(PG8_SB(1, 1), b3 + hstep, voffB); PG8_STAGE(PG8_SA(1, 0), a3, voffA);
            PG8_WAIT_V(8); PG8_WAIT_L(0); PG8_BAR; PG8_MMA(1, 0, At, B0); PG8_MMA(1, 1, At, B1); PG8_BAR; PG8_SCHED;
            } else {
            PG8_LDB(B0, 0, 0); PG8_SCHED; PG8_LDA(At, 0, 0); PG8_STAGE(PG8_SA(1, 1), a1 + hstep, voffA);
            PG8_WAIT_L(8); PG8_BAR; PG8_WAIT_L(0); PG8_MMA(0, 0, At, B0); PG8_BAR; PG8_SCHED;
            PG8_LDB(B1, 0, 1); PG8_STAGE(PG8_SB(0, 0), b2, voffB);
            PG8_BAR; PG8_WAIT_L(0); PG8_MMA(0, 1, At, B1); PG8_BAR;
            PG8_LDA(At, 0, 1); PG8_STAGE(PG8_SA(0, 0), a2, voffA);
            PG8_BAR; PG8_WAIT_L(0); PG8_MMA(1, 0, At, B0); PG8_BAR; PG8_SCHED;
            PG8_STAGE(PG8_SB(0, 1), b2 + hstep, voffB);
            PG8_WAIT_V(6); PG8_BAR; PG8_MMA(1, 1, At, B1); PG8_BAR;
            PG8_LDB(B0, 1, 0); PG8_SCHED; PG8_LDA(At, 1, 0); PG8_STAGE(PG8_SA(0, 1), a2 + hstep, voffA);
            PG8_WAIT_L(8); PG8_BAR; PG8_WAIT_L(0); PG8_MMA(0, 0, At, B0); PG8_BAR; PG8_SCHED;
            PG8_LDB(B1, 1, 1); PG8_STAGE(PG8_SB(1, 0), b3, voffB);
            PG8_BAR; PG8_WAIT_L(0); PG8_MMA(0, 1, At, B1); PG8_BAR;
            PG8_LDA(At, 1, 1); PG8_STAGE(PG8_SA(1, 0), a3, voffA);
            PG8_BAR; PG8_WAIT_L(0); PG8_MMA(1, 0, At, B0); PG8_BAR; PG8_SCHED;
            PG8_STAGE(PG8_SB(1, 1), b3 + hstep, voffB);
            PG8_WAIT_V(6); PG8_BAR; PG8_MMA(1, 1, At, B1); PG8_BAR;
            }
        }
        if constexpr (ALIGN_EPI) { if (wr == 0) PG8_BAR; }
        if constexpr (!Epi::AFTER_DRAIN) { E(acc, cur, wr, wc, fr, fq); S.done(cur); }
        if (!has_next) break;
#pragma unroll
        for (int a = 0; a < 2; ++a)
#pragma unroll
            for (int b = 0; b < 2; ++b)
#pragma unroll
                for (int m = 0; m < 4; ++m)
#pragma unroll
                    for (int n = 0; n < 2; ++n) acc[a][b][m][n] = (f32x4){0.f, 0.f, 0.f, 0.f};
        cur = nxt; cA = nA; cB = nB; ++ui;
        if constexpr (ALIGN_EPI) { if (wr == 1) PG8_BAR; }
    }
    PG8_WAIT_V(0);
    if constexpr (!ALIGN_EPI) { if (wr == 0) PG8_BAR; }
    PG8_BAR;
    if constexpr (Epi::AFTER_DRAIN) { E.fused(acc, cur, wr, wc, fr, fq, lds, wid, lane); S.done(cur); }
#undef PG8_SA
#undef PG8_SB
#undef PG8_STAGE
#undef PG8_LDA
#undef PG8_LDB
#undef PG8_MMA
#undef PG8_WAIT_V
#undef PG8_WAIT_L
#undef PG8_BAR
#undef PG8_SCHED
}
}
#define LAS __attribute__((address_space(3)))
#define GAS __attribute__((address_space(1)))
typedef unsigned short bf16;
typedef unsigned v4u __attribute__((ext_vector_type(4)));
typedef float f32x4 __attribute__((ext_vector_type(4)));
constexpr int NWAVES = 8, NTHREADS = 512;
constexpr int SEQ = 8192, DM = 1024, MTOK = 16384, DIN = 9744, N1 = 9728, PLD = 6656, FF = 4096;
constexpr float EPS = 1e-6f;
constexpr size_t MiB = 1u << 20;
constexpr size_t WS_WIN = 1 * MiB, WS_WA = 20 * MiB, WS_WB = 21 * MiB, WS_WO = 23 * MiB, WS_WUP = 25 * MiB, WS_WDN = 33 * MiB;
constexpr size_t WS_XB = 41 * MiB, WS_PROJ = 73 * MiB, WS_VT = 177 * MiB, WS_A1 = 193 * MiB, WS_A2 = 209 * MiB;
constexpr size_t WS_R1 = 241 * MiB, WS_PA = 242 * MiB, WS_SS2 = 243 * MiB, WS_MISC = 244 * MiB;
constexpr size_t WS_MIXED = 73 * MiB, WS_U = 73 * MiB, WS_END = 256 * MiB;
constexpr int LDS_BYTES = 155648, LDS_BARST = 155584;
constexpr size_t WS_BAR = 0;

__device__ __forceinline__ float bf2f(bf16 h) { return __uint_as_float(((unsigned)h) << 16); }
__device__ __forceinline__ unsigned f2bf(float f) { unsigned u = __builtin_bit_cast(unsigned, f); return (u + 0x7fffu + ((u >> 16) & 1u)) >> 16; }
__device__ __forceinline__ unsigned pk2(float lo, float hi) { return f2bf(lo) | (f2bf(hi) << 16); }
__device__ __forceinline__ float wave_sum(float v) {
#pragma unroll
    for (int o = 1; o < 64; o <<= 1) v += __shfl_xor(v, o);
    return v;
}
__device__ __forceinline__ float log_sigmoid(float x) { return fminf(x, 0.f) - log1pf(__expf(-fabsf(x))); }

#ifndef REPMASK
#define REPMASK 0
#endif
struct Args { const float* in[15]; float* out; unsigned char* ws; int ph_lo, ph_hi, rep, pad; };

__device__ __forceinline__ void p0_transpose_item(const float* W, int ldw, int srccol0, const float* kscale, int kmask, float cscale,
                                                  bf16* WT, int K, int dstrow0, int k0, LAS float* scr, int lane) {
    float v[32];
    const GAS float* wp = (const GAS float*)W + (size_t)(k0 + (lane >> 5)) * ldw + srccol0 + (lane & 31);
#pragma unroll
    for (int i = 0; i < 32; ++i) v[i] = wp[(size_t)(2 * i) * ldw];
    const int c = lane & 7;
    f32x4 s0 = (f32x4){cscale, cscale, cscale, cscale}, s1 = s0;
    if (kscale) { const int kb = (k0 + 8 * c) & kmask; s0 = *(const GAS f32x4*)((const GAS float*)kscale + kb) * cscale; s1 = *(const GAS f32x4*)((const GAS float*)kscale + kb + 4) * cscale; }
#pragma unroll
    for (int i = 0; i < 32; ++i) scr[(2 * i + (lane >> 5)) * 33 + (lane & 31)] = v[i];
    asm volatile("s_waitcnt lgkmcnt(0)" ::: "memory");
#pragma unroll
    for (int j = 0; j < 4; ++j) { const int n = (lane >> 3) + 8 * j; const LAS float* s = scr + (8 * c) * 33 + n;
        v4u o; o.x = pk2(s[0 * 33] * s0[0], s[1 * 33] * s0[1]); o.y = pk2(s[2 * 33] * s0[2], s[3 * 33] * s0[3]); o.z = pk2(s[4 * 33] * s1[0], s[5 * 33] * s1[1]); o.w = pk2(s[6 * 33] * s1[2], s[7 * 33] * s1[3]);
        *(GAS v4u*)((GAS bf16*)WT + (size_t)(dstrow0 + n) * K + k0 + 8 * c) = o; }
    asm volatile("s_waitcnt lgkmcnt(0)" ::: "memory");
}

#define XB_TMO      128
#define XB_XCNT(j)  (256  + 64 * (j))
#define XB_XSUB(j)  (1280 + 64 * (j))
#define XB_XGEN(j)  (2304 + 64 * (j))
#define XB_TOP      3328
#define XB_TOPGEN   3392
#define XCD_BAR_WORDS 3456
#define XB_SPIN_CAP (1u << 18)

__device__ __forceinline__ unsigned xb_ld(unsigned* p)              { return __hip_atomic_load(p, __ATOMIC_RELAXED, __HIP_MEMORY_SCOPE_AGENT); }
__device__ __forceinline__ unsigned xb_add(unsigned* p, unsigned v) { return __hip_atomic_fetch_add(p, v, __ATOMIC_RELAXED, __HIP_MEMORY_SCOPE_AGENT); }
__device__ __forceinline__ unsigned xb_xcc_id() { return (unsigned)__builtin_amdgcn_s_getreg((3 << 11) | 20) & 0xFu; }
#define XB_SPIN(cond, bar) do { unsigned _sp = 0; while (cond) { __builtin_amdgcn_s_sleep(1); \
    if ((++_sp & 255u) == 0u) { if (xb_ld(&(bar)[XB_TMO])) break; if (_sp > XB_SPIN_CAP) { atomicAdd(&(bar)[XB_TMO], 1u); break; } } } } while (0)

struct XcdBarrier {
    unsigned* bar; unsigned x;
    volatile LAS unsigned* st;
};

__device__ __forceinline__ XcdBarrier xcd_barrier_post(unsigned* bar, volatile LAS unsigned* st) {
    XcdBarrier b; b.bar = bar; b.x = xb_xcc_id(); b.st = st;
    if (threadIdx.x == 0) (void)xb_add(&bar[XB_XCNT(b.x)], 1u);
    return b;
}
__device__ __forceinline__ void xcd_barrier_complete(unsigned* bar, unsigned x, unsigned& nloc, unsigned& nx) {
    const unsigned G = gridDim.x * gridDim.y * gridDim.z;
    unsigned sum, cnt, mine, sp = 0u;
    for (;;) {
        sum = 0u; cnt = 0u; mine = 0u;
#pragma unroll
        for (unsigned j = 0; j < 16; ++j) { const unsigned c = xb_ld(&bar[XB_XCNT(j)]); sum += c; cnt += (c > 0u) ? 1u : 0u; mine = (j == x) ? c : mine; }
        if (sum == G) break;
        __builtin_amdgcn_s_sleep(1);
        if ((++sp & 255u) == 0u) { if (xb_ld(&bar[XB_TMO])) break; if (sp > XB_SPIN_CAP) { atomicAdd(&bar[XB_TMO], 1u); break; } }
    }
    nloc = mine > 0u ? mine : 1u; nx = cnt > 0u ? cnt : 1u;
}

__device__ __forceinline__ void xcd_barrier(const XcdBarrier& b) {
    asm volatile("s_waitcnt vmcnt(0)" ::: "memory");
    __syncthreads();
    if (threadIdx.x == 0) {
        unsigned* bar = b.bar;
        __builtin_amdgcn_s_waitcnt(0);
        unsigned nloc = b.st[0], nx = b.st[1];
        if (nloc == 0u) { xcd_barrier_complete(bar, b.x, nloc, nx); b.st[0] = nloc; b.st[1] = nx; }
        const unsigned old = xb_add(&bar[XB_XSUB(b.x)], 1u);
        const unsigned gen = old / nloc;
        if (old + 1u == (gen + 1u) * nloc) {
            __builtin_amdgcn_fence(__ATOMIC_RELEASE, "agent");
            asm volatile("s_waitcnt vmcnt(0)" ::: "memory");
            const unsigned og = xb_add(&bar[XB_TOP], 1u);
            const unsigned tg = og / nx;
            if (og + 1u == (tg + 1u) * nx) xb_add(&bar[XB_TOPGEN], 1u);
            else XB_SPIN(xb_ld(&bar[XB_TOPGEN]) == tg, bar);
            __builtin_amdgcn_fence(__ATOMIC_ACQUIRE, "agent");
            xb_add(&bar[XB_XGEN(b.x)], 1u);
            asm volatile("s_waitcnt vmcnt(0)" ::: "memory");
        } else {
            XB_SPIN(xb_ld(&bar[XB_XGEN(b.x)]) == gen, bar);
            __builtin_amdgcn_fence(__ATOMIC_ACQUIRE, "agent");
            asm volatile("s_waitcnt vmcnt(0)" ::: "memory");
        }
    }
    __syncthreads();
}

typedef short bf16x8_t __attribute__((ext_vector_type(8)));
typedef short s16x4_t __attribute__((ext_vector_type(4)));
constexpr int AT_PITCH = 144;
constexpr int AT_KL = 0, AT_VL = 256 * AT_PITCH;
constexpr int N_ATT_ITEMS = 1536;
struct AttnRegs { v4u k[4], v[4], q[2]; };
__device__ __forceinline__ void attn_decode(int it, int& g, int& slot, int& d, int& r, int& n) {
    g = it >> 9; const int rem = it & 511; slot = rem & 7; const int rest = rem >> 3; const int sh = 2 * g; d = 1 << sh; r = rest >> (6 - sh); n = rest & ((64 >> sh) - 1);
}
__device__ __forceinline__ void attn_prefetch(AttnRegs& R, const bf16* PROJ_, int it, int tid, int wave, int lane) {
    int g, slot, d, r, n; attn_decode(it, g, slot, d, r, n); const int hd = g * 8 + slot; const int c = tid & 7;
#pragma unroll
    for (int p = 0; p < 4; ++p) { const int row = p * 64 + (tid >> 3); const int sp = (n - 1) * 128 + row;
        if (n > 0 || p >= 2) { const GAS bf16* base = (const GAS bf16*)PROJ_ + (size_t)(sp * d + r) * PLD + hd * 64 + c * 8; R.k[p] = *(const GAS v4u*)(base + 1536); R.v[p] = *(const GAS v4u*)(base + 3072); }
        else { R.k[p] = (v4u){0u, 0u, 0u, 0u}; R.v[p] = (v4u){0u, 0u, 0u, 0u}; } }
    const int fr = lane & 15, fq = lane >> 4; const GAS bf16* qb = (const GAS bf16*)PROJ_ + (size_t)((n * 128 + 16 * wave + fr) * d + r) * PLD + hd * 64 + 8 * fq;
    R.q[0] = *(const GAS v4u*)(qb); R.q[1] = *(const GAS v4u*)(qb + 32);
}
__device__ __forceinline__ void attn_stage(const AttnRegs& R, LAS unsigned char* lds, const float (&gkr)[8], int tid) {
    const int c = tid & 7;
#pragma unroll
    for (int p = 0; p < 4; ++p) { const int row = p * 64 + (tid >> 3); float f[8]; pg8::unpack8(R.k[p], f); float ss = 0.f;
#pragma unroll
        for (int i = 0; i < 8; ++i) ss += f[i] * f[i];
        ss += __shfl_xor(ss, 1); ss += __shfl_xor(ss, 2); ss += __shfl_xor(ss, 4);
        const float rs = 1.0f / sqrtf(ss * (1.0f / 64.0f) + EPS);
#pragma unroll
        for (int i = 0; i < 8; ++i) f[i] = f[i] * rs * gkr[i];
        *(LAS v4u*)(lds + AT_KL + row * AT_PITCH + c * 16) = pg8::pack8(f);
        *(LAS v4u*)(lds + AT_VL + row * AT_PITCH + c * 16) = R.v[p]; }
}
__device__ __forceinline__ void attn_compute(const AttnRegs& R, LAS unsigned char* lds, bf16* PROJ_, float* ML_, const float (&gqr)[16], int it, int wave, int lane, bool do_store) {
    int g, slot, d, r, n; attn_decode(it, g, slot, d, r, n); const int hd = g * 8 + slot;
    const int fr = lane & 15, fq = lane >> 4, w = wave;
    float qf[16]; { float t0[8], t1[8]; pg8::unpack8(R.q[0], t0); pg8::unpack8(R.q[1], t1);
#pragma unroll
        for (int i = 0; i < 8; ++i) { qf[i] = t0[i]; qf[8 + i] = t1[i]; } }
    float ss = 0.f;
#pragma unroll
    for (int i = 0; i < 16; ++i) ss += qf[i] * qf[i];
    ss += __shfl_xor(ss, 16); ss += __shfl_xor(ss, 32);
    const float qs = (1.0f / sqrtf(ss * (1.0f / 64.0f) + EPS)) * (0.125f * 1.4426950408889634f);
    bf16x8_t qa[2];
    { float t0[8], t1[8];
#pragma unroll
      for (int i = 0; i < 8; ++i) { t0[i] = qf[i] * qs * gqr[i]; t1[i] = qf[8 + i] * qs * gqr[8 + i]; }
      qa[0] = __builtin_bit_cast(bf16x8_t, pg8::pack8(t0)); qa[1] = __builtin_bit_cast(bf16x8_t, pg8::pack8(t1)); }
    f32x4 sc[9];
#pragma unroll
    for (int kti = 0; kti < 9; ++kti) { f32x4 acc = (f32x4){0.f, 0.f, 0.f, 0.f}; const LAS unsigned char* kp = lds + AT_KL + ((w + kti) * 16 + fr) * AT_PITCH + fq * 16;
#pragma unroll
        for (int ks = 0; ks < 2; ++ks) { const bf16x8_t kf = *(const LAS bf16x8_t*)(kp + ks * 64); acc = __builtin_amdgcn_mfma_f32_16x16x32_bf16(kf, qa[ks], acc, 0, 0, 0); }
        sc[kti] = acc; if (kti % 3 == 2) __builtin_amdgcn_sched_barrier(0); }
    float mx = -INFINITY;
#pragma unroll
    for (int j = 0; j < 4; ++j) { if (4 * fq + j < fr) sc[0][j] = -INFINITY; if (4 * fq + j > fr) sc[8][j] = -INFINITY; }
#pragma unroll
    for (int kti = 0; kti < 9; ++kti) { if (n == 0 && w + kti < 8) sc[kti] = (f32x4){-INFINITY, -INFINITY, -INFINITY, -INFINITY};
#pragma unroll
        for (int j = 0; j < 4; ++j) mx = fmaxf(mx, sc[kti][j]); }
    mx = fmaxf(mx, __shfl_xor(mx, 16)); mx = fmaxf(mx, __shfl_xor(mx, 32));
    float den = 0.f;
#pragma unroll
    for (int kti = 0; kti < 9; ++kti)
#pragma unroll
        for (int j = 0; j < 4; ++j) { const float pv = __builtin_amdgcn_exp2f(sc[kti][j] - mx); sc[kti][j] = pv; den += pv; }
    den += __shfl_xor(den, 16); den += __shfl_xor(den, 32);
    __builtin_amdgcn_sched_barrier(0);
    f32x4 o[4];
#pragma unroll
    for (int et = 0; et < 4; ++et) o[et] = (f32x4){0.f, 0.f, 0.f, 0.f};
    const int q_ = (lane >> 2) & 3, p_ = lane & 3;
#pragma unroll
    for (int kk = 0; kk < 5; ++kk) { const int kt0 = w + 2 * kk, kt1 = (kk < 4) ? kt0 + 1 : kt0;
        v4u aw; aw.x = pg8::cvt_pk_bf16(sc[2 * kk][0], sc[2 * kk][1]); aw.y = pg8::cvt_pk_bf16(sc[2 * kk][2], sc[2 * kk][3]);
        if (kk < 4) { aw.z = pg8::cvt_pk_bf16(sc[(kk < 4) ? 2 * kk + 1 : 0][0], sc[(kk < 4) ? 2 * kk + 1 : 0][1]); aw.w = pg8::cvt_pk_bf16(sc[(kk < 4) ? 2 * kk + 1 : 0][2], sc[(kk < 4) ? 2 * kk + 1 : 0][3]); } else { aw.z = 0u; aw.w = 0u; }
        const bf16x8_t af = __builtin_bit_cast(bf16x8_t, aw);
        const LAS unsigned char* v0 = lds + AT_VL + (kt0 * 16 + 4 * fq + q_) * AT_PITCH + p_ * 8; const LAS unsigned char* v1 = lds + AT_VL + (kt1 * 16 + 4 * fq + q_) * AT_PITCH + p_ * 8;
#pragma unroll
        for (int et = 0; et < 4; ++et) {
            const s16x4_t lo = __builtin_bit_cast(s16x4_t, __builtin_amdgcn_ds_read_tr16_b64_v4i16((LAS s16x4_t*)(v0 + et * 32)));
            const s16x4_t hi = __builtin_bit_cast(s16x4_t, __builtin_amdgcn_ds_read_tr16_b64_v4i16((LAS s16x4_t*)(v1 + et * 32)));
            const bf16x8_t bfr = (bf16x8_t){lo[0], lo[1], lo[2], lo[3], hi[0], hi[1], hi[2], hi[3]};
            o[et] = __builtin_amdgcn_mfma_f32_16x16x32_bf16(af, bfr, o[et], 0, 0, 0); }
        __builtin_amdgcn_sched_barrier(0); }
    if (do_store)
#pragma unroll
    for (int j = 0; j < 4; ++j) { GAS bf16* op = (GAS bf16*)PROJ_ + (size_t)((n * 128 + 16 * w + 4 * fq + j) * d + r) * PLD + hd * 64 + fr;
#pragma unroll
        for (int et = 0; et < 4; ++et) op[et * 16] = (bf16)f2bf(o[et][j]); }
    if (fq == 0) { GAS float* mp = (GAS float*)ML_ + (size_t)((n * 128 + 16 * w + fr) * d + r) * 48 + (g * 8 + slot) * 2; mp[0] = mx; mp[1] = den; }
}


constexpr int GL_QG = 0, GL_KG = 17408, GL_KDT = 34816, GL_VTL = 53248, GL_PL = 90112, GL_EB = 99328, GL_PAL = 99840, GL_GT = 103936, GL_SSQ = 105984, GL_RS = 108032, GL_QR = 108544, GL_KR = 124928, GL_UP = 141312;
typedef unsigned u32x2_t __attribute__((ext_vector_type(2)));
struct GlaLd { v4u vt[4], q[2], k[2]; float pa[2]; };
template <bool FULL>
__device__ __forceinline__ void gla_load(GlaLd& L, int b, int h, int tok0, const bf16* PROJ_, const bf16* VT_, const float* PA_, int tid) {
    const GAS float* pap = (const GAS float*)PA_ + (size_t)(b * SEQ + tok0) * 16; L.pa[0] = pap[tid]; L.pa[1] = pap[tid + 512];
#pragma unroll
    for (int i = 0; i < 4; ++i) { const int piece = tid + 512 * i, v = piece >> 3, cc = piece & 7; L.vt[i] = *(const GAS v4u*)((const GAS bf16*)VT_ + (size_t)(h * 256 + v) * SEQ + tok0 + cc * 8); }
#pragma unroll
    for (int i = 0; i < 2; ++i) { const int piece = tid + 512 * i, row = piece >> 4, c16 = piece & 15; const GAS bf16* rp = (const GAS bf16*)PROJ_ + (size_t)(tok0 + row) * PLD + h * 128 + c16 * 8;
        L.k[i] = *(const GAS v4u*)(rp + 5120); if (FULL) L.q[i] = *(const GAS v4u*)(rp + 4608); }
}
template <bool FULL>
__device__ __forceinline__ void gla_stage(const GlaLd& L, LAS unsigned char* lds, int tid) {
    LAS float* PAL = (LAS float*)(lds + GL_PAL); PAL[tid] = L.pa[0]; PAL[tid + 512] = L.pa[1];
#pragma unroll
    for (int i = 0; i < 4; ++i) { const int piece = tid + 512 * i, v = piece >> 3, cc = piece & 7; *(LAS v4u*)(lds + GL_VTL + v * 144 + cc * 16) = L.vt[i]; }
#pragma unroll
    for (int i = 0; i < 2; ++i) { const int piece = tid + 512 * i; *(LAS v4u*)(lds + GL_KR + piece * 16) = L.k[i]; if (FULL) *(LAS v4u*)(lds + GL_QR + piece * 16) = L.q[i]; }
}
__device__ __forceinline__ float log_sigmoid_fast(float x) { return fminf(x, 0.f) - __logf(1.0f + __expf(-fabsf(x))); }
template <bool FULL>
__device__ __forceinline__ void gla_item(LAS unsigned char* lds, int b, int item, const bf16* PROJ_, const bf16* VT_, const float* PA_, const float* gate_up_, const float* gate_bias_,
                                         float* SBUF_, float* DBUF_, bf16* A2_, int tid_in, int wave, int lane_in) {
    int tid = tid_in, lane = lane_in; asm volatile("" : "+v"(tid), "+v"(lane));
    const int h = item >> 5, seg = item & 31;
    const int kd = tid & 127, tq = tid >> 7, fr = lane & 15, fq = lane >> 4, w = wave;
    GlaLd L; gla_load<FULL>(L, b, h, seg * 256, PROJ_, VT_, PA_, tid);
    { LAS float* UP = (LAS float*)(lds + GL_UP);
#pragma unroll
      for (int i = 0; i < 4; ++i) { const int idx = tid + 512 * i, r = idx >> 7, k2 = idx & 127; UP[k2 * 20 + r] = gate_up_[r * 512 + h * 128 + k2]; } }
    const float bk = gate_bias_[h * 128 + kd];
    f32x4 S[8][2];
#pragma unroll
    for (int mtk = 0; mtk < 8; ++mtk)
#pragma unroll
        for (int nt = 0; nt < 2; ++nt)
#pragma unroll
            for (int j = 0; j < 4; ++j) S[mtk][nt][j] = FULL ? ((const GAS float*)SBUF_)[((size_t)item * 64 + (mtk * 2 + nt) * 4 + j) * 512 + tid] : 0.f;
    float segsum = 0.f;
    const int tid_item = tid, lane_item = lane;
    for (int c = 0; c < 4; ++c) {
        const int tok0 = seg * 256 + c * 64;
        int tid = tid_item, lane = lane_item; asm volatile("" : "+v"(tid), "+v"(lane));
        const int kd = tid & 127, tq = tid >> 7, fr = lane & 15, fq = lane >> 4;
        gla_stage<FULL>(L, lds, tid);
        __syncthreads();
        if (!FULL && c < 3) gla_load<FULL>(L, b, h, tok0 + 64, PROJ_, VT_, PA_, tid);
        float cb[16];
        { const LAS f32x4* pl = (const LAS f32x4*)(lds + GL_PAL); float run = 0.f; float upr[16];
          { const LAS f32x4* up4 = (const LAS f32x4*)(lds + GL_UP + kd * 80);
#pragma unroll
            for (int q4 = 0; q4 < 4; ++q4) { const f32x4 u = up4[q4]; upr[4 * q4] = u[0]; upr[4 * q4 + 1] = u[1]; upr[4 * q4 + 2] = u[2]; upr[4 * q4 + 3] = u[3]; } }
#pragma unroll
          for (int i = 0; i < 16; ++i) { const int t = 16 * tq + i; float lg = bk;
#pragma unroll
              for (int q4 = 0; q4 < 4; ++q4) { const f32x4 pv = pl[t * 4 + q4]; lg += pv[0] * upr[4 * q4] + pv[1] * upr[4 * q4 + 1] + pv[2] * upr[4 * q4 + 2] + pv[3] * upr[4 * q4 + 3]; }
              run += log_sigmoid_fast(lg) * (1.0f / 16.0f); cb[i] = run; } }
        { LAS float* GT = (LAS float*)(lds + GL_GT); GT[tq * 128 + kd] = cb[15]; }
        __syncthreads();
        float off = 0.f, tot = 0.f;
        { const LAS float* GT = (const LAS float*)(lds + GL_GT);
#pragma unroll
          for (int q = 0; q < 4; ++q) { const float gv = GT[q * 128 + kd]; tot += gv; off += (q < tq) ? gv : 0.f; } }
        { float kdv[16];
#pragma unroll
          for (int i = 0; i < 16; ++i) { const int t = 16 * tq + i; const float bc = cb[i] + off; const float kf = bf2f(*(const LAS unsigned short*)(lds + GL_KR + t * 256 + kd * 2)); kdv[i] = kf * __expf(tot - bc);
              if (FULL) { const float qf = bf2f(*(const LAS unsigned short*)(lds + GL_QR + t * 256 + kd * 2));
                  *(LAS unsigned short*)(lds + GL_QG + t * 272 + kd * 2) = (unsigned short)f2bf(qf * __expf(bc));
                  *(LAS unsigned short*)(lds + GL_KG + t * 272 + kd * 2) = (unsigned short)f2bf(kf * __expf(-bc)); } }
          float lo8[8], hi8[8];
#pragma unroll
          for (int i = 0; i < 8; ++i) { lo8[i] = kdv[i]; hi8[i] = kdv[8 + i]; }
          *(LAS v4u*)(lds + GL_KDT + kd * 144 + tq * 32) = pg8::pack8(lo8); *(LAS v4u*)(lds + GL_KDT + kd * 144 + tq * 32 + 16) = pg8::pack8(hi8); }
        if (tq == 0) ((LAS float*)(lds + GL_EB))[kd] = __expf(tot);
        segsum += tot;
        __syncthreads();
        if (FULL) {
            const int mt = w >> 1;
#pragma unroll
            for (int sti = 0; sti < 2; ++sti) { const int st = 2 * (w & 1) + sti; f32x4 acc = (f32x4){0.f, 0.f, 0.f, 0.f};
                if (st <= mt) {
#pragma unroll
                    for (int ks = 0; ks < 4; ++ks) { const bf16x8_t kf = *(const LAS bf16x8_t*)(lds + GL_KG + (16 * st + fr) * 272 + (32 * ks + 8 * fq) * 2);
                        const bf16x8_t qf = *(const LAS bf16x8_t*)(lds + GL_QG + (16 * mt + fr) * 272 + (32 * ks + 8 * fq) * 2);
                        acc = __builtin_amdgcn_mfma_f32_16x16x32_bf16(kf, qf, acc, 0, 0, 0); }
                    if (st == mt) {
#pragma unroll
                        for (int j = 0; j < 4; ++j) if (4 * fq + j > fr) acc[j] = 0.f; } }
                u32x2_t wv; wv.x = pg8::cvt_pk_bf16(acc[0], acc[1]); wv.y = pg8::cvt_pk_bf16(acc[2], acc[3]);
                *(LAS u32x2_t*)(lds + GL_PL + (16 * mt + fr) * 144 + (16 * st + 4 * fq) * 2) = wv; }
            __syncthreads();
        }
        bf16x8_t vf[2][2];
#pragma unroll
        for (int ks2 = 0; ks2 < 2; ++ks2)
#pragma unroll
            for (int nt = 0; nt < 2; ++nt) vf[ks2][nt] = *(const LAS bf16x8_t*)(lds + GL_VTL + (32 * w + 16 * nt + fr) * 144 + (32 * ks2 + 8 * fq) * 2);
        f32x4 o[4][2];
        if (FULL) {
#pragma unroll
            for (int mt = 0; mt < 4; ++mt) { o[mt][0] = (f32x4){0.f, 0.f, 0.f, 0.f}; o[mt][1] = (f32x4){0.f, 0.f, 0.f, 0.f}; }
#pragma unroll
            for (int ks = 0; ks < 4; ++ks) { bf16x8_t bfr[2];
#pragma unroll
                for (int nt = 0; nt < 2; ++nt) { v4u wv; wv.x = pg8::cvt_pk_bf16(S[2 * ks][nt][0], S[2 * ks][nt][1]); wv.y = pg8::cvt_pk_bf16(S[2 * ks][nt][2], S[2 * ks][nt][3]);
                    wv.z = pg8::cvt_pk_bf16(S[2 * ks + 1][nt][0], S[2 * ks + 1][nt][1]); wv.w = pg8::cvt_pk_bf16(S[2 * ks + 1][nt][2], S[2 * ks + 1][nt][3]); bfr[nt] = __builtin_bit_cast(bf16x8_t, wv); }
#pragma unroll
                for (int mt = 0; mt < 4; ++mt) { const u32x2_t a0 = *(const LAS u32x2_t*)(lds + GL_QG + (16 * mt + fr) * 272 + (32 * ks + 4 * fq) * 2), a1 = *(const LAS u32x2_t*)(lds + GL_QG + (16 * mt + fr) * 272 + (32 * ks + 16 + 4 * fq) * 2);
                    const v4u aw = (v4u){a0.x, a0.y, a1.x, a1.y}; const bf16x8_t af = __builtin_bit_cast(bf16x8_t, aw);
                    o[mt][0] = __builtin_amdgcn_mfma_f32_16x16x32_bf16(af, bfr[0], o[mt][0], 0, 0, 0); o[mt][1] = __builtin_amdgcn_mfma_f32_16x16x32_bf16(af, bfr[1], o[mt][1], 0, 0, 0); } }
#pragma unroll
            for (int ks2 = 0; ks2 < 2; ++ks2)
#pragma unroll
                for (int mt = 0; mt < 4; ++mt) { const bf16x8_t pf = *(const LAS bf16x8_t*)(lds + GL_PL + (16 * mt + fr) * 144 + (32 * ks2 + 8 * fq) * 2);
                    o[mt][0] = __builtin_amdgcn_mfma_f32_16x16x32_bf16(pf, vf[ks2][0], o[mt][0], 0, 0, 0); o[mt][1] = __builtin_amdgcn_mfma_f32_16x16x32_bf16(pf, vf[ks2][1], o[mt][1], 0, 0, 0); }
        }
#pragma unroll
        for (int mtk = 0; mtk < 8; ++mtk) { const f32x4 eb = *(const LAS f32x4*)(lds + GL_EB + (16 * mtk + 4 * fq) * 4);
            S[mtk][0] = S[mtk][0] * eb; S[mtk][1] = S[mtk][1] * eb;
#pragma unroll
            for (int ks2 = 0; ks2 < 2; ++ks2) { const bf16x8_t kf = *(const LAS bf16x8_t*)(lds + GL_KDT + (16 * mtk + fr) * 144 + (32 * ks2 + 8 * fq) * 2);
                S[mtk][0] = __builtin_amdgcn_mfma_f32_16x16x32_bf16(kf, vf[ks2][0], S[mtk][0], 0, 0, 0); S[mtk][1] = __builtin_amdgcn_mfma_f32_16x16x32_bf16(kf, vf[ks2][1], S[mtk][1], 0, 0, 0); } }
        if (FULL) {
            if (c < 3) gla_load<FULL>(L, b, h, tok0 + 64, PROJ_, VT_, PA_, tid);
#pragma unroll
            for (int mt = 0; mt < 4; ++mt)
#pragma unroll
                for (int j = 0; j < 4; ++j) { float sq = o[mt][0][j] * o[mt][0][j] + o[mt][1][j] * o[mt][1][j];
                    sq += __shfl_xor(sq, 1); sq += __shfl_xor(sq, 2); sq += __shfl_xor(sq, 4); sq += __shfl_xor(sq, 8);
                    if (fr == 0) ((LAS float*)(lds + GL_SSQ))[w * 64 + 16 * mt + 4 * fq + j] = sq; }
            __syncthreads();
            if (tid < 64) { const LAS float* sp = (const LAS float*)(lds + GL_SSQ); float tsum = 0.f;
#pragma unroll
                for (int q = 0; q < 8; ++q) tsum += sp[q * 64 + tid];
                ((LAS float*)(lds + GL_RS))[tid] = 1.0f / sqrtf(tsum * (1.0f / 256.0f) + EPS); }
            __syncthreads();
#pragma unroll
            for (int mt = 0; mt < 4; ++mt) { const f32x4 rs = *(const LAS f32x4*)(lds + GL_RS + (16 * mt + 4 * fq) * 4);
#pragma unroll
                for (int j = 0; j < 4; ++j)
#pragma unroll
                    for (int nt = 0; nt < 2; ++nt) *(LAS unsigned short*)(lds + (16 * mt + 4 * fq + j) * 528 + (32 * w + 16 * nt + fr) * 2) = (unsigned short)f2bf(o[mt][nt][j] * rs[j]); }
            __syncthreads();
            v4u rg[4];
#pragma unroll
            for (int i = 0; i < 4; ++i) { const int piece = tid + 512 * i, t = piece >> 5, c8 = piece & 31; rg[i] = *(const GAS v4u*)((const GAS bf16*)PROJ_ + (size_t)(tok0 + t) * PLD + 5632 + h * 256 + c8 * 8); }
#pragma unroll
            for (int i = 0; i < 4; ++i) { const int piece = tid + 512 * i, t = piece >> 5, c8 = piece & 31; float ov[8], rv[8];
                pg8::unpack8(*(const LAS v4u*)(lds + t * 528 + c8 * 16), ov); pg8::unpack8(rg[i], rv);
#pragma unroll
                for (int e = 0; e < 8; ++e) ov[e] *= rv[e];
                *(GAS v4u*)((GAS bf16*)A2_ + (size_t)(b * SEQ + tok0 + t) * DM + h * 256 + c8 * 8) = pg8::pack8(ov); }
        } else {
            __syncthreads();
        }
    }
    if (!FULL) {
#pragma unroll
        for (int mtk = 0; mtk < 8; ++mtk)
#pragma unroll
            for (int nt = 0; nt < 2; ++nt)
#pragma unroll
                for (int j = 0; j < 4; ++j) ((GAS float*)SBUF_)[((size_t)item * 64 + (mtk * 2 + nt) * 4 + j) * 512 + tid] = S[mtk][nt][j];
        if (tq == 0) ((GAS float*)DBUF_)[item * 128 + kd] = __expf(segsum);
    }
}

__global__ void __launch_bounds__(NTHREADS, 2) fwd_kernel(Args a) {
    extern __shared__ __attribute__((aligned(16))) unsigned char lds_raw[];
    LAS unsigned char* lds = (LAS unsigned char*)lds_raw;
    cg::grid_group grid = cg::this_grid();
    const int tid = threadIdx.x, lane = tid & 63, wave = __builtin_amdgcn_readfirstlane(tid >> 6);
    const int G = gridDim.x, bx = blockIdx.x;
    const int gw = bx * NWAVES + wave, NGW = G * NWAVES;
    unsigned char* ws = a.ws;
    const float* x = a.in[0]; const float* g1 = a.in[1]; const float* w_in = a.in[2]; const float* gq = a.in[3]; const float* gk = a.in[4];
    const float* gate_up = a.in[5]; const float* gate_bias = a.in[6]; const float* gla_g = a.in[7]; const float* bgate_bias = a.in[8];
    const float* w_ab = a.in[9]; const float* w_gb = a.in[10]; const float* w_out = a.in[11]; const float* g2 = a.in[12]; const float* w_up = a.in[13]; const float* w_dn = a.in[14];
    bf16* WIN = (bf16*)(ws + WS_WIN); bf16* WA = (bf16*)(ws + WS_WA); bf16* WB = (bf16*)(ws + WS_WB); bf16* WO = (bf16*)(ws + WS_WO);
    bf16* WUP = (bf16*)(ws + WS_WUP); bf16* WDN = (bf16*)(ws + WS_WDN); bf16* XB = (bf16*)(ws + WS_XB); bf16* PROJ = (bf16*)(ws + WS_PROJ);
    bf16* VT = (bf16*)(ws + WS_VT); bf16* A1 = (bf16*)(ws + WS_A1); bf16* A2 = (bf16*)(ws + WS_A2);
    float* R1 = (float*)(ws + WS_R1); float* PA = (float*)(ws + WS_PA); float* SS2 = (float*)(ws + WS_SS2);
    bf16* MIXED = (bf16*)(ws + WS_MIXED); bf16* UB = (bf16*)(ws + WS_U); bf16* GATES = (bf16*)a.out;
    const int lo = a.ph_lo, hi = a.ph_hi; const int repm = a.rep;
    if (tid < 16) ((LAS unsigned*)(lds + LDS_BARST))[tid] = 0u;
    if (bx == 0 && a.ph_lo == 0) for (int i = tid; i < XCD_BAR_WORDS; i += NTHREADS) ((unsigned*)(ws + WS_BAR))[i] = 0u;
    __syncthreads();
#define NREP(bit) (REPMASK ? (((repm >> (bit)) & 1) + 1) : 1)
#define IN(k) (lo <= (k) && (k) < hi)
#define LAUNDER(p) asm volatile("" : "+s"(p))
#define XBAR_OBJ(bb) XcdBarrier bb; bb.bar = (unsigned*)(ws + WS_BAR); bb.x = xb_xcc_id(); bb.st = (volatile LAS unsigned*)(lds + LDS_BARST)
#define SYNC(k) do { if (IN(k) && IN((k) + 1)) { asm volatile("s_waitcnt vmcnt(0) lgkmcnt(0)" ::: "memory"); \
        if ((k) == 0) { grid.sync(); if (threadIdx.x == 0) (void)xb_add((unsigned*)(ws + WS_BAR) + XB_XCNT(xb_xcc_id()), 1u); } \
        else { XBAR_OBJ(bb_); for (int rs_ = 0; rs_ < NREP(8); ++rs_) xcd_barrier(bb_); } } } while (0)

    if (IN(0)) for (int rep_ = 0; rep_ < NREP(0); ++rep_) {
        LAS float* scr = (LAS float*)(lds + 81920 + wave * 8448);
        constexpr int I_IN = 16 * 304, I_A = 8 * 32, I_B = 16 * 32, I_O = 16 * 32, I_UP = 16 * 128, I_DN = 64 * 32;
        constexpr int NITEMS = I_IN + I_A + I_B + I_O + I_UP + I_DN;
        for (int it = gw; it < NITEMS; it += NGW) {
            int r = it;
            if (r < I_IN) { const int kb = r / 304, nb = r % 304; const int n0 = nb * 32; const int src = n0 < 7680 ? n0 : n0 + 16;
                const float cs = (n0 >= 4608 && n0 < 5120) ? 0.08838834764831845f : 1.0f;
                p0_transpose_item(w_in, DIN, src, g1, 1023, cs, WIN, 1024, n0, kb * 64, scr, lane); continue; } r -= I_IN;
            if (r < I_A) { const int kb = r / 32, nb = r % 32; p0_transpose_item(w_ab, 1024, nb * 32, nullptr, 0, 1.0f, WA, 512, nb * 32, kb * 64, scr, lane); continue; } r -= I_A;
            if (r < I_B) { const int kb = r / 32, nb = r % 32; p0_transpose_item(w_gb, 1024, nb * 32, gla_g, 255, 1.0f, WB, 1024, nb * 32, kb * 64, scr, lane); continue; } r -= I_B;
            if (r < I_O) { const int kb = r / 32, nb = r % 32; p0_transpose_item(w_out, 1024, nb * 32, nullptr, 0, 1.0f, WO, 1024, nb * 32, kb * 64, scr, lane); continue; } r -= I_O;
            if (r < I_UP) { const int kb = r / 128, nb = r % 128; p0_transpose_item(w_up, 4096, nb * 32, g2, 1023, 1.0f, WUP, 1024, nb * 32, kb * 64, scr, lane); continue; } r -= I_UP;
            { const int kb = r / 32, nb = r % 32; p0_transpose_item(w_dn, 1024, nb * 32, nullptr, 0, 1.0f, WDN, 4096, nb * 32, kb * 64, scr, lane); }
        }
        LAS float* WAl = (LAS float*)lds;
        for (int idx = tid; idx < 1024 * 16; idx += NTHREADS) { const int k = idx >> 4, r = idx & 15; const int rho = ((k >> 8) * 4 + (k & 3)) * 64 + ((k >> 2) & 63);
            WAl[rho * 20 + r] = w_in[(size_t)k * DIN + 7680 + r] * g1[k]; }
        __syncthreads();
        f32x4 nv[4];
        if (gw < MTOK) { const GAS f32x4* xr0 = (const GAS f32x4*)(x + (size_t)gw * DM) + lane;
#pragma unroll
            for (int j = 0; j < 4; ++j) nv[j] = xr0[64 * j]; }
        for (int row = gw; row < MTOK; row += NGW) {
            asm volatile("" ::: "memory");
            f32x4 v[4]; float ss = 0.f;
#pragma unroll
            for (int j = 0; j < 4; ++j) { v[j] = nv[j]; ss += (v[j][0] * v[j][0] + v[j][1] * v[j][1]) + (v[j][2] * v[j][2] + v[j][3] * v[j][3]); }
            if (row + NGW < MTOK) { const GAS f32x4* xrn = (const GAS f32x4*)(x + (size_t)(row + NGW) * DM) + lane;
#pragma unroll
                for (int j = 0; j < 4; ++j) nv[j] = xrn[64 * j]; }
            ss = wave_sum(ss); const float r1 = 1.0f / sqrtf(ss * (1.0f / 1024.0f) + EPS);
            float pa[16];
#pragma unroll
            for (int r = 0; r < 16; ++r) pa[r] = 0.f;
#pragma unroll
            for (int j = 0; j < 4; ++j)
#pragma unroll
                for (int c = 0; c < 4; ++c) { const float xv = v[j][c]; const LAS f32x4* wp = (const LAS f32x4*)(WAl + ((j * 4 + c) * 64 + lane) * 20);
#pragma unroll
                    for (int q = 0; q < 4; ++q) { const f32x4 w = wp[q]; pa[4 * q] += xv * w[0]; pa[4 * q + 1] += xv * w[1]; pa[4 * q + 2] += xv * w[2]; pa[4 * q + 3] += xv * w[3]; } }
            float mine = 0.f;
#pragma unroll
            for (int r = 0; r < 16; ++r) { const float s = wave_sum(pa[r]); mine = (lane == r) ? s : mine; }
            if (lane < 16) PA[(size_t)row * 16 + lane] = mine * r1;
            if (lane == 0) R1[row] = r1;
            unsigned long long* o8 = (unsigned long long*)(XB + (size_t)row * DM) + lane;
#pragma unroll
            for (int j = 0; j < 4; ++j) o8[64 * j] = (unsigned long long)pk2(v[j][0], v[j][1]) | ((unsigned long long)pk2(v[j][2], v[j][3]) << 32);
        }
        __syncthreads();
    }
    SYNC(0);

    for (int bq = 0; bq < 2; ++bq) {
        int b = bq; LAUNDER(b);
        const int p1 = 1 + 4 * b;
        if (IN(p1)) for (int rep_ = 0; rep_ < NREP(1); ++rep_) {
            pg8::Gemm g{XB + (size_t)b * SEQ * DM, WIN, SEQ, N1, DM}; pg8::StaticOrder S; S.init(SEQ, N1, G, bx);
            pg8::EpiProj E{PROJ, VT, GATES + (size_t)b * SEQ * 2048, R1 + b * SEQ, bgate_bias};
            pg8::gemm_phase<pg8::EpiProj, pg8::StaticOrder, true, true>(lds, g, S, E);
        }
        SYNC(p1);
        int tid_ = threadIdx.x; asm volatile("" : "+v"(tid_)); const int lane_ = tid_ & 63; const int wave_ = __builtin_amdgcn_readfirstlane(tid_ >> 6); int bx_ = bx; LAUNDER(bx_);
        const float* gate_up_ = gate_up; const float* gate_bias_ = gate_bias; const float* PA_ = PA; const bf16* PROJ_ = PROJ; const bf16* VT_ = VT; bf16* A1_ = A1; bf16* A2_ = A2; const float* gq_ = gq; const float* gk_ = gk;
        float* SBUF_ = (float*)(ws + WS_XB); float* DBUF_ = (float*)(ws + WS_MISC + 2 * MiB); float* ML_ = (float*)(ws + WS_MISC);
        LAUNDER(gate_up_); LAUNDER(gate_bias_); LAUNDER(PA_); LAUNDER(PROJ_); LAUNDER(VT_); LAUNDER(A1_); LAUNDER(A2_); LAUNDER(gq_); LAUNDER(gk_); LAUNDER(SBUF_); LAUNDER(DBUF_); LAUNDER(ML_);
        if (IN(p1 + 1)) {
            if (bx_ < 128) for (int rep_ = 0; rep_ < NREP(2); ++rep_) { gla_item<false>(lds, b, bx_, PROJ_, VT_, PA_, gate_up_, gate_bias_, SBUF_, DBUF_, A2_, tid_, wave_, lane_); }
            {
                float gkr[8], gqr[16];
#pragma unroll
                for (int i = 0; i < 8; ++i) gkr[i] = gk_[(tid_ & 7) * 8 + i];
#pragma unroll
                for (int i = 0; i < 8; ++i) { gqr[i] = gq_[8 * (lane_ >> 4) + i]; gqr[8 + i] = gq_[32 + 8 * (lane_ >> 4) + i]; }
                bf16* PROJW = (bf16*)PROJ_;
                const int first = bx_ < 128 ? bx_ : 640 + (bx_ - 128), cnt = bx_ < 128 ? 5 : 7;
                const int nrep_ = NREP(7);
                for (int rep_ = 0; rep_ < nrep_; ++rep_)
                for (int k = 0; k < cnt; ++k) { const int it = first + 128 * k;
                    AttnRegs R; attn_prefetch(R, PROJ_, it, tid_, wave_, lane_);
                    __syncthreads();
                    attn_stage(R, lds, gkr, tid_);
                    __syncthreads();
                    attn_compute(R, lds, PROJW, ML_, gqr, it, wave_, lane_, rep_ == nrep_ - 1);
                }
            }
        }
        SYNC(p1 + 1);
        if (IN(p1 + 2)) {
            { const int gid = bx_ * NTHREADS + tid_;
              if (gid < 4 * 64 * 512) { const int h = gid >> 15, r = (gid >> 9) & 63, tl = gid & 511; const int kdr = 16 * (r >> 3) + 4 * ((tl & 63) >> 4) + (r & 3);
                float loc[32], dec[32];
#pragma unroll
                for (int sg = 0; sg < 32; ++sg) { loc[sg] = ((const GAS float*)SBUF_)[((size_t)(h * 32 + sg) * 64 + r) * 512 + tl]; dec[sg] = ((const GAS float*)DBUF_)[(h * 32 + sg) * 128 + kdr]; }
                float cur = 0.f;
#pragma unroll
                for (int sg = 0; sg < 32; ++sg) { ((GAS float*)SBUF_)[((size_t)(h * 32 + sg) * 64 + r) * 512 + tl] = cur; cur = dec[sg] * cur + loc[sg]; } } }
            {
                for (int idx = bx_ * NTHREADS + tid_; idx < SEQ * 64; idx += G * NTHREADS) {
                    const int t = idx >> 6, slot = (idx >> 3) & 7, c8 = idx & 7;
                    float m[3], dn[3];
#pragma unroll
                    for (int g = 0; g < 3; ++g) { const GAS float* mp = (const GAS float*)ML_ + (size_t)t * 48 + (g * 8 + slot) * 2; m[g] = mp[0]; dn[g] = mp[1]; }
                    const float M = fmaxf(m[0], fmaxf(m[1], m[2])); float D = 0.f; float acc[8];
#pragma unroll
                    for (int i = 0; i < 8; ++i) acc[i] = 0.f;
#pragma unroll
                    for (int g = 0; g < 3; ++g) { const float wg = __builtin_amdgcn_exp2f(m[g] - M); D += wg * dn[g]; float f[8];
                        pg8::unpack8(*(const GAS v4u*)((const GAS bf16*)PROJ_ + (size_t)t * PLD + (g * 8 + slot) * 64 + c8 * 8), f);
#pragma unroll
                        for (int i = 0; i < 8; ++i) acc[i] += wg * f[i]; }
                    const float inv = 1.0f / D;
#pragma unroll
                    for (int i = 0; i < 8; ++i) acc[i] *= inv;
                    *(GAS v4u*)((GAS bf16*)A1_ + (size_t)(b * SEQ + t) * 512 + slot * 64 + c8 * 8) = pg8::pack8(acc);
                }
            }
        }
        SYNC(p1 + 2);
        if (IN(p1 + 3)) {
            if (bx_ < 128) for (int rep_ = 0; rep_ < NREP(3); ++rep_) { gla_item<true>(lds, b, bx_, PROJ_, VT_, PA_, gate_up_, gate_bias_, SBUF_, DBUF_, A2_, tid_, wave_, lane_); __syncthreads(); }
        }
        SYNC(p1 + 3);
    }
    if (IN(9)) for (int rep_ = 0; rep_ < NREP(4); ++rep_) {
        { pg8::Gemm g{A1, WA, MTOK, DM, 512}; pg8::StaticOrder S; S.init(MTOK, DM, G, bx); pg8::EpiBranch E{MIXED, GATES, 0, 0};
          pg8::gemm_phase<pg8::EpiBranch, pg8::StaticOrder, true, true>(lds, g, S, E); }
        __syncthreads();
        { pg8::Gemm g{A2, WB, MTOK, DM, 1024}; pg8::StaticOrder S; S.init(MTOK, DM, G, bx); pg8::EpiBranch E{MIXED, GATES, 1024, 1};
          pg8::gemm_phase<pg8::EpiBranch, pg8::StaticOrder, true, true>(lds, g, S, E); }
    }
    SYNC(9);
    if (IN(10)) for (int rep_ = 0; rep_ < NREP(5); ++rep_) { pg8::Gemm g{MIXED, WO, MTOK, DM, 1024}; pg8::StaticOrder S; S.init(MTOK, DM, G, bx); pg8::EpiOut1 E{x, a.out, XB, SS2};
        pg8::gemm_phase<pg8::EpiOut1, pg8::StaticOrder, true, true>(lds, g, S, E); }
    SYNC(10);
    if (IN(11)) for (int rep_ = 0; rep_ < NREP(6); ++rep_) { pg8::Gemm g{XB, WUP, MTOK, FF, 1024}; pg8::StaticOrder S; S.init(MTOK, FF, G, bx); pg8::EpiUp E{UB, SS2};
        pg8::gemm_phase<pg8::EpiUp, pg8::StaticOrder, true, true>(lds, g, S, E); }
    SYNC(11);
    if (IN(12)) { pg8::Gemm g{UB, WDN, MTOK, DM, FF}; pg8::StaticOrder S; S.init(MTOK, DM, G, bx); pg8::EpiDown E{a.out};
        pg8::gemm_phase<pg8::EpiDown, pg8::StaticOrder, true, true>(lds, g, S, E); }
#undef IN
#undef SYNC
}

extern "C" void kernel_launch(void* const* d_in, const int* in_sizes, int n_in, void* d_out, int out_size, void* d_ws, size_t ws_size, hipStream_t stream) {
    static int grid = 0;
    if (grid == 0) {
        if (n_in != 15 || out_size != MTOK * DM || ws_size < WS_END) { fprintf(stderr, "kernel_launch: unexpected shapes (n_in %d, out %d, ws %zu)\n", n_in, out_size, ws_size); grid = -1; return; }
        int dev = 0, cus = 0, per_cu = 0;
        hipGetDevice(&dev); hipDeviceGetAttribute(&cus, hipDeviceAttributeMultiprocessorCount, dev);
        if (hipFuncSetAttribute((const void*)fwd_kernel, hipFuncAttributeMaxDynamicSharedMemorySize, LDS_BYTES) != hipSuccess) { fprintf(stderr, "kernel_launch: hipFuncSetAttribute failed\n"); grid = -1; return; }
        if (hipOccupancyMaxActiveBlocksPerMultiprocessor(&per_cu, (const void*)fwd_kernel, NTHREADS, LDS_BYTES) != hipSuccess || per_cu < 1) per_cu = 1;
        (void)hipGetLastError();
        grid = cus * per_cu;
        fprintf(stderr, "kernel_launch: grid %d (cus %d x %d)\n", grid, cus, per_cu);
    }
    if (grid < 0) return;
    Args a{};
    for (int i = 0; i < 15; ++i) a.in[i] = (const float*)d_in[i];
    a.out = (float*)d_out; a.ws = (unsigned char*)d_ws; a.ph_lo = 0; a.ph_hi = 13; a.rep = REPMASK; a.pad = 0;
    void* args[] = {&a};
    hipError_t e = hipLaunchCooperativeKernel((const void*)fwd_kernel, dim3(grid), dim3(NTHREADS), args, LDS_BYTES, stream);
    if (e != hipSuccess) fprintf(stderr, "cooperative launch failed: %s (grid %d)\n", hipGetErrorString(e), grid);
}
```

```cpp
#include <hip/hip_runtime.h>
#include <hip/hip_cooperative_groups.h>
#include <cstdio>
#include <cstdint>
#include <cmath>
namespace cg = cooperative_groups;
namespace pg8 {
#define PG8_LAS __attribute__((address_space(3)))
typedef unsigned short bf16_t;
typedef short bf16x8 __attribute__((ext_vector_type(8)));
typedef float f32x4 __attribute__((ext_vector_type(4)));
typedef unsigned u32x4 __attribute__((ext_vector_type(4)));
constexpr int BM = 256, BK = 64, HALF = 128, HTB = HALF * BK * 2  , STAGE_BYTES = 8 * HTB, NXCD = 8, WGM = 8;

__host__ __device__ __forceinline__ int lds_byte(int r, int c) { const int st = (r >> 4) * 2 + (c >> 5), rr = r & 15, cc = c & 31, ob = rr * 64 + cc * 2; return st * 1024 + (ob ^ (((ob >> 9) & 1) << 5)); }
__host__ __device__ __forceinline__ void stage_rc(int b, int& R, int& C) { const int st = b / 1024, sb = b % 1024, swz = sb ^ (((sb >> 9) & 1) << 5); R = (st >> 1) * 16 + swz / 64; C = (st & 1) * 32 + (swz % 64) / 2; }
__host__ __device__ __forceinline__ int perm32(int rho) { const int n = rho >> 4, i = rho & 15; return 8 * (i >> 2) + 4 * n + (i & 3); }

struct Unit { int pm, pn; };
struct Gemm { const bf16_t* A; const bf16_t* Bt; int M, N, K; };

struct StaticOrder {
    int nM, nN, nwg, G, c;
    __host__ __device__ void init(int M, int N, int G_, int c_) { nM = M / BM; nN = N / BM; nwg = nM * nN; G = G_; c = c_; }
    __host__ __device__ bool next(int i, Unit& u) const {
        const long L = (long)i * G + c; if (L >= nwg) return false;
        int wgid = (int)L; { const int q = nwg / NXCD, r = nwg % NXCD, xcd = wgid % NXCD, off = wgid / NXCD; wgid = (xcd < r ? xcd * (q + 1) : r * (q + 1) + (xcd - r) * q) + off; }
        const int nig = WGM * nN, gid = wgid / nig, fm = gid * WGM, gsz = (nM - fm) < WGM ? (nM - fm) : WGM;
        u.pm = fm + ((wgid % nig) % gsz); u.pn = (wgid % nig) / gsz; return true;
    }
    __device__ __forceinline__ void a_ready(const Unit&) const {}
    __device__ __forceinline__ void done(const Unit&) const {}
};
typedef float f32x2 __attribute__((ext_vector_type(2)));
typedef __bf16 bf16x2_cv __attribute__((ext_vector_type(2)));
__device__ __forceinline__ unsigned cvt_pk_bf16(float lo, float hi) { const f32x2 v = {lo, hi}; const bf16x2_cv b = __builtin_convertvector(v, bf16x2_cv); return __builtin_bit_cast(unsigned, b); }
__device__ __forceinline__ float bflo(unsigned w) { return __uint_as_float(w << 16); }
__device__ __forceinline__ float bfhi(unsigned w) { return __uint_as_float(w & 0xffff0000u); }
__device__ __forceinline__ void unpack8(const u32x4 w, float (&f)[8]) { f[0] = bflo(w.x); f[1] = bfhi(w.x); f[2] = bflo(w.y); f[3] = bfhi(w.y); f[4] = bflo(w.z); f[5] = bfhi(w.z); f[6] = bflo(w.w); f[7] = bfhi(w.w); }
__device__ __forceinline__ u32x4 pack8(const float (&v)[8]) { u32x4 w; w.x = cvt_pk_bf16(v[0], v[1]); w.y = cvt_pk_bf16(v[2], v[3]); w.z = cvt_pk_bf16(v[4], v[5]); w.w = cvt_pk_bf16(v[6], v[7]); return w; }
__device__ __forceinline__ float fsigmoid(float x) { return 1.0f / (1.0f + __expf(-x)); }

struct EpiProj {
    static constexpr bool PERM = true, AFTER_DRAIN = false;
    bf16_t* proj; bf16_t* vt; bf16_t* gates; const float* r1; const float* gbias;
    __device__ __forceinline__ void operator()(const f32x4 (&acc)[2][2][4][2], const Unit& u, int wr, int wc, int fr_in, int fq_in) const {
        int fr = fr_in, fq = fq_in; asm volatile("" : "+v"(fr), "+v"(fq));
        const int ct = u.pn; const int row0 = u.pm * BM + wr * 64 + fr; const int cl = wc * 32 + 8 * fq;
#pragma unroll
        for (int ai = 0; ai < 2; ++ai)
#pragma unroll
            for (int m = 0; m < 4; ++m) {
                const int row = row0 + ai * HALF + m * 16; const float rs = r1[row];
#pragma unroll
                for (int bj = 0; bj < 2; ++bj) {
                    const f32x4 v0 = acc[ai][bj][m][0] * rs, v1 = acc[ai][bj][m][1] * rs;
                    float v[8] = {v0[0], v0[1], v0[2], v0[3], v1[0], v1[1], v1[2], v1[3]};
                    const int c = cl + bj * HALF;
                    if (ct < 22) { *(u32x4*)(proj + (size_t)row * 6656 + ct * 256 + c) = pack8(v); }
                    else if (ct < 26) { const u32x4 w = pack8(v); bf16_t* p = vt + (size_t)((ct - 22) * 256 + c) * 8192 + row;
                        p[0] = (bf16_t)(w.x & 0xffffu); p[8192] = (bf16_t)(w.x >> 16); p[2 * 8192] = (bf16_t)(w.y & 0xffffu); p[3 * 8192] = (bf16_t)(w.y >> 16);
                        p[4 * 8192] = (bf16_t)(w.z & 0xffffu); p[5 * 8192] = (bf16_t)(w.z >> 16); p[6 * 8192] = (bf16_t)(w.w & 0xffffu); p[7 * 8192] = (bf16_t)(w.w >> 16); }
                    else if (ct < 30) {
#pragma unroll
                        for (int i = 0; i < 8; ++i) v[i] = v[i] * fsigmoid(v[i]);
                        *(u32x4*)(proj + (size_t)row * 6656 + (ct - 4) * 256 + c) = pack8(v); }
                    else { const int gc = (ct - 30) * 256 + c; const f32x4 b0 = *(const f32x4*)(gbias + gc), b1 = *(const f32x4*)(gbias + gc + 4);
                        const float bb[8] = {b0[0], b0[1], b0[2], b0[3], b1[0], b1[1], b1[2], b1[3]};
#pragma unroll
                        for (int i = 0; i < 8; ++i) v[i] = fsigmoid(v[i] + bb[i]);
                        *(u32x4*)(gates + (size_t)row * 2048 + gc) = pack8(v); }
                }
            }
    }
};
struct EpiBranch {
    static constexpr bool PERM = true, AFTER_DRAIN = false;
    bf16_t* mixed; const bf16_t* gates; int goff; int add;
    __device__ __forceinline__ void operator()(const f32x4 (&acc)[2][2][4][2], const Unit& u, int wr, int wc, int fr_in, int fq_in) const {
        int fr = fr_in, fq = fq_in; asm volatile("" : "+v"(fr), "+v"(fq));
        const int row0 = u.pm * BM + wr * 64 + fr; const int cl = u.pn * BM + wc * 32 + 8 * fq;
#pragma unroll
        for (int ai = 0; ai < 2; ++ai)
#pragma unroll
            for (int m = 0; m < 4; ++m) {
                const int row = row0 + ai * HALF + m * 16;
#pragma unroll
                for (int bj = 0; bj < 2; ++bj) {
                    const int c = cl + bj * HALF; float g[8], v[8];
                    unpack8(*(const u32x4*)(gates + (size_t)row * 2048 + goff + c), g);
                    const f32x4 v0 = acc[ai][bj][m][0], v1 = acc[ai][bj][m][1];
                    v[0] = v0[0] * g[0]; v[1] = v0[1] * g[1]; v[2] = v0[2] * g[2]; v[3] = v0[3] * g[3]; v[4] = v1[0] * g[4]; v[5] = v1[1] * g[5]; v[6] = v1[2] * g[6]; v[7] = v1[3] * g[7];
                    if (add) { float t[8]; unpack8(*(const u32x4*)(mixed + (size_t)row * 1024 + c), t);
#pragma unroll
                        for (int i = 0; i < 8; ++i) v[i] += t[i]; }
                    *(u32x4*)(mixed + (size_t)row * 1024 + c) = pack8(v);
                }
            }
    }
};
struct EpiOut1 {
    static constexpr bool PERM = true, AFTER_DRAIN = false;
    const float* x; float* out; bf16_t* x1b; float* ss2;
    __device__ __forceinline__ void operator()(const f32x4 (&acc)[2][2][4][2], const Unit& u, int wr, int wc, int fr_in, int fq_in) const {
        int fr = fr_in, fq = fq_in; asm volatile("" : "+v"(fr), "+v"(fq));
        const int row0 = u.pm * BM + wr * 64 + fr; const int cl = u.pn * BM + wc * 32 + 8 * fq;
#pragma unroll
        for (int ai = 0; ai < 2; ++ai)
#pragma unroll
            for (int m = 0; m < 4; ++m) {
                const int row = row0 + ai * HALF + m * 16; float ssq = 0.f;
#pragma unroll
                for (int bj = 0; bj < 2; ++bj) {
                    const size_t off = (size_t)row * 1024 + cl + bj * HALF;
                    const f32x4 o0 = *(const f32x4*)(x + off) + acc[ai][bj][m][0], o1 = *(const f32x4*)(x + off + 4) + acc[ai][bj][m][1];
                    *(f32x4*)(out + off) = o0; *(f32x4*)(out + off + 4) = o1;
                    const float v[8] = {o0[0], o0[1], o0[2], o0[3], o1[0], o1[1], o1[2], o1[3]};
                    *(u32x4*)(x1b + off) = pack8(v);
#pragma unroll
                    for (int i = 0; i < 8; ++i) ssq += v[i] * v[i];
                }
                ssq += __shfl_xor(ssq, 16); ssq += __shfl_xor(ssq, 32);
                if (fq == 0) ss2[(size_t)row * 16 + u.pn * 4 + wc] = ssq;
            }
    }
};
struct EpiUp {
    static constexpr bool PERM = true, AFTER_DRAIN = false;
    bf16_t* U; const float* ss2;
    __device__ __forceinline__ void operator()(const f32x4 (&acc)[2][2][4][2], const Unit& u, int wr, int wc, int fr_in, int fq_in) const {
        int fr = fr_in, fq = fq_in; asm volatile("" : "+v"(fr), "+v"(fq));
        const int row0 = u.pm * BM + wr * 64 + fr; const int cl = u.pn * BM + wc * 32 + 8 * fq;
#pragma unroll
        for (int ai = 0; ai < 2; ++ai)
#pragma unroll
            for (int m = 0; m < 4; ++m) {
                const int row = row0 + ai * HALF + m * 16;
                const f32x4* sp = (const f32x4*)(ss2 + (size_t)row * 16); const f32x4 s0 = sp[0], s1 = sp[1], s2 = sp[2], s3 = sp[3];
                const float s = ((s0[0] + s0[1]) + (s0[2] + s0[3])) + ((s1[0] + s1[1]) + (s1[2] + s1[3])) + ((s2[0] + s2[1]) + (s2[2] + s2[3])) + ((s3[0] + s3[1]) + (s3[2] + s3[3]));
                const float rs = 1.0f / sqrtf(s * (1.0f / 1024.0f) + 1e-6f);
#pragma unroll
                for (int bj = 0; bj < 2; ++bj) {
                    const f32x4 v0 = acc[ai][bj][m][0] * rs, v1 = acc[ai][bj][m][1] * rs;
                    float v[8] = {v0[0], v0[1], v0[2], v0[3], v1[0], v1[1], v1[2], v1[3]};
#pragma unroll
                    for (int i = 0; i < 8; ++i) { const float r = fmaxf(v[i], 0.f); v[i] = r * r; }
                    *(u32x4*)(U + (size_t)row * 4096 + cl + bj * HALF) = pack8(v);
                }
            }
    }
};
struct EpiDown {
    static constexpr bool PERM = true, AFTER_DRAIN = false;
    float* out;
    __device__ __forceinline__ void operator()(const f32x4 (&acc)[2][2][4][2], const Unit& u, int wr, int wc, int fr_in, int fq_in) const {
        int fr = fr_in, fq = fq_in; asm volatile("" : "+v"(fr), "+v"(fq));
        const int row0 = u.pm * BM + wr * 64 + fr; const int cl = u.pn * BM + wc * 32 + 8 * fq;
#pragma unroll
        for (int ai = 0; ai < 2; ++ai)
#pragma unroll
            for (int m = 0; m < 4; ++m) {
                const int row = row0 + ai * HALF + m * 16;
#pragma unroll
                for (int bj = 0; bj < 2; ++bj) {
                    const size_t off = (size_t)row * 1024 + cl + bj * HALF;
                    const f32x4 o0 = *(const f32x4*)(out + off) + acc[ai][bj][m][0], o1 = *(const f32x4*)(out + off + 4) + acc[ai][bj][m][1];
                    *(f32x4*)(out + off) = o0; *(f32x4*)(out + off + 4) = o1;
                }
            }
    }
};
template <class Epi, class Sched, bool ALIGN_EPI = false, bool SP2 = false>
__device__ __forceinline__ void gemm_phase(PG8_LAS unsigned char* lds, const Gemm g, const Sched& S, const Epi& E) {
    int tid_l = threadIdx.x; asm volatile("" : "+v"(tid_l));
    const int tid = tid_l, wid = __builtin_amdgcn_readfirstlane(tid >> 6), lane = tid & 63, wr = wid >> 2, wc = wid & 3, fr = lane & 15, fq = lane >> 4;
    const int K = g.K, nt = K / BK;
    unsigned voffA[2], voffB[2];
#pragma unroll
    for (int i = 0; i < 2; ++i) { int R, C; stage_rc(tid * 16 + i * 8192, R, C); const int Rb = Epi::PERM ? ((R & ~31) + perm32(R & 31)) : R;
        voffA[i] = (unsigned)(R * K + C) * 2u; voffB[i] = (unsigned)(Rb * K + C) * 2u; }
    const size_t kstep = (size_t)(BK * 2);
    const size_t hstep = (size_t)HALF * K * 2;
    const size_t tstep = 2 * hstep;
    const unsigned ldsw = (unsigned)wid * 1024u;
    const int aoff = lds_byte(wr * 64 + fr, fq * 8), boff = lds_byte(wc * 32 + fr, fq * 8);
#define PG8_SA(b, h) (((b) * 2 + (h)) * HTB)
#define PG8_SB(b, h) ((4 + (b) * 2 + (h)) * HTB)
#define PG8_STAGE(bufoff, gbase, voff) do { _Pragma("unroll") for (int _i = 0; _i < 2; ++_i) \
        __builtin_amdgcn_global_load_lds((const unsigned*)((const char*)(gbase) + (voff)[_i]), (PG8_LAS unsigned*)(lds + (bufoff) + ldsw + _i * 8192), 16, 0, 0); } while (0)
#define PG8_LDA(dst, b, h) do { _Pragma("unroll") for (int m = 0; m < 4; ++m) _Pragma("unroll") for (int k = 0; k < 2; ++k) dst[m][k] = *(const PG8_LAS bf16x8*)(lds + PG8_SA(b, h) + aoff + m * 2048 + k * 1024); } while (0)
#define PG8_LDB(dst, b, h) do { _Pragma("unroll") for (int n = 0; n < 2; ++n) _Pragma("unroll") for (int k = 0; k < 2; ++k) dst[n][k] = *(const PG8_LAS bf16x8*)(lds + PG8_SB(b, h) + boff + n * 2048 + k * 1024); } while (0)
#define PG8_MMA(ai, bj, At, Bt) do { __builtin_amdgcn_s_setprio(1); _Pragma("unroll") for (int m = 0; m < 4; ++m) _Pragma("unroll") for (int n = 0; n < 2; ++n) _Pragma("unroll") for (int k = 0; k < 2; ++k) \
        acc[ai][bj][m][n] = __builtin_amdgcn_mfma_f32_16x16x32_bf16(Bt[n][k], At[m][k], acc[ai][bj][m][n], 0, 0, 0); __builtin_amdgcn_s_setprio(0); } while (0)
#define PG8_WAIT_V(n) asm volatile("s_waitcnt vmcnt(" #n ")" ::: "memory")
#define PG8_WAIT_L(n) asm volatile("s_waitcnt lgkmcnt(" #n ")" ::: "memory")
#define PG8_BAR __builtin_amdgcn_s_barrier()
#define PG8_SCHED __builtin_amdgcn_sched_barrier(0)
    Unit cur, nxt; int ui = 0;
    if (!S.next(0, cur)) return;
    f32x4 acc[2][2][4][2];
#pragma unroll
    for (int a = 0; a < 2; ++a)
#pragma unroll
        for (int b = 0; b < 2; ++b)
#pragma unroll
            for (int m = 0; m < 4; ++m)
#pragma unroll
                for (int n = 0; n < 2; ++n) acc[a][b][m][n] = (f32x4){0.f, 0.f, 0.f, 0.f};
    bf16x8 At[4][2], B0[2][2], B1[2][2];
    const char* cA = (const char*)g.A + (size_t)cur.pm * tstep; const char* cB = (const char*)g.Bt + (size_t)cur.pn * tstep;
    S.a_ready(cur);
    if constexpr (SP2) {
        PG8_STAGE(PG8_SB(0, 0), cB, voffB); PG8_STAGE(PG8_SB(0, 1), cB + hstep, voffB); PG8_STAGE(PG8_SA(0, 0), cA, voffA); PG8_STAGE(PG8_SA(0, 1), cA + hstep, voffA);
        if (wr == 1) PG8_BAR;
        PG8_WAIT_V(2); PG8_BAR;
        PG8_STAGE(PG8_SB(1, 0), cB + kstep, voffB); PG8_STAGE(PG8_SA(1, 0), cA + kstep, voffA); PG8_STAGE(PG8_SB(1, 1), cB + hstep + kstep, voffB);
        PG8_WAIT_V(6); PG8_BAR;
    } else {
        PG8_STAGE(PG8_SB(0, 0), cB, voffB); PG8_STAGE(PG8_SA(0, 0), cA, voffA); PG8_STAGE(PG8_SB(0, 1), cB + hstep, voffB); PG8_STAGE(PG8_SA(0, 1), cA + hstep, voffA);
        if (wr == 1) PG8_BAR;
        PG8_WAIT_V(4); PG8_BAR;
        PG8_STAGE(PG8_SB(1, 0), cB + kstep, voffB); PG8_STAGE(PG8_SA(1, 0), cA + kstep, voffA); PG8_STAGE(PG8_SB(1, 1), cB + hstep + kstep, voffB);
        PG8_WAIT_V(6); PG8_BAR;
    }
    for (;;) {
        const bool has_next = S.next(ui + 1, nxt);
        const char* nA = has_next ? (const char*)g.A + (size_t)nxt.pm * tstep : cA; const char* nB = has_next ? (const char*)g.Bt + (size_t)nxt.pn * tstep : cB;
        for (int t = 0; t < nt; t += 2) {
            const bool last = (t == nt - 2);
            const char* a1 = cA + (size_t)(t + 1) * kstep;
            const char* a2 = last ? nA : cA + (size_t)(t + 2) * kstep; const char* b2 = last ? nB : cB + (size_t)(t + 2) * kstep;
            const char* a3 = a2 + kstep; const char* b3 = b2 + kstep;
            if (last && has_next) S.a_ready(nxt);
            if constexpr (SP2) {
            PG8_LDB(B0, 0, 0); PG8_LDB(B1, 0, 1); PG8_SCHED; PG8_LDA(At, 0, 0); PG8_STAGE(PG8_SA(1, 1), a1 + hstep, voffA);
            PG8_WAIT_V(8); PG8_WAIT_L(0); PG8_BAR; PG8_MMA(0, 0, At, B0); PG8_MMA(0, 1, At, B1); PG8_BAR; PG8_SCHED;
            PG8_LDA(At, 0, 1); PG8_STAGE(PG8_SB(0, 0), b2, voffB); PG8_STAGE(PG8_SB(0, 1), b2 + hstep, voffB); PG8_STAGE(PG8_SA(0, 0), a2, voffA);
            PG8_WAIT_V(8); PG8_WAIT_L(0); PG8_BAR; PG8_MMA(1, 0, At, B0); PG8_MMA(1, 1, At, B1); PG8_BAR; PG8_SCHED;
            PG8_LDB(B0, 1, 0); PG8_LDB(B1, 1, 1); PG8_SCHED; PG8_LDA(At, 1, 0); PG8_STAGE(PG8_SA(0, 1), a2 + hstep, voffA);
            PG8_WAIT_V(8); PG8_WAIT_L(0); PG8_BAR; PG8_MMA(0, 0, At, B0); PG8_MMA(0, 1, At, B1); PG8_BAR; PG8_SCHED;
            PG8_LDA(At, 1, 1); PG8_STAGE(PG8_SB(1, 0), b3, voffB); PG8_STAGE(PG8_SB(1, 1), b3 + hstep, voffB); PG8_STAGE(PG8_SA(1, 0), a3, voffA);
            PG8_WAIT_V(8); PG8_WAIT_L(0); PG8_BAR; PG8_MMA(1, 0, At, B0); PG8_MMA(1, 1, At, B1); PG8_BAR; PG8_SCHED;
            } else {
            PG8_LDB(B0, 0, 0); PG8_SCHED; PG8_LDA(At, 0, 0); PG8_STAGE(PG8_SA(1, 1), a1 + hstep, voffA);
            PG8_WAIT_L(8); PG8_BAR; PG8_WAIT_L(0); PG8_MMA(0, 0, At, B0); PG8_BAR; PG8_SCHED;
            PG8_LDB(B1, 0, 1); PG8_STAGE(PG8_SB(0, 0), b2, voffB);
            PG8_BAR; PG8_WAIT_L(0); PG8_MMA(0, 1, At, B1); PG8_BAR;
            PG8_LDA(At, 0, 1); PG8_STAGE(PG8_SA(0, 0), a2, voffA);
            PG8_BAR; PG8_WAIT_L(0); PG8_MMA(1, 0, At, B0); PG8_BAR; PG8_SCHED;
            PG8_STAGE(PG8_SB(0, 1), b2 + hstep, voffB);
            PG8_WAIT_V(6); PG8_BAR; PG8_MMA(1, 1, At, B1); PG8_BAR;
            PG8_LDB(B0, 1, 0); PG8_SCHED; PG8_LDA(At, 1, 0); PG8_STAGE(PG8_SA(0, 1), a2 + hstep, voffA);
            PG8_WAIT_L(8); PG8_BAR; PG8_WAIT_L(0); PG8_MMA(0, 0, At, B0); PG8_BAR; PG8_SCHED;
            PG8_LDB(B1, 1, 1); PG8_STAGE(PG8_SB(1, 0), b3, voffB);
            PG8_BAR; PG8_WAIT_L(0); PG8_MMA(0, 1, At, B1); PG8_BAR;
            PG8_LDA(At, 1, 1); PG8_STAGE(PG8_SA(1, 0), a3, voffA);
            PG8_BAR; PG8_WAIT_L(0); PG8_MMA(1, 0, At, B0); PG8_BAR; PG8_SCHED;
            PG8_STAGE(PG8_SB(1, 1), b3 + hstep, voffB);
            PG8_WAIT_V(6); PG8_BAR; PG8_MMA(1, 1, At, B1); PG8_BAR;
            }
        }
        if constexpr (ALIGN_EPI) { if (wr == 0) PG8_BAR; }
        if constexpr (!Epi::AFTER_DRAIN) { E(acc, cur, wr, wc, fr, fq); S.done(cur); }
        if (!has_next) break;
#pragma unroll
        for (int a = 0; a < 2; ++a)
#pragma unroll
            for (int b = 0; b < 2; ++b)
#pragma unroll
                for (int m = 0; m < 4; ++m)
#pragma unroll
                    for (int n = 0; n < 2; ++n) acc[a][b][m][n] = (f32x4){0.f, 0.f, 0.f, 0.f};
        cur = nxt; cA = nA; cB = nB; ++ui;
        if constexpr (ALIGN_EPI) { if (wr == 1) PG8_BAR; }
    }
    PG8_WAIT_V(0);
    if constexpr (!ALIGN_EPI) { if (wr == 0) PG8_BAR; }
    PG8_BAR;
    if constexpr (Epi::AFTER_DRAIN) { E.fused(acc, cur, wr, wc, fr, fq, lds, wid, lane); S.done(cur); }
#undef PG8_SA
#undef PG8_SB
#undef PG8_STAGE
#undef PG8_LDA
#undef PG8_LDB
#undef PG8_MMA
#undef PG8_WAIT_V
#undef PG8_WAIT_L
#undef PG8_BAR
#undef PG8_SCHED
}
}
#define LAS __attribute__((address_space(3)))
#define GAS __attribute__((address_space(1)))
typedef unsigned short bf16;
typedef unsigned v4u __attribute__((ext_vector_type(4)));
typedef float f32x4 __attribute__((ext_vector_type(4)));
constexpr int NWAVES = 8, NTHREADS = 512;
constexpr int SEQ = 8192, DM = 1024, MTOK = 16384, DIN = 9744, N1 = 9728, PLD = 6656, FF = 4096;
constexpr float EPS = 1e-6f;
constexpr size_t MiB = 1u << 20;
constexpr size_t WS_WIN = 1 * MiB, WS_WA = 20 * MiB, WS_WB = 21 * MiB, WS_WO = 23 * MiB, WS_WUP = 25 * MiB, WS_WDN = 33 * MiB;
constexpr size_t WS_XB = 41 * MiB, WS_PROJ = 73 * MiB, WS_VT = 177 * MiB, WS_A1 = 193 * MiB, WS_A2 = 209 * MiB;
constexpr size_t WS_R1 = 241 * MiB, WS_PA = 242 * MiB, WS_SS2 = 243 * MiB, WS_MISC = 244 * MiB;
constexpr size_t WS_MIXED = 73 * MiB, WS_U = 73 * MiB, WS_END = 256 * MiB;
constexpr int LDS_BYTES = 155648, LDS_BARST = 155584;
constexpr size_t WS_BAR = 0;

__device__ __forceinline__ float bf2f(bf16 h) { return __uint_as_float(((unsigned)h) << 16); }
__device__ __forceinline__ unsigned f2bf(float f) { unsigned u = __builtin_bit_cast(unsigned, f); return (u + 0x7fffu + ((u >> 16) & 1u)) >> 16; }
__device__ __forceinline__ unsigned pk2(float lo, float hi) { return f2bf(lo) | (f2bf(hi) << 16); }
__device__ __forceinline__ float wave_sum(float v) {
#pragma unroll
    for (int o = 1; o < 64; o <<= 1) v += __shfl_xor(v, o);
    return v;
}
__device__ __forceinline__ float log_sigmoid(float x) { return fminf(x, 0.f) - log1pf(__expf(-fabsf(x))); }

#ifndef REPMASK
#define REPMASK 0
#endif
struct Args { const float* in[15]; float* out; unsigned char* ws; int ph_lo, ph_hi, rep, pad; };

__device__ __forceinline__ void p0_transpose_item(const float* W, int ldw, int srccol0, const float* kscale, int kmask, float cscale,
                                                  bf16* WT, int K, int dstrow0, int k0, LAS float* scr, int lane) {
    float v[32];
    const GAS float* wp = (const GAS float*)W + (size_t)(k0 + (lane >> 5)) * ldw + srccol0 + (lane & 31);
#pragma unroll
    for (int i = 0; i < 32; ++i) v[i] = wp[(size_t)(2 * i) * ldw];
    const int c = lane & 7;
    f32x4 s0 = (f32x4){cscale, cscale, cscale, cscale}, s1 = s0;
    if (kscale) { const int kb = (k0 + 8 * c) & kmask; s0 = *(const GAS f32x4*)((const GAS float*)kscale + kb) * cscale; s1 = *(const GAS f32x4*)((const GAS float*)kscale + kb + 4) * cscale; }
#pragma unroll
    for (int i = 0; i < 32; ++i) scr[(2 * i + (lane >> 5)) * 33 + (lane & 31)] = v[i];
    asm volatile("s_waitcnt lgkmcnt(0)" ::: "memory");
#pragma unroll
    for (int j = 0; j < 4; ++j) { const int n = (lane >> 3) + 8 * j; const LAS float* s = scr + (8 * c) * 33 + n;
        v4u o; o.x = pk2(s[0 * 33] * s0[0], s[1 * 33] * s0[1]); o.y = pk2(s[2 * 33] * s0[2], s[3 * 33] * s0[3]); o.z = pk2(s[4 * 33] * s1[0], s[5 * 33] * s1[1]); o.w = pk2(s[6 * 33] * s1[2], s[7 * 33] * s1[3]);
        *(GAS v4u*)((GAS bf16*)WT + (size_t)(dstrow0 + n) * K + k0 + 8 * c) = o; }
    asm volatile("s_waitcnt lgkmcnt(0)" ::: "memory");
}

#define XB_TMO      128
#define XB_XCNT(j)  (256  + 64 * (j))
#define XB_XSUB(j)  (1280 + 64 * (j))
#define XB_XGEN(j)  (2304 + 64 * (j))
#define XB_TOP      3328
#define XB_TOPGEN   3392
#define XCD_BAR_WORDS 3456
#define XB_SPIN_CAP (1u << 18)

__device__ __forceinline__ unsigned xb_ld(unsigned* p)              { return __hip_atomic_load(p, __ATOMIC_RELAXED, __HIP_MEMORY_SCOPE_AGENT); }
__device__ __forceinline__ unsigned xb_add(unsigned* p, unsigned v) { return __hip_atomic_fetch_add(p, v, __ATOMIC_RELAXED, __HIP_MEMORY_SCOPE_AGENT); }
__device__ __forceinline__ unsigned xb_xcc_id() { return (unsigned)__builtin_amdgcn_s_getreg((3 << 11) | 20) & 0xFu; }
#define XB_SPIN(cond, bar) do { unsigned _sp = 0; while (cond) { __builtin_amdgcn_s_sleep(1); \
    if ((++_sp & 255u) == 0u) { if (xb_ld(&(bar)[XB_TMO])) break; if (_sp > XB_SPIN_CAP) { atomicAdd(&(bar)[XB_TMO], 1u); break; } } } } while (0)

struct XcdBarrier {
    unsigned* bar; unsigned x;
    volatile LAS unsigned* st;
};

__device__ __forceinline__ XcdBarrier xcd_barrier_post(unsigned* bar, volatile LAS unsigned* st) {
    XcdBarrier b; b.bar = bar; b.x = xb_xcc_id(); b.st = st;
    if (threadIdx.x == 0) (void)xb_add(&bar[XB_XCNT(b.x)], 1u);
    return b;
}
__device__ __forceinline__ void xcd_barrier_complete(unsigned* bar, unsigned x, unsigned& nloc, unsigned& nx) {
    const unsigned G = gridDim.x * gridDim.y * gridDim.z;
    unsigned sum, cnt, mine, sp = 0u;
    for (;;) {
        sum = 0u; cnt = 0u; mine = 0u;
#pragma unroll
        for (unsigned j = 0; j < 16; ++j) { const unsigned c = xb_ld(&bar[XB_XCNT(j)]); sum += c; cnt += (c > 0u) ? 1u : 0u; mine = (j == x) ? c : mine; }
        if (sum == G) break;
        __builtin_amdgcn_s_sleep(1);
        if ((++sp & 255u) == 0u) { if (xb_ld(&bar[XB_TMO])) break; if (sp > XB_SPIN_CAP) { atomicAdd(&bar[XB_TMO], 1u); break; } }
    }
    nloc = mine > 0u ? mine : 1u; nx = cnt > 0u ? cnt : 1u;
}

__device__ __forceinline__ void xcd_barrier(const XcdBarrier& b) {
    asm volatile("s_waitcnt vmcnt(0)" ::: "memory");
    __syncthreads();
    if (threadIdx.x == 0) {
        unsigned* bar = b.bar;
        __builtin_amdgcn_s_waitcnt(0);
        unsigned nloc = b.st[0], nx = b.st[1];
        if (nloc == 0u) { xcd_barrier_complete(bar, b.x, nloc, nx); b.st[0] = nloc; b.st[1] = nx; }
        const unsigned old = xb_add(&bar[XB_XSUB(b.x)], 1u);
        const unsigned gen = old / nloc;
        if (old + 1u == (gen + 1u) * nloc) {
            __builtin_amdgcn_fence(__ATOMIC_RELEASE, "agent");
            asm volatile("s_waitcnt vmcnt(0)" ::: "memory");
            const unsigned og = xb_add(&bar[XB_TOP], 1u);
            const unsigned tg = og / nx;
            if (og + 1u == (tg + 1u) * nx) xb_add(&bar[XB_TOPGEN], 1u);
            else XB_SPIN(xb_ld(&bar[XB_TOPGEN]) == tg, bar);
            __builtin_amdgcn_fence(__ATOMIC_ACQUIRE, "agent");
            xb_add(&bar[XB_XGEN(b.x)], 1u);
            asm volatile("s_waitcnt vmcnt(0)" ::: "memory");
        } else {
            XB_SPIN(xb_ld(&bar[XB_XGEN(b.x)]) == gen, bar);
            __builtin_amdgcn_fence(__ATOMIC_ACQUIRE, "agent");
            asm volatile("s_waitcnt vmcnt(0)" ::: "memory");
        }
    }
    __syncthreads();
}

typedef short bf16x8_t __attribute__((ext_vector_type(8)));
typedef short s16x4_t __attribute__((ext_vector_type(4)));
constexpr int AT_PITCH = 144;
constexpr int AT_KL = 0, AT_VL = 256 * AT_PITCH;
constexpr int N_ATT_ITEMS = 1536;
struct AttnKQ { v4u k[4], q[2]; };
__device__ __forceinline__ void attn_decode(int it, int& g, int& slot, int& d, int& r, int& n) {
    g = it >> 9; const int rem = it & 511; slot = rem & 7; const int rest = rem >> 3; const int sh = 2 * g; d = 1 << sh; r = rest >> (6 - sh); n = rest & ((64 >> sh) - 1);
}
__device__ __forceinline__ void attn_load_kq(AttnKQ& R, const bf16* PROJ_, int it, int tid, int wave, int lane) {
    int g, slot, d, r, n; attn_decode(it, g, slot, d, r, n); const int hd = g * 8 + slot; const int c = tid & 7;
#pragma unroll
    for (int p = 0; p < 4; ++p) { const int row = p * 64 + (tid >> 3); const int sp = (n - 1) * 128 + row;
        if (n > 0 || p >= 2) R.k[p] = *(const GAS v4u*)((const GAS bf16*)PROJ_ + (size_t)(sp * d + r) * PLD + 1536 + hd * 64 + c * 8);
        else R.k[p] = (v4u){0u, 0u, 0u, 0u}; }
    const int fr = lane & 15, fq = lane >> 4; const GAS bf16* qb = (const GAS bf16*)PROJ_ + (size_t)((n * 128 + 16 * wave + fr) * d + r) * PLD + hd * 64 + 8 * fq;
    R.q[0] = *(const GAS v4u*)(qb); R.q[1] = *(const GAS v4u*)(qb + 32);
}
__device__ __forceinline__ void attn_load_v(v4u (&V)[4], const bf16* PROJ_, int it, int tid) {
    int g, slot, d, r, n; attn_decode(it, g, slot, d, r, n); const int hd = g * 8 + slot; const int c = tid & 7;
#pragma unroll
    for (int p = 0; p < 4; ++p) { const int row = p * 64 + (tid >> 3); const int sp = (n - 1) * 128 + row;
        if (n > 0 || p >= 2) V[p] = *(const GAS v4u*)((const GAS bf16*)PROJ_ + (size_t)(sp * d + r) * PLD + 3072 + hd * 64 + c * 8);
        else V[p] = (v4u){0u, 0u, 0u, 0u}; }
}
__device__ __forceinline__ void attn_stage_k(const AttnKQ& R, LAS unsigned char* lds, const float (&gkr)[8], int tid) {
    const int c = tid & 7;
#pragma unroll
    for (int p = 0; p < 4; ++p) { const int row = p * 64 + (tid >> 3); float f[8]; pg8::unpack8(R.k[p], f); float ss = 0.f;
#pragma unroll
        for (int i = 0; i < 8; ++i) ss += f[i] * f[i];
        ss += __shfl_xor(ss, 1); ss += __shfl_xor(ss, 2); ss += __shfl_xor(ss, 4);
        const float rs = 1.0f / sqrtf(ss * (1.0f / 64.0f) + EPS);
#pragma unroll
        for (int i = 0; i < 8; ++i) f[i] = f[i] * rs * gkr[i];
        *(LAS v4u*)(lds + AT_KL + row * AT_PITCH + c * 16) = pg8::pack8(f); }
}
__device__ __forceinline__ void attn_stage_v(const v4u (&V)[4], LAS unsigned char* lds, int tid) {
    const int c = tid & 7;
#pragma unroll
    for (int p = 0; p < 4; ++p) { const int row = p * 64 + (tid >> 3); *(LAS v4u*)(lds + AT_VL + row * AT_PITCH + c * 16) = V[p]; }
}
__device__ __forceinline__ void attn_scores(f32x4 (&sc)[9], float& mx, float& den, v4u q0, v4u q1, LAS unsigned char* lds, const float (&gqr)[16], int it, int wave, int lane) {
    int g, slot, d, r, n; attn_decode(it, g, slot, d, r, n);
    const int fr = lane & 15, fq = lane >> 4, w = wave;
    float qf[16]; { float t0[8], t1[8]; pg8::unpack8(q0, t0); pg8::unpack8(q1, t1);
#pragma unroll
        for (int i = 0; i < 8; ++i) { qf[i] = t0[i]; qf[8 + i] = t1[i]; } }
    float ss = 0.f;
#pragma unroll
    for (int i = 0; i < 16; ++i) ss += qf[i] * qf[i];
    ss += __shfl_xor(ss, 16); ss += __shfl_xor(ss, 32);
    const float qs = (1.0f / sqrtf(ss * (1.0f / 64.0f) + EPS)) * (0.125f * 1.4426950408889634f);
    bf16x8_t qa[2];
    { float t0[8], t1[8];
#pragma unroll
      for (int i = 0; i < 8; ++i) { t0[i] = qf[i] * qs * gqr[i]; t1[i] = qf[8 + i] * qs * gqr[8 + i]; }
      qa[0] = __builtin_bit_cast(bf16x8_t, pg8::pack8(t0)); qa[1] = __builtin_bit_cast(bf16x8_t, pg8::pack8(t1)); }
#pragma unroll
    for (int kti = 0; kti < 9; ++kti) { f32x4 acc = (f32x4){0.f, 0.f, 0.f, 0.f}; const LAS unsigned char* kp = lds + AT_KL + ((w + kti) * 16 + fr) * AT_PITCH + fq * 16;
#pragma unroll
        for (int ks = 0; ks < 2; ++ks) { const bf16x8_t kf = *(const LAS bf16x8_t*)(kp + ks * 64); acc = __builtin_amdgcn_mfma_f32_16x16x32_bf16(kf, qa[ks], acc, 0, 0, 0); }
        sc[kti] = acc; if (kti % 3 == 2) __builtin_amdgcn_sched_barrier(0); }
    mx = -INFINITY;
#pragma unroll
    for (int j = 0; j < 4; ++j) { if (4 * fq + j < fr) sc[0][j] = -INFINITY; if (4 * fq + j > fr) sc[8][j] = -INFINITY; }
#pragma unroll
    for (int kti = 0; kti < 9; ++kti) { if (n == 0 && w + kti < 8) sc[kti] = (f32x4){-INFINITY, -INFINITY, -INFINITY, -INFINITY};
#pragma unroll
        for (int j = 0; j < 4; ++j) mx = fmaxf(mx, sc[kti][j]); }
    mx = fmaxf(mx, __shfl_xor(mx, 16)); mx = fmaxf(mx, __shfl_xor(mx, 32));
    den = 0.f;
#pragma unroll
    for (int kti = 0; kti < 9; ++kti)
#pragma unroll
        for (int j = 0; j < 4; ++j) { const float pv = __builtin_amdgcn_exp2f(sc[kti][j] - mx); sc[kti][j] = pv; den += pv; }
    den += __shfl_xor(den, 16); den += __shfl_xor(den, 32);
    __builtin_amdgcn_sched_barrier(0);
}
__device__ __forceinline__ void attn_pv(const f32x4 (&sc)[9], float mx, float den, LAS unsigned char* lds, bf16* PROJ_, float* ML_, int it, int wave, int lane, bool do_store) {
    int g, slot, d, r, n; attn_decode(it, g, slot, d, r, n); const int hd = g * 8 + slot;
    const int fr = lane & 15, fq = lane >> 4, w = wave;
    f32x4 o[4];
#pragma unroll
    for (int et = 0; et < 4; ++et) o[et] = (f32x4){0.f, 0.f, 0.f, 0.f};
    const int q_ = (lane >> 2) & 3, p_ = lane & 3;
#pragma unroll
    for (int kk = 0; kk < 5; ++kk) { const int kt0 = w + 2 * kk, kt1 = (kk < 4) ? kt0 + 1 : kt0;
        v4u aw; aw.x = pg8::cvt_pk_bf16(sc[2 * kk][0], sc[2 * kk][1]); aw.y = pg8::cvt_pk_bf16(sc[2 * kk][2], sc[2 * kk][3]);
        if (kk < 4) { aw.z = pg8::cvt_pk_bf16(sc[(kk < 4) ? 2 * kk + 1 : 0][0], sc[(kk < 4) ? 2 * kk + 1 : 0][1]); aw.w = pg8::cvt_pk_bf16(sc[(kk < 4) ? 2 * kk + 1 : 0][2], sc[(kk < 4) ? 2 * kk + 1 : 0][3]); } else { aw.z = 0u; aw.w = 0u; }
        const bf16x8_t af = __builtin_bit_cast(bf16x8_t, aw);
        const LAS unsigned char* v0 = lds + AT_VL + (kt0 * 16 + 4 * fq + q_) * AT_PITCH + p_ * 8; const LAS unsigned char* v1 = lds + AT_VL + (kt1 * 16 + 4 * fq + q_) * AT_PITCH + p_ * 8;
#pragma unroll
        for (int et = 0; et < 4; ++et) {
            const s16x4_t lo = __builtin_bit_cast(s16x4_t, __builtin_amdgcn_ds_read_tr16_b64_v4i16((LAS s16x4_t*)(v0 + et * 32)));
            const s16x4_t hi = __builtin_bit_cast(s16x4_t, __builtin_amdgcn_ds_read_tr16_b64_v4i16((LAS s16x4_t*)(v1 + et * 32)));
            const bf16x8_t bfr = (bf16x8_t){lo[0], lo[1], lo[2], lo[3], hi[0], hi[1], hi[2], hi[3]};
            o[et] = __builtin_amdgcn_mfma_f32_16x16x32_bf16(af, bfr, o[et], 0, 0, 0); }
        __builtin_amdgcn_sched_barrier(0); }
    if (do_store)
#pragma unroll
    for (int j = 0; j < 4; ++j) { GAS bf16* op = (GAS bf16*)PROJ_ + (size_t)((n * 128 + 16 * w + 4 * fq + j) * d + r) * PLD + hd * 64 + fr;
#pragma unroll
        for (int et = 0; et < 4; ++et) op[et * 16] = (bf16)f2bf(o[et][j]); }
    if (fq == 0) { GAS float* mp = (GAS float*)ML_ + (size_t)((n * 128 + 16 * w + fr) * d + r) * 48 + (g * 8 + slot) * 2; mp[0] = mx; mp[1] = den; }
}

constexpr int GL_QG = 0, GL_KG = 17408, GL_KDT = 34816, GL_VTL = 53248, GL_PL = 90112, GL_EB = 99328, GL_PAL = 99840, GL_GT = 103936, GL_SSQ = 105984, GL_RS = 108032, GL_QR = 108544, GL_KR = 124928, GL_UP = 141312;
typedef unsigned u32x2_t __attribute__((ext_vector_type(2)));
struct GlaLd { v4u vt[4], q[2], k[2]; float pa[2]; };
__device__ __forceinline__ void gla_load(GlaLd& L, int b, int h, int tok0, const bf16* PROJ_, const bf16* VT_, const float* PA_, int tid) {
    const GAS float* pap = (const GAS float*)PA_ + (size_t)(b * SEQ + tok0) * 16; L.pa[0] = pap[tid]; L.pa[1] = pap[tid + 512];
#pragma unroll
    for (int i = 0; i < 4; ++i) { const int piece = tid + 512 * i, v = piece >> 3, cc = piece & 7; L.vt[i] = *(const GAS v4u*)((const GAS bf16*)VT_ + (size_t)(h * 256 + v) * SEQ + tok0 + cc * 8); }
#pragma unroll
    for (int i = 0; i < 2; ++i) { const int piece = tid + 512 * i, row = piece >> 4, c16 = piece & 15; const GAS bf16* rp = (const GAS bf16*)PROJ_ + (size_t)(tok0 + row) * PLD + h * 128 + c16 * 8;
        L.k[i] = *(const GAS v4u*)(rp + 5120); L.q[i] = *(const GAS v4u*)(rp + 4608); }
}
__device__ __forceinline__ void gla_stage(const GlaLd& L, LAS unsigned char* lds, int tid) {
    LAS float* PAL = (LAS float*)(lds + GL_PAL); PAL[tid] = L.pa[0]; PAL[tid + 512] = L.pa[1];
#pragma unroll
    for (int i = 0; i < 4; ++i) { const int piece = tid + 512 * i, v = piece >> 3, cc = piece & 7; *(LAS v4u*)(lds + GL_VTL + v * 144 + cc * 16) = L.vt[i]; }
#pragma unroll
    for (int i = 0; i < 2; ++i) { const int piece = tid + 512 * i; *(LAS v4u*)(lds + GL_KR + piece * 16) = L.k[i]; *(LAS v4u*)(lds + GL_QR + piece * 16) = L.q[i]; }
}
__device__ __forceinline__ float log_sigmoid_fast(float x) { return fminf(x, 0.f) - __logf(1.0f + __expf(-fabsf(x))); }
__device__ __forceinline__ void gla_local(LAS unsigned char* lds, int b, int item, const bf16* PROJ_, const bf16* VT_, const float* PA_, const float* gate_up_, const float* gate_bias_,
                                          float* SBUF_, float* DBUF_, bf16* A2_, bf16* QGS_, int tid_in, int wave, int lane_in) {
    int tid = tid_in, lane = lane_in; asm volatile("" : "+v"(tid), "+v"(lane));
    const int h = item >> 5, seg = item & 31;
    const int w = wave;
    GlaLd L; gla_load(L, b, h, seg * 256, PROJ_, VT_, PA_, tid);
    { LAS float* UP = (LAS float*)(lds + GL_UP);
#pragma unroll
      for (int i = 0; i < 4; ++i) { const int idx = tid + 512 * i, r = idx >> 7, k2 = idx & 127; UP[k2 * 20 + r] = gate_up_[r * 512 + h * 128 + k2]; } }
    const float bk = gate_bias_[h * 128 + (tid & 127)];
    f32x4 S[8][2];
#pragma unroll
    for (int mtk = 0; mtk < 8; ++mtk) { S[mtk][0] = (f32x4){0.f, 0.f, 0.f, 0.f}; S[mtk][1] = (f32x4){0.f, 0.f, 0.f, 0.f}; }
    float segsum = 0.f;
    asm volatile("" :: "v"(bk), "v"(L.k[1]));
    const int tid_item = tid, lane_item = lane;
    for (int c = 0; c < 4; ++c) {
        const int tok0 = seg * 256 + c * 64;
        int tid = tid_item, lane = lane_item; asm volatile("" : "+v"(tid), "+v"(lane));
        const int kd = tid & 127, tq = tid >> 7, fr = lane & 15, fq = lane >> 4;
        gla_stage(L, lds, tid);
        __syncthreads();
        if (c < 3) gla_load(L, b, h, tok0 + 64, PROJ_, VT_, PA_, tid);
        float cb[16];
        { const LAS f32x4* pl = (const LAS f32x4*)(lds + GL_PAL); float run = 0.f; float upr[16];
          { const LAS f32x4* up4 = (const LAS f32x4*)(lds + GL_UP + kd * 80);
#pragma unroll
            for (int q4 = 0; q4 < 4; ++q4) { const f32x4 u = up4[q4]; upr[4 * q4] = u[0]; upr[4 * q4 + 1] = u[1]; upr[4 * q4 + 2] = u[2]; upr[4 * q4 + 3] = u[3]; } }
#pragma unroll
          for (int i = 0; i < 16; ++i) { const int t = 16 * tq + i; float lg = bk;
#pragma unroll
              for (int q4 = 0; q4 < 4; ++q4) { const f32x4 pv = pl[t * 4 + q4]; lg += pv[0] * upr[4 * q4] + pv[1] * upr[4 * q4 + 1] + pv[2] * upr[4 * q4 + 2] + pv[3] * upr[4 * q4 + 3]; }
              run += log_sigmoid_fast(lg) * (1.0f / 16.0f); cb[i] = run; } }
        { LAS float* GT = (LAS float*)(lds + GL_GT); GT[tq * 128 + kd] = cb[15]; }
        __syncthreads();
        float off = 0.f, tot = 0.f;
        { const LAS float* GT = (const LAS float*)(lds + GL_GT);
#pragma unroll
          for (int q = 0; q < 4; ++q) { const float gv = GT[q * 128 + kd]; tot += gv; off += (q < tq) ? gv : 0.f; } }
        const float etot = __expf(tot), eseg = __expf(segsum);
        { float kdv[16];
          GAS bf16* qgs = (GAS bf16*)QGS_ + (size_t)(tok0 + 16 * tq) * 512 + h * 128 + kd;
#pragma unroll
          for (int i = 0; i < 16; i += 2) { const int t = 16 * tq + i; const float bc0 = cb[i] + off, bc1 = cb[i + 1] + off;
              const float kf0 = bf2f(*(const LAS unsigned short*)(lds + GL_KR + t * 256 + kd * 2)), kf1 = bf2f(*(const LAS unsigned short*)(lds + GL_KR + (t + 1) * 256 + kd * 2));
              const float en0 = __expf(-bc0), en1 = __expf(-bc1);
              const float kg0 = kf0 * en0, kg1 = kf1 * en1; kdv[i] = kg0 * etot; kdv[i + 1] = kg1 * etot;
              const float qf0 = bf2f(*(const LAS unsigned short*)(lds + GL_QR + t * 256 + kd * 2)), qf1 = bf2f(*(const LAS unsigned short*)(lds + GL_QR + (t + 1) * 256 + kd * 2));
              const float qg0 = qf0 * __expf(bc0), qg1 = qf1 * __expf(bc1);
              const unsigned qw = pg8::cvt_pk_bf16(qg0, qg1), kw = pg8::cvt_pk_bf16(kg0, kg1), sw = pg8::cvt_pk_bf16(qg0 * eseg, qg1 * eseg);
              *(LAS unsigned short*)(lds + GL_QG + t * 272 + kd * 2) = (unsigned short)(qw & 0xffffu); *(LAS unsigned short*)(lds + GL_QG + (t + 1) * 272 + kd * 2) = (unsigned short)(qw >> 16);
              *(LAS unsigned short*)(lds + GL_KG + t * 272 + kd * 2) = (unsigned short)(kw & 0xffffu); *(LAS unsigned short*)(lds + GL_KG + (t + 1) * 272 + kd * 2) = (unsigned short)(kw >> 16);
              qgs[(size_t)i * 512] = (bf16)(sw & 0xffffu); qgs[(size_t)(i + 1) * 512] = (bf16)(sw >> 16); }
          float lo8[8], hi8[8];
#pragma unroll
          for (int i = 0; i < 8; ++i) { lo8[i] = kdv[i]; hi8[i] = kdv[8 + i]; }
          *(LAS v4u*)(lds + GL_KDT + kd * 144 + tq * 32) = pg8::pack8(lo8); *(LAS v4u*)(lds + GL_KDT + kd * 144 + tq * 32 + 16) = pg8::pack8(hi8); }
        if (tq == 0) ((LAS float*)(lds + GL_EB))[kd] = etot;
        segsum += tot;
        __syncthreads();
        {
            const int mt = w >> 1;
#pragma unroll
            for (int sti = 0; sti < 2; ++sti) { const int st = 2 * (w & 1) + sti; f32x4 acc = (f32x4){0.f, 0.f, 0.f, 0.f};
                if (st <= mt) {
#pragma unroll
                    for (int ks = 0; ks < 4; ++ks) { const bf16x8_t kf = *(const LAS bf16x8_t*)(lds + GL_KG + (16 * st + fr) * 272 + (32 * ks + 8 * fq) * 2);
                        const bf16x8_t qf = *(const LAS bf16x8_t*)(lds + GL_QG + (16 * mt + fr) * 272 + (32 * ks + 8 * fq) * 2);
                        acc = __builtin_amdgcn_mfma_f32_16x16x32_bf16(kf, qf, acc, 0, 0, 0); }
                    if (st == mt) {
#pragma unroll
                        for (int j = 0; j < 4; ++j) if (4 * fq + j > fr) acc[j] = 0.f; } }
                u32x2_t wv; wv.x = pg8::cvt_pk_bf16(acc[0], acc[1]); wv.y = pg8::cvt_pk_bf16(acc[2], acc[3]);
                *(LAS u32x2_t*)(lds + GL_PL + (16 * mt + fr) * 144 + (16 * st + 4 * fq) * 2) = wv; }
            __syncthreads();
        }
        bf16x8_t vf[2][2];
#pragma unroll
        for (int ks2 = 0; ks2 < 2; ++ks2)
#pragma unroll
            for (int nt = 0; nt < 2; ++nt) vf[ks2][nt] = *(const LAS bf16x8_t*)(lds + GL_VTL + (32 * w + 16 * nt + fr) * 144 + (32 * ks2 + 8 * fq) * 2);
        f32x4 o[4][2];
#pragma unroll
        for (int mt = 0; mt < 4; ++mt) { o[mt][0] = (f32x4){0.f, 0.f, 0.f, 0.f}; o[mt][1] = (f32x4){0.f, 0.f, 0.f, 0.f}; }
#pragma unroll
        for (int ks = 0; ks < 4; ++ks) { bf16x8_t bfr[2];
#pragma unroll
            for (int nt = 0; nt < 2; ++nt) { v4u wv; wv.x = pg8::cvt_pk_bf16(S[2 * ks][nt][0], S[2 * ks][nt][1]); wv.y = pg8::cvt_pk_bf16(S[2 * ks][nt][2], S[2 * ks][nt][3]);
                wv.z = pg8::cvt_pk_bf16(S[2 * ks + 1][nt][0], S[2 * ks + 1][nt][1]); wv.w = pg8::cvt_pk_bf16(S[2 * ks + 1][nt][2], S[2 * ks + 1][nt][3]); bfr[nt] = __builtin_bit_cast(bf16x8_t, wv); }
#pragma unroll
            for (int mt = 0; mt < 4; ++mt) { const u32x2_t a0 = *(const LAS u32x2_t*)(lds + GL_QG + (16 * mt + fr) * 272 + (32 * ks + 4 * fq) * 2), a1 = *(const LAS u32x2_t*)(lds + GL_QG + (16 * mt + fr) * 272 + (32 * ks + 16 + 4 * fq) * 2);
                const v4u aw = (v4u){a0.x, a0.y, a1.x, a1.y}; const bf16x8_t af = __builtin_bit_cast(bf16x8_t, aw);
                o[mt][0] = __builtin_amdgcn_mfma_f32_16x16x32_bf16(bfr[0], af, o[mt][0], 0, 0, 0); o[mt][1] = __builtin_amdgcn_mfma_f32_16x16x32_bf16(bfr[1], af, o[mt][1], 0, 0, 0); } }
#pragma unroll
        for (int ks2 = 0; ks2 < 2; ++ks2)
#pragma unroll
            for (int mt = 0; mt < 4; ++mt) { const bf16x8_t pf = *(const LAS bf16x8_t*)(lds + GL_PL + (16 * mt + fr) * 144 + (32 * ks2 + 8 * fq) * 2);
                o[mt][0] = __builtin_amdgcn_mfma_f32_16x16x32_bf16(vf[ks2][0], pf, o[mt][0], 0, 0, 0); o[mt][1] = __builtin_amdgcn_mfma_f32_16x16x32_bf16(vf[ks2][1], pf, o[mt][1], 0, 0, 0); }
#pragma unroll
        for (int mtk = 0; mtk < 8; ++mtk) { const f32x4 eb = *(const LAS f32x4*)(lds + GL_EB + (16 * mtk + 4 * fq) * 4);
            S[mtk][0] = S[mtk][0] * eb; S[mtk][1] = S[mtk][1] * eb;
#pragma unroll
            for (int ks2 = 0; ks2 < 2; ++ks2) { const bf16x8_t kf = *(const LAS bf16x8_t*)(lds + GL_KDT + (16 * mtk + fr) * 144 + (32 * ks2 + 8 * fq) * 2);
                S[mtk][0] = __builtin_amdgcn_mfma_f32_16x16x32_bf16(kf, vf[ks2][0], S[mtk][0], 0, 0, 0); S[mtk][1] = __builtin_amdgcn_mfma_f32_16x16x32_bf16(kf, vf[ks2][1], S[mtk][1], 0, 0, 0); } }
        __syncthreads();
#pragma unroll
        for (int mt = 0; mt < 4; ++mt)
#pragma unroll
            for (int nt = 0; nt < 2; ++nt) { u32x2_t wv; wv.x = pg8::cvt_pk_bf16(o[mt][nt][0], o[mt][nt][1]); wv.y = pg8::cvt_pk_bf16(o[mt][nt][2], o[mt][nt][3]);
                *(LAS u32x2_t*)(lds + (16 * mt + fr) * 528 + (32 * w + 16 * nt + 4 * fq) * 2) = wv; }
        __syncthreads();
#pragma unroll
        for (int i = 0; i < 4; ++i) { const int piece = tid + 512 * i, t = piece >> 5, c8 = piece & 31;
            *(GAS v4u*)((GAS bf16*)A2_ + (size_t)(b * SEQ + tok0 + t) * DM + h * 256 + c8 * 8) = *(const LAS v4u*)(lds + t * 528 + c8 * 16); }
    }
#pragma unroll
    for (int mtk = 0; mtk < 8; ++mtk)
#pragma unroll
        for (int nt = 0; nt < 2; ++nt)
#pragma unroll
            for (int j = 0; j < 4; ++j) ((GAS float*)SBUF_)[((size_t)item * 64 + (mtk * 2 + nt) * 4 + j) * 512 + tid] = S[mtk][nt][j];
    if ((tid >> 7) == 0) ((GAS float*)DBUF_)[item * 128 + (tid & 127)] = __expf(segsum);
    __syncthreads();
}
constexpr int GF_QG = 0, GF_OL = 17408, GF_SSQ = 51200, GF_RS = 53248;
__device__ __forceinline__ void gla_fix(LAS unsigned char* lds, int b, int unit, const bf16* PROJ_, const float* SBUF_, bf16* A2_, const bf16* QGS_, int tid_in, int wave, int lane_in) {
    int tid = tid_in, lane = lane_in; asm volatile("" : "+v"(tid), "+v"(lane));
    const int item = unit >> 1, half = unit & 1, h = item >> 5, seg = item & 31, w = wave, fr = lane & 15, fq = lane >> 4;
    bf16x8_t bfr[4][2];
#pragma unroll
    for (int ks = 0; ks < 4; ++ks)
#pragma unroll
        for (int nt = 0; nt < 2; ++nt) { float sv[8];
#pragma unroll
            for (int j = 0; j < 4; ++j) { sv[j] = ((const GAS float*)SBUF_)[((size_t)item * 64 + ((2 * ks) * 2 + nt) * 4 + j) * 512 + tid]; sv[4 + j] = ((const GAS float*)SBUF_)[((size_t)item * 64 + ((2 * ks + 1) * 2 + nt) * 4 + j) * 512 + tid]; }
            bfr[ks][nt] = __builtin_bit_cast(bf16x8_t, pg8::pack8(sv)); }
    for (int cc = 0; cc < 2; ++cc) {
        const int tok0 = seg * 256 + (2 * half + cc) * 64;
        v4u rg[4], ol[4], qg[2];
#pragma unroll
        for (int i = 0; i < 4; ++i) { const int piece = tid + 512 * i, t = piece >> 5, c8 = piece & 31;
            rg[i] = *(const GAS v4u*)((const GAS bf16*)PROJ_ + (size_t)(tok0 + t) * PLD + 5632 + h * 256 + c8 * 8);
            ol[i] = *(const GAS v4u*)((const GAS bf16*)A2_ + (size_t)(b * SEQ + tok0 + t) * DM + h * 256 + c8 * 8); }
#pragma unroll
        for (int i = 0; i < 2; ++i) { const int piece = tid + 512 * i, t = piece >> 4, c16 = piece & 15; qg[i] = *(const GAS v4u*)((const GAS bf16*)QGS_ + (size_t)(tok0 + t) * 512 + h * 128 + c16 * 8); }
        __syncthreads();
#pragma unroll
        for (int i = 0; i < 4; ++i) { const int piece = tid + 512 * i, t = piece >> 5, c8 = piece & 31; *(LAS v4u*)(lds + GF_OL + t * 528 + c8 * 16) = ol[i]; }
#pragma unroll
        for (int i = 0; i < 2; ++i) { const int piece = tid + 512 * i, t = piece >> 4, c16 = piece & 15; *(LAS v4u*)(lds + GF_QG + t * 272 + c16 * 16) = qg[i]; }
        __syncthreads();
        f32x4 o[4][2];
#pragma unroll
        for (int mt = 0; mt < 4; ++mt)
#pragma unroll
            for (int nt = 0; nt < 2; ++nt) { const u32x2_t wv = *(const LAS u32x2_t*)(lds + GF_OL + (16 * mt + fr) * 528 + (32 * w + 16 * nt + 4 * fq) * 2);
                o[mt][nt] = (f32x4){pg8::bflo(wv.x), pg8::bfhi(wv.x), pg8::bflo(wv.y), pg8::bfhi(wv.y)}; }
#pragma unroll
        for (int ks = 0; ks < 4; ++ks)
#pragma unroll
            for (int mt = 0; mt < 4; ++mt) { const u32x2_t a0 = *(const LAS u32x2_t*)(lds + GF_QG + (16 * mt + fr) * 272 + (32 * ks + 4 * fq) * 2), a1 = *(const LAS u32x2_t*)(lds + GF_QG + (16 * mt + fr) * 272 + (32 * ks + 16 + 4 * fq) * 2);
                const v4u aw = (v4u){a0.x, a0.y, a1.x, a1.y}; const bf16x8_t af = __builtin_bit_cast(bf16x8_t, aw);
                o[mt][0] = __builtin_amdgcn_mfma_f32_16x16x32_bf16(bfr[ks][0], af, o[mt][0], 0, 0, 0); o[mt][1] = __builtin_amdgcn_mfma_f32_16x16x32_bf16(bfr[ks][1], af, o[mt][1], 0, 0, 0); }
#pragma unroll
        for (int mt = 0; mt < 4; ++mt) { float sq = 0.f;
#pragma unroll
            for (int j = 0; j < 4; ++j) sq += o[mt][0][j] * o[mt][0][j] + o[mt][1][j] * o[mt][1][j];
            sq += __shfl_xor(sq, 16); sq += __shfl_xor(sq, 32);
            if (fq == 0) ((LAS float*)(lds + GF_SSQ))[w * 64 + 16 * mt + fr] = sq; }
        __syncthreads();
        if (tid < 64) { const LAS float* sp = (const LAS float*)(lds + GF_SSQ); float tsum = 0.f;
#pragma unroll
            for (int q = 0; q < 8; ++q) tsum += sp[q * 64 + tid];
            ((LAS float*)(lds + GF_RS))[tid] = 1.0f / sqrtf(tsum * (1.0f / 256.0f) + EPS); }
        __syncthreads();
#pragma unroll
        for (int mt = 0; mt < 4; ++mt) { const float rs = ((const LAS float*)(lds + GF_RS))[16 * mt + fr];
#pragma unroll
            for (int nt = 0; nt < 2; ++nt) { u32x2_t wv; wv.x = pg8::cvt_pk_bf16(o[mt][nt][0] * rs, o[mt][nt][1] * rs); wv.y = pg8::cvt_pk_bf16(o[mt][nt][2] * rs, o[mt][nt][3] * rs);
                *(LAS u32x2_t*)(lds + GF_OL + (16 * mt + fr) * 528 + (32 * w + 16 * nt + 4 * fq) * 2) = wv; } }
        __syncthreads();
#pragma unroll
        for (int i = 0; i < 4; ++i) { const int piece = tid + 512 * i, t = piece >> 5, c8 = piece & 31; float ov[8], rv[8];
            pg8::unpack8(*(const LAS v4u*)(lds + GF_OL + t * 528 + c8 * 16), ov); pg8::unpack8(rg[i], rv);
#pragma unroll
            for (int e2 = 0; e2 < 8; ++e2) ov[e2] *= rv[e2];
            *(GAS v4u*)((GAS bf16*)A2_ + (size_t)(b * SEQ + tok0 + t) * DM + h * 256 + c8 * 8) = pg8::pack8(ov); }
    }
    __syncthreads();
}

__global__ void __launch_bounds__(NTHREADS, 2) fwd_kernel(Args a) {
    extern __shared__ __attribute__((aligned(16))) unsigned char lds_raw[];
    LAS unsigned char* lds = (LAS unsigned char*)lds_raw;
    cg::grid_group grid = cg::this_grid();
    const int tid = threadIdx.x, lane = tid & 63, wave = __builtin_amdgcn_readfirstlane(tid >> 6);
    const int G = gridDim.x, bx = blockIdx.x;
    const int gw = bx * NWAVES + wave, NGW = G * NWAVES;
    unsigned char* ws = a.ws;
    const float* x = a.in[0]; const float* g1 = a.in[1]; const float* w_in = a.in[2]; const float* gq = a.in[3]; const float* gk = a.in[4];
    const float* gate_up = a.in[5]; const float* gate_bias = a.in[6]; const float* gla_g = a.in[7]; const float* bgate_bias = a.in[8];
    const float* w_ab = a.in[9]; const float* w_gb = a.in[10]; const float* w_out = a.in[11]; const float* g2 = a.in[12]; const float* w_up = a.in[13]; const float* w_dn = a.in[14];
    bf16* WIN = (bf16*)(ws + WS_WIN); bf16* WA = (bf16*)(ws + WS_WA); bf16* WB = (bf16*)(ws + WS_WB); bf16* WO = (bf16*)(ws + WS_WO);
    bf16* WUP = (bf16*)(ws + WS_WUP); bf16* WDN = (bf16*)(ws + WS_WDN); bf16* XB = (bf16*)(ws + WS_XB); bf16* PROJ = (bf16*)(ws + WS_PROJ);
    bf16* VT = (bf16*)(ws + WS_VT); bf16* A1 = (bf16*)(ws + WS_A1); bf16* A2 = (bf16*)(ws + WS_A2);
    float* R1 = (float*)(ws + WS_R1); float* PA = (float*)(ws + WS_PA); float* SS2 = (float*)(ws + WS_SS2);
    bf16* MIXED = (bf16*)(ws + WS_MIXED); bf16* UB = (bf16*)(ws + WS_U); bf16* GATES = (bf16*)a.out;
    const int lo = a.ph_lo, hi = a.ph_hi; const int repm = a.rep;
    if (tid < 16) ((LAS unsigned*)(lds + LDS_BARST))[tid] = 0u;
    __syncthreads();
    if (a.ph_lo < 0) grid.sync();
    if (a.ph_lo == 0) {
        unsigned* bw = (unsigned*)(ws + WS_BAR);
        if (bx == 0) { for (int i = tid; i < 4032; i += NTHREADS) bw[i] = 0u;
            asm volatile("s_waitcnt vmcnt(0)" ::: "memory"); __syncthreads();
            if (tid == 0) { __builtin_amdgcn_fence(__ATOMIC_RELEASE, "agent"); asm volatile("s_waitcnt vmcnt(0)" ::: "memory"); __hip_atomic_store(bw + 4064, 0x600DBA55u, __ATOMIC_RELAXED, __HIP_MEMORY_SCOPE_AGENT); } }
        if (tid == 0) { unsigned sp_ = 0; while (xb_ld(bw + 4064) != 0x600DBA55u) { __builtin_amdgcn_s_sleep(1); if (++sp_ > (1u << 22)) break; }
            __builtin_amdgcn_fence(__ATOMIC_ACQUIRE, "agent"); asm volatile("s_waitcnt vmcnt(0)" ::: "memory");
            (void)xb_add(bw + XB_XCNT(xb_xcc_id()), 1u); }
        __syncthreads();
    }
#define NREP(bit) (REPMASK ? (((repm >> (bit)) & 1) + 1) : 1)
#define IN(k) (lo <= (k) && (k) < hi)
#define LAUNDER(p) asm volatile("" : "+s"(p))
#define XBAR_OBJ(bb) XcdBarrier bb; bb.bar = (unsigned*)(ws + WS_BAR); bb.x = xb_xcc_id(); bb.st = (volatile LAS unsigned*)(lds + LDS_BARST)
#define SYNC(k) do { if (IN(k) && IN((k) + 1)) { asm volatile("s_waitcnt vmcnt(0) lgkmcnt(0)" ::: "memory"); \
        XBAR_OBJ(bb_); for (int rs_ = 0; rs_ < NREP(8); ++rs_) xcd_barrier(bb_); } } while (0)

    if (IN(0)) for (int rep_ = 0; rep_ < NREP(0); ++rep_) {
        LAS float* scr = (LAS float*)(lds + 81920 + wave * 8448);
        constexpr int I_IN = 16 * 304, I_A = 8 * 32, I_B = 16 * 32, I_O = 16 * 32, I_UP = 16 * 128, I_DN = 64 * 32;
        constexpr int NITEMS = I_IN + I_A + I_B + I_O + I_UP + I_DN;
        for (int it = gw; it < NITEMS; it += NGW) {
            int r = it;
            if (r < I_IN) { const int kb = r / 304, nb = r % 304; const int n0 = nb * 32; const int src = n0 < 7680 ? n0 : n0 + 16;
                const float cs = (n0 >= 4608 && n0 < 5120) ? 0.08838834764831845f : 1.0f;
                p0_transpose_item(w_in, DIN, src, g1, 1023, cs, WIN, 1024, n0, kb * 64, scr, lane); continue; } r -= I_IN;
            if (r < I_A) { const int kb = r / 32, nb = r % 32; p0_transpose_item(w_ab, 1024, nb * 32, nullptr, 0, 1.0f, WA, 512, nb * 32, kb * 64, scr, lane); continue; } r -= I_A;
            if (r < I_B) { const int kb = r / 32, nb = r % 32; p0_transpose_item(w_gb, 1024, nb * 32, gla_g, 255, 1.0f, WB, 1024, nb * 32, kb * 64, scr, lane); continue; } r -= I_B;
            if (r < I_O) { const int kb = r / 32, nb = r % 32; p0_transpose_item(w_out, 1024, nb * 32, nullptr, 0, 1.0f, WO, 1024, nb * 32, kb * 64, scr, lane); continue; } r -= I_O;
            if (r < I_UP) { const int kb = r / 128, nb = r % 128; p0_transpose_item(w_up, 4096, nb * 32, g2, 1023, 1.0f, WUP, 1024, nb * 32, kb * 64, scr, lane); continue; } r -= I_UP;
            { const int kb = r / 32, nb = r % 32; p0_transpose_item(w_dn, 1024, nb * 32, nullptr, 0, 1.0f, WDN, 4096, nb * 32, kb * 64, scr, lane); }
        }
        LAS float* WAl = (LAS float*)lds;
        for (int idx = tid; idx < 1024 * 16; idx += NTHREADS) { const int k = idx >> 4, r = idx & 15; const int rho = ((k >> 8) * 4 + (k & 3)) * 64 + ((k >> 2) & 63);
            WAl[rho * 20 + r] = w_in[(size_t)k * DIN + 7680 + r] * g1[k]; }
        __syncthreads();
        f32x4 nv[4];
        if (gw < MTOK) { const GAS f32x4* xr0 = (const GAS f32x4*)(x + (size_t)gw * DM) + lane;
#pragma unroll
            for (int j = 0; j < 4; ++j) nv[j] = xr0[64 * j]; }
        for (int row = gw; row < MTOK; row += NGW) {
            asm volatile("" ::: "memory");
            f32x4 v[4]; float ss = 0.f;
#pragma unroll
            for (int j = 0; j < 4; ++j) { v[j] = nv[j]; ss += (v[j][0] * v[j][0] + v[j][1] * v[j][1]) + (v[j][2] * v[j][2] + v[j][3] * v[j][3]); }
            if (row + NGW < MTOK) { const GAS f32x4* xrn = (const GAS f32x4*)(x + (size_t)(row + NGW) * DM) + lane;
#pragma unroll
                for (int j = 0; j < 4; ++j) nv[j] = xrn[64 * j]; }
            ss = wave_sum(ss); const float r1 = 1.0f / sqrtf(ss * (1.0f / 1024.0f) + EPS);
            float pa[16];
#pragma unroll
            for (int r = 0; r < 16; ++r) pa[r] = 0.f;
#pragma unroll
            for (int j = 0; j < 4; ++j)
#pragma unroll
                for (int c = 0; c < 4; ++c) { const float xv = v[j][c]; const LAS f32x4* wp = (const LAS f32x4*)(WAl + ((j * 4 + c) * 64 + lane) * 20);
#pragma unroll
                    for (int q = 0; q < 4; ++q) { const f32x4 w = wp[q]; pa[4 * q] += xv * w[0]; pa[4 * q + 1] += xv * w[1]; pa[4 * q + 2] += xv * w[2]; pa[4 * q + 3] += xv * w[3]; } }
            float mine = 0.f;
#pragma unroll
            for (int r = 0; r < 16; ++r) { const float s = wave_sum(pa[r]); mine = (lane == r) ? s : mine; }
            if (lane < 16) PA[(size_t)row * 16 + lane] = mine * r1;
            if (lane == 0) R1[row] = r1;
            unsigned long long* o8 = (unsigned long long*)(XB + (size_t)row * DM) + lane;
#pragma unroll
            for (int j = 0; j < 4; ++j) o8[64 * j] = (unsigned long long)pk2(v[j][0], v[j][1]) | ((unsigned long long)pk2(v[j][2], v[j][3]) << 32);
        }
        __syncthreads();
    }
    SYNC(0);
    if (bx == 0 && tid == 0 && a.ph_lo == 0) __hip_atomic_store((unsigned*)(ws + WS_BAR) + 4064, 0u, __ATOMIC_RELAXED, __HIP_MEMORY_SCOPE_AGENT);

    for (int bq = 0; bq < 2; ++bq) {
        int b = bq; LAUNDER(b);
        const int p1 = 1 + 3 * b;
        if (IN(p1)) for (int rep_ = 0; rep_ < NREP(1); ++rep_) {
            pg8::Gemm g{XB + (size_t)b * SEQ * DM, WIN, SEQ, N1, DM}; pg8::StaticOrder S; S.init(SEQ, N1, G, bx);
            pg8::EpiProj E{PROJ, VT, GATES + (size_t)b * SEQ * 2048, R1 + b * SEQ, bgate_bias};
            pg8::gemm_phase<pg8::EpiProj, pg8::StaticOrder, true, true>(lds, g, S, E);
        }
        SYNC(p1);
        int tid_ = threadIdx.x; asm volatile("" : "+v"(tid_)); const int lane_ = tid_ & 63; const int wave_ = __builtin_amdgcn_readfirstlane(tid_ >> 6); int bx_ = bx; LAUNDER(bx_);
        const float* gate_up_ = gate_up; const float* gate_bias_ = gate_bias; const float* PA_ = PA; const bf16* PROJ_ = PROJ; const bf16* VT_ = VT; bf16* A1_ = A1; bf16* A2_ = A2; const float* gq_ = gq; const float* gk_ = gk;
        float* SBUF_ = (float*)(ws + WS_XB); float* DBUF_ = (float*)(ws + WS_MISC + 2 * MiB); float* ML_ = (float*)(ws + WS_MISC);
        bf16* QGS_ = (b == 0) ? (A1 + (size_t)SEQ * 512) : (bf16*)(ws + 247 * MiB);
        LAUNDER(QGS_);
        LAUNDER(gate_up_); LAUNDER(gate_bias_); LAUNDER(PA_); LAUNDER(PROJ_); LAUNDER(VT_); LAUNDER(A1_); LAUNDER(A2_); LAUNDER(gq_); LAUNDER(gk_); LAUNDER(SBUF_); LAUNDER(DBUF_); LAUNDER(ML_);
        if (IN(p1 + 1)) {
            if (bx_ < 128) { for (int rep_ = 0; rep_ < NREP(2); ++rep_) { gla_local(lds, b, bx_, PROJ_, VT_, PA_, gate_up_, gate_bias_, SBUF_, DBUF_, A2_, QGS_, tid_, wave_, lane_); }
                asm volatile("s_waitcnt vmcnt(0) lgkmcnt(0)" ::: "memory"); __syncthreads();
                if (tid_ == 0) { unsigned* cw = (unsigned*)(ws + WS_BAR) + 3520 + 64 * b;
                    __builtin_amdgcn_fence(__ATOMIC_RELEASE, "agent"); asm volatile("s_waitcnt vmcnt(0)" ::: "memory");
                    (void)xb_add(cw, 1u);
                    unsigned sp_ = 0; while (xb_ld(cw) < 128u) { __builtin_amdgcn_s_sleep(1); if (++sp_ > (1u << 22)) break; }
                    __builtin_amdgcn_fence(__ATOMIC_ACQUIRE, "agent"); asm volatile("s_waitcnt vmcnt(0)" ::: "memory"); }
                __syncthreads();
#pragma unroll 1
                for (int e2 = 0; e2 < 2; ++e2) { const int gid = bx_ * NTHREADS + tid_ + e2 * 65536;
                    const int h = gid >> 15, r = (gid >> 9) & 63, tl = gid & 511; const int kdr = 16 * (r >> 3) + 4 * ((tl & 63) >> 4) + (r & 3);
                    float loc[32], dec[32];
#pragma unroll
                    for (int sg = 0; sg < 32; ++sg) { loc[sg] = ((const GAS float*)SBUF_)[((size_t)(h * 32 + sg) * 64 + r) * 512 + tl]; dec[sg] = ((const GAS float*)DBUF_)[(h * 32 + sg) * 128 + kdr]; }
                    float cur = 0.f;
#pragma unroll
                    for (int sg = 0; sg < 32; ++sg) { ((GAS float*)SBUF_)[((size_t)(h * 32 + sg) * 64 + r) * 512 + tl] = cur; cur = dec[sg] * cur + loc[sg]; } }
            }
            {
                float gkr[8], gqr[16];
#pragma unroll
                for (int i = 0; i < 8; ++i) gkr[i] = gk_[(tid_ & 7) * 8 + i];
#pragma unroll
                for (int i = 0; i < 8; ++i) { gqr[i] = gq_[8 * (lane_ >> 4) + i]; gqr[8 + i] = gq_[32 + 8 * (lane_ >> 4) + i]; }
                bf16* PROJW = (bf16*)PROJ_;
                asm volatile("" :: "v"(gkr[7]), "v"(gqr[15]));
                const int first = bx_ < 128 ? bx_ : (bx_ - 128), cnt = bx_ < 128 ? 0 : 12;
                const int nrep_ = NREP(7);
                for (int rep_ = 0; rep_ < nrep_; ++rep_) {
                    AttnKQ R; if (cnt > 0) attn_load_kq(R, PROJ_, first, tid_, wave_, lane_);
                    for (int k = 0; k < cnt; ++k) { const int it = first + 128 * k;
                        __syncthreads();
                        attn_stage_k(R, lds, gkr, tid_);
                        v4u Vr[4]; attn_load_v(Vr, PROJ_, it, tid_);
                        const v4u q0 = R.q[0], q1 = R.q[1];
                        __syncthreads();
                        f32x4 sc[9]; float mx, den; attn_scores(sc, mx, den, q0, q1, lds, gqr, it, wave_, lane_);
                        attn_stage_v(Vr, lds, tid_);
                        __syncthreads();
                        if (k + 1 < cnt) attn_load_kq(R, PROJ_, it + 128, tid_, wave_, lane_);
                        attn_pv(sc, mx, den, lds, PROJW, ML_, it, wave_, lane_, rep_ == nrep_ - 1);
                    }
                }
            }
        }
        SYNC(p1 + 1);
        if (IN(p1 + 2)) {
            for (int rep_ = 0; rep_ < NREP(3); ++rep_) { gla_fix(lds, b, bx_, PROJ_, SBUF_, A2_, QGS_, tid_, wave_, lane_); }
            {
            for (int rep_ = 0; rep_ < NREP(9); ++rep_) {
                for (int idx = bx_ * NTHREADS + tid_; idx < SEQ * 64; idx += G * NTHREADS) {
                    const int t = idx >> 6, slot = (idx >> 3) & 7, c8 = idx & 7;
                    float m[3], dn[3];
#pragma unroll
                    for (int g = 0; g < 3; ++g) { const GAS float* mp = (const GAS float*)ML_ + (size_t)t * 48 + (g * 8 + slot) * 2; m[g] = mp[0]; dn[g] = mp[1]; }
                    const float M = fmaxf(m[0], fmaxf(m[1], m[2])); float D = 0.f; float acc[8];
#pragma unroll
                    for (int i = 0; i < 8; ++i) acc[i] = 0.f;
#pragma unroll
                    for (int g = 0; g < 3; ++g) { const float wg = __builtin_amdgcn_exp2f(m[g] - M); D += wg * dn[g]; float f[8];
                        pg8::unpack8(*(const GAS v4u*)((const GAS bf16*)PROJ_ + (size_t)t * PLD + (g * 8 + slot) * 64 + c8 * 8), f);
#pragma unroll
                        for (int i = 0; i < 8; ++i) acc[i] += wg * f[i]; }
                    const float inv = 1.0f / D;
#pragma unroll
                    for (int i = 0; i < 8; ++i) acc[i] *= inv;
                    *(GAS v4u*)((GAS bf16*)A1_ + (size_t)(b * SEQ + t) * 512 + slot * 64 + c8 * 8) = pg8::pack8(acc);
                }
            }
            }
        }
        SYNC(p1 + 2);
    }
    if (IN(7)) for (int rep_ = 0; rep_ < NREP(4); ++rep_) {
        { pg8::Gemm g{A1, WA, MTOK, DM, 512}; pg8::StaticOrder S; S.init(MTOK, DM, G, bx); pg8::EpiBranch E{MIXED, GATES, 0, 0};
          pg8::gemm_phase<pg8::EpiBranch, pg8::StaticOrder, true, true>(lds, g, S, E); }
        __syncthreads();
        { pg8::Gemm g{A2, WB, MTOK, DM, 1024}; pg8::StaticOrder S; S.init(MTOK, DM, G, bx); pg8::EpiBranch E{MIXED, GATES, 1024, 1};
          pg8::gemm_phase<pg8::EpiBranch, pg8::StaticOrder, true, true>(lds, g, S, E); }
    }
    SYNC(7);
    if (IN(8)) for (int rep_ = 0; rep_ < NREP(5); ++rep_) { pg8::Gemm g{MIXED, WO, MTOK, DM, 1024}; pg8::StaticOrder S; S.init(MTOK, DM, G, bx); pg8::EpiOut1 E{x, a.out, XB, SS2};
        pg8::gemm_phase<pg8::EpiOut1, pg8::StaticOrder, true, true>(lds, g, S, E); }
    SYNC(8);
    if (IN(9)) for (int rep_ = 0; rep_ < NREP(6); ++rep_) { pg8::Gemm g{XB, WUP, MTOK, FF, 1024}; pg8::StaticOrder S; S.init(MTOK, FF, G, bx); pg8::EpiUp E{UB, SS2};
        pg8::gemm_phase<pg8::EpiUp, pg8::StaticOrder, true, true>(lds, g, S, E); }
    SYNC(9);
    if (IN(10)) { pg8::Gemm g{UB, WDN, MTOK, DM, FF}; pg8::StaticOrder S; S.init(MTOK, DM, G, bx); pg8::EpiDown E{a.out};
        pg8::gemm_phase<pg8::EpiDown, pg8::StaticOrder, true, true>(lds, g, S, E); }
#undef IN
#undef SYNC
}

extern "C" void kernel_launch(void* const* d_in, const int* in_sizes, int n_in, void* d_out, int out_size, void* d_ws, size_t ws_size, hipStream_t stream) {
    static int grid = 0;
    if (grid == 0) {
        if (n_in != 15 || out_size != MTOK * DM || ws_size < WS_END) { fprintf(stderr, "kernel_launch: unexpected shapes (n_in %d, out %d, ws %zu)\n", n_in, out_size, ws_size); grid = -1; return; }
        int dev = 0, cus = 0, per_cu = 0;
        hipGetDevice(&dev); hipDeviceGetAttribute(&cus, hipDeviceAttributeMultiprocessorCount, dev);
        if (hipFuncSetAttribute((const void*)fwd_kernel, hipFuncAttributeMaxDynamicSharedMemorySize, LDS_BYTES) != hipSuccess) { fprintf(stderr, "kernel_launch: hipFuncSetAttribute failed\n"); grid = -1; return; }
        if (hipOccupancyMaxActiveBlocksPerMultiprocessor(&per_cu, (const void*)fwd_kernel, NTHREADS, LDS_BYTES) != hipSuccess || per_cu < 1) per_cu = 1;
        (void)hipGetLastError();
        grid = cus * per_cu;
        fprintf(stderr, "kernel_launch: grid %d (cus %d x %d)\n", grid, cus, per_cu);
    }
    if (grid < 0) return;
    Args a{};
    for (int i = 0; i < 15; ++i) a.in[i] = (const float*)d_in[i];
    a.out = (float*)d_out; a.ws = (unsigned char*)d_ws; a.ph_lo = 0; a.ph_hi = 11; a.rep = REPMASK; a.pad = 0;
    void* args[] = {&a};
    hipError_t e = hipLaunchCooperativeKernel((const void*)fwd_kernel, dim3(grid), dim3(NTHREADS), args, LDS_BYTES, stream);
    if (e != hipSuccess) fprintf(stderr, "cooperative launch failed: %s (grid %d)\n", hipGetErrorString(e), grid);
}
```

```cpp
#include <hip/hip_runtime.h>
#include <hip/hip_cooperative_groups.h>
#include <cstdio>
#include <cstdint>
#include <cmath>
namespace cg = cooperative_groups;
namespace pg8 {
#define PG8_LAS __attribute__((address_space(3)))
typedef unsigned short bf16_t;
typedef short bf16x8 __attribute__((ext_vector_type(8)));
typedef float f32x4 __attribute__((ext_vector_type(4)));
typedef unsigned u32x4 __attribute__((ext_vector_type(4)));
constexpr int BM = 256, BK = 64, HALF = 128, HTB = HALF * BK * 2  , STAGE_BYTES = 8 * HTB, NXCD = 8, WGM = 8;

__host__ __device__ __forceinline__ int lds_byte(int r, int c) { const int st = (r >> 4) * 2 + (c >> 5), rr = r & 15, cc = c & 31, ob = rr * 64 + cc * 2; return st * 1024 + (ob ^ (((ob >> 9) & 1) << 5)); }
__host__ __device__ __forceinline__ void stage_rc(int b, int& R, int& C) { const int st = b / 1024, sb = b % 1024, swz = sb ^ (((sb >> 9) & 1) << 5); R = (st >> 1) * 16 + swz / 64; C = (st & 1) * 32 + (swz % 64) / 2; }
__host__ __device__ __forceinline__ int perm32(int rho) { const int n = rho >> 4, i = rho & 15; return 8 * (i >> 2) + 4 * n + (i & 3); }

struct Unit { int pm, pn; };
struct Gemm { const bf16_t* A; const bf16_t* Bt; int M, N, K; };

struct StaticOrder {
    int nM, nN, nwg, G, c;
    __host__ __device__ void init(int M, int N, int G_, int c_) { nM = M / BM; nN = N / BM; nwg = nM * nN; G = G_; c = c_; }
    __host__ __device__ bool next(int i, Unit& u) const {
        const long L = (long)i * G + c; if (L >= nwg) return false;
        int wgid = (int)L; { const int q = nwg / NXCD, r = nwg % NXCD, xcd = wgid % NXCD, off = wgid / NXCD; wgid = (xcd < r ? xcd * (q + 1) : r * (q + 1) + (xcd - r) * q) + off; }
        const int nig = WGM * nN, gid = wgid / nig, fm = gid * WGM, gsz = (nM - fm) < WGM ? (nM - fm) : WGM;
        u.pm = fm + ((wgid % nig) % gsz); u.pn = (wgid % nig) / gsz; return true;
    }
    __device__ __forceinline__ void a_ready(const Unit&) const {}
    __device__ __forceinline__ void done(const Unit&) const {}
};
typedef float f32x2 __attribute__((ext_vector_type(2)));
typedef __bf16 bf16x2_cv __attribute__((ext_vector_type(2)));
__device__ __forceinline__ unsigned cvt_pk_bf16(float lo, float hi) { const f32x2 v = {lo, hi}; const bf16x2_cv b = __builtin_convertvector(v, bf16x2_cv); return __builtin_bit_cast(unsigned, b); }
__device__ __forceinline__ float bflo(unsigned w) { return __uint_as_float(w << 16); }
__device__ __forceinline__ float bfhi(unsigned w) { return __uint_as_float(w & 0xffff0000u); }
__device__ __forceinline__ void unpack8(const u32x4 w, float (&f)[8]) { f[0] = bflo(w.x); f[1] = bfhi(w.x); f[2] = bflo(w.y); f[3] = bfhi(w.y); f[4] = bflo(w.z); f[5] = bfhi(w.z); f[6] = bflo(w.w); f[7] = bfhi(w.w); }
__device__ __forceinline__ u32x4 pack8(const float (&v)[8]) { u32x4 w; w.x = cvt_pk_bf16(v[0], v[1]); w.y = cvt_pk_bf16(v[2], v[3]); w.z = cvt_pk_bf16(v[4], v[5]); w.w = cvt_pk_bf16(v[6], v[7]); return w; }
__device__ __forceinline__ float fsigmoid(float x) { return __builtin_amdgcn_rcpf(1.0f + __builtin_amdgcn_exp2f(x * -1.4426950408889634f)); }

struct EpiProj {
    static constexpr bool PERM = true, AFTER_DRAIN = false;
    bf16_t* proj; bf16_t* vt; bf16_t* gates; const float* r1; const float* gbias;
    __device__ __forceinline__ void operator()(const f32x4 (&acc)[2][2][4][2], const Unit& u, int wr, int wc, int fr_in, int fq_in) const {
        int fr = fr_in, fq = fq_in; asm volatile("" : "+v"(fr), "+v"(fq));
        const int ct = u.pn; const int row0 = u.pm * BM + wr * 64 + fr; const int cl = wc * 32 + 8 * fq;
        float rsv[2][4];
#pragma unroll
        for (int ai = 0; ai < 2; ++ai)
#pragma unroll
            for (int m = 0; m < 4; ++m) rsv[ai][m] = r1[row0 + ai * HALF + m * 16];
        f32x4 gb[2][2];
        if (ct >= 30) {
#pragma unroll
            for (int bj = 0; bj < 2; ++bj) { const int gc = (ct - 30) * 256 + cl + bj * HALF; gb[bj][0] = *(const f32x4*)(gbias + gc); gb[bj][1] = *(const f32x4*)(gbias + gc + 4); } }
        else { gb[0][0] = gb[0][1] = gb[1][0] = gb[1][1] = (f32x4){0.f, 0.f, 0.f, 0.f}; }
#pragma unroll
        for (int ai = 0; ai < 2; ++ai)
#pragma unroll
            for (int m = 0; m < 4; ++m) {
                const int row = row0 + ai * HALF + m * 16; const float rs = rsv[ai][m];
#pragma unroll
                for (int bj = 0; bj < 2; ++bj) {
                    const f32x4 v0 = acc[ai][bj][m][0] * rs, v1 = acc[ai][bj][m][1] * rs;
                    float v[8] = {v0[0], v0[1], v0[2], v0[3], v1[0], v1[1], v1[2], v1[3]};
                    const int c = cl + bj * HALF;
                    if (ct < 22) { *(u32x4*)(proj + (size_t)row * 6656 + ct * 256 + c) = pack8(v); }
                    else if (ct < 26) { const u32x4 w = pack8(v); bf16_t* p = vt + (size_t)((ct - 22) * 256 + c) * 8192 + row;
                        p[0] = (bf16_t)(w.x & 0xffffu); p[8192] = (bf16_t)(w.x >> 16); p[2 * 8192] = (bf16_t)(w.y & 0xffffu); p[3 * 8192] = (bf16_t)(w.y >> 16);
                        p[4 * 8192] = (bf16_t)(w.z & 0xffffu); p[5 * 8192] = (bf16_t)(w.z >> 16); p[6 * 8192] = (bf16_t)(w.w & 0xffffu); p[7 * 8192] = (bf16_t)(w.w >> 16); }
                    else if (ct < 30) {
#pragma unroll
                        for (int i = 0; i < 8; ++i) v[i] = v[i] * fsigmoid(v[i]);
                        *(u32x4*)(proj + (size_t)row * 6656 + (ct - 4) * 256 + c) = pack8(v); }
                    else { const int gc = (ct - 30) * 256 + c; const float bb[8] = {gb[bj][0][0], gb[bj][0][1], gb[bj][0][2], gb[bj][0][3], gb[bj][1][0], gb[bj][1][1], gb[bj][1][2], gb[bj][1][3]};
#pragma unroll
                        for (int i = 0; i < 8; ++i) v[i] = fsigmoid(v[i] + bb[i]);
                        *(u32x4*)(gates + (size_t)row * 2048 + gc) = pack8(v); }
                }
            }
    }
};
struct EpiBranch {
    static constexpr bool PERM = true, AFTER_DRAIN = false;
    bf16_t* mixed; const bf16_t* gates; int goff; int add;
    __device__ __forceinline__ void operator()(const f32x4 (&acc)[2][2][4][2], const Unit& u, int wr, int wc, int fr_in, int fq_in) const {
        int fr = fr_in, fq = fq_in; asm volatile("" : "+v"(fr), "+v"(fq));
        const int row0 = u.pm * BM + wr * 64 + fr; const int cl = u.pn * BM + wc * 32 + 8 * fq;
#pragma unroll
        for (int ai = 0; ai < 2; ++ai) {
            u32x4 gw[4][2], tw[4][2];
#pragma unroll
            for (int m = 0; m < 4; ++m)
#pragma unroll
                for (int bj = 0; bj < 2; ++bj) { const int row = row0 + ai * HALF + m * 16, c = cl + bj * HALF;
                    gw[m][bj] = *(const u32x4*)(gates + (size_t)row * 2048 + goff + c);
                    tw[m][bj] = add ? *(const u32x4*)(mixed + (size_t)row * 1024 + c) : (u32x4){0u, 0u, 0u, 0u}; }
#pragma unroll
            for (int m = 0; m < 4; ++m)
#pragma unroll
                for (int bj = 0; bj < 2; ++bj) { const int row = row0 + ai * HALF + m * 16, c = cl + bj * HALF; float g[8], t[8], v[8];
                    unpack8(gw[m][bj], g); unpack8(tw[m][bj], t);
                    const f32x4 v0 = acc[ai][bj][m][0], v1 = acc[ai][bj][m][1];
                    v[0] = v0[0] * g[0] + t[0]; v[1] = v0[1] * g[1] + t[1]; v[2] = v0[2] * g[2] + t[2]; v[3] = v0[3] * g[3] + t[3];
                    v[4] = v1[0] * g[4] + t[4]; v[5] = v1[1] * g[5] + t[5]; v[6] = v1[2] * g[6] + t[6]; v[7] = v1[3] * g[7] + t[7];
                    *(u32x4*)(mixed + (size_t)row * 1024 + c) = pack8(v); }
        }
    }
};
struct EpiOut1 {
    static constexpr bool PERM = true, AFTER_DRAIN = false;
    const float* x; float* out; bf16_t* x1b; float* ss2;
    __device__ __forceinline__ void operator()(const f32x4 (&acc)[2][2][4][2], const Unit& u, int wr, int wc, int fr_in, int fq_in) const {
        int fr = fr_in, fq = fq_in; asm volatile("" : "+v"(fr), "+v"(fq));
        const int row0 = u.pm * BM + wr * 64 + fr; const int cl = u.pn * BM + wc * 32 + 8 * fq;
#pragma unroll
        for (int ai = 0; ai < 2; ++ai) {
            f32x4 xv[4][2][2];
#pragma unroll
            for (int m = 0; m < 4; ++m)
#pragma unroll
                for (int bj = 0; bj < 2; ++bj) { const size_t off = (size_t)(row0 + ai * HALF + m * 16) * 1024 + cl + bj * HALF; xv[m][bj][0] = *(const f32x4*)(x + off); xv[m][bj][1] = *(const f32x4*)(x + off + 4); }
#pragma unroll
            for (int m = 0; m < 4; ++m) {
                const int row = row0 + ai * HALF + m * 16; float ssq = 0.f;
#pragma unroll
                for (int bj = 0; bj < 2; ++bj) {
                    const size_t off = (size_t)row * 1024 + cl + bj * HALF;
                    const f32x4 o0 = xv[m][bj][0] + acc[ai][bj][m][0], o1 = xv[m][bj][1] + acc[ai][bj][m][1];
                    *(f32x4*)(out + off) = o0; *(f32x4*)(out + off + 4) = o1;
                    const float v[8] = {o0[0], o0[1], o0[2], o0[3], o1[0], o1[1], o1[2], o1[3]};
                    *(u32x4*)(x1b + off) = pack8(v);
#pragma unroll
                    for (int i = 0; i < 8; ++i) ssq += v[i] * v[i];
                }
                ssq += __shfl_xor(ssq, 16); ssq += __shfl_xor(ssq, 32);
                if (fq == 0) ss2[(size_t)row * 16 + u.pn * 4 + wc] = ssq;
            }
        }
    }
};
struct EpiUp {
    static constexpr bool PERM = true, AFTER_DRAIN = false;
    bf16_t* U; const float* ss2;
    __device__ __forceinline__ void operator()(const f32x4 (&acc)[2][2][4][2], const Unit& u, int wr, int wc, int fr_in, int fq_in) const {
        int fr = fr_in, fq = fq_in; asm volatile("" : "+v"(fr), "+v"(fq));
        const int row0 = u.pm * BM + wr * 64 + fr; const int cl = u.pn * BM + wc * 32 + 8 * fq;
        float rsv[2][4];
#pragma unroll
        for (int ai = 0; ai < 2; ++ai) { f32x4 sv[4][4];
#pragma unroll
            for (int m = 0; m < 4; ++m) { const f32x4* sp = (const f32x4*)(ss2 + (size_t)(row0 + ai * HALF + m * 16) * 16); sv[m][0] = sp[0]; sv[m][1] = sp[1]; sv[m][2] = sp[2]; sv[m][3] = sp[3]; }
#pragma unroll
            for (int m = 0; m < 4; ++m) { const f32x4 t = (sv[m][0] + sv[m][1]) + (sv[m][2] + sv[m][3]); const float sum = (t[0] + t[1]) + (t[2] + t[3]);
                rsv[ai][m] = __builtin_amdgcn_rsqf(sum * (1.0f / 1024.0f) + 1e-6f); } }
#pragma unroll
        for (int ai = 0; ai < 2; ++ai)
#pragma unroll
            for (int m = 0; m < 4; ++m) {
                const int row = row0 + ai * HALF + m * 16; const float rs = rsv[ai][m];
#pragma unroll
                for (int bj = 0; bj < 2; ++bj) {
                    const f32x4 v0 = acc[ai][bj][m][0] * rs, v1 = acc[ai][bj][m][1] * rs;
                    float v[8] = {v0[0], v0[1], v0[2], v0[3], v1[0], v1[1], v1[2], v1[3]};
#pragma unroll
                    for (int i = 0; i < 8; ++i) { const float r = fmaxf(v[i], 0.f); v[i] = r * r; }
                    *(u32x4*)(U + (size_t)row * 4096 + cl + bj * HALF) = pack8(v);
                }
            }
    }
};
struct EpiDown {
    static constexpr bool PERM = true, AFTER_DRAIN = false;
    float* out; int store;
    __device__ __forceinline__ void operator()(const f32x4 (&acc)[2][2][4][2], const Unit& u, int wr, int wc, int fr_in, int fq_in) const {
        int fr = fr_in, fq = fq_in; asm volatile("" : "+v"(fr), "+v"(fq));
        const int row0 = u.pm * BM + wr * 64 + fr; const int cl = u.pn * BM + wc * 32 + 8 * fq;
#pragma unroll
        for (int ai = 0; ai < 2; ++ai) {
            f32x4 xv[4][2][2];
#pragma unroll
            for (int m = 0; m < 4; ++m)
#pragma unroll
                for (int bj = 0; bj < 2; ++bj) { const size_t off = (size_t)(row0 + ai * HALF + m * 16) * 1024 + cl + bj * HALF; xv[m][bj][0] = *(const f32x4*)(out + off); xv[m][bj][1] = *(const f32x4*)(out + off + 4); }
#pragma unroll
            for (int m = 0; m < 4; ++m)
#pragma unroll
                for (int bj = 0; bj < 2; ++bj) {
                    const size_t off = (size_t)(row0 + ai * HALF + m * 16) * 1024 + cl + bj * HALF;
                    const f32x4 o0 = xv[m][bj][0] + acc[ai][bj][m][0], o1 = xv[m][bj][1] + acc[ai][bj][m][1];
                    if (store) { *(f32x4*)(out + off) = o0; *(f32x4*)(out + off + 4) = o1; }
                }
        }
    }
};
template <class Epi, class Sched, bool ALIGN_EPI = false, bool SP2 = false>
__device__ __forceinline__ void gemm_phase(PG8_LAS unsigned char* lds, const Gemm g, const Sched& S, const Epi& E) {
    int tid_l = threadIdx.x; asm volatile("" : "+v"(tid_l));
    const int tid = tid_l, wid = __builtin_amdgcn_readfirstlane(tid >> 6), lane = tid & 63, wr = wid >> 2, wc = wid & 3, fr = lane & 15, fq = lane >> 4;
    const int K = g.K, nt = K / BK;
    unsigned voffA[2], voffB[2];
#pragma unroll
    for (int i = 0; i < 2; ++i) { int R, C; stage_rc(tid * 16 + i * 8192, R, C); const int Rb = Epi::PERM ? ((R & ~31) + perm32(R & 31)) : R;
        voffA[i] = (unsigned)(R * K + C) * 2u; voffB[i] = (unsigned)(Rb * K + C) * 2u; }
    const size_t kstep = (size_t)(BK * 2);
    const size_t hstep = (size_t)HALF * K * 2;
    const size_t tstep = 2 * hstep;
    const unsigned ldsw = (unsigned)wid * 1024u;
    const int aoff = lds_byte(wr * 64 + fr, fq * 8), boff = lds_byte(wc * 32 + fr, fq * 8);
#define PG8_SA(b, h) (((b) * 2 + (h)) * HTB)
#define PG8_SB(b, h) ((4 + (b) * 2 + (h)) * HTB)
#define PG8_STAGE(bufoff, gbase, voff) do { _Pragma("unroll") for (int _i = 0; _i < 2; ++_i) \
        __builtin_amdgcn_global_load_lds((const unsigned*)((const char*)(gbase) + (voff)[_i]), (PG8_LAS unsigned*)(lds + (bufoff) + ldsw + _i * 8192), 16, 0, 0); } while (0)
#define PG8_LDA(dst, b, h) do { _Pragma("unroll") for (int m = 0; m < 4; ++m) _Pragma("unroll") for (int k = 0; k < 2; ++k) dst[m][k] = *(const PG8_LAS bf16x8*)(lds + PG8_SA(b, h) + aoff + m * 2048 + k * 1024); } while (0)
#define PG8_LDB(dst, b, h) do { _Pragma("unroll") for (int n = 0; n < 2; ++n) _Pragma("unroll") for (int k = 0; k < 2; ++k) dst[n][k] = *(const PG8_LAS bf16x8*)(lds + PG8_SB(b, h) + boff + n * 2048 + k * 1024); } while (0)
#define PG8_MMA(ai, bj, At, Bt) do { __builtin_amdgcn_s_setprio(1); _Pragma("unroll") for (int m = 0; m < 4; ++m) _Pragma("unroll") for (int n = 0; n < 2; ++n) _Pragma("unroll") for (int k = 0; k < 2; ++k) \
        acc[ai][bj][m][n] = __builtin_amdgcn_mfma_f32_16x16x32_bf16(Bt[n][k], At[m][k], acc[ai][bj][m][n], 0, 0, 0); __builtin_amdgcn_s_setprio(0); } while (0)
#define PG8_WAIT_V(n) asm volatile("s_waitcnt vmcnt(" #n ")" ::: "memory")
#define PG8_WAIT_L(n) asm volatile("s_waitcnt lgkmcnt(" #n ")" ::: "memory")
#define PG8_BAR __builtin_amdgcn_s_barrier()
#define PG8_SCHED __builtin_amdgcn_sched_barrier(0)
    Unit cur, nxt; int ui = 0;
    if (!S.next(0, cur)) return;
    f32x4 acc[2][2][4][2];
#pragma unroll
    for (int a = 0; a < 2; ++a)
#pragma unroll
        for (int b = 0; b < 2; ++b)
#pragma unroll
            for (int m = 0; m < 4; ++m)
#pragma unroll
                for (int n = 0; n < 2; ++n) acc[a][b][m][n] = (f32x4){0.f, 0.f, 0.f, 0.f};
    bf16x8 At[4][2], B0[2][2], B1[2][2];
    const char* cA = (const char*)g.A + (size_t)cur.pm * tstep; const char* cB = (const char*)g.Bt + (size_t)cur.pn * tstep;
    S.a_ready(cur);
    if constexpr (SP2) {
        PG8_STAGE(PG8_SB(0, 0), cB, voffB); PG8_STAGE(PG8_SB(0, 1), cB + hstep, voffB); PG8_STAGE(PG8_SA(0, 0), cA, voffA); PG8_STAGE(PG8_SA(0, 1), cA + hstep, voffA);
        if (wr == 1) PG8_BAR;
        PG8_WAIT_V(2); PG8_BAR;
        PG8_STAGE(PG8_SB(1, 0), cB + kstep, voffB); PG8_STAGE(PG8_SA(1, 0), cA + kstep, voffA); PG8_STAGE(PG8_SB(1, 1), cB + hstep + kstep, voffB);
        PG8_WAIT_V(6); PG8_BAR;
    } else {
        PG8_STAGE(PG8_SB(0, 0), cB, voffB); PG8_STAGE(PG8_SA(0, 0), cA, voffA); PG8_STAGE(PG8_SB(0, 1), cB + hstep, voffB); PG8_STAGE(PG8_SA(0, 1), cA + hstep, voffA);
        if (wr == 1) PG8_BAR;
        PG8_WAIT_V(4); PG8_BAR;
        PG8_STAGE(PG8_SB(1, 0), cB + kstep, voffB); PG8_STAGE(PG8_SA(1, 0), cA + kstep, voffA); PG8_STAGE(PG8_SB(1, 1), cB + hstep + kstep, voffB);
        PG8_WAIT_V(6); PG8_BAR;
    }
    for (;;) {
        const bool has_next = S.next(ui + 1, nxt);
        const char* nA = has_next ? (const char*)g.A + (size_t)nxt.pm * tstep : cA; const char* nB = has_next ? (const char*)g.Bt + (size_t)nxt.pn * tstep : cB;
        for (int t = 0; t < nt; t += 2) {
            const bool last = (t == nt - 2);
            const char* a1 = cA + (size_t)(t + 1) * kstep;
            const char* a2 = last ? nA : cA + (size_t)(t + 2) * kstep; const char* b2 = last ? nB : cB + (size_t)(t + 2) * kstep;
            const char* a3 = a2 + kstep; const char* b3 = b2 + kstep;
            if (last && has_next) S.a_ready(nxt);
            if constexpr (SP2) {
            PG8_LDB(B0, 0, 0); PG8_LDB(B1, 0, 1); PG8_SCHED; PG8_LDA(At, 0, 0); PG8_STAGE(PG8_SA(1, 1), a1 + hstep, voffA);
            PG8_WAIT_V(8); PG8_WAIT_L(0); PG8_BAR; PG8_MMA(0, 0, At, B0); PG8_MMA(0, 1, At, B1); PG8_BAR; PG8_SCHED;
            PG8_LDA(At, 0, 1); PG8_STAGE(PG8_SB(0, 0), b2, voffB); PG8_STAGE(PG8_SB(0, 1), b2 + hstep, voffB); PG8_STAGE(PG8_SA(0, 0), a2, voffA);
            PG8_WAIT_V(8); PG8_WAIT_L(0); PG8_BAR; PG8_MMA(1, 0, At, B0); PG8_MMA(1, 1, At, B1); PG8_BAR; PG8_SCHED;
            PG8_LDB(B0, 1, 0); PG8_LDB(B1, 1, 1); PG8_SCHED; PG8_LDA(At, 1, 0); PG8_STAGE(PG8_SA(0, 1), a2 + hstep, voffA);
            PG8_WAIT_V(8); PG8_WAIT_L(0); PG8_BAR; PG8_MMA(0, 0, At, B0); PG8_MMA(0, 1, At, B1); PG8_BAR; PG8_SCHED;
            PG8_LDA(At, 1, 1); PG8_STAGE(PG8_SB(1, 0), b3, voffB); PG8_STAGE(PG8_SB(1, 1), b3 + hstep, voffB); PG8_STAGE(PG8_SA(1, 0), a3, voffA);
            PG8_WAIT_V(8); PG8_WAIT_L(0); PG8_BAR; PG8_MMA(1, 0, At, B0); PG8_MMA(1, 1, At, B1); PG8_BAR; PG8_SCHED;
            } else {
            PG8_LDB(B0, 0, 0); PG8_SCHED; PG8_LDA(At, 0, 0); PG8_STAGE(PG8_SA(1, 1), a1 + hstep, voffA);
            PG8_WAIT_L(8); PG8_BAR; PG8_WAIT_L(0); PG8_MMA(0, 0, At, B0); PG8_BAR; PG8_SCHED;
            PG8_LDB(B1, 0, 1); PG8_STAGE(PG8_SB(0, 0), b2, voffB);
            PG8_BAR; PG8_WAIT_L(0); PG8_MMA(0, 1, At, B1); PG8_BAR;
            PG8_LDA(At, 0, 1); PG8_STAGE(PG8_SA(0, 0), a2, voffA);
            PG8_BAR; PG8_WAIT_L(0); PG8_MMA(1, 0, At, B0); PG8_BAR; PG8_SCHED;
            PG8_STAGE(PG8_SB(0, 1), b2 + hstep, voffB);
            PG8_WAIT_V(6); PG8_BAR; PG8_MMA(1, 1, At, B1); PG8_BAR;
            PG8_LDB(B0, 1, 0); PG8_SCHED; PG8_LDA(At, 1, 0); PG8_STAGE(PG8_SA(0, 1), a2 + hstep, voffA);
            PG8_WAIT_L(8); PG8_BAR; PG8_WAIT_L(0); PG8_MMA(0, 0, At, B0); PG8_BAR; PG8_SCHED;
            PG8_LDB(B1, 1, 1); PG8_STAGE(PG8_SB(1, 0), b3, voffB);
            PG8_BAR; PG8_WAIT_L(0); PG8_MMA(0, 1, At, B1); PG8_BAR;
            PG8_LDA(At, 1, 1); PG8_STAGE(PG8_SA(1, 0), a3, voffA);
            PG8_BAR; PG8_WAIT_L(0); PG8_MMA(1, 0, At, B0); PG8_BAR; PG8_SCHED;
            PG8_STAGE(PG8_SB(1, 1), b3 + hstep, voffB);
            PG8_WAIT_V(6); PG8_BAR; PG8_MMA(1, 1, At, B1); PG8_BAR;
            }
        }
        if constexpr (ALIGN_EPI) { if (wr == 0) PG8_BAR; }
        if constexpr (!Epi::AFTER_DRAIN) { E(acc, cur, wr, wc, fr, fq); S.done(cur); }
        if (!has_next) break;
#pragma unroll
        for (int a = 0; a < 2; ++a)
#pragma unroll
            for (int b = 0; b < 2; ++b)
#pragma unroll
                for (int m = 0; m < 4; ++m)
#pragma unroll
                    for (int n = 0; n < 2; ++n) acc[a][b][m][n] = (f32x4){0.f, 0.f, 0.f, 0.f};
        cur = nxt; cA = nA; cB = nB; ++ui;
        if constexpr (ALIGN_EPI) { if (wr == 1) PG8_BAR; }
    }
    PG8_WAIT_V(0);
    if constexpr (!ALIGN_EPI) { if (wr == 0) PG8_BAR; }
    PG8_BAR;
    if constexpr (Epi::AFTER_DRAIN) { E.fused(acc, cur, wr, wc, fr, fq, lds, wid, lane); S.done(cur); }
#undef PG8_SA
#undef PG8_SB
#undef PG8_STAGE
#undef PG8_LDA
#undef PG8_LDB
#undef PG8_MMA
#undef PG8_WAIT_V
#undef PG8_WAIT_L
#undef PG8_BAR
#undef PG8_SCHED
}
}
#define LAS __attribute__((address_space(3)))
#define GAS __attribute__((address_space(1)))
#define LDS_BARRIER() do { asm volatile("s_waitcnt lgkmcnt(0)" ::: "memory"); __builtin_amdgcn_s_barrier(); asm volatile("" ::: "memory"); } while (0)
typedef unsigned short bf16;
typedef unsigned v4u __attribute__((ext_vector_type(4)));
typedef float f32x4 __attribute__((ext_vector_type(4)));
constexpr int NWAVES = 8, NTHREADS = 512;
constexpr int SEQ = 8192, DM = 1024, MTOK = 16384, DIN = 9744, N1 = 9728, PLD = 6656, FF = 4096;
constexpr float EPS = 1e-6f;
constexpr size_t MiB = 1u << 20;
constexpr size_t WS_WIN = 1 * MiB, WS_WA = 20 * MiB, WS_WB = 21 * MiB, WS_WO = 23 * MiB, WS_WUP = 25 * MiB, WS_WDN = 33 * MiB;
constexpr size_t WS_XB = 41 * MiB, WS_PROJ = 73 * MiB, WS_VT = 177 * MiB, WS_A1 = 193 * MiB, WS_A2 = 209 * MiB;
constexpr size_t WS_R1 = 241 * MiB, WS_PA = 242 * MiB, WS_SS2 = 243 * MiB, WS_MISC = 244 * MiB;
constexpr size_t WS_MIXED = 73 * MiB, WS_U = 73 * MiB, WS_END = 256 * MiB;
constexpr int LDS_BYTES = 155648, LDS_BARST = 155584;
constexpr size_t WS_BAR = 0;

__device__ __forceinline__ float bf2f(bf16 h) { return __uint_as_float(((unsigned)h) << 16); }
__device__ __forceinline__ unsigned f2bf(float f) { unsigned u = __builtin_bit_cast(unsigned, f); return (u + 0x7fffu + ((u >> 16) & 1u)) >> 16; }
__device__ __forceinline__ unsigned pk2(float lo, float hi) { return f2bf(lo) | (f2bf(hi) << 16); }
__device__ __forceinline__ float wave_sum(float v) {
#pragma unroll
    for (int o = 1; o < 64; o <<= 1) v += __shfl_xor(v, o);
    return v;
}
__device__ __forceinline__ float log_sigmoid(float x) { return fminf(x, 0.f) - log1pf(__expf(-fabsf(x))); }

#ifndef TPROBE
#define TPROBE -1
#endif
#ifndef TPBLK
#define TPBLK 0
#endif
#ifndef TPB
#define TPB (TPROBE + 1)
#endif
#ifndef REPMASK
#define REPMASK 0
#endif
struct Args { const float* in[15]; float* out; unsigned char* ws; int ph_lo, ph_hi, rep, pad; };

__device__ __forceinline__ void p0_transpose_item(const float* W, int ldw, int srccol0, const float* kscale, int kmask, float cscale,
                                                  bf16* WT, int K, int dstrow0, int k0, LAS float* scr, int lane) {
    float v[64];
    const GAS float* wp = (const GAS float*)W + (size_t)k0 * ldw + srccol0 + lane;
#pragma unroll
    for (int i = 0; i < 64; ++i) v[i] = wp[(size_t)i * ldw];
    const int c = lane & 7;
    f32x4 s0 = (f32x4){cscale, cscale, cscale, cscale}, s1 = s0;
    if (kscale) { const int kb = (k0 + 8 * c) & kmask; s0 = *(const GAS f32x4*)((const GAS float*)kscale + kb) * cscale; s1 = *(const GAS f32x4*)((const GAS float*)kscale + kb + 4) * cscale; }
#pragma unroll
    for (int i = 0; i < 64; ++i) scr[i * 65 + lane] = v[i];
    asm volatile("s_waitcnt lgkmcnt(0)" ::: "memory");
#pragma unroll
    for (int j = 0; j < 8; ++j) { const int n = (lane >> 3) + 8 * j; const LAS float* s = scr + (8 * c) * 65 + n;
        v4u o; o.x = pk2(s[0 * 65] * s0[0], s[1 * 65] * s0[1]); o.y = pk2(s[2 * 65] * s0[2], s[3 * 65] * s0[3]); o.z = pk2(s[4 * 65] * s1[0], s[5 * 65] * s1[1]); o.w = pk2(s[6 * 65] * s1[2], s[7 * 65] * s1[3]);
        *(GAS v4u*)((GAS bf16*)WT + (size_t)(dstrow0 + n) * K + k0 + 8 * c) = o; }
    asm volatile("s_waitcnt lgkmcnt(0)" ::: "memory");
}

#define XB_TMO      128
#define XB_XCNT(j)  (256  + 64 * (j))
#define XB_XSUB(j)  (1280 + 64 * (j))
#define XB_XGEN(j)  (2304 + 64 * (j))
#define XB_TOP      3328
#define XB_TOPGEN   3392
#define XCD_BAR_WORDS 3456
#define XB_SPIN_CAP (1u << 18)

__device__ __forceinline__ unsigned xb_ld(unsigned* p)              { return __hip_atomic_load(p, __ATOMIC_RELAXED, __HIP_MEMORY_SCOPE_AGENT); }
__device__ __forceinline__ unsigned xb_add(unsigned* p, unsigned v) { return __hip_atomic_fetch_add(p, v, __ATOMIC_RELAXED, __HIP_MEMORY_SCOPE_AGENT); }
__device__ __forceinline__ unsigned xb_xcc_id() { return (unsigned)__builtin_amdgcn_s_getreg((3 << 11) | 20) & 0xFu; }
#define XB_SPIN(cond, bar) do { unsigned _sp = 0; while (cond) { __builtin_amdgcn_s_sleep(1); \
    if ((++_sp & 255u) == 0u) { if (xb_ld(&(bar)[XB_TMO])) break; if (_sp > XB_SPIN_CAP) { atomicAdd(&(bar)[XB_TMO], 1u); break; } } } } while (0)

struct XcdBarrier {
    unsigned* bar; unsigned x;
    volatile LAS unsigned* st;
};

__device__ __forceinline__ XcdBarrier xcd_barrier_post(unsigned* bar, volatile LAS unsigned* st) {
    XcdBarrier b; b.bar = bar; b.x = xb_xcc_id(); b.st = st;
    if (threadIdx.x == 0) (void)xb_add(&bar[XB_XCNT(b.x)], 1u);
    return b;
}
__device__ __forceinline__ void xcd_barrier_complete(unsigned* bar, unsigned x, unsigned& nloc, unsigned& nx) {
    const unsigned G = gridDim.x * gridDim.y * gridDim.z;
    unsigned sum, cnt, mine, sp = 0u;
    for (;;) {
        sum = 0u; cnt = 0u; mine = 0u;
#pragma unroll
        for (unsigned j = 0; j < 16; ++j) { const unsigned c = xb_ld(&bar[XB_XCNT(j)]); sum += c; cnt += (c > 0u) ? 1u : 0u; mine = (j == x) ? c : mine; }
        if (sum == G) break;
        __builtin_amdgcn_s_sleep(1);
        if ((++sp & 255u) == 0u) { if (xb_ld(&bar[XB_TMO])) break; if (sp > XB_SPIN_CAP) { atomicAdd(&bar[XB_TMO], 1u); break; } }
    }
    nloc = mine > 0u ? mine : 1u; nx = cnt > 0u ? cnt : 1u;
}

__device__ __forceinline__ void xcd_barrier(const XcdBarrier& b) {
    asm volatile("s_waitcnt vmcnt(0)" ::: "memory");
    __syncthreads();
    if (threadIdx.x == 0) {
        unsigned* bar = b.bar;
        __builtin_amdgcn_s_waitcnt(0);
        unsigned nloc = b.st[0], nx = b.st[1];
        if (nloc == 0u) { xcd_barrier_complete(bar, b.x, nloc, nx); b.st[0] = nloc; b.st[1] = nx; }
        const unsigned old = xb_add(&bar[XB_XSUB(b.x)], 1u);
        const unsigned gen = old / nloc;
        if (old + 1u == (gen + 1u) * nloc) {
            __builtin_amdgcn_fence(__ATOMIC_RELEASE, "agent");
            asm volatile("s_waitcnt vmcnt(0)" ::: "memory");
            const unsigned og = xb_add(&bar[XB_TOP], 1u);
            const unsigned tg = og / nx;
            if (og + 1u == (tg + 1u) * nx) xb_add(&bar[XB_TOPGEN], 1u);
            else XB_SPIN(xb_ld(&bar[XB_TOPGEN]) == tg, bar);
            __builtin_amdgcn_fence(__ATOMIC_ACQUIRE, "agent");
            xb_add(&bar[XB_XGEN(b.x)], 1u);
            asm volatile("s_waitcnt vmcnt(0)" ::: "memory");
        } else {
            XB_SPIN(xb_ld(&bar[XB_XGEN(b.x)]) == gen, bar);
            __builtin_amdgcn_fence(__ATOMIC_ACQUIRE, "agent");
            asm volatile("s_waitcnt vmcnt(0)" ::: "memory");
        }
    }
    __syncthreads();
}

typedef short bf16x8_t __attribute__((ext_vector_type(8)));
typedef short s16x4_t __attribute__((ext_vector_type(4)));
constexpr int AT_PITCH = 144;
constexpr int AT_KL = 0, AT_VL = 384 * AT_PITCH;
constexpr int N_ATT_ITEMS = 768;
constexpr int AT_ROWS = 384;
struct AttnKQ { v4u k[6], q[4]; };
__device__ __forceinline__ void attn_decode(int it2, int& g, int& slot, int& d, int& r, int& n) {
    g = it2 >> 8; const int rem = it2 & 255; slot = rem & 7; const int rest = rem >> 3; const int sh = 2 * g; d = 1 << sh; r = rest >> (5 - sh); n = 2 * (rest & ((32 >> sh) - 1));
}
__device__ __forceinline__ bool it_first_block(int it2) { int g, slot, d, r, n; attn_decode(it2, g, slot, d, r, n); return n == 0; }
__device__ __forceinline__ void attn_load_kq(AttnKQ& R, const bf16* PROJ_, int it, int tid, int wave, int lane) {
    int g, slot, d, r, n; attn_decode(it, g, slot, d, r, n); const int hd = g * 8 + slot; const int c = tid & 7;
#pragma unroll
    for (int p = 0; p < 6; ++p) { const int row = p * 64 + (tid >> 3); const int sp = (n - 1) * 128 + row;
        if (n > 0 || p >= 2) R.k[p] = *(const GAS v4u*)((const GAS bf16*)PROJ_ + (size_t)(sp * d + r) * PLD + 1536 + hd * 64 + c * 8);
        else R.k[p] = (v4u){0u, 0u, 0u, 0u}; }
    const int fr = lane & 15, fq = lane >> 4; const GAS bf16* qb = (const GAS bf16*)PROJ_ + (size_t)((n * 128 + 16 * wave + fr) * d + r) * PLD + hd * 64 + 8 * fq;
    R.q[0] = *(const GAS v4u*)(qb); R.q[1] = *(const GAS v4u*)(qb + 32);
    const GAS bf16* qb2 = qb + (size_t)128 * d * PLD; R.q[2] = *(const GAS v4u*)(qb2); R.q[3] = *(const GAS v4u*)(qb2 + 32);
}
__device__ __forceinline__ void attn_load_v(v4u (&V)[6], const bf16* PROJ_, int it, int tid) {
    int g, slot, d, r, n; attn_decode(it, g, slot, d, r, n); const int hd = g * 8 + slot; const int c = tid & 7;
#pragma unroll
    for (int p = 0; p < 6; ++p) { const int row = p * 64 + (tid >> 3); const int sp = (n - 1) * 128 + row;
        if (n > 0 || p >= 2) V[p] = *(const GAS v4u*)((const GAS bf16*)PROJ_ + (size_t)(sp * d + r) * PLD + 3072 + hd * 64 + c * 8);
        else V[p] = (v4u){0u, 0u, 0u, 0u}; }
}
__device__ __forceinline__ void attn_stage_k(const AttnKQ& R, LAS unsigned char* lds, const float (&gkr)[8], int tid) {
    const int c = tid & 7;
#pragma unroll
    for (int p = 0; p < 6; ++p) { const int row = p * 64 + (tid >> 3); float f[8]; pg8::unpack8(R.k[p], f); float ss = 0.f;
#pragma unroll
        for (int i = 0; i < 8; ++i) ss += f[i] * f[i];
        ss += __shfl_xor(ss, 1); ss += __shfl_xor(ss, 2); ss += __shfl_xor(ss, 4);
        const float rs = __builtin_amdgcn_rsqf(ss * (1.0f / 64.0f) + EPS);
#pragma unroll
        for (int i = 0; i < 8; ++i) f[i] = f[i] * (rs * gkr[i]);
        *(LAS v4u*)(lds + AT_KL + row * AT_PITCH + c * 16) = pg8::pack8(f); }
}
__device__ __forceinline__ void attn_stage_v(const v4u (&V)[6], LAS unsigned char* lds, int tid) {
    const int c = tid & 7;
#pragma unroll
    for (int p = 0; p < 6; ++p) { const int row = p * 64 + (tid >> 3); *(LAS v4u*)(lds + AT_VL + row * AT_PITCH + c * 16) = V[p]; }
}
__device__ __forceinline__ void attn_scores(f32x4 (&sc)[9], float& mx, float& den, v4u q0, v4u q1, LAS unsigned char* lds, const float (&gqr)[16], int koff, bool firstblk, int wave, int lane) {
    const int fr = lane & 15, fq = lane >> 4, w = wave;
    float qf[16]; { float t0[8], t1[8]; pg8::unpack8(q0, t0); pg8::unpack8(q1, t1);
#pragma unroll
        for (int i = 0; i < 8; ++i) { qf[i] = t0[i]; qf[8 + i] = t1[i]; } }
    float ss = 0.f;
#pragma unroll
    for (int i = 0; i < 16; ++i) ss += qf[i] * qf[i];
    ss += __shfl_xor(ss, 16); ss += __shfl_xor(ss, 32);
    const float qs = __builtin_amdgcn_rsqf(ss * (1.0f / 64.0f) + EPS) * (0.125f * 1.4426950408889634f);
    bf16x8_t qa[2];
    { float t0[8], t1[8];
#pragma unroll
      for (int i = 0; i < 8; ++i) { t0[i] = qf[i] * (qs * gqr[i]); t1[i] = qf[8 + i] * (qs * gqr[8 + i]); }
      qa[0] = __builtin_bit_cast(bf16x8_t, pg8::pack8(t0)); qa[1] = __builtin_bit_cast(bf16x8_t, pg8::pack8(t1)); }
#pragma unroll
    for (int kti = 0; kti < 9; ++kti) { f32x4 acc = (f32x4){0.f, 0.f, 0.f, 0.f}; const LAS unsigned char* kp = lds + AT_KL + ((koff + w + kti) * 16 + fr) * AT_PITCH + fq * 16;
#pragma unroll
        for (int ks = 0; ks < 2; ++ks) { const bf16x8_t kf = *(const LAS bf16x8_t*)(kp + ks * 64); acc = __builtin_amdgcn_mfma_f32_16x16x32_bf16(kf, qa[ks], acc, 0, 0, 0); }
        sc[kti] = acc; if (kti % 3 == 2) __builtin_amdgcn_sched_barrier(0); }
    mx = -INFINITY;
#pragma unroll
    for (int j = 0; j < 4; ++j) { if (4 * fq + j < fr) sc[0][j] = -INFINITY; if (4 * fq + j > fr) sc[8][j] = -INFINITY; }
    if (firstblk) {
#pragma unroll
        for (int kti = 0; kti < 9; ++kti) if (w + kti < 8) sc[kti] = (f32x4){-INFINITY, -INFINITY, -INFINITY, -INFINITY}; }
#pragma unroll
    for (int kti = 0; kti < 9; ++kti)
#pragma unroll
        for (int j = 0; j < 4; ++j) mx = fmaxf(mx, sc[kti][j]);
    mx = fmaxf(mx, __shfl_xor(mx, 16)); mx = fmaxf(mx, __shfl_xor(mx, 32));
    den = 0.f;
#pragma unroll
    for (int kti = 0; kti < 9; ++kti)
#pragma unroll
        for (int j = 0; j < 4; ++j) { const float pv = __builtin_amdgcn_exp2f(sc[kti][j] - mx); sc[kti][j] = pv; den += pv; }
    den += __shfl_xor(den, 16); den += __shfl_xor(den, 32);
    __builtin_amdgcn_sched_barrier(0);
}
__device__ __forceinline__ void attn_pv(const f32x4 (&sc)[9], float mx, float den, LAS unsigned char* lds, bf16* PROJ_, float* ML_, int it, int koff, int wave, int lane, bool do_store) {
    int g, slot, d, r, n; attn_decode(it, g, slot, d, r, n); const int hd = g * 8 + slot; n += koff >> 3;
    const int fr = lane & 15, fq = lane >> 4, w = wave;
    f32x4 o[4];
#pragma unroll
    for (int et = 0; et < 4; ++et) o[et] = (f32x4){0.f, 0.f, 0.f, 0.f};
    const int q_ = (lane >> 2) & 3, p_ = lane & 3;
#pragma unroll
    for (int kk = 0; kk < 5; ++kk) { const int kt0 = koff + w + 2 * kk, kt1 = (kk < 4) ? kt0 + 1 : kt0;
        v4u aw; aw.x = pg8::cvt_pk_bf16(sc[2 * kk][0], sc[2 * kk][1]); aw.y = pg8::cvt_pk_bf16(sc[2 * kk][2], sc[2 * kk][3]);
        if (kk < 4) { aw.z = pg8::cvt_pk_bf16(sc[(kk < 4) ? 2 * kk + 1 : 0][0], sc[(kk < 4) ? 2 * kk + 1 : 0][1]); aw.w = pg8::cvt_pk_bf16(sc[(kk < 4) ? 2 * kk + 1 : 0][2], sc[(kk < 4) ? 2 * kk + 1 : 0][3]); } else { aw.z = 0u; aw.w = 0u; }
        const bf16x8_t af = __builtin_bit_cast(bf16x8_t, aw);
        const LAS unsigned char* v0 = lds + AT_VL + (kt0 * 16 + 4 * fq + q_) * AT_PITCH + p_ * 8; const LAS unsigned char* v1 = lds + AT_VL + (kt1 * 16 + 4 * fq + q_) * AT_PITCH + p_ * 8;
#pragma unroll
        for (int et = 0; et < 4; ++et) {
            const s16x4_t lo = __builtin_bit_cast(s16x4_t, __builtin_amdgcn_ds_read_tr16_b64_v4i16((LAS s16x4_t*)(v0 + et * 32)));
            const s16x4_t hi = __builtin_bit_cast(s16x4_t, __builtin_amdgcn_ds_read_tr16_b64_v4i16((LAS s16x4_t*)(v1 + et * 32)));
            const bf16x8_t bfr = (bf16x8_t){lo[0], lo[1], lo[2], lo[3], hi[0], hi[1], hi[2], hi[3]};
            o[et] = __builtin_amdgcn_mfma_f32_16x16x32_bf16(af, bfr, o[et], 0, 0, 0); }
        __builtin_amdgcn_sched_barrier(0); }
    if (do_store)
#pragma unroll
    for (int j = 0; j < 4; j += 2) { GAS bf16* op0 = (GAS bf16*)PROJ_ + (size_t)((n * 128 + 16 * w + 4 * fq + j) * d + r) * PLD + hd * 64 + fr; GAS bf16* op1 = op0 + (size_t)d * PLD;
#pragma unroll
        for (int et = 0; et < 4; ++et) { const unsigned wv = pg8::cvt_pk_bf16(o[et][j], o[et][j + 1]); op0[et * 16] = (bf16)(wv & 0xffffu); op1[et * 16] = (bf16)(wv >> 16); } }
    if (fq == 0) { GAS float* mp = (GAS float*)ML_ + (size_t)((n * 128 + 16 * w + fr) * d + r) * 48 + (g * 8 + slot) * 2; mp[0] = mx; mp[1] = den; }
}

constexpr int GL_QG = 0, GL_KG = 17408, GL_KDT = 34816, GL_VTL = 53248, GL_PL = 90112, GL_EB = 99328, GL_PAL = 99840, GL_GT = 103936, GL_SSQ = 105984, GL_RS = 108032, GL_QR = 108544, GL_KR = 124928, GL_UP = 141312;
typedef unsigned u32x2_t __attribute__((ext_vector_type(2)));
struct GlaLd { v4u vt[4], q[2], k[2]; float pa[2]; };
__device__ __forceinline__ void gla_load(GlaLd& L, int b, int h, int tok0, const bf16* PROJ_, const bf16* VT_, const float* PA_, int tid) {
    const GAS float* pap = (const GAS float*)PA_ + (size_t)(b * SEQ + tok0) * 16; L.pa[0] = pap[tid]; L.pa[1] = pap[tid + 512];
#pragma unroll
    for (int i = 0; i < 4; ++i) { const int piece = tid + 512 * i, v = piece >> 3, cc = piece & 7; L.vt[i] = *(const GAS v4u*)((const GAS bf16*)VT_ + (size_t)(h * 256 + v) * SEQ + tok0 + cc * 8); }
#pragma unroll
    for (int i = 0; i < 2; ++i) { const int piece = tid + 512 * i, row = piece >> 4, c16 = piece & 15; const GAS bf16* rp = (const GAS bf16*)PROJ_ + (size_t)(tok0 + row) * PLD + h * 128 + c16 * 8;
        L.k[i] = *(const GAS v4u*)(rp + 5120); L.q[i] = *(const GAS v4u*)(rp + 4608); }
}
__device__ __forceinline__ void gla_stage(const GlaLd& L, LAS unsigned char* lds, int tid) {
    LAS float* PAL = (LAS float*)(lds + GL_PAL); PAL[tid] = L.pa[0]; PAL[tid + 512] = L.pa[1];
#pragma unroll
    for (int i = 0; i < 4; ++i) { const int piece = tid + 512 * i, v = piece >> 3, cc = piece & 7; *(LAS v4u*)(lds + GL_VTL + v * 144 + cc * 16) = L.vt[i]; }
#pragma unroll
    for (int i = 0; i < 2; ++i) { const int piece = tid + 512 * i; *(LAS v4u*)(lds + GL_KR + piece * 16) = L.k[i]; *(LAS v4u*)(lds + GL_QR + piece * 16) = L.q[i]; }
}
__device__ __forceinline__ float fexp(float x) { return __builtin_amdgcn_exp2f(x * 1.4426950408889634f); }
__device__ __forceinline__ float log_sigmoid_fast(float x) { return fminf(x, 0.f) - 0.6931471805599453f * __builtin_amdgcn_logf(1.0f + __builtin_amdgcn_exp2f(fabsf(x) * -1.4426950408889634f)); }
__device__ __forceinline__ void gla_local(LAS unsigned char* lds, int b, int item, const bf16* PROJ_, const bf16* VT_, const float* PA_, const float* gate_up_, const float* gate_bias_,
                                          float* SBUF_, float* DBUF_, bf16* A2_, bf16* QGS_, int tid_in, int wave, int lane_in) {
    int tid = tid_in, lane = lane_in; asm volatile("" : "+v"(tid), "+v"(lane));
    const int h = item >> 5, seg = item & 31;
    const int w = wave;
    GlaLd L; gla_load(L, b, h, seg * 256, PROJ_, VT_, PA_, tid);
    { LAS float* UP = (LAS float*)(lds + GL_UP);
#pragma unroll
      for (int i = 0; i < 4; ++i) { const int idx = tid + 512 * i, r = idx >> 7, k2 = idx & 127; UP[k2 * 20 + r] = gate_up_[r * 512 + h * 128 + k2]; } }
    const float bk = gate_bias_[h * 128 + (tid & 127)];
    f32x4 S[8][2];
#pragma unroll
    for (int mtk = 0; mtk < 8; ++mtk) { S[mtk][0] = (f32x4){0.f, 0.f, 0.f, 0.f}; S[mtk][1] = (f32x4){0.f, 0.f, 0.f, 0.f}; }
    float segsum = 0.f;
    asm volatile("" :: "v"(bk), "v"(L.k[1]));
    const int tid_item = tid, lane_item = lane;
    for (int c = 0; c < 4; ++c) {
        const int tok0 = seg * 256 + c * 64;
        int tid = tid_item, lane = lane_item; asm volatile("" : "+v"(tid), "+v"(lane));
        const int kd = tid & 127, tq = tid >> 7, fr = lane & 15, fq = lane >> 4;
        gla_stage(L, lds, tid);
        LDS_BARRIER();
        if (c < 3) gla_load(L, b, h, tok0 + 64, PROJ_, VT_, PA_, tid);
        { const LAS float* pal = (const LAS float*)(lds + GL_PAL); const LAS float* upl = (const LAS float*)(lds + GL_UP) + (16 * w + fr) * 20 + fq;
          const float ub0 = upl[0], ub1 = upl[4], ub2 = upl[8], ub3 = upl[12];
#pragma unroll
          for (int mt = 0; mt < 4; ++mt) { const LAS float* pa4 = pal + (16 * mt + fr) * 16 + fq; f32x4 lacc = (f32x4){0.f, 0.f, 0.f, 0.f};
              lacc = __builtin_amdgcn_mfma_f32_16x16x4f32(pa4[0], ub0, lacc, 0, 0, 0); lacc = __builtin_amdgcn_mfma_f32_16x16x4f32(pa4[4], ub1, lacc, 0, 0, 0);
              lacc = __builtin_amdgcn_mfma_f32_16x16x4f32(pa4[8], ub2, lacc, 0, 0, 0); lacc = __builtin_amdgcn_mfma_f32_16x16x4f32(pa4[12], ub3, lacc, 0, 0, 0);
#pragma unroll
              for (int j = 0; j < 4; ++j) ((LAS float*)lds)[(16 * mt + 4 * fq + j) * 128 + 16 * w + fr] = lacc[j]; } }
        LDS_BARRIER();
        float cb[16];
        { float run = 0.f;
#pragma unroll
          for (int i = 0; i < 16; ++i) { const int t = 16 * tq + i; const float lg = bk + ((const LAS float*)lds)[t * 128 + kd];
              run += log_sigmoid_fast(lg) * (1.0f / 16.0f); cb[i] = run; } }
        { LAS float* GT = (LAS float*)(lds + GL_GT); GT[tq * 128 + kd] = cb[15]; }
        LDS_BARRIER();
        float off = 0.f, tot = 0.f;
        { const LAS float* GT = (const LAS float*)(lds + GL_GT);
#pragma unroll
          for (int q = 0; q < 4; ++q) { const float gv = GT[q * 128 + kd]; tot += gv; off += (q < tq) ? gv : 0.f; } }
        const float etot = fexp(tot), eseg = fexp(segsum);
        { float kdv[16];
          GAS bf16* qgs = (GAS bf16*)QGS_ + (size_t)(tok0 + 16 * tq) * 512 + h * 128 + kd;
#pragma unroll
          for (int i = 0; i < 16; i += 2) { const int t = 16 * tq + i; const float bc0 = cb[i] + off, bc1 = cb[i + 1] + off;
              const float kf0 = bf2f(*(const LAS unsigned short*)(lds + GL_KR + t * 256 + kd * 2)), kf1 = bf2f(*(const LAS unsigned short*)(lds + GL_KR + (t + 1) * 256 + kd * 2));
              const float en0 = fexp(-bc0), en1 = fexp(-bc1);
              const float kg0 = kf0 * en0, kg1 = kf1 * en1; kdv[i] = kg0 * etot; kdv[i + 1] = kg1 * etot;
              const float qf0 = bf2f(*(const LAS unsigned short*)(lds + GL_QR + t * 256 + kd * 2)), qf1 = bf2f(*(const LAS unsigned short*)(lds + GL_QR + (t + 1) * 256 + kd * 2));
              const float qg0 = qf0 * fexp(bc0), qg1 = qf1 * fexp(bc1);
              const unsigned qw = pg8::cvt_pk_bf16(qg0, qg1), kw = pg8::cvt_pk_bf16(kg0, kg1), sw = pg8::cvt_pk_bf16(qg0 * eseg, qg1 * eseg);
              *(LAS unsigned short*)(lds + GL_QG + t * 272 + kd * 2) = (unsigned short)(qw & 0xffffu); *(LAS unsigned short*)(lds + GL_QG + (t + 1) * 272 + kd * 2) = (unsigned short)(qw >> 16);
              *(LAS unsigned short*)(lds + GL_KG + t * 272 + kd * 2) = (unsigned short)(kw & 0xffffu); *(LAS unsigned short*)(lds + GL_KG + (t + 1) * 272 + kd * 2) = (unsigned short)(kw >> 16);
              qgs[(size_t)i * 512] = (bf16)(sw & 0xffffu); qgs[(size_t)(i + 1) * 512] = (bf16)(sw >> 16); }
          float lo8[8], hi8[8];
#pragma unroll
          for (int i = 0; i < 8; ++i) { lo8[i] = kdv[i]; hi8[i] = kdv[8 + i]; }
          *(LAS v4u*)(lds + GL_KDT + kd * 144 + tq * 32) = pg8::pack8(lo8); *(LAS v4u*)(lds + GL_KDT + kd * 144 + tq * 32 + 16) = pg8::pack8(hi8); }
        if (tq == 0) ((LAS float*)(lds + GL_EB))[kd] = etot;
        segsum += tot;
        LDS_BARRIER();
        {
            const int mt = w >> 1;
#pragma unroll
            for (int sti = 0; sti < 2; ++sti) { const int st = 2 * (w & 1) + sti; f32x4 acc = (f32x4){0.f, 0.f, 0.f, 0.f};
                if (st <= mt) {
#pragma unroll
                    for (int ks = 0; ks < 4; ++ks) { const bf16x8_t kf = *(const LAS bf16x8_t*)(lds + GL_KG + (16 * st + fr) * 272 + (32 * ks + 8 * fq) * 2);
                        const bf16x8_t qf = *(const LAS bf16x8_t*)(lds + GL_QG + (16 * mt + fr) * 272 + (32 * ks + 8 * fq) * 2);
                        acc = __builtin_amdgcn_mfma_f32_16x16x32_bf16(kf, qf, acc, 0, 0, 0); }
                    if (st == mt) {
#pragma unroll
                        for (int j = 0; j < 4; ++j) if (4 * fq + j > fr) acc[j] = 0.f; } }
                u32x2_t wv; wv.x = pg8::cvt_pk_bf16(acc[0], acc[1]); wv.y = pg8::cvt_pk_bf16(acc[2], acc[3]);
                *(LAS u32x2_t*)(lds + GL_PL + (16 * mt + fr) * 144 + (16 * st + 4 * fq) * 2) = wv; }
            LDS_BARRIER();
        }
        bf16x8_t vf[2][2];
#pragma unroll
        for (int ks2 = 0; ks2 < 2; ++ks2)
#pragma unroll
            for (int nt = 0; nt < 2; ++nt) vf[ks2][nt] = *(const LAS bf16x8_t*)(lds + GL_VTL + (32 * w + 16 * nt + fr) * 144 + (32 * ks2 + 8 * fq) * 2);
        f32x4 o[4][2];
#pragma unroll
        for (int mt = 0; mt < 4; ++mt) { o[mt][0] = (f32x4){0.f, 0.f, 0.f, 0.f}; o[mt][1] = (f32x4){0.f, 0.f, 0.f, 0.f}; }
#pragma unroll
        for (int ks = 0; ks < 4; ++ks) { bf16x8_t bfr[2];
#pragma unroll
            for (int nt = 0; nt < 2; ++nt) { v4u wv; wv.x = pg8::cvt_pk_bf16(S[2 * ks][nt][0], S[2 * ks][nt][1]); wv.y = pg8::cvt_pk_bf16(S[2 * ks][nt][2], S[2 * ks][nt][3]);
                wv.z = pg8::cvt_pk_bf16(S[2 * ks + 1][nt][0], S[2 * ks + 1][nt][1]); wv.w = pg8::cvt_pk_bf16(S[2 * ks + 1][nt][2], S[2 * ks + 1][nt][3]); bfr[nt] = __builtin_bit_cast(bf16x8_t, wv); }
#pragma unroll
            for (int mt = 0; mt < 4; ++mt) { const u32x2_t a0 = *(const LAS u32x2_t*)(lds + GL_QG + (16 * mt + fr) * 272 + (32 * ks + 4 * fq) * 2), a1 = *(const LAS u32x2_t*)(lds + GL_QG + (16 * mt + fr) * 272 + (32 * ks + 16 + 4 * fq) * 2);
                const v4u aw = (v4u){a0.x, a0.y, a1.x, a1.y}; const bf16x8_t af = __builtin_bit_cast(bf16x8_t, aw);
                o[mt][0] = __builtin_amdgcn_mfma_f32_16x16x32_bf16(bfr[0], af, o[mt][0], 0, 0, 0); o[mt][1] = __builtin_amdgcn_mfma_f32_16x16x32_bf16(bfr[1], af, o[mt][1], 0, 0, 0); } }
#pragma unroll
        for (int ks2 = 0; ks2 < 2; ++ks2)
#pragma unroll
            for (int mt = 0; mt < 4; ++mt) { const bf16x8_t pf = *(const LAS bf16x8_t*)(lds + GL_PL + (16 * mt + fr) * 144 + (32 * ks2 + 8 * fq) * 2);
                o[mt][0] = __builtin_amdgcn_mfma_f32_16x16x32_bf16(vf[ks2][0], pf, o[mt][0], 0, 0, 0); o[mt][1] = __builtin_amdgcn_mfma_f32_16x16x32_bf16(vf[ks2][1], pf, o[mt][1], 0, 0, 0); }
#pragma unroll
        for (int mtk = 0; mtk < 8; ++mtk) { const f32x4 eb = *(const LAS f32x4*)(lds + GL_EB + (16 * mtk + 4 * fq) * 4);
            S[mtk][0] = S[mtk][0] * eb; S[mtk][1] = S[mtk][1] * eb;
#pragma unroll
            for (int ks2 = 0; ks2 < 2; ++ks2) { const bf16x8_t kf = *(const LAS bf16x8_t*)(lds + GL_KDT + (16 * mtk + fr) * 144 + (32 * ks2 + 8 * fq) * 2);
                S[mtk][0] = __builtin_amdgcn_mfma_f32_16x16x32_bf16(kf, vf[ks2][0], S[mtk][0], 0, 0, 0); S[mtk][1] = __builtin_amdgcn_mfma_f32_16x16x32_bf16(kf, vf[ks2][1], S[mtk][1], 0, 0, 0); } }
        LDS_BARRIER();
#pragma unroll
        for (int mt = 0; mt < 4; ++mt)
#pragma unroll
            for (int nt = 0; nt < 2; ++nt) { u32x2_t wv; wv.x = pg8::cvt_pk_bf16(o[mt][nt][0], o[mt][nt][1]); wv.y = pg8::cvt_pk_bf16(o[mt][nt][2], o[mt][nt][3]);
                *(LAS u32x2_t*)(lds + (16 * mt + fr) * 528 + (32 * w + 16 * nt + 4 * fq) * 2) = wv; }
        LDS_BARRIER();
#pragma unroll
        for (int i = 0; i < 4; ++i) { const int piece = tid + 512 * i, t = piece >> 5, c8 = piece & 31;
            *(GAS v4u*)((GAS bf16*)A2_ + (size_t)(b * SEQ + tok0 + t) * DM + h * 256 + c8 * 8) = *(const LAS v4u*)(lds + t * 528 + c8 * 16); }
    }
#pragma unroll
    for (int mtk = 0; mtk < 8; ++mtk)
#pragma unroll
        for (int nt = 0; nt < 2; ++nt)
#pragma unroll
            for (int j = 0; j < 4; ++j) ((GAS float*)SBUF_)[((size_t)item * 64 + (mtk * 2 + nt) * 4 + j) * 512 + tid] = S[mtk][nt][j];
    if ((tid >> 7) == 0) ((GAS float*)DBUF_)[item * 128 + (tid & 127)] = fexp(segsum);
    LDS_BARRIER();
}
constexpr int GF_QG = 0, GF_OL = 17408, GF_SSQ = 51200, GF_RS = 53248;
__device__ __forceinline__ void gla_fix(LAS unsigned char* lds, int b, int unit, const bf16* PROJ_, const bf16* SB16_, bf16* A2_, const bf16* QGS_, int tid_in, int wave, int lane_in) {
    int tid = tid_in, lane = lane_in; asm volatile("" : "+v"(tid), "+v"(lane));
    const int item = unit >> 1, half = unit & 1, h = item >> 5, seg = item & 31, w = wave, fr = lane & 15, fq = lane >> 4;
    bf16x8_t bfr[4][2];
#pragma unroll
    for (int ks = 0; ks < 4; ++ks)
#pragma unroll
        for (int nt = 0; nt < 2; ++nt) { unsigned hv[8];
#pragma unroll
            for (int j = 0; j < 4; ++j) { hv[j] = ((const GAS unsigned short*)SB16_)[((size_t)item * 64 + ((2 * ks) * 2 + nt) * 4 + j) * 512 + tid]; hv[4 + j] = ((const GAS unsigned short*)SB16_)[((size_t)item * 64 + ((2 * ks + 1) * 2 + nt) * 4 + j) * 512 + tid]; }
            const v4u wv = (v4u){hv[0] | (hv[1] << 16), hv[2] | (hv[3] << 16), hv[4] | (hv[5] << 16), hv[6] | (hv[7] << 16)};
            bfr[ks][nt] = __builtin_bit_cast(bf16x8_t, wv); }
    for (int cc = 0; cc < 2; ++cc) {
        const int tok0 = seg * 256 + (2 * half + cc) * 64;
        v4u rg[4], ol[4], qg[2];
#pragma unroll
        for (int i = 0; i < 4; ++i) { const int piece = tid + 512 * i, t = piece >> 5, c8 = piece & 31;
            rg[i] = *(const GAS v4u*)((const GAS bf16*)PROJ_ + (size_t)(tok0 + t) * PLD + 5632 + h * 256 + c8 * 8);
            ol[i] = *(const GAS v4u*)((const GAS bf16*)A2_ + (size_t)(b * SEQ + tok0 + t) * DM + h * 256 + c8 * 8); }
#pragma unroll
        for (int i = 0; i < 2; ++i) { const int piece = tid + 512 * i, t = piece >> 4, c16 = piece & 15; qg[i] = *(const GAS v4u*)((const GAS bf16*)QGS_ + (size_t)(tok0 + t) * 512 + h * 128 + c16 * 8); }
        LDS_BARRIER();
#pragma unroll
        for (int i = 0; i < 4; ++i) { const int piece = tid + 512 * i, t = piece >> 5, c8 = piece & 31; *(LAS v4u*)(lds + GF_OL + t * 528 + c8 * 16) = ol[i]; }
#pragma unroll
        for (int i = 0; i < 2; ++i) { const int piece = tid + 512 * i, t = piece >> 4, c16 = piece & 15; *(LAS v4u*)(lds + GF_QG + t * 272 + c16 * 16) = qg[i]; }
        LDS_BARRIER();
        f32x4 o[4][2];
#pragma unroll
        for (int mt = 0; mt < 4; ++mt)
#pragma unroll
            for (int nt = 0; nt < 2; ++nt) { const u32x2_t wv = *(const LAS u32x2_t*)(lds + GF_OL + (16 * mt + fr) * 528 + (32 * w + 16 * nt + 4 * fq) * 2);
                o[mt][nt] = (f32x4){pg8::bflo(wv.x), pg8::bfhi(wv.x), pg8::bflo(wv.y), pg8::bfhi(wv.y)}; }
#pragma unroll
        for (int ks = 0; ks < 4; ++ks)
#pragma unroll
            for (int mt = 0; mt < 4; ++mt) { const u32x2_t a0 = *(const LAS u32x2_t*)(lds + GF_QG + (16 * mt + fr) * 272 + (32 * ks + 4 * fq) * 2), a1 = *(const LAS u32x2_t*)(lds + GF_QG + (16 * mt + fr) * 272 + (32 * ks + 16 + 4 * fq) * 2);
                const v4u aw = (v4u){a0.x, a0.y, a1.x, a1.y}; const bf16x8_t af = __builtin_bit_cast(bf16x8_t, aw);
                o[mt][0] = __builtin_amdgcn_mfma_f32_16x16x32_bf16(bfr[ks][0], af, o[mt][0], 0, 0, 0); o[mt][1] = __builtin_amdgcn_mfma_f32_16x16x32_bf16(bfr[ks][1], af, o[mt][1], 0, 0, 0); }
#pragma unroll
        for (int mt = 0; mt < 4; ++mt) { float sq = 0.f;
#pragma unroll
            for (int j = 0; j < 4; ++j) sq += o[mt][0][j] * o[mt][0][j] + o[mt][1][j] * o[mt][1][j];
            sq += __shfl_xor(sq, 16); sq += __shfl_xor(sq, 32);
            if (fq == 0) ((LAS float*)(lds + GF_SSQ))[w * 64 + 16 * mt + fr] = sq; }
        LDS_BARRIER();
        if (tid < 64) { const LAS float* sp = (const LAS float*)(lds + GF_SSQ); float tsum = 0.f;
#pragma unroll
            for (int q = 0; q < 8; ++q) tsum += sp[q * 64 + tid];
            ((LAS float*)(lds + GF_RS))[tid] = 1.0f / sqrtf(tsum * (1.0f / 256.0f) + EPS); }
        LDS_BARRIER();
#pragma unroll
        for (int mt = 0; mt < 4; ++mt) { const float rs = ((const LAS float*)(lds + GF_RS))[16 * mt + fr];
#pragma unroll
            for (int nt = 0; nt < 2; ++nt) { u32x2_t wv; wv.x = pg8::cvt_pk_bf16(o[mt][nt][0] * rs, o[mt][nt][1] * rs); wv.y = pg8::cvt_pk_bf16(o[mt][nt][2] * rs, o[mt][nt][3] * rs);
                *(LAS u32x2_t*)(lds + GF_OL + (16 * mt + fr) * 528 + (32 * w + 16 * nt + 4 * fq) * 2) = wv; } }
        LDS_BARRIER();
#pragma unroll
        for (int i = 0; i < 4; ++i) { const int piece = tid + 512 * i, t = piece >> 5, c8 = piece & 31; float ov[8], rv[8];
            pg8::unpack8(*(const LAS v4u*)(lds + GF_OL + t * 528 + c8 * 16), ov); pg8::unpack8(rg[i], rv);
#pragma unroll
            for (int e2 = 0; e2 < 8; ++e2) ov[e2] *= rv[e2];
            *(GAS v4u*)((GAS bf16*)A2_ + (size_t)(b * SEQ + tok0 + t) * DM + h * 256 + c8 * 8) = pg8::pack8(ov); }
    }
    LDS_BARRIER();
}

__global__ void __launch_bounds__(NTHREADS, 2) fwd_kernel(Args a) {
    extern __shared__ __attribute__((aligned(16))) unsigned char lds_raw[];
    LAS unsigned char* lds = (LAS unsigned char*)lds_raw;
    cg::grid_group grid = cg::this_grid();
    const int tid = threadIdx.x, lane = tid & 63, wave = __builtin_amdgcn_readfirstlane(tid >> 6);
    const int G = gridDim.x, bx = blockIdx.x;
    const int gw = bx * NWAVES + wave, NGW = G * NWAVES;
    unsigned char* ws = a.ws;
    const float* x = a.in[0]; const float* g1 = a.in[1]; const float* w_in = a.in[2]; const float* gq = a.in[3]; const float* gk = a.in[4];
    const float* gate_up = a.in[5]; const float* gate_bias = a.in[6]; const float* gla_g = a.in[7]; const float* bgate_bias = a.in[8];
    const float* w_ab = a.in[9]; const float* w_gb = a.in[10]; const float* w_out = a.in[11]; const float* g2 = a.in[12]; const float* w_up = a.in[13]; const float* w_dn = a.in[14];
    bf16* WIN = (bf16*)(ws + WS_WIN); bf16* WA = (bf16*)(ws + WS_WA); bf16* WB = (bf16*)(ws + WS_WB); bf16* WO = (bf16*)(ws + WS_WO);
    bf16* WUP = (bf16*)(ws + WS_WUP); bf16* WDN = (bf16*)(ws + WS_WDN); bf16* XB = (bf16*)(ws + WS_XB); bf16* PROJ = (bf16*)(ws + WS_PROJ);
    bf16* VT = (bf16*)(ws + WS_VT); bf16* A1 = (bf16*)(ws + WS_A1); bf16* A2 = (bf16*)(ws + WS_A2);
    float* R1 = (float*)(ws + WS_R1); float* PA = (float*)(ws + WS_PA); float* SS2 = (float*)(ws + WS_SS2);
    bf16* MIXED = (bf16*)(ws + WS_MIXED); bf16* UB = (bf16*)(ws + WS_U); bf16* GATES = (bf16*)a.out;
    const int lo = a.ph_lo, hi = a.ph_hi; const int repm = a.rep;
    if (tid < 16) ((LAS unsigned*)(lds + LDS_BARST))[tid] = 0u;
    __syncthreads();
#define TS(i) do { if (TPROBE >= 0 && bx == TPBLK && tid == 0) ((LAS unsigned long long*)(lds + LDS_BARST + 16))[0 + ((i) == TPROBE ? 0 : ((i) == TPB ? 1 : 2))] = __builtin_amdgcn_s_memrealtime(); } while (0)
    TS(0);
    if (a.ph_lo < 0) grid.sync();
    if (a.ph_lo == 0) {
        unsigned* bw = (unsigned*)(ws + WS_BAR);
        if (bx == 0) { for (int i = tid; i < 4032; i += NTHREADS) bw[i] = 0u;
            asm volatile("s_waitcnt vmcnt(0)" ::: "memory"); __syncthreads();
            if (tid == 0) { __builtin_amdgcn_fence(__ATOMIC_RELEASE, "agent"); asm volatile("s_waitcnt vmcnt(0)" ::: "memory"); __hip_atomic_store(bw + 4064, 0x600DBA55u, __ATOMIC_RELAXED, __HIP_MEMORY_SCOPE_AGENT); } }
        if (tid == 0) { unsigned sp_ = 0; while (xb_ld(bw + 4064) != 0x600DBA55u) { __builtin_amdgcn_s_sleep(1); if (++sp_ > (1u << 22)) break; }
            __builtin_amdgcn_fence(__ATOMIC_ACQUIRE, "agent"); asm volatile("s_waitcnt vmcnt(0)" ::: "memory");
            (void)xb_add(bw + XB_XCNT(xb_xcc_id()), 1u); }
        __syncthreads();
    }
#define NREP(bit) (REPMASK ? (((repm >> (bit)) & 1) + 1) : 1)
#define IN(k) (lo <= (k) && (k) < hi)
#define LAUNDER(p) asm volatile("" : "+s"(p))
#define XBAR_OBJ(bb) XcdBarrier bb; bb.bar = (unsigned*)(ws + WS_BAR); bb.x = xb_xcc_id(); bb.st = (volatile LAS unsigned*)(lds + LDS_BARST)
#define SYNC(k) do { if (IN(k) && IN((k) + 1)) { asm volatile("s_waitcnt vmcnt(0) lgkmcnt(0)" ::: "memory"); \
        XBAR_OBJ(bb_); for (int rs_ = 0; rs_ < NREP(8); ++rs_) xcd_barrier(bb_); } } while (0)

    TS(39);
    if (IN(0)) for (int rep_ = 0; rep_ < NREP(0); ++rep_) {
#pragma unroll 1
        for (int pass = 0; pass < 2; ++pass) {
          if ((pass == 1) == ((bx & 1) != 0)) {
        LAS float* scr = (LAS float*)(lds + wave * 16640);
        constexpr int I_IN = 16 * 152, I_A = 8 * 16, I_B = 16 * 16, I_O = 16 * 16, I_UP = 16 * 64, I_DN = 64 * 16;
        constexpr int NITEMS = I_IN + I_A + I_B + I_O + I_UP + I_DN;
        for (int it = wave * G + bx; it < NITEMS; it += NGW) {
            int r = it;
            if (r < I_IN) { const int kb = r / 152, nb = r % 152; const int n0 = nb * 64; const int src = n0 < 7680 ? n0 : n0 + 16;
                const float cs = (n0 >= 4608 && n0 < 5120) ? 0.08838834764831845f : 1.0f;
                p0_transpose_item(w_in, DIN, src, g1, 1023, cs, WIN, 1024, n0, kb * 64, scr, lane); continue; } r -= I_IN;
            if (r < I_A) { const int kb = r / 16, nb = r % 16; p0_transpose_item(w_ab, 1024, nb * 64, nullptr, 0, 1.0f, WA, 512, nb * 64, kb * 64, scr, lane); continue; } r -= I_A;
            if (r < I_B) { const int kb = r / 16, nb = r % 16; p0_transpose_item(w_gb, 1024, nb * 64, gla_g, 255, 1.0f, WB, 1024, nb * 64, kb * 64, scr, lane); continue; } r -= I_B;
            if (r < I_O) { const int kb = r / 16, nb = r % 16; p0_transpose_item(w_out, 1024, nb * 64, nullptr, 0, 1.0f, WO, 1024, nb * 64, kb * 64, scr, lane); continue; } r -= I_O;
            if (r < I_UP) { const int kb = r / 64, nb = r % 64; p0_transpose_item(w_up, 4096, nb * 64, g2, 1023, 1.0f, WUP, 1024, nb * 64, kb * 64, scr, lane); continue; } r -= I_UP;
            { const int kb = r / 16, nb = r % 16; p0_transpose_item(w_dn, 1024, nb * 64, nullptr, 0, 1.0f, WDN, 4096, nb * 64, kb * 64, scr, lane); }
        }
        __syncthreads();
          } else {
        LAS float* WAl = (LAS float*)lds;
        for (int idx = tid; idx < 1024 * 16; idx += NTHREADS) { const int k = idx >> 4, r = idx & 15; WAl[k * 20 + r] = w_in[(size_t)k * DIN + 7680 + r] * g1[k]; }
        __syncthreads();
        { const int fr = lane & 15, fq = lane >> 4, half = wave & 1; LAS float* xch = (LAS float*)(lds + 86016) + (wave >> 1) * 320;
          for (int tile = bx * 4 + (wave >> 1); tile < MTOK / 16; tile += G * 4) {
            asm volatile("" ::: "memory");
            const int row = tile * 16 + fr;
            const GAS f32x4* xr = (const GAS f32x4*)(x + (size_t)row * DM) + 2 * fq;
            GAS v4u* xo = (GAS v4u*)(XB + (size_t)row * DM) + fq;
            f32x4 acc = (f32x4){0.f, 0.f, 0.f, 0.f}; float ss = 0.f;
#pragma unroll 1
            for (int jb = 16 * half; jb < 16 * half + 16; jb += 8) {
                f32x4 v[8][2];
#pragma unroll
                for (int u = 0; u < 8; ++u) { v[u][0] = xr[(jb + u) * 8]; v[u][1] = xr[(jb + u) * 8 + 1]; }
#pragma unroll
                for (int u = 0; u < 8; ++u) { const int j = jb + u; const f32x4 a0 = v[u][0], a1 = v[u][1];
                    ss += ((a0[0] * a0[0] + a0[1] * a0[1]) + (a0[2] * a0[2] + a0[3] * a0[3])) + ((a1[0] * a1[0] + a1[1] * a1[1]) + (a1[2] * a1[2] + a1[3] * a1[3]));
                    v4u o; o.x = pk2(a0[0], a0[1]); o.y = pk2(a0[2], a0[3]); o.z = pk2(a1[0], a1[1]); o.w = pk2(a1[2], a1[3]); xo[j * 4] = o;
                    const LAS float* wp = WAl + (32 * j + 8 * fq) * 20 + fr;
                    acc = __builtin_amdgcn_mfma_f32_16x16x4f32(a0[0], wp[0], acc, 0, 0, 0); acc = __builtin_amdgcn_mfma_f32_16x16x4f32(a0[1], wp[20], acc, 0, 0, 0);
                    acc = __builtin_amdgcn_mfma_f32_16x16x4f32(a0[2], wp[40], acc, 0, 0, 0); acc = __builtin_amdgcn_mfma_f32_16x16x4f32(a0[3], wp[60], acc, 0, 0, 0);
                    acc = __builtin_amdgcn_mfma_f32_16x16x4f32(a1[0], wp[80], acc, 0, 0, 0); acc = __builtin_amdgcn_mfma_f32_16x16x4f32(a1[1], wp[100], acc, 0, 0, 0);
                    acc = __builtin_amdgcn_mfma_f32_16x16x4f32(a1[2], wp[120], acc, 0, 0, 0); acc = __builtin_amdgcn_mfma_f32_16x16x4f32(a1[3], wp[140], acc, 0, 0, 0); }
            }
            if (half == 1) { xch[lane] = acc[0]; xch[64 + lane] = acc[1]; xch[128 + lane] = acc[2]; xch[192 + lane] = acc[3]; xch[256 + lane] = ss; }
            __syncthreads();
            if (half == 0) { acc[0] += xch[lane]; acc[1] += xch[64 + lane]; acc[2] += xch[128 + lane]; acc[3] += xch[192 + lane]; ss += xch[256 + lane];
                ss += __shfl_xor(ss, 16); ss += __shfl_xor(ss, 32);
                const float r1 = 1.0f / sqrtf(ss * (1.0f / 1024.0f) + EPS);
#pragma unroll
                for (int j = 0; j < 4; ++j) { const float rr = __shfl(r1, 4 * fq + j); PA[(size_t)(tile * 16 + 4 * fq + j) * 16 + fr] = acc[j] * rr; }
                if (fq == 0) R1[row] = r1; }
            __syncthreads();
          } }
        __syncthreads();
          }
        }
    }
    TS(41);
    SYNC(0); TS(1);
    if (bx == 0 && tid == 0 && a.ph_lo == 0) __hip_atomic_store((unsigned*)(ws + WS_BAR) + 4064, 0u, __ATOMIC_RELAXED, __HIP_MEMORY_SCOPE_AGENT);

    for (int bq = 0; bq < 2; ++bq) {
        int b = bq; LAUNDER(b);
        const int p1 = 1 + 3 * b;
        if (IN(p1)) for (int rep_ = 0; rep_ < NREP(1); ++rep_) {
            pg8::Gemm g{XB + (size_t)b * SEQ * DM, WIN, SEQ, N1, DM}; pg8::StaticOrder S; S.init(SEQ, N1, G, bx);
            pg8::EpiProj E{PROJ, VT, GATES + (size_t)b * SEQ * 2048, R1 + b * SEQ, bgate_bias};
            pg8::gemm_phase<pg8::EpiProj, pg8::StaticOrder, true, true>(lds, g, S, E);
        }
        SYNC(p1); TS(p1 + 1);
        int tid_ = threadIdx.x; asm volatile("" : "+v"(tid_)); const int lane_ = tid_ & 63; const int wave_ = __builtin_amdgcn_readfirstlane(tid_ >> 6); int bx_ = bx; LAUNDER(bx_);
        const float* gate_up_ = gate_up; const float* gate_bias_ = gate_bias; const float* PA_ = PA; const bf16* PROJ_ = PROJ; const bf16* VT_ = VT; bf16* A1_ = A1; bf16* A2_ = A2; const float* gq_ = gq; const float* gk_ = gk;
        float* SBUF_ = (float*)(ws + WS_XB); float* DBUF_ = (float*)(ws + WS_MISC + 2 * MiB); float* ML_ = (float*)(ws + WS_MISC);
        bf16* SB16_ = (b == 0) ? (A2 + (size_t)SEQ * DM) : (XB + (size_t)SEQ * DM);
        LAUNDER(SB16_);
        bf16* QGS_ = (b == 0) ? (A1 + (size_t)SEQ * 512) : (bf16*)(ws + 247 * MiB);
        LAUNDER(QGS_);
        LAUNDER(gate_up_); LAUNDER(gate_bias_); LAUNDER(PA_); LAUNDER(PROJ_); LAUNDER(VT_); LAUNDER(A1_); LAUNDER(A2_); LAUNDER(gq_); LAUNDER(gk_); LAUNDER(SBUF_); LAUNDER(DBUF_); LAUNDER(ML_);
        if (IN(p1 + 1)) {
            if (bx_ < 128) { for (int rep_ = 0; rep_ < NREP(2); ++rep_) { gla_local(lds, b, bx_, PROJ_, VT_, PA_, gate_up_, gate_bias_, SBUF_, DBUF_, A2_, QGS_, tid_, wave_, lane_); }
                if (b == 0) TS(20);
                asm volatile("s_waitcnt vmcnt(0) lgkmcnt(0)" ::: "memory"); __syncthreads();
                if (tid_ == 0) { unsigned* cw = (unsigned*)(ws + WS_BAR) + 3520 + 64 * b;
                    __builtin_amdgcn_fence(__ATOMIC_RELEASE, "agent"); asm volatile("s_waitcnt vmcnt(0)" ::: "memory");
                    (void)xb_add(cw, 1u); }
            }
            if (b == 0) TS(21);
            {
                float gkr[8], gqr[16];
#pragma unroll
                for (int i = 0; i < 8; ++i) gkr[i] = gk_[(tid_ & 7) * 8 + i];
#pragma unroll
                for (int i = 0; i < 8; ++i) { gqr[i] = gq_[8 * (lane_ >> 4) + i]; gqr[8 + i] = gq_[32 + 8 * (lane_ >> 4) + i]; }
                bf16* PROJW = (bf16*)PROJ_;
                asm volatile("" :: "v"(gkr[7]), "v"(gqr[15]));
                const int first = bx_, cnt = bx_ < 128 ? 1 : 5;
                const int nrep_ = NREP(7);
                for (int rep_ = 0; rep_ < nrep_; ++rep_) {
                    AttnKQ R; v4u Vr[6]; attn_load_kq(R, PROJ_, first, tid_, wave_, lane_); attn_load_v(Vr, PROJ_, first, tid_);
                    for (int k = 0; k < cnt; ++k) { const int it = first + 128 * k;
                        LDS_BARRIER();
                        attn_stage_k(R, lds, gkr, tid_); attn_stage_v(Vr, lds, tid_);
                        const v4u q0 = R.q[0], q1 = R.q[1], q2 = R.q[2], q3 = R.q[3];
                        LDS_BARRIER();
                        if (k + 1 < cnt) { attn_load_kq(R, PROJ_, it + 128, tid_, wave_, lane_); attn_load_v(Vr, PROJ_, it + 128, tid_); }
                        { f32x4 sc[9]; float mx, den; attn_scores(sc, mx, den, q0, q1, lds, gqr, 0, it_first_block(it), wave_, lane_);
                          attn_pv(sc, mx, den, lds, PROJW, ML_, it, 0, wave_, lane_, rep_ == nrep_ - 1); }
                        { f32x4 sc[9]; float mx, den; attn_scores(sc, mx, den, q2, q3, lds, gqr, 8, false, wave_, lane_);
                          attn_pv(sc, mx, den, lds, PROJW, ML_, it, 8, wave_, lane_, rep_ == nrep_ - 1); }
                    }
                }
            }
        }
        if (IN(p1 + 1)) {
            if (tid_ == 0) { unsigned* cw = (unsigned*)(ws + WS_BAR) + 3520 + 64 * b; unsigned sp_ = 0;
                while (xb_ld(cw) < 128u) { __builtin_amdgcn_s_sleep(1); if (++sp_ > (1u << 22)) break; }
                __builtin_amdgcn_fence(__ATOMIC_ACQUIRE, "agent"); asm volatile("s_waitcnt vmcnt(0)" ::: "memory"); }
            __syncthreads();
            { const int gid = bx_ * NTHREADS + tid_; const int h = gid >> 15, r = (gid >> 9) & 63, tl = gid & 511; const int kdr = 16 * (r >> 3) + 4 * ((tl & 63) >> 4) + (r & 3);
              float loc[32], dec[32];
#pragma unroll
              for (int sg = 0; sg < 32; ++sg) { loc[sg] = ((const GAS float*)SBUF_)[((size_t)(h * 32 + sg) * 64 + r) * 512 + tl]; dec[sg] = ((const GAS float*)DBUF_)[(h * 32 + sg) * 128 + kdr]; }
              float cur = 0.f;
#pragma unroll
              for (int sg = 0; sg < 32; ++sg) { ((GAS unsigned short*)SB16_)[((size_t)(h * 32 + sg) * 64 + r) * 512 + tl] = (unsigned short)f2bf(cur); cur = dec[sg] * cur + loc[sg]; } }
        }
        SYNC(p1 + 1); TS(p1 + 2);
        if (IN(p1 + 2)) {
            for (int rep_ = 0; rep_ < NREP(3); ++rep_) { gla_fix(lds, b, bx_, PROJ_, SB16_, A2_, QGS_, tid_, wave_, lane_); }
            {
            for (int rep_ = 0; rep_ < NREP(9); ++rep_) {
                for (int idx = bx_ * NTHREADS + tid_; idx < SEQ * 64; idx += G * NTHREADS) {
                    const int t = idx >> 6, slot = (idx >> 3) & 7, c8 = idx & 7;
                    float m[3], dn[3];
#pragma unroll
                    for (int g = 0; g < 3; ++g) { const GAS float* mp = (const GAS float*)ML_ + (size_t)t * 48 + (g * 8 + slot) * 2; m[g] = mp[0]; dn[g] = mp[1]; }
                    const float M = fmaxf(m[0], fmaxf(m[1], m[2])); float D = 0.f; float acc[8];
#pragma unroll
                    for (int i = 0; i < 8; ++i) acc[i] = 0.f;
#pragma unroll
                    for (int g = 0; g < 3; ++g) { const float wg = __builtin_amdgcn_exp2f(m[g] - M); D += wg * dn[g]; float f[8];
                        pg8::unpack8(*(const GAS v4u*)((const GAS bf16*)PROJ_ + (size_t)t * PLD + (g * 8 + slot) * 64 + c8 * 8), f);
#pragma unroll
                        for (int i = 0; i < 8; ++i) acc[i] += wg * f[i]; }
                    const float inv = 1.0f / D;
#pragma unroll
                    for (int i = 0; i < 8; ++i) acc[i] *= inv;
                    *(GAS v4u*)((GAS bf16*)A1_ + (size_t)(b * SEQ + t) * 512 + slot * 64 + c8 * 8) = pg8::pack8(acc);
                }
            }
            }
        }
        SYNC(p1 + 2); TS(p1 + 3);
    }
    if (IN(7)) for (int rep_ = 0; rep_ < NREP(4); ++rep_) {
#pragma unroll 1
        for (int pass = 0; pass < 2; ++pass) {
            const bool useB = (((bx & 1) != 0) != (pass == 1));
            pg8::Gemm g{useB ? A2 : A1, useB ? WB : WA, MTOK, DM, useB ? 1024 : 512}; pg8::StaticOrder S; S.init(MTOK, DM, G, bx); pg8::EpiBranch E{MIXED, GATES, useB ? 1024 : 0, pass};
            pg8::gemm_phase<pg8::EpiBranch, pg8::StaticOrder, true, true>(lds, g, S, E);
            __syncthreads();
        }
    }
    SYNC(7); TS(8);
    if (IN(8)) for (int rep_ = 0; rep_ < NREP(5); ++rep_) { pg8::Gemm g{MIXED, WO, MTOK, DM, 1024}; pg8::StaticOrder S; S.init(MTOK, DM, G, bx); pg8::EpiOut1 E{x, a.out, XB, SS2};
        pg8::gemm_phase<pg8::EpiOut1, pg8::StaticOrder, true, true>(lds, g, S, E); }
    SYNC(8); TS(9);
    if (IN(9)) for (int rep_ = 0; rep_ < NREP(6); ++rep_) { pg8::Gemm g{XB, WUP, MTOK, FF, 1024}; pg8::StaticOrder S; S.init(MTOK, FF, G, bx); pg8::EpiUp E{UB, SS2};
        pg8::gemm_phase<pg8::EpiUp, pg8::StaticOrder, true, true>(lds, g, S, E); }
    SYNC(9); TS(10);
    if (IN(10)) for (int rep_ = 0; rep_ < NREP(10); ++rep_) { pg8::Gemm g{UB, WDN, MTOK, DM, FF}; pg8::StaticOrder S; S.init(MTOK, DM, G, bx); pg8::EpiDown E{a.out, rep_ == NREP(10) - 1};
        pg8::gemm_phase<pg8::EpiDown, pg8::StaticOrder, true, true>(lds, g, S, E); }
    TS(11);
    if (TPROBE >= 0 && bx == TPBLK && tid == 0) { const LAS unsigned long long* tsp = (const LAS unsigned long long*)(lds + LDS_BARST + 16); const unsigned long long dt = tsp[1] - tsp[0];
        const unsigned long long tend = __builtin_amdgcn_s_memrealtime() + 4ull * dt; while (__builtin_amdgcn_s_memrealtime() < tend) __builtin_amdgcn_s_sleep(8); }
#undef IN
#undef SYNC
}

extern "C" void kernel_launch(void* const* d_in, const int* in_sizes, int n_in, void* d_out, int out_size, void* d_ws, size_t ws_size, hipStream_t stream) {
    static int grid = 0;
    if (grid == 0) {
        if (n_in != 15 || out_size != MTOK * DM || ws_size < WS_END) { fprintf(stderr, "kernel_launch: unexpected shapes (n_in %d, out %d, ws %zu)\n", n_in, out_size, ws_size); grid = -1; return; }
        int dev = 0, cus = 0, per_cu = 0;
        hipGetDevice(&dev); hipDeviceGetAttribute(&cus, hipDeviceAttributeMultiprocessorCount, dev);
        if (hipFuncSetAttribute((const void*)fwd_kernel, hipFuncAttributeMaxDynamicSharedMemorySize, LDS_BYTES) != hipSuccess) { fprintf(stderr, "kernel_launch: hipFuncSetAttribute failed\n"); grid = -1; return; }
        if (hipOccupancyMaxActiveBlocksPerMultiprocessor(&per_cu, (const void*)fwd_kernel, NTHREADS, LDS_BYTES) != hipSuccess || per_cu < 1) per_cu = 1;
        (void)hipGetLastError();
        grid = cus * per_cu;
        fprintf(stderr, "kernel_launch: grid %d (cus %d x %d)\n", grid, cus, per_cu);
    }
    if (grid < 0) return;
    Args a{};
    for (int i = 0; i < 15; ++i) a.in[i] = (const float*)d_in[i];
    a.out = (float*)d_out; a.ws = (unsigned char*)d_ws; a.ph_lo = 0; a.ph_hi = 11; a.rep = REPMASK; a.pad = 0;
    void* args[] = {&a};
    hipError_t e = hipLaunchCooperativeKernel((const void*)fwd_kernel, dim3(grid), dim3(NTHREADS), args, LDS_BYTES, stream);
    if (e != hipSuccess) fprintf(stderr, "cooperative launch failed: %s (grid %d)\n", hipGetErrorString(e), grid);
}
```

```cpp
#include <hip/hip_runtime.h>
#include <hip/hip_cooperative_groups.h>
#include <cstdio>
#include <cstdint>
#include <cmath>
namespace cg = cooperative_groups;
namespace pg8 {
#define PG8_LAS __attribute__((address_space(3)))
typedef unsigned short bf16_t;
typedef short bf16x8 __attribute__((ext_vector_type(8)));
typedef float f32x4 __attribute__((ext_vector_type(4)));
typedef unsigned u32x4 __attribute__((ext_vector_type(4)));
constexpr int BM = 256, BK = 64, HALF = 128, HTB = HALF * BK * 2  , STAGE_BYTES = 8 * HTB, NXCD = 8, WGM = 8;

__host__ __device__ __forceinline__ int lds_byte(int r, int c) { const int st = (r >> 4) * 2 + (c >> 5), rr = r & 15, cc = c & 31, ob = rr * 64 + cc * 2; return st * 1024 + (ob ^ (((ob >> 9) & 1) << 5)); }
__host__ __device__ __forceinline__ void stage_rc(int b, int& R, int& C) { const int st = b / 1024, sb = b % 1024, swz = sb ^ (((sb >> 9) & 1) << 5); R = (st >> 1) * 16 + swz / 64; C = (st & 1) * 32 + (swz % 64) / 2; }
__host__ __device__ __forceinline__ int perm32(int rho) { const int n = rho >> 4, i = rho & 15; return 8 * (i >> 2) + 4 * n + (i & 3); }

struct Unit { int pm, pn; };
struct Gemm { const bf16_t* A; const bf16_t* Bt; int M, N, K; };

struct StaticOrder {
    int nM, nN, nwg, G, c;
    __host__ __device__ void init(int M, int N, int G_, int c_) { nM = M / BM; nN = N / BM; nwg = nM * nN; G = G_; c = c_; }
    __host__ __device__ bool next(int i, Unit& u) const {
        const long L = (long)i * G + c; if (L >= nwg) return false;
        int wgid = (int)L; { const int q = nwg / NXCD, r = nwg % NXCD, xcd = wgid % NXCD, off = wgid / NXCD; wgid = (xcd < r ? xcd * (q + 1) : r * (q + 1) + (xcd - r) * q) + off; }
        const int nig = WGM * nN, gid = wgid / nig, fm = gid * WGM, gsz = (nM - fm) < WGM ? (nM - fm) : WGM;
        u.pm = fm + ((wgid % nig) % gsz); u.pn = (wgid % nig) / gsz; return true;
    }
    __device__ __forceinline__ void a_ready(const Unit&) const {}
    __device__ __forceinline__ void done(const Unit&) const {}
};
typedef float f32x2 __attribute__((ext_vector_type(2)));
typedef __bf16 bf16x2_cv __attribute__((ext_vector_type(2)));
__device__ __forceinline__ unsigned cvt_pk_bf16(float lo, float hi) { const f32x2 v = {lo, hi}; const bf16x2_cv b = __builtin_convertvector(v, bf16x2_cv); return __builtin_bit_cast(unsigned, b); }
__device__ __forceinline__ float bflo(unsigned w) { return __uint_as_float(w << 16); }
__device__ __forceinline__ float bfhi(unsigned w) { return __uint_as_float(w & 0xffff0000u); }
__device__ __forceinline__ void unpack8(const u32x4 w, float (&f)[8]) { f[0] = bflo(w.x); f[1] = bfhi(w.x); f[2] = bflo(w.y); f[3] = bfhi(w.y); f[4] = bflo(w.z); f[5] = bfhi(w.z); f[6] = bflo(w.w); f[7] = bfhi(w.w); }
__device__ __forceinline__ u32x4 pack8(const float (&v)[8]) { u32x4 w; w.x = cvt_pk_bf16(v[0], v[1]); w.y = cvt_pk_bf16(v[2], v[3]); w.z = cvt_pk_bf16(v[4], v[5]); w.w = cvt_pk_bf16(v[6], v[7]); return w; }
__device__ __forceinline__ float fsigmoid(float x) { return __builtin_amdgcn_rcpf(1.0f + __builtin_amdgcn_exp2f(x * -1.4426950408889634f)); }

struct EpiProj {
    static constexpr bool PERM = true, AFTER_DRAIN = false;
    bf16_t* proj; bf16_t* vt; bf16_t* gates; const float* r1; const float* gbias;
    __device__ __forceinline__ void operator()(const f32x4 (&acc)[2][2][4][2], const Unit& u, int wr, int wc, int fr_in, int fq_in) const {
        int fr = fr_in, fq = fq_in; asm volatile("" : "+v"(fr), "+v"(fq));
        const int ct = u.pn; const int row0 = u.pm * BM + wr * 64 + fr; const int cl = wc * 32 + 8 * fq;
        float rsv[2][4];
#pragma unroll
        for (int ai = 0; ai < 2; ++ai)
#pragma unroll
            for (int m = 0; m < 4; ++m) rsv[ai][m] = r1[row0 + ai * HALF + m * 16];
        f32x4 gb[2][2];
        if (ct >= 30) {
#pragma unroll
            for (int bj = 0; bj < 2; ++bj) { const int gc = (ct - 30) * 256 + cl + bj * HALF; gb[bj][0] = *(const f32x4*)(gbias + gc); gb[bj][1] = *(const f32x4*)(gbias + gc + 4); } }
        else { gb[0][0] = gb[0][1] = gb[1][0] = gb[1][1] = (f32x4){0.f, 0.f, 0.f, 0.f}; }
#pragma unroll
        for (int ai = 0; ai < 2; ++ai)
#pragma unroll
            for (int m = 0; m < 4; ++m) {
                const int row = row0 + ai * HALF + m * 16; const float rs = rsv[ai][m];
#pragma unroll
                for (int bj = 0; bj < 2; ++bj) {
                    const f32x4 v0 = acc[ai][bj][m][0] * rs, v1 = acc[ai][bj][m][1] * rs;
                    float v[8] = {v0[0], v0[1], v0[2], v0[3], v1[0], v1[1], v1[2], v1[3]};
                    const int c = cl + bj * HALF;
                    if (ct < 22) { *(u32x4*)(proj + (size_t)row * 6656 + ct * 256 + c) = pack8(v); }
                    else if (ct < 26) { const u32x4 w = pack8(v); bf16_t* p = vt + (size_t)((ct - 22) * 256 + c) * 8192 + row;
                        p[0] = (bf16_t)(w.x & 0xffffu); p[8192] = (bf16_t)(w.x >> 16); p[2 * 8192] = (bf16_t)(w.y & 0xffffu); p[3 * 8192] = (bf16_t)(w.y >> 16);
                        p[4 * 8192] = (bf16_t)(w.z & 0xffffu); p[5 * 8192] = (bf16_t)(w.z >> 16); p[6 * 8192] = (bf16_t)(w.w & 0xffffu); p[7 * 8192] = (bf16_t)(w.w >> 16); }
                    else if (ct < 30) {
#pragma unroll
                        for (int i = 0; i < 8; ++i) v[i] = v[i] * fsigmoid(v[i]);
                        *(u32x4*)(proj + (size_t)row * 6656 + (ct - 4) * 256 + c) = pack8(v); }
                    else { const int gc = (ct - 30) * 256 + c; const float bb[8] = {gb[bj][0][0], gb[bj][0][1], gb[bj][0][2], gb[bj][0][3], gb[bj][1][0], gb[bj][1][1], gb[bj][1][2], gb[bj][1][3]};
#pragma unroll
                        for (int i = 0; i < 8; ++i) v[i] = fsigmoid(v[i] + bb[i]);
                        *(u32x4*)(gates + (size_t)row * 2048 + gc) = pack8(v); }
                }
            }
    }
};
struct EpiBranch {
    static constexpr bool PERM = true, AFTER_DRAIN = false;
    bf16_t* mixed; const bf16_t* gates; int goff; int add;
    __device__ __forceinline__ void operator()(const f32x4 (&acc)[2][2][4][2], const Unit& u, int wr, int wc, int fr_in, int fq_in) const {
        int fr = fr_in, fq = fq_in; asm volatile("" : "+v"(fr), "+v"(fq));
        const int row0 = u.pm * BM + wr * 64 + fr; const int cl = u.pn * BM + wc * 32 + 8 * fq;
#pragma unroll
        for (int ai = 0; ai < 2; ++ai) {
            u32x4 gw[4][2], tw[4][2];
#pragma unroll
            for (int m = 0; m < 4; ++m)
#pragma unroll
                for (int bj = 0; bj < 2; ++bj) { const int row = row0 + ai * HALF + m * 16, c = cl + bj * HALF;
                    gw[m][bj] = *(const u32x4*)(gates + (size_t)row * 2048 + goff + c);
                    tw[m][bj] = add ? *(const u32x4*)(mixed + (size_t)row * 1024 + c) : (u32x4){0u, 0u, 0u, 0u}; }
#pragma unroll
            for (int m = 0; m < 4; ++m)
#pragma unroll
                for (int bj = 0; bj < 2; ++bj) { const int row = row0 + ai * HALF + m * 16, c = cl + bj * HALF; float g[8], t[8], v[8];
                    unpack8(gw[m][bj], g); unpack8(tw[m][bj], t);
                    const f32x4 v0 = acc[ai][bj][m][0], v1 = acc[ai][bj][m][1];
                    v[0] = v0[0] * g[0] + t[0]; v[1] = v0[1] * g[1] + t[1]; v[2] = v0[2] * g[2] + t[2]; v[3] = v0[3] * g[3] + t[3];
                    v[4] = v1[0] * g[4] + t[4]; v[5] = v1[1] * g[5] + t[5]; v[6] = v1[2] * g[6] + t[6]; v[7] = v1[3] * g[7] + t[7];
                    *(u32x4*)(mixed + (size_t)row * 1024 + c) = pack8(v); }
        }
    }
};
struct EpiOut1 {
    static constexpr bool PERM = true, AFTER_DRAIN = false;
    const float* x; float* out; bf16_t* x1b; float* ss2;
    __device__ __forceinline__ void operator()(const f32x4 (&acc)[2][2][4][2], const Unit& u, int wr, int wc, int fr_in, int fq_in) const {
        int fr = fr_in, fq = fq_in; asm volatile("" : "+v"(fr), "+v"(fq));
        const int row0 = u.pm * BM + wr * 64 + fr; const int cl = u.pn * BM + wc * 32 + 8 * fq;
#pragma unroll
        for (int ai = 0; ai < 2; ++ai) {
            f32x4 xv[4][2][2];
#pragma unroll
            for (int m = 0; m < 4; ++m)
#pragma unroll
                for (int bj = 0; bj < 2; ++bj) { const size_t off = (size_t)(row0 + ai * HALF + m * 16) * 1024 + cl + bj * HALF; xv[m][bj][0] = *(const f32x4*)(x + off); xv[m][bj][1] = *(const f32x4*)(x + off + 4); }
#pragma unroll
            for (int m = 0; m < 4; ++m) {
                const int row = row0 + ai * HALF + m * 16; float ssq = 0.f;
#pragma unroll
                for (int bj = 0; bj < 2; ++bj) {
                    const size_t off = (size_t)row * 1024 + cl + bj * HALF;
                    const f32x4 o0 = xv[m][bj][0] + acc[ai][bj][m][0], o1 = xv[m][bj][1] + acc[ai][bj][m][1];
                    *(f32x4*)(out + off) = o0; *(f32x4*)(out + off + 4) = o1;
                    const float v[8] = {o0[0], o0[1], o0[2], o0[3], o1[0], o1[1], o1[2], o1[3]};
                    *(u32x4*)(x1b + off) = pack8(v);
#pragma unroll
                    for (int i = 0; i < 8; ++i) ssq += v[i] * v[i];
                }
                ssq += __shfl_xor(ssq, 16); ssq += __shfl_xor(ssq, 32);
                if (fq == 0) ss2[(size_t)row * 16 + u.pn * 4 + wc] = ssq;
            }
        }
    }
};
struct EpiUp {
    static constexpr bool PERM = true, AFTER_DRAIN = false;
    bf16_t* U; const float* ss2;
    __device__ __forceinline__ void operator()(const f32x4 (&acc)[2][2][4][2], const Unit& u, int wr, int wc, int fr_in, int fq_in) const {
        int fr = fr_in, fq = fq_in; asm volatile("" : "+v"(fr), "+v"(fq));
        const int row0 = u.pm * BM + wr * 64 + fr; const int cl = u.pn * BM + wc * 32 + 8 * fq;
        float rsv[2][4];
#pragma unroll
        for (int ai = 0; ai < 2; ++ai) { f32x4 sv[4][4];
#pragma unroll
            for (int m = 0; m < 4; ++m) { const f32x4* sp = (const f32x4*)(ss2 + (size_t)(row0 + ai * HALF + m * 16) * 16); sv[m][0] = sp[0]; sv[m][1] = sp[1]; sv[m][2] = sp[2]; sv[m][3] = sp[3]; }
#pragma unroll
            for (int m = 0; m < 4; ++m) { const f32x4 t = (sv[m][0] + sv[m][1]) + (sv[m][2] + sv[m][3]); const float sum = (t[0] + t[1]) + (t[2] + t[3]);
                rsv[ai][m] = __builtin_amdgcn_rsqf(sum * (1.0f / 1024.0f) + 1e-6f); } }
#pragma unroll
        for (int ai = 0; ai < 2; ++ai)
#pragma unroll
            for (int m = 0; m < 4; ++m) {
                const int row = row0 + ai * HALF + m * 16; const float rs = rsv[ai][m];
#pragma unroll
                for (int bj = 0; bj < 2; ++bj) {
                    const f32x4 v0 = acc[ai][bj][m][0] * rs, v1 = acc[ai][bj][m][1] * rs;
                    float v[8] = {v0[0], v0[1], v0[2], v0[3], v1[0], v1[1], v1[2], v1[3]};
#pragma unroll
                    for (int i = 0; i < 8; ++i) { const float r = fmaxf(v[i], 0.f); v[i] = r * r; }
                    *(u32x4*)(U + (size_t)row * 4096 + cl + bj * HALF) = pack8(v);
                }
            }
    }
};
struct EpiDown {
    static constexpr bool PERM = true, AFTER_DRAIN = false;
    float* out; int store;
    __device__ __forceinline__ void operator()(const f32x4 (&acc)[2][2][4][2], const Unit& u, int wr, int wc, int fr_in, int fq_in) const {
        int fr = fr_in, fq = fq_in; asm volatile("" : "+v"(fr), "+v"(fq));
        const int row0 = u.pm * BM + wr * 64 + fr; const int cl = u.pn * BM + wc * 32 + 8 * fq;
#pragma unroll
        for (int ai = 0; ai < 2; ++ai) {
            f32x4 xv[4][2][2];
#pragma unroll
            for (int m = 0; m < 4; ++m)
#pragma unroll
                for (int bj = 0; bj < 2; ++bj) { const size_t off = (size_t)(row0 + ai * HALF + m * 16) * 1024 + cl + bj * HALF; xv[m][bj][0] = *(const f32x4*)(out + off); xv[m][bj][1] = *(const f32x4*)(out + off + 4); }
#pragma unroll
            for (int m = 0; m < 4; ++m)
#pragma unroll
                for (int bj = 0; bj < 2; ++bj) {
                    const size_t off = (size_t)(row0 + ai * HALF + m * 16) * 1024 + cl + bj * HALF;
                    const f32x4 o0 = xv[m][bj][0] + acc[ai][bj][m][0], o1 = xv[m][bj][1] + acc[ai][bj][m][1];
                    if (store) { *(f32x4*)(out + off) = o0; *(f32x4*)(out + off + 4) = o1; }
                }
        }
    }
};
template <class Epi, class Sched, bool ALIGN_EPI = false, bool SP2 = false>
__device__ __forceinline__ void gemm_phase(PG8_LAS unsigned char* lds, const Gemm g, const Sched& S, const Epi& E) {
    int tid_l = threadIdx.x; asm volatile("" : "+v"(tid_l));
    const int tid = tid_l, wid = __builtin_amdgcn_readfirstlane(tid >> 6), lane = tid & 63, wr = wid >> 2, wc = wid & 3, fr = lane & 15, fq = lane >> 4;
    const int K = g.K, nt = K / BK;
    unsigned voffA[2], voffB[2];
#pragma unroll
    for (int i = 0; i < 2; ++i) { int R, C; stage_rc(tid * 16 + i * 8192, R, C); const int Rb = Epi::PERM ? ((R & ~31) + perm32(R & 31)) : R;
        voffA[i] = (unsigned)(R * K + C) * 2u; voffB[i] = (unsigned)(Rb * K + C) * 2u; }
    const size_t kstep = (size_t)(BK * 2);
    const size_t hstep = (size_t)HALF * K * 2;
    const size_t tstep = 2 * hstep;
    const unsigned ldsw = (unsigned)wid * 1024u;
    const int aoff = lds_byte(wr * 64 + fr, fq * 8), boff = lds_byte(wc * 32 + fr, fq * 8);
#define PG8_SA(b, h) (((b) * 2 + (h)) * HTB)
#define PG8_SB(b, h) ((4 + (b) * 2 + (h)) * HTB)
#define PG8_STAGE(bufoff, gbase, voff) do { _Pragma("unroll") for (int _i = 0; _i < 2; ++_i) \
        __builtin_amdgcn_global_load_lds((const unsigned*)((const char*)(gbase) + (voff)[_i]), (PG8_LAS unsigned*)(lds + (bufoff) + ldsw + _i * 8192), 16, 0, 0); } while (0)
#define PG8_LDA(dst, b, h) do { _Pragma("unroll") for (int m = 0; m < 4; ++m) _Pragma("unroll") for (int k = 0; k < 2; ++k) dst[m][k] = *(const PG8_LAS bf16x8*)(lds + PG8_SA(b, h) + aoff + m * 2048 + k * 1024); } while (0)
#define PG8_LDB(dst, b, h) do { _Pragma("unroll") for (int n = 0; n < 2; ++n) _Pragma("unroll") for (int k = 0; k < 2; ++k) dst[n][k] = *(const PG8_LAS bf16x8*)(lds + PG8_SB(b, h) + boff + n * 2048 + k * 1024); } while (0)
#define PG8_MMA(ai, bj, At, Bt) do { __builtin_amdgcn_s_setprio(1); _Pragma("unroll") for (int m = 0; m < 4; ++m) _Pragma("unroll") for (int n = 0; n < 2; ++n) _Pragma("unroll") for (int k = 0; k < 2; ++k) \
        acc[ai][bj][m][n] = __builtin_amdgcn_mfma_f32_16x16x32_bf16(Bt[n][k], At[m][k], acc[ai][bj][m][n], 0, 0, 0); __builtin_amdgcn_s_setprio(0); } while (0)
#define PG8_WAIT_V(n) asm volatile("s_waitcnt vmcnt(" #n ")" ::: "memory")
#define PG8_WAIT_L(n) asm volatile("s_waitcnt lgkmcnt(" #n ")" ::: "memory")
#define PG8_BAR __builtin_amdgcn_s_barrier()
#define PG8_SCHED __builtin_amdgcn_sched_barrier(0)
    Unit cur, nxt; int ui = 0;
    if (!S.next(0, cur)) return;
    f32x4 acc[2][2][4][2];
#pragma unroll
    for (int a = 0; a < 2; ++a)
#pragma unroll
        for (int b = 0; b < 2; ++b)
#pragma unroll
            for (int m = 0; m < 4; ++m)
#pragma unroll
                for (int n = 0; n < 2; ++n) acc[a][b][m][n] = (f32x4){0.f, 0.f, 0.f, 0.f};
    bf16x8 At[4][2], B0[2][2], B1[2][2];
    const char* cA = (const char*)g.A + (size_t)cur.pm * tstep; const char* cB = (const char*)g.Bt + (size_t)cur.pn * tstep;
    S.a_ready(cur);
    if constexpr (SP2) {
        PG8_STAGE(PG8_SB(0, 0), cB, voffB); PG8_STAGE(PG8_SB(0, 1), cB + hstep, voffB); PG8_STAGE(PG8_SA(0, 0), cA, voffA); PG8_STAGE(PG8_SA(0, 1), cA + hstep, voffA);
        if (wr == 1) PG8_BAR;
        PG8_WAIT_V(2); PG8_BAR;
        PG8_STAGE(PG8_SB(1, 0), cB + kstep, voffB); PG8_STAGE(PG8_SA(1, 0), cA + kstep, voffA); PG8_STAGE(PG8_SB(1, 1), cB + hstep + kstep, voffB);
        PG8_WAIT_V(6); PG8_BAR;
    } else {
        PG8_STAGE(PG8_SB(0, 0), cB, voffB); PG8_STAGE(PG8_SA(0, 0), cA, voffA); PG8_STAGE(PG8_SB(0, 1), cB + hstep, voffB); PG8_STAGE(PG8_SA(0, 1), cA + hstep, voffA);
        if (wr == 1) PG8_BAR;
        PG8_WAIT_V(4); PG8_BAR;
        PG8_STAGE(PG8_SB(1, 0), cB + kstep, voffB); PG8_STAGE(PG8_SA(1, 0), cA + kstep, voffA); PG8_STAGE(PG8_SB(1, 1), cB + hstep + kstep, voffB);
        PG8_WAIT_V(6); PG8_BAR;
    }
    for (;;) {
        const bool has_next = S.next(ui + 1, nxt);
        const char* nA = has_next ? (const char*)g.A + (size_t)nxt.pm * tstep : cA; const char* nB = has_next ? (const char*)g.Bt + (size_t)nxt.pn * tstep : cB;
        for (int t = 0; t < nt; t += 2) {
            const bool last = (t == nt - 2);
            const char* a1 = cA + (size_t)(t + 1) * kstep;
            const char* a2 = last ? nA : cA + (size_t)(t + 2) * kstep; const char* b2 = last ? nB : cB + (size_t)(t + 2) * kstep;
            const char* a3 = a2 + kstep; const char* b3 = b2 + kstep;
            if (last && has_next) S.a_ready(nxt);
            if constexpr (SP2) {
            PG8_LDB(B0, 0, 0); PG8_LDB(B1, 0, 1); PG8_SCHED; PG8_LDA(At, 0, 0); PG8_STAGE(PG8_SA(1, 1), a1 + hstep, voffA);
            PG8_WAIT_V(8); PG8_WAIT_L(0); PG8_BAR; PG8_MMA(0, 0, At, B0); PG8_MMA(0, 1, At, B1); PG8_BAR; PG8_SCHED;
            PG8_LDA(At, 0, 1); PG8_STAGE(PG8_SB(0, 0), b2, voffB); PG8_STAGE(PG8_SB(0, 1), b2 + hstep, voffB); PG8_STAGE(PG8_SA(0, 0), a2, voffA);
            PG8_WAIT_V(8); PG8_WAIT_L(0); PG8_BAR; PG8_MMA(1, 0, At, B0); PG8_MMA(1, 1, At, B1); PG8_BAR; PG8_SCHED;
            PG8_LDB(B0, 1, 0); PG8_LDB(B1, 1, 1); PG8_SCHED; PG8_LDA(At, 1, 0); PG8_STAGE(PG8_SA(0, 1), a2 + hstep, voffA);
            PG8_WAIT_V(8); PG8_WAIT_L(0); PG8_BAR; PG8_MMA(0, 0, At, B0); PG8_MMA(0, 1, At, B1); PG8_BAR; PG8_SCHED;
            PG8_LDA(At, 1, 1); PG8_STAGE(PG8_SB(1, 0), b3, voffB); PG8_STAGE(PG8_SB(1, 1), b3 + hstep, voffB); PG8_STAGE(PG8_SA(1, 0), a3, voffA);
            PG8_WAIT_V(8); PG8_WAIT_L(0); PG8_BAR; PG8_MMA(1, 0, At, B0); PG8_MMA(1, 1, At, B1); PG8_BAR; PG8_SCHED;
            } else {
            PG8_LDB(B0, 0, 0); PG8_SCHED; PG8_LDA(At, 0, 0); PG8_STAGE(PG8_SA(1, 1), a1 + hstep, voffA);
            PG8_WAIT_L(8); PG8_BAR; PG8_WAIT_L(0); PG8_MMA(0, 0, At, B0); PG8_BAR; PG8_SCHED;
            PG8_LDB(B1, 0, 1); PG8_STAGE(PG8_SB(0, 0), b2, voffB);
            PG8_BAR; PG8_WAIT_L(0); PG8_MMA(0, 1, At, B1); PG8_BAR;
            PG8_LDA(At, 0, 1); PG8_STAGE(PG8_SA(0, 0), a2, voffA);
            PG8_BAR; PG8_WAIT_L(0); PG8_MMA(1, 0, At, B0); PG8_BAR; PG8_SCHED;
            PG8_STAGE(PG8_SB(0, 1), b2 + hstep, voffB);
            PG8_WAIT_V(6); PG8_BAR; PG8_MMA(1, 1, At, B1); PG8_BAR;
            PG8_LDB(B0, 1, 0); PG8_SCHED; PG8_LDA(At, 1, 0); PG8_STAGE(PG8_SA(0, 1), a2 + hstep, voffA);
            PG8_WAIT_L(8); PG8_BAR; PG8_WAIT_L(0); PG8_MMA(0, 0, At, B0); PG8_BAR; PG8_SCHED;
            PG8_LDB(B1, 1, 1); PG8_STAGE(PG8_SB(1, 0), b3, voffB);
            PG8_BAR; PG8_WAIT_L(0); PG8_MMA(0, 1, At, B1); PG8_BAR;
            PG8_LDA(At, 1, 1); PG8_STAGE(PG8_SA(1, 0), a3, voffA);
            PG8_BAR; PG8_WAIT_L(0); PG8_MMA(1, 0, At, B0); PG8_BAR; PG8_SCHED;
            PG8_STAGE(PG8_SB(1, 1), b3 + hstep, voffB);
            PG8_WAIT_V(6); PG8_BAR; PG8_MMA(1, 1, At, B1); PG8_BAR;
            }
        }
        if constexpr (ALIGN_EPI) { if (wr == 0) PG8_BAR; }
        if constexpr (!Epi::AFTER_DRAIN) { E(acc, cur, wr, wc, fr, fq); S.done(cur); }
        if (!has_next) break;
#pragma unroll
        for (int a = 0; a < 2; ++a)
#pragma unroll
            for (int b = 0; b < 2; ++b)
#pragma unroll
                for (int m = 0; m < 4; ++m)
#pragma unroll
                    for (int n = 0; n < 2; ++n) acc[a][b][m][n] = (f32x4){0.f, 0.f, 0.f, 0.f};
        cur = nxt; cA = nA; cB = nB; ++ui;
        if constexpr (ALIGN_EPI) { if (wr == 1) PG8_BAR; }
    }
    PG8_WAIT_V(0);
    if constexpr (!ALIGN_EPI) { if (wr == 0) PG8_BAR; }
    PG8_BAR;
    if constexpr (Epi::AFTER_DRAIN) { E.fused(acc, cur, wr, wc, fr, fq, lds, wid, lane); S.done(cur); }
#undef PG8_SA
#undef PG8_SB
#undef PG8_STAGE
#undef PG8_LDA
#undef PG8_LDB
#undef PG8_MMA
#undef PG8_WAIT_V
#undef PG8_WAIT_L
#undef PG8_BAR
#undef PG8_SCHED
}
}
#define LAS __attribute__((address_space(3)))
#define GAS __attribute__((address_space(1)))
#define LDS_BARRIER() do { asm volatile("s_waitcnt lgkmcnt(0)" ::: "memory"); __builtin_amdgcn_s_barrier(); asm volatile("" ::: "memory"); } while (0)
typedef unsigned short bf16;
typedef unsigned v4u __attribute__((ext_vector_type(4)));
typedef float f32x4 __attribute__((ext_vector_type(4)));
constexpr int NWAVES = 8, NTHREADS = 512;
constexpr int SEQ = 8192, DM = 1024, MTOK = 16384, DIN = 9744, N1 = 9728, PLD = 6656, FF = 4096;
constexpr float EPS = 1e-6f;
constexpr size_t MiB = 1u << 20;
constexpr size_t WS_WIN = 1 * MiB, WS_WA = 20 * MiB, WS_WB = 21 * MiB, WS_WO = 23 * MiB, WS_WUP = 25 * MiB, WS_WDN = 33 * MiB;
constexpr size_t WS_XB = 41 * MiB, WS_PROJ = 73 * MiB, WS_VT = 177 * MiB, WS_A1 = 193 * MiB, WS_A2 = 209 * MiB;
constexpr size_t WS_R1 = 241 * MiB, WS_PA = 242 * MiB, WS_SS2 = 243 * MiB, WS_MISC = 244 * MiB;
constexpr size_t WS_MIXED = 73 * MiB, WS_U = 73 * MiB, WS_END = 256 * MiB;
constexpr int LDS_BYTES = 155648, LDS_BARST = 155584;
constexpr size_t WS_BAR = 0;

__device__ __forceinline__ float bf2f(bf16 h) { return __uint_as_float(((unsigned)h) << 16); }
__device__ __forceinline__ unsigned f2bf(float f) { unsigned u = __builtin_bit_cast(unsigned, f); return (u + 0x7fffu + ((u >> 16) & 1u)) >> 16; }
__device__ __forceinline__ unsigned pk2(float lo, float hi) { return f2bf(lo) | (f2bf(hi) << 16); }
__device__ __forceinline__ float wave_sum(float v) {
#pragma unroll
    for (int o = 1; o < 64; o <<= 1) v += __shfl_xor(v, o);
    return v;
}
__device__ __forceinline__ float log_sigmoid(float x) { return fminf(x, 0.f) - log1pf(__expf(-fabsf(x))); }

#ifndef TPROBE
#define TPROBE -1
#endif
#ifndef TPBLK
#define TPBLK 0
#endif
#ifndef TPB
#define TPB (TPROBE + 1)
#endif
#ifndef REPMASK
#define REPMASK 0
#endif
struct Args { const float* in[15]; float* out; unsigned char* ws; int ph_lo, ph_hi, rep, pad; };

__device__ __forceinline__ void p0_transpose_item(const float* W, int ldw, int srccol0, const float* kscale, int kmask, float cscale,
                                                  bf16* WT, int K, int dstrow0, int k0, LAS float* scr, int lane) {
    float v[64];
    const GAS float* wp = (const GAS float*)W + (size_t)k0 * ldw + srccol0 + lane;
#pragma unroll
    for (int i = 0; i < 64; ++i) v[i] = __builtin_nontemporal_load(wp + (size_t)i * ldw);
    const int c = lane & 7;
    f32x4 s0 = (f32x4){cscale, cscale, cscale, cscale}, s1 = s0;
    if (kscale) { const int kb = (k0 + 8 * c) & kmask; s0 = *(const GAS f32x4*)((const GAS float*)kscale + kb) * cscale; s1 = *(const GAS f32x4*)((const GAS float*)kscale + kb + 4) * cscale; }
#pragma unroll
    for (int i = 0; i < 64; ++i) scr[i * 65 + lane] = v[i];
    asm volatile("s_waitcnt lgkmcnt(0)" ::: "memory");
#pragma unroll
    for (int j = 0; j < 8; ++j) { const int n = (lane >> 3) + 8 * j; const LAS float* s = scr + (8 * c) * 65 + n;
        v4u o; o.x = pk2(s[0 * 65] * s0[0], s[1 * 65] * s0[1]); o.y = pk2(s[2 * 65] * s0[2], s[3 * 65] * s0[3]); o.z = pk2(s[4 * 65] * s1[0], s[5 * 65] * s1[1]); o.w = pk2(s[6 * 65] * s1[2], s[7 * 65] * s1[3]);
        *(GAS v4u*)((GAS bf16*)WT + (size_t)(dstrow0 + n) * K + k0 + 8 * c) = o; }
    asm volatile("s_waitcnt lgkmcnt(0)" ::: "memory");
}

#define XB_TMO      128
#define XB_XCNT(j)  (256  + 64 * (j))
#define XB_XSUB(j)  (1280 + 64 * (j))
#define XB_XGEN(j)  (2304 + 64 * (j))
#define XB_TOP      3328
#define XB_TOPGEN   3392
#define XCD_BAR_WORDS 3456
#define XB_SPIN_CAP (1u << 18)

__device__ __forceinline__ unsigned xb_ld(unsigned* p)              { return __hip_atomic_load(p, __ATOMIC_RELAXED, __HIP_MEMORY_SCOPE_AGENT); }
__device__ __forceinline__ unsigned xb_add(unsigned* p, unsigned v) { return __hip_atomic_fetch_add(p, v, __ATOMIC_RELAXED, __HIP_MEMORY_SCOPE_AGENT); }
__device__ __forceinline__ unsigned xb_xcc_id() { return (unsigned)__builtin_amdgcn_s_getreg((3 << 11) | 20) & 0xFu; }
#define XB_SPIN(cond, bar) do { unsigned _sp = 0; while (cond) { __builtin_amdgcn_s_sleep(1); \
    if ((++_sp & 255u) == 0u) { if (xb_ld(&(bar)[XB_TMO])) break; if (_sp > XB_SPIN_CAP) { atomicAdd(&(bar)[XB_TMO], 1u); break; } } } } while (0)

struct XcdBarrier {
    unsigned* bar; unsigned x;
    volatile LAS unsigned* st;
};

__device__ __forceinline__ XcdBarrier xcd_barrier_post(unsigned* bar, volatile LAS unsigned* st) {
    XcdBarrier b; b.bar = bar; b.x = xb_xcc_id(); b.st = st;
    if (threadIdx.x == 0) (void)xb_add(&bar[XB_XCNT(b.x)], 1u);
    return b;
}
__device__ __forceinline__ void xcd_barrier_complete(unsigned* bar, unsigned x, unsigned& nloc, unsigned& nx) {
    const unsigned G = gridDim.x * gridDim.y * gridDim.z;
    unsigned sum, cnt, mine, sp = 0u;
    for (;;) {
        sum = 0u; cnt = 0u; mine = 0u;
#pragma unroll
        for (unsigned j = 0; j < 16; ++j) { const unsigned c = xb_ld(&bar[XB_XCNT(j)]); sum += c; cnt += (c > 0u) ? 1u : 0u; mine = (j == x) ? c : mine; }
        if (sum == G) break;
        __builtin_amdgcn_s_sleep(1);
        if ((++sp & 255u) == 0u) { if (xb_ld(&bar[XB_TMO])) break; if (sp > XB_SPIN_CAP) { atomicAdd(&bar[XB_TMO], 1u); break; } }
    }
    nloc = mine > 0u ? mine : 1u; nx = cnt > 0u ? cnt : 1u;
}

__device__ __forceinline__ void xcd_barrier(const XcdBarrier& b) {
    asm volatile("s_waitcnt vmcnt(0)" ::: "memory");
    __syncthreads();
    if (threadIdx.x == 0) {
        unsigned* bar = b.bar;
        __builtin_amdgcn_s_waitcnt(0);
        unsigned nloc = b.st[0], nx = b.st[1];
        if (nloc == 0u) { xcd_barrier_complete(bar, b.x, nloc, nx); b.st[0] = nloc; b.st[1] = nx; }
        const unsigned old = xb_add(&bar[XB_XSUB(b.x)], 1u);
        const unsigned gen = old / nloc;
        if (old + 1u == (gen + 1u) * nloc) {
            __builtin_amdgcn_fence(__ATOMIC_RELEASE, "agent");
            asm volatile("s_waitcnt vmcnt(0)" ::: "memory");
            const unsigned og = xb_add(&bar[XB_TOP], 1u);
            const unsigned tg = og / nx;
            if (og + 1u == (tg + 1u) * nx) xb_add(&bar[XB_TOPGEN], 1u);
            else XB_SPIN(xb_ld(&bar[XB_TOPGEN]) == tg, bar);
            __builtin_amdgcn_fence(__ATOMIC_ACQUIRE, "agent");
            xb_add(&bar[XB_XGEN(b.x)], 1u);
            asm volatile("s_waitcnt vmcnt(0)" ::: "memory");
        } else {
            XB_SPIN(xb_ld(&bar[XB_XGEN(b.x)]) == gen, bar);
            __builtin_amdgcn_fence(__ATOMIC_ACQUIRE, "agent");
            asm volatile("s_waitcnt vmcnt(0)" ::: "memory");
        }
    }
    __syncthreads();
}

typedef short bf16x8_t __attribute__((ext_vector_type(8)));
typedef short s16x4_t __attribute__((ext_vector_type(4)));
constexpr int AT_PITCH = 144;
constexpr int AT_KL = 0, AT_VL = 384 * AT_PITCH;
constexpr int N_ATT_ITEMS = 768;
constexpr int AT_ROWS = 384;
struct AttnKQ { v4u k[6], q[4]; };
__device__ __forceinline__ void attn_decode(int it2, int& g, int& slot, int& d, int& r, int& n) {
    g = it2 >> 8; const int rem = it2 & 255; slot = rem & 7; const int rest = rem >> 3; const int sh = 2 * g; d = 1 << sh; r = rest >> (5 - sh); n = 2 * (rest & ((32 >> sh) - 1));
}
__device__ __forceinline__ bool it_first_block(int it2) { int g, slot, d, r, n; attn_decode(it2, g, slot, d, r, n); return n == 0; }
__device__ __forceinline__ void attn_load_kq(AttnKQ& R, const bf16* PROJ_, int it, int tid, int wave, int lane) {
    int g, slot, d, r, n; attn_decode(it, g, slot, d, r, n); const int hd = g * 8 + slot; const int c = tid & 7;
#pragma unroll
    for (int p = 0; p < 6; ++p) { const int row = p * 64 + (tid >> 3); const int sp = (n - 1) * 128 + row;
        if (n > 0 || p >= 2) R.k[p] = *(const GAS v4u*)((const GAS bf16*)PROJ_ + (size_t)(sp * d + r) * PLD + 1536 + hd * 64 + c * 8);
        else R.k[p] = (v4u){0u, 0u, 0u, 0u}; }
    const int fr = lane & 15, fq = lane >> 4; const GAS bf16* qb = (const GAS bf16*)PROJ_ + (size_t)((n * 128 + 16 * wave + fr) * d + r) * PLD + hd * 64 + 8 * fq;
    R.q[0] = *(const GAS v4u*)(qb); R.q[1] = *(const GAS v4u*)(qb + 32);
    const GAS bf16* qb2 = qb + (size_t)128 * d * PLD; R.q[2] = *(const GAS v4u*)(qb2); R.q[3] = *(const GAS v4u*)(qb2 + 32);
}
__device__ __forceinline__ void attn_load_v(v4u (&V)[6], const bf16* PROJ_, int it, int tid) {
    int g, slot, d, r, n; attn_decode(it, g, slot, d, r, n); const int hd = g * 8 + slot; const int c = tid & 7;
#pragma unroll
    for (int p = 0; p < 6; ++p) { const int row = p * 64 + (tid >> 3); const int sp = (n - 1) * 128 + row;
        if (n > 0 || p >= 2) V[p] = *(const GAS v4u*)((const GAS bf16*)PROJ_ + (size_t)(sp * d + r) * PLD + 3072 + hd * 64 + c * 8);
        else V[p] = (v4u){0u, 0u, 0u, 0u}; }
}
__device__ __forceinline__ void attn_stage_k(const AttnKQ& R, LAS unsigned char* lds, const float (&gkr)[8], int tid) {
    const int c = tid & 7;
#pragma unroll
    for (int p = 0; p < 6; ++p) { const int row = p * 64 + (tid >> 3); float f[8]; pg8::unpack8(R.k[p], f); float ss = 0.f;
#pragma unroll
        for (int i = 0; i < 8; ++i) ss += f[i] * f[i];
        ss += __shfl_xor(ss, 1); ss += __shfl_xor(ss, 2); ss += __shfl_xor(ss, 4);
        const float rs = __builtin_amdgcn_rsqf(ss * (1.0f / 64.0f) + EPS);
#pragma unroll
        for (int i = 0; i < 8; ++i) f[i] = f[i] * (rs * gkr[i]);
        *(LAS v4u*)(lds + AT_KL + row * AT_PITCH + c * 16) = pg8::pack8(f); }
}
__device__ __forceinline__ void attn_stage_v(const v4u (&V)[6], LAS unsigned char* lds, int tid) {
    const int c = tid & 7;
#pragma unroll
    for (int p = 0; p < 6; ++p) { const int row = p * 64 + (tid >> 3); *(LAS v4u*)(lds + AT_VL + row * AT_PITCH + c * 16) = V[p]; }
}
__device__ __forceinline__ void attn_scores(f32x4 (&sc)[9], float& mx, float& den, v4u q0, v4u q1, LAS unsigned char* lds, const float (&gqr)[16], int koff, bool firstblk, int wave, int lane) {
    const int fr = lane & 15, fq = lane >> 4, w = wave;
    float qf[16]; { float t0[8], t1[8]; pg8::unpack8(q0, t0); pg8::unpack8(q1, t1);
#pragma unroll
        for (int i = 0; i < 8; ++i) { qf[i] = t0[i]; qf[8 + i] = t1[i]; } }
    float ss = 0.f;
#pragma unroll
    for (int i = 0; i < 16; ++i) ss += qf[i] * qf[i];
    ss += __shfl_xor(ss, 16); ss += __shfl_xor(ss, 32);
    const float qs = __builtin_amdgcn_rsqf(ss * (1.0f / 64.0f) + EPS) * (0.125f * 1.4426950408889634f);
    bf16x8_t qa[2];
    { float t0[8], t1[8];
#pragma unroll
      for (int i = 0; i < 8; ++i) { t0[i] = qf[i] * (qs * gqr[i]); t1[i] = qf[8 + i] * (qs * gqr[8 + i]); }
      qa[0] = __builtin_bit_cast(bf16x8_t, pg8::pack8(t0)); qa[1] = __builtin_bit_cast(bf16x8_t, pg8::pack8(t1)); }
#pragma unroll
    for (int kti = 0; kti < 9; ++kti) { f32x4 acc = (f32x4){0.f, 0.f, 0.f, 0.f}; const LAS unsigned char* kp = lds + AT_KL + ((koff + w + kti) * 16 + fr) * AT_PITCH + fq * 16;
#pragma unroll
        for (int ks = 0; ks < 2; ++ks) { const bf16x8_t kf = *(const LAS bf16x8_t*)(kp + ks * 64); acc = __builtin_amdgcn_mfma_f32_16x16x32_bf16(kf, qa[ks], acc, 0, 0, 0); }
        sc[kti] = acc; if (kti % 3 == 2) __builtin_amdgcn_sched_barrier(0); }
    mx = -INFINITY;
#pragma unroll
    for (int j = 0; j < 4; ++j) { if (4 * fq + j < fr) sc[0][j] = -INFINITY; if (4 * fq + j > fr) sc[8][j] = -INFINITY; }
    if (firstblk) {
#pragma unroll
        for (int kti = 0; kti < 9; ++kti) if (w + kti < 8) sc[kti] = (f32x4){-INFINITY, -INFINITY, -INFINITY, -INFINITY}; }
#pragma unroll
    for (int kti = 0; kti < 9; ++kti)
#pragma unroll
        for (int j = 0; j < 4; ++j) mx = fmaxf(mx, sc[kti][j]);
    mx = fmaxf(mx, __shfl_xor(mx, 16)); mx = fmaxf(mx, __shfl_xor(mx, 32));
    den = 0.f;
#pragma unroll
    for (int kti = 0; kti < 9; ++kti)
#pragma unroll
        for (int j = 0; j < 4; ++j) { const float pv = __builtin_amdgcn_exp2f(sc[kti][j] - mx); sc[kti][j] = pv; den += pv; }
    den += __shfl_xor(den, 16); den += __shfl_xor(den, 32);
    __builtin_amdgcn_sched_barrier(0);
}
__device__ __forceinline__ void attn_pv(const f32x4 (&sc)[9], float mx, float den, LAS unsigned char* lds, bf16* PROJ_, float* ML_, int it, int koff, int wave, int lane, bool do_store) {
    int g, slot, d, r, n; attn_decode(it, g, slot, d, r, n); const int hd = g * 8 + slot; n += koff >> 3;
    const int fr = lane & 15, fq = lane >> 4, w = wave;
    f32x4 o[4];
#pragma unroll
    for (int et = 0; et < 4; ++et) o[et] = (f32x4){0.f, 0.f, 0.f, 0.f};
    const int q_ = (lane >> 2) & 3, p_ = lane & 3;
#pragma unroll
    for (int kk = 0; kk < 5; ++kk) { const int kt0 = koff + w + 2 * kk, kt1 = (kk < 4) ? kt0 + 1 : kt0;
        v4u aw; aw.x = pg8::cvt_pk_bf16(sc[2 * kk][0], sc[2 * kk][1]); aw.y = pg8::cvt_pk_bf16(sc[2 * kk][2], sc[2 * kk][3]);
        if (kk < 4) { aw.z = pg8::cvt_pk_bf16(sc[(kk < 4) ? 2 * kk + 1 : 0][0], sc[(kk < 4) ? 2 * kk + 1 : 0][1]); aw.w = pg8::cvt_pk_bf16(sc[(kk < 4) ? 2 * kk + 1 : 0][2], sc[(kk < 4) ? 2 * kk + 1 : 0][3]); } else { aw.z = 0u; aw.w = 0u; }
        const bf16x8_t af = __builtin_bit_cast(bf16x8_t, aw);
        const LAS unsigned char* v0 = lds + AT_VL + (kt0 * 16 + 4 * fq + q_) * AT_PITCH + p_ * 8; const LAS unsigned char* v1 = lds + AT_VL + (kt1 * 16 + 4 * fq + q_) * AT_PITCH + p_ * 8;
#pragma unroll
        for (int et = 0; et < 4; ++et) {
            const s16x4_t lo = __builtin_bit_cast(s16x4_t, __builtin_amdgcn_ds_read_tr16_b64_v4i16((LAS s16x4_t*)(v0 + et * 32)));
            const s16x4_t hi = __builtin_bit_cast(s16x4_t, __builtin_amdgcn_ds_read_tr16_b64_v4i16((LAS s16x4_t*)(v1 + et * 32)));
            const bf16x8_t bfr = (bf16x8_t){lo[0], lo[1], lo[2], lo[3], hi[0], hi[1], hi[2], hi[3]};
            o[et] = __builtin_amdgcn_mfma_f32_16x16x32_bf16(af, bfr, o[et], 0, 0, 0); }
        __builtin_amdgcn_sched_barrier(0); }
    if (do_store)
#pragma unroll
    for (int j = 0; j < 4; j += 2) { GAS bf16* op0 = (GAS bf16*)PROJ_ + (size_t)((n * 128 + 16 * w + 4 * fq + j) * d + r) * PLD + hd * 64 + fr; GAS bf16* op1 = op0 + (size_t)d * PLD;
#pragma unroll
        for (int et = 0; et < 4; ++et) { const unsigned wv = pg8::cvt_pk_bf16(o[et][j], o[et][j + 1]); op0[et * 16] = (bf16)(wv & 0xffffu); op1[et * 16] = (bf16)(wv >> 16); } }
    if (fq == 0) { GAS float* mp = (GAS float*)ML_ + (size_t)((n * 128 + 16 * w + fr) * d + r) * 48 + (g * 8 + slot) * 2; mp[0] = mx; mp[1] = den; }
}

constexpr int GL_QG = 0, GL_KG = 17408, GL_KDT = 34816, GL_VTL = 53248, GL_PL = 90112, GL_EB = 99328, GL_PAL = 99840, GL_GT = 103936, GL_SSQ = 105984, GL_RS = 108032, GL_QR = 108544, GL_KR = 124928, GL_UP = 141312;
typedef unsigned u32x2_t __attribute__((ext_vector_type(2)));
struct GlaLd { v4u vt[4], q[2], k[2]; float pa[2]; };
__device__ __forceinline__ void gla_load(GlaLd& L, int b, int h, int tok0, const bf16* PROJ_, const bf16* VT_, const float* PA_, int tid) {
    const GAS float* pap = (const GAS float*)PA_ + (size_t)(b * SEQ + tok0) * 16; L.pa[0] = pap[tid]; L.pa[1] = pap[tid + 512];
#pragma unroll
    for (int i = 0; i < 4; ++i) { const int piece = tid + 512 * i, v = piece >> 3, cc = piece & 7; L.vt[i] = *(const GAS v4u*)((const GAS bf16*)VT_ + (size_t)(h * 256 + v) * SEQ + tok0 + cc * 8); }
#pragma unroll
    for (int i = 0; i < 2; ++i) { const int piece = tid + 512 * i, row = piece >> 4, c16 = piece & 15; const GAS bf16* rp = (const GAS bf16*)PROJ_ + (size_t)(tok0 + row) * PLD + h * 128 + c16 * 8;
        L.k[i] = *(const GAS v4u*)(rp + 5120); L.q[i] = *(const GAS v4u*)(rp + 4608); }
}
__device__ __forceinline__ void gla_stage(const GlaLd& L, LAS unsigned char* lds, int tid) {
    LAS float* PAL = (LAS float*)(lds + GL_PAL); PAL[tid] = L.pa[0]; PAL[tid + 512] = L.pa[1];
#pragma unroll
    for (int i = 0; i < 4; ++i) { const int piece = tid + 512 * i, v = piece >> 3, cc = piece & 7; *(LAS v4u*)(lds + GL_VTL + v * 144 + cc * 16) = L.vt[i]; }
#pragma unroll
    for (int i = 0; i < 2; ++i) { const int piece = tid + 512 * i; *(LAS v4u*)(lds + GL_KR + piece * 16) = L.k[i]; *(LAS v4u*)(lds + GL_QR + piece * 16) = L.q[i]; }
}
__device__ __forceinline__ float fexp(float x) { return __builtin_amdgcn_exp2f(x * 1.4426950408889634f); }
__device__ __forceinline__ float log_sigmoid_fast(float x) { return fminf(x, 0.f) - 0.6931471805599453f * __builtin_amdgcn_logf(1.0f + __builtin_amdgcn_exp2f(fabsf(x) * -1.4426950408889634f)); }
__device__ __forceinline__ void gla_local(LAS unsigned char* lds, int b, int item, const bf16* PROJ_, const bf16* VT_, const float* PA_, const float* gate_up_, const float* gate_bias_,
                                          float* SBUF_, float* DBUF_, bf16* A2_, bf16* QGS_, int tid_in, int wave, int lane_in) {
    int tid = tid_in, lane = lane_in; asm volatile("" : "+v"(tid), "+v"(lane));
    const int h = item >> 5, seg = item & 31;
    const int w = wave;
    GlaLd L; gla_load(L, b, h, seg * 256, PROJ_, VT_, PA_, tid);
    { LAS float* UP = (LAS float*)(lds + GL_UP);
#pragma unroll
      for (int i = 0; i < 4; ++i) { const int idx = tid + 512 * i, r = idx >> 7, k2 = idx & 127; UP[k2 * 20 + r] = gate_up_[r * 512 + h * 128 + k2]; } }
    const float bk = gate_bias_[h * 128 + (tid & 127)];
    f32x4 S[8][2];
#pragma unroll
    for (int mtk = 0; mtk < 8; ++mtk) { S[mtk][0] = (f32x4){0.f, 0.f, 0.f, 0.f}; S[mtk][1] = (f32x4){0.f, 0.f, 0.f, 0.f}; }
    float segsum = 0.f;
    asm volatile("" :: "v"(bk), "v"(L.k[1]));
    const int tid_item = tid, lane_item = lane;
    for (int c = 0; c < 4; ++c) {
        const int tok0 = seg * 256 + c * 64;
        int tid = tid_item, lane = lane_item; asm volatile("" : "+v"(tid), "+v"(lane));
        const int kd = tid & 127, tq = tid >> 7, fr = lane & 15, fq = lane >> 4;
        gla_stage(L, lds, tid);
        LDS_BARRIER();
        if (c < 3) gla_load(L, b, h, tok0 + 64, PROJ_, VT_, PA_, tid);
        { const LAS float* pal = (const LAS float*)(lds + GL_PAL); const LAS float* upl = (const LAS float*)(lds + GL_UP) + (16 * w + fr) * 20 + fq;
          const float ub0 = upl[0], ub1 = upl[4], ub2 = upl[8], ub3 = upl[12];
#pragma unroll
          for (int mt = 0; mt < 4; ++mt) { const LAS float* pa4 = pal + (16 * mt + fr) * 16 + fq; f32x4 lacc = (f32x4){0.f, 0.f, 0.f, 0.f};
              lacc = __builtin_amdgcn_mfma_f32_16x16x4f32(pa4[0], ub0, lacc, 0, 0, 0); lacc = __builtin_amdgcn_mfma_f32_16x16x4f32(pa4[4], ub1, lacc, 0, 0, 0);
              lacc = __builtin_amdgcn_mfma_f32_16x16x4f32(pa4[8], ub2, lacc, 0, 0, 0); lacc = __builtin_amdgcn_mfma_f32_16x16x4f32(pa4[12], ub3, lacc, 0, 0, 0);
#pragma unroll
              for (int j = 0; j < 4; ++j) ((LAS float*)lds)[(16 * mt + 4 * fq + j) * 128 + 16 * w + fr] = lacc[j]; } }
        LDS_BARRIER();
        float cb[16];
        { float run = 0.f;
#pragma unroll
          for (int i = 0; i < 16; ++i) { const int t = 16 * tq + i; const float lg = bk + ((const LAS float*)lds)[t * 128 + kd];
              run += log_sigmoid_fast(lg) * (1.0f / 16.0f); cb[i] = run; } }
        { LAS float* GT = (LAS float*)(lds + GL_GT); GT[tq * 128 + kd] = cb[15]; }
        LDS_BARRIER();
        float off = 0.f, tot = 0.f;
        { const LAS float* GT = (const LAS float*)(lds + GL_GT);
#pragma unroll
          for (int q = 0; q < 4; ++q) { const float gv = GT[q * 128 + kd]; tot += gv; off += (q < tq) ? gv : 0.f; } }
        const float etot = fexp(tot), eseg = fexp(segsum);
        { float kdv[16];
          GAS bf16* qgs = (GAS bf16*)QGS_ + (size_t)(tok0 + 16 * tq) * 512 + h * 128 + kd;
#pragma unroll
          for (int i = 0; i < 16; i += 2) { const int t = 16 * tq + i; const float bc0 = cb[i] + off, bc1 = cb[i + 1] + off;
              const float kf0 = bf2f(*(const LAS unsigned short*)(lds + GL_KR + t * 256 + kd * 2)), kf1 = bf2f(*(const LAS unsigned short*)(lds + GL_KR + (t + 1) * 256 + kd * 2));
              const float en0 = fexp(-bc0), en1 = fexp(-bc1);
              const float kg0 = kf0 * en0, kg1 = kf1 * en1; kdv[i] = kg0 * etot; kdv[i + 1] = kg1 * etot;
              const float qf0 = bf2f(*(const LAS unsigned short*)(lds + GL_QR + t * 256 + kd * 2)), qf1 = bf2f(*(const LAS unsigned short*)(lds + GL_QR + (t + 1) * 256 + kd * 2));
              const float qg0 = qf0 * fexp(bc0), qg1 = qf1 * fexp(bc1);
              const unsigned qw = pg8::cvt_pk_bf16(qg0, qg1), kw = pg8::cvt_pk_bf16(kg0, kg1), sw = pg8::cvt_pk_bf16(qg0 * eseg, qg1 * eseg);
              *(LAS unsigned short*)(lds + GL_QG + t * 272 + kd * 2) = (unsigned short)(qw & 0xffffu); *(LAS unsigned short*)(lds + GL_QG + (t + 1) * 272 + kd * 2) = (unsigned short)(qw >> 16);
              *(LAS unsigned short*)(lds + GL_KG + t * 272 + kd * 2) = (unsigned short)(kw & 0xffffu); *(LAS unsigned short*)(lds + GL_KG + (t + 1) * 272 + kd * 2) = (unsigned short)(kw >> 16);
              qgs[(size_t)i * 512] = (bf16)(sw & 0xffffu); qgs[(size_t)(i + 1) * 512] = (bf16)(sw >> 16); }
          float lo8[8], hi8[8];
#pragma unroll
          for (int i = 0; i < 8; ++i) { lo8[i] = kdv[i]; hi8[i] = kdv[8 + i]; }
          *(LAS v4u*)(lds + GL_KDT + kd * 144 + tq * 32) = pg8::pack8(lo8); *(LAS v4u*)(lds + GL_KDT + kd * 144 + tq * 32 + 16) = pg8::pack8(hi8); }
        if (tq == 0) ((LAS float*)(lds + GL_EB))[kd] = etot;
        segsum += tot;
        LDS_BARRIER();
        {
            const int mt = w >> 1;
#pragma unroll
            for (int sti = 0; sti < 2; ++sti) { const int st = 2 * (w & 1) + sti; f32x4 acc = (f32x4){0.f, 0.f, 0.f, 0.f};
                if (st <= mt) {
#pragma unroll
                    for (int ks = 0; ks < 4; ++ks) { const bf16x8_t kf = *(const LAS bf16x8_t*)(lds + GL_KG + (16 * st + fr) * 272 + (32 * ks + 8 * fq) * 2);
                        const bf16x8_t qf = *(const LAS bf16x8_t*)(lds + GL_QG + (16 * mt + fr) * 272 + (32 * ks + 8 * fq) * 2);
                        acc = __builtin_amdgcn_mfma_f32_16x16x32_bf16(kf, qf, acc, 0, 0, 0); }
                    if (st == mt) {
#pragma unroll
                        for (int j = 0; j < 4; ++j) if (4 * fq + j > fr) acc[j] = 0.f; } }
                u32x2_t wv; wv.x = pg8::cvt_pk_bf16(acc[0], acc[1]); wv.y = pg8::cvt_pk_bf16(acc[2], acc[3]);
                *(LAS u32x2_t*)(lds + GL_PL + (16 * mt + fr) * 144 + (16 * st + 4 * fq) * 2) = wv; }
            LDS_BARRIER();
        }
        bf16x8_t vf[2][2];
#pragma unroll
        for (int ks2 = 0; ks2 < 2; ++ks2)
#pragma unroll
            for (int nt = 0; nt < 2; ++nt) vf[ks2][nt] = *(const LAS bf16x8_t*)(lds + GL_VTL + (32 * w + 16 * nt + fr) * 144 + (32 * ks2 + 8 * fq) * 2);
        f32x4 o[4][2];
#pragma unroll
        for (int mt = 0; mt < 4; ++mt) { o[mt][0] = (f32x4){0.f, 0.f, 0.f, 0.f}; o[mt][1] = (f32x4){0.f, 0.f, 0.f, 0.f}; }
#pragma unroll
        for (int ks = 0; ks < 4; ++ks) { bf16x8_t bfr[2];
#pragma unroll
            for (int nt = 0; nt < 2; ++nt) { v4u wv; wv.x = pg8::cvt_pk_bf16(S[2 * ks][nt][0], S[2 * ks][nt][1]); wv.y = pg8::cvt_pk_bf16(S[2 * ks][nt][2], S[2 * ks][nt][3]);
                wv.z = pg8::cvt_pk_bf16(S[2 * ks + 1][nt][0], S[2 * ks + 1][nt][1]); wv.w = pg8::cvt_pk_bf16(S[2 * ks + 1][nt][2], S[2 * ks + 1][nt][3]); bfr[nt] = __builtin_bit_cast(bf16x8_t, wv); }
#pragma unroll
            for (int mt = 0; mt < 4; ++mt) { const u32x2_t a0 = *(const LAS u32x2_t*)(lds + GL_QG + (16 * mt + fr) * 272 + (32 * ks + 4 * fq) * 2), a1 = *(const LAS u32x2_t*)(lds + GL_QG + (16 * mt + fr) * 272 + (32 * ks + 16 + 4 * fq) * 2);
                const v4u aw = (v4u){a0.x, a0.y, a1.x, a1.y}; const bf16x8_t af = __builtin_bit_cast(bf16x8_t, aw);
                o[mt][0] = __builtin_amdgcn_mfma_f32_16x16x32_bf16(bfr[0], af, o[mt][0], 0, 0, 0); o[mt][1] = __builtin_amdgcn_mfma_f32_16x16x32_bf16(bfr[1], af, o[mt][1], 0, 0, 0); } }
#pragma unroll
        for (int ks2 = 0; ks2 < 2; ++ks2)
#pragma unroll
            for (int mt = 0; mt < 4; ++mt) { const bf16x8_t pf = *(const LAS bf16x8_t*)(lds + GL_PL + (16 * mt + fr) * 144 + (32 * ks2 + 8 * fq) * 2);
                o[mt][0] = __builtin_amdgcn_mfma_f32_16x16x32_bf16(vf[ks2][0], pf, o[mt][0], 0, 0, 0); o[mt][1] = __builtin_amdgcn_mfma_f32_16x16x32_bf16(vf[ks2][1], pf, o[mt][1], 0, 0, 0); }
#pragma unroll
        for (int mtk = 0; mtk < 8; ++mtk) { const f32x4 eb = *(const LAS f32x4*)(lds + GL_EB + (16 * mtk + 4 * fq) * 4);
            S[mtk][0] = S[mtk][0] * eb; S[mtk][1] = S[mtk][1] * eb;
#pragma unroll
            for (int ks2 = 0; ks2 < 2; ++ks2) { const bf16x8_t kf = *(const LAS bf16x8_t*)(lds + GL_KDT + (16 * mtk + fr) * 144 + (32 * ks2 + 8 * fq) * 2);
                S[mtk][0] = __builtin_amdgcn_mfma_f32_16x16x32_bf16(kf, vf[ks2][0], S[mtk][0], 0, 0, 0); S[mtk][1] = __builtin_amdgcn_mfma_f32_16x16x32_bf16(kf, vf[ks2][1], S[mtk][1], 0, 0, 0); } }
        LDS_BARRIER();
#pragma unroll
        for (int mt = 0; mt < 4; ++mt)
#pragma unroll
            for (int nt = 0; nt < 2; ++nt) { u32x2_t wv; wv.x = pg8::cvt_pk_bf16(o[mt][nt][0], o[mt][nt][1]); wv.y = pg8::cvt_pk_bf16(o[mt][nt][2], o[mt][nt][3]);
                *(LAS u32x2_t*)(lds + (16 * mt + fr) * 528 + (32 * w + 16 * nt + 4 * fq) * 2) = wv; }
        LDS_BARRIER();
#pragma unroll
        for (int i = 0; i < 4; ++i) { const int piece = tid + 512 * i, t = piece >> 5, c8 = piece & 31;
            *(GAS v4u*)((GAS bf16*)A2_ + (size_t)(b * SEQ + tok0 + t) * DM + h * 256 + c8 * 8) = *(const LAS v4u*)(lds + t * 528 + c8 * 16); }
    }
#pragma unroll
    for (int mtk = 0; mtk < 8; ++mtk)
#pragma unroll
        for (int nt = 0; nt < 2; ++nt)
#pragma unroll
            for (int j = 0; j < 4; ++j) ((GAS float*)SBUF_)[((size_t)item * 64 + (mtk * 2 + nt) * 4 + j) * 512 + tid] = S[mtk][nt][j];
    if ((tid >> 7) == 0) ((GAS float*)DBUF_)[item * 128 + (tid & 127)] = fexp(segsum);
    LDS_BARRIER();
}
constexpr int GF_QG = 0, GF_OL = 17408, GF_SSQ = 51200, GF_RS = 53248;
__device__ __forceinline__ void gla_fix(LAS unsigned char* lds, int b, int unit, const bf16* PROJ_, const bf16* SB16_, bf16* A2_, const bf16* QGS_, int tid_in, int wave, int lane_in) {
    int tid = tid_in, lane = lane_in; asm volatile("" : "+v"(tid), "+v"(lane));
    const int item = unit >> 1, half = unit & 1, h = item >> 5, seg = item & 31, w = wave, fr = lane & 15, fq = lane >> 4;
    bf16x8_t bfr[4][2];
#pragma unroll
    for (int ks = 0; ks < 4; ++ks)
#pragma unroll
        for (int nt = 0; nt < 2; ++nt) { unsigned hv[8];
#pragma unroll
            for (int j = 0; j < 4; ++j) { hv[j] = ((const GAS unsigned short*)SB16_)[((size_t)item * 64 + ((2 * ks) * 2 + nt) * 4 + j) * 512 + tid]; hv[4 + j] = ((const GAS unsigned short*)SB16_)[((size_t)item * 64 + ((2 * ks + 1) * 2 + nt) * 4 + j) * 512 + tid]; }
            const v4u wv = (v4u){hv[0] | (hv[1] << 16), hv[2] | (hv[3] << 16), hv[4] | (hv[5] << 16), hv[6] | (hv[7] << 16)};
            bfr[ks][nt] = __builtin_bit_cast(bf16x8_t, wv); }
    for (int cc = 0; cc < 2; ++cc) {
        const int tok0 = seg * 256 + (2 * half + cc) * 64;
        v4u rg[4], ol[4], qg[2];
#pragma unroll
        for (int i = 0; i < 4; ++i) { const int piece = tid + 512 * i, t = piece >> 5, c8 = piece & 31;
            rg[i] = *(const GAS v4u*)((const GAS bf16*)PROJ_ + (size_t)(tok0 + t) * PLD + 5632 + h * 256 + c8 * 8);
            ol[i] = *(const GAS v4u*)((const GAS bf16*)A2_ + (size_t)(b * SEQ + tok0 + t) * DM + h * 256 + c8 * 8); }
#pragma unroll
        for (int i = 0; i < 2; ++i) { const int piece = tid + 512 * i, t = piece >> 4, c16 = piece & 15; qg[i] = *(const GAS v4u*)((const GAS bf16*)QGS_ + (size_t)(tok0 + t) * 512 + h * 128 + c16 * 8); }
        LDS_BARRIER();
#pragma unroll
        for (int i = 0; i < 4; ++i) { const int piece = tid + 512 * i, t = piece >> 5, c8 = piece & 31; *(LAS v4u*)(lds + GF_OL + t * 528 + c8 * 16) = ol[i]; }
#pragma unroll
        for (int i = 0; i < 2; ++i) { const int piece = tid + 512 * i, t = piece >> 4, c16 = piece & 15; *(LAS v4u*)(lds + GF_QG + t * 272 + c16 * 16) = qg[i]; }
        LDS_BARRIER();
        f32x4 o[4][2];
#pragma unroll
        for (int mt = 0; mt < 4; ++mt)
#pragma unroll
            for (int nt = 0; nt < 2; ++nt) { const u32x2_t wv = *(const LAS u32x2_t*)(lds + GF_OL + (16 * mt + fr) * 528 + (32 * w + 16 * nt + 4 * fq) * 2);
                o[mt][nt] = (f32x4){pg8::bflo(wv.x), pg8::bfhi(wv.x), pg8::bflo(wv.y), pg8::bfhi(wv.y)}; }
#pragma unroll
        for (int ks = 0; ks < 4; ++ks)
#pragma unroll
            for (int mt = 0; mt < 4; ++mt) { const u32x2_t a0 = *(const LAS u32x2_t*)(lds + GF_QG + (16 * mt + fr) * 272 + (32 * ks + 4 * fq) * 2), a1 = *(const LAS u32x2_t*)(lds + GF_QG + (16 * mt + fr) * 272 + (32 * ks + 16 + 4 * fq) * 2);
                const v4u aw = (v4u){a0.x, a0.y, a1.x, a1.y}; const bf16x8_t af = __builtin_bit_cast(bf16x8_t, aw);
                o[mt][0] = __builtin_amdgcn_mfma_f32_16x16x32_bf16(bfr[ks][0], af, o[mt][0], 0, 0, 0); o[mt][1] = __builtin_amdgcn_mfma_f32_16x16x32_bf16(bfr[ks][1], af, o[mt][1], 0, 0, 0); }
#pragma unroll
        for (int mt = 0; mt < 4; ++mt) { float sq = 0.f;
#pragma unroll
            for (int j = 0; j < 4; ++j) sq += o[mt][0][j] * o[mt][0][j] + o[mt][1][j] * o[mt][1][j];
            sq += __shfl_xor(sq, 16); sq += __shfl_xor(sq, 32);
            if (fq == 0) ((LAS float*)(lds + GF_SSQ))[w * 64 + 16 * mt + fr] = sq; }
        LDS_BARRIER();
        if (tid < 64) { const LAS float* sp = (const LAS float*)(lds + GF_SSQ); float tsum = 0.f;
#pragma unroll
            for (int q = 0; q < 8; ++q) tsum += sp[q * 64 + tid];
            ((LAS float*)(lds + GF_RS))[tid] = 1.0f / sqrtf(tsum * (1.0f / 256.0f) + EPS); }
        LDS_BARRIER();
#pragma unroll
        for (int mt = 0; mt < 4; ++mt) { const float rs = ((const LAS float*)(lds + GF_RS))[16 * mt + fr];
#pragma unroll
            for (int nt = 0; nt < 2; ++nt) { u32x2_t wv; wv.x = pg8::cvt_pk_bf16(o[mt][nt][0] * rs, o[mt][nt][1] * rs); wv.y = pg8::cvt_pk_bf16(o[mt][nt][2] * rs, o[mt][nt][3] * rs);
                *(LAS u32x2_t*)(lds + GF_OL + (16 * mt + fr) * 528 + (32 * w + 16 * nt + 4 * fq) * 2) = wv; } }
        LDS_BARRIER();
#pragma unroll
        for (int i = 0; i < 4; ++i) { const int piece = tid + 512 * i, t = piece >> 5, c8 = piece & 31; float ov[8], rv[8];
            pg8::unpack8(*(const LAS v4u*)(lds + GF_OL + t * 528 + c8 * 16), ov); pg8::unpack8(rg[i], rv);
#pragma unroll
            for (int e2 = 0; e2 < 8; ++e2) ov[e2] *= rv[e2];
            *(GAS v4u*)((GAS bf16*)A2_ + (size_t)(b * SEQ + tok0 + t) * DM + h * 256 + c8 * 8) = pg8::pack8(ov); }
    }
    LDS_BARRIER();
}

__global__ void __launch_bounds__(NTHREADS, 2) fwd_kernel(Args a) {
    extern __shared__ __attribute__((aligned(16))) unsigned char lds_raw[];
    LAS unsigned char* lds = (LAS unsigned char*)lds_raw;
    cg::grid_group grid = cg::this_grid();
    const int tid = threadIdx.x, lane = tid & 63, wave = __builtin_amdgcn_readfirstlane(tid >> 6);
    const int G = gridDim.x, bx = blockIdx.x;
    const int gw = bx * NWAVES + wave, NGW = G * NWAVES;
    unsigned char* ws = a.ws;
    const float* x = a.in[0]; const float* g1 = a.in[1]; const float* w_in = a.in[2]; const float* gq = a.in[3]; const float* gk = a.in[4];
    const float* gate_up = a.in[5]; const float* gate_bias = a.in[6]; const float* gla_g = a.in[7]; const float* bgate_bias = a.in[8];
    const float* w_ab = a.in[9]; const float* w_gb = a.in[10]; const float* w_out = a.in[11]; const float* g2 = a.in[12]; const float* w_up = a.in[13]; const float* w_dn = a.in[14];
    bf16* WIN = (bf16*)(ws + WS_WIN); bf16* WA = (bf16*)(ws + WS_WA); bf16* WB = (bf16*)(ws + WS_WB); bf16* WO = (bf16*)(ws + WS_WO);
    bf16* WUP = (bf16*)(ws + WS_WUP); bf16* WDN = (bf16*)(ws + WS_WDN); bf16* XB = (bf16*)(ws + WS_XB); bf16* PROJ = (bf16*)(ws + WS_PROJ);
    bf16* VT = (bf16*)(ws + WS_VT); bf16* A1 = (bf16*)(ws + WS_A1); bf16* A2 = (bf16*)(ws + WS_A2);
    float* R1 = (float*)(ws + WS_R1); float* PA = (float*)(ws + WS_PA); float* SS2 = (float*)(ws + WS_SS2);
    bf16* MIXED = (bf16*)(ws + WS_MIXED); bf16* UB = (bf16*)(ws + WS_U); bf16* GATES = (bf16*)a.out;
    const int lo = a.ph_lo, hi = a.ph_hi; const int repm = a.rep;
    if (tid < 16) ((LAS unsigned*)(lds + LDS_BARST))[tid] = 0u;
    __syncthreads();
#define TS(i) do { if (TPROBE >= 0 && bx == TPBLK && tid == 0) ((LAS unsigned long long*)(lds + LDS_BARST + 16))[0 + ((i) == TPROBE ? 0 : ((i) == TPB ? 1 : 2))] = __builtin_amdgcn_s_memrealtime(); } while (0)
    TS(0);
    if (a.ph_lo < 0) grid.sync();
    if (a.ph_lo == 0) {
        unsigned* bw = (unsigned*)(ws + WS_BAR);
        if (bx == 0) { for (int i = tid; i < 4032; i += NTHREADS) bw[i] = 0u;
            asm volatile("s_waitcnt vmcnt(0)" ::: "memory"); __syncthreads();
            if (tid == 0) { __builtin_amdgcn_fence(__ATOMIC_RELEASE, "agent"); asm volatile("s_waitcnt vmcnt(0)" ::: "memory"); __hip_atomic_store(bw + 4064, 0x600DBA55u, __ATOMIC_RELAXED, __HIP_MEMORY_SCOPE_AGENT); } }
        if (tid == 0) { unsigned sp_ = 0; while (xb_ld(bw + 4064) != 0x600DBA55u) { __builtin_amdgcn_s_sleep(1); if (++sp_ > (1u << 22)) break; }
            __builtin_amdgcn_fence(__ATOMIC_ACQUIRE, "agent"); asm volatile("s_waitcnt vmcnt(0)" ::: "memory");
            (void)xb_add(bw + XB_XCNT(xb_xcc_id()), 1u); }
        __syncthreads();
    }
#define NREP(bit) (REPMASK ? (((repm >> (bit)) & 1) + 1) : 1)
#define IN(k) (lo <= (k) && (k) < hi)
#define LAUNDER(p) asm volatile("" : "+s"(p))
#define XBAR_OBJ(bb) XcdBarrier bb; bb.bar = (unsigned*)(ws + WS_BAR); bb.x = xb_xcc_id(); bb.st = (volatile LAS unsigned*)(lds + LDS_BARST)
#define SYNC(k) do { if (IN(k) && IN((k) + 1)) { asm volatile("s_waitcnt vmcnt(0) lgkmcnt(0)" ::: "memory"); \
        XBAR_OBJ(bb_); for (int rs_ = 0; rs_ < NREP(8); ++rs_) xcd_barrier(bb_); } } while (0)

    TS(39);
    if (IN(0)) for (int rep_ = 0; rep_ < NREP(0); ++rep_) {
        LAS float* scr = (LAS float*)(lds + wave * 16640);
        constexpr int I_IN = 16 * 152, I_A = 8 * 16, I_B = 16 * 16, I_O = 16 * 16, I_UP = 16 * 64, I_DN = 64 * 16;
        constexpr int NITEMS = I_IN + I_A + I_B + I_O + I_UP + I_DN;
        for (int it = wave * G + bx; it < NITEMS; it += NGW) {
            int r = it;
            if (r < I_IN) { const int kb = r / 152, nb = r % 152; const int n0 = nb * 64; const int src = n0 < 7680 ? n0 : n0 + 16;
                const float cs = (n0 >= 4608 && n0 < 5120) ? 0.08838834764831845f : 1.0f;
                p0_transpose_item(w_in, DIN, src, g1, 1023, cs, WIN, 1024, n0, kb * 64, scr, lane); continue; } r -= I_IN;
            if (r < I_A) { const int kb = r / 16, nb = r % 16; p0_transpose_item(w_ab, 1024, nb * 64, nullptr, 0, 1.0f, WA, 512, nb * 64, kb * 64, scr, lane); continue; } r -= I_A;
            if (r < I_B) { const int kb = r / 16, nb = r % 16; p0_transpose_item(w_gb, 1024, nb * 64, gla_g, 255, 1.0f, WB, 1024, nb * 64, kb * 64, scr, lane); continue; } r -= I_B;
            if (r < I_O) { const int kb = r / 16, nb = r % 16; p0_transpose_item(w_out, 1024, nb * 64, nullptr, 0, 1.0f, WO, 1024, nb * 64, kb * 64, scr, lane); continue; } r -= I_O;
            if (r < I_UP) { const int kb = r / 64, nb = r % 64; p0_transpose_item(w_up, 4096, nb * 64, g2, 1023, 1.0f, WUP, 1024, nb * 64, kb * 64, scr, lane); continue; } r -= I_UP;
            { const int kb = r / 16, nb = r % 16; p0_transpose_item(w_dn, 1024, nb * 64, nullptr, 0, 1.0f, WDN, 4096, nb * 64, kb * 64, scr, lane); }
        }
        __syncthreads();
        TS(40);
        LAS float* WAl = (LAS float*)lds;
        for (int idx = tid; idx < 1024 * 16; idx += NTHREADS) { const int k = idx >> 4, r = idx & 15; WAl[k * 20 + r] = w_in[(size_t)k * DIN + 7680 + r] * g1[k]; }
        __syncthreads();
        { const int fr = lane & 15, fq = lane >> 4, half = wave & 1; LAS float* xch = (LAS float*)(lds + 86016) + (wave >> 1) * 320;
          for (int tile = bx * 4 + (wave >> 1); tile < MTOK / 16; tile += G * 4) {
            asm volatile("" ::: "memory");
            const int row = tile * 16 + fr;
            const GAS f32x4* xr = (const GAS f32x4*)(x + (size_t)row * DM) + 2 * fq;
            GAS v4u* xo = (GAS v4u*)(XB + (size_t)row * DM) + fq;
            f32x4 acc = (f32x4){0.f, 0.f, 0.f, 0.f}; float ss = 0.f;
#pragma unroll 1
            for (int jb = 16 * half; jb < 16 * half + 16; jb += 8) {
                f32x4 v[8][2];
#pragma unroll
                for (int u = 0; u < 8; ++u) { v[u][0] = __builtin_nontemporal_load(xr + (jb + u) * 8); v[u][1] = __builtin_nontemporal_load(xr + (jb + u) * 8 + 1); }
#pragma unroll
                for (int u = 0; u < 8; ++u) { const int j = jb + u; const f32x4 a0 = v[u][0], a1 = v[u][1];
                    ss += ((a0[0] * a0[0] + a0[1] * a0[1]) + (a0[2] * a0[2] + a0[3] * a0[3])) + ((a1[0] * a1[0] + a1[1] * a1[1]) + (a1[2] * a1[2] + a1[3] * a1[3]));
                    v4u o; o.x = pk2(a0[0], a0[1]); o.y = pk2(a0[2], a0[3]); o.z = pk2(a1[0], a1[1]); o.w = pk2(a1[2], a1[3]); xo[j * 4] = o;
                    const LAS float* wp = WAl + (32 * j + 8 * fq) * 20 + fr;
                    acc = __builtin_amdgcn_mfma_f32_16x16x4f32(a0[0], wp[0], acc, 0, 0, 0); acc = __builtin_amdgcn_mfma_f32_16x16x4f32(a0[1], wp[20], acc, 0, 0, 0);
                    acc = __builtin_amdgcn_mfma_f32_16x16x4f32(a0[2], wp[40], acc, 0, 0, 0); acc = __builtin_amdgcn_mfma_f32_16x16x4f32(a0[3], wp[60], acc, 0, 0, 0);
                    acc = __builtin_amdgcn_mfma_f32_16x16x4f32(a1[0], wp[80], acc, 0, 0, 0); acc = __builtin_amdgcn_mfma_f32_16x16x4f32(a1[1], wp[100], acc, 0, 0, 0);
                    acc = __builtin_amdgcn_mfma_f32_16x16x4f32(a1[2], wp[120], acc, 0, 0, 0); acc = __builtin_amdgcn_mfma_f32_16x16x4f32(a1[3], wp[140], acc, 0, 0, 0); }
            }
            if (half == 1) { xch[lane] = acc[0]; xch[64 + lane] = acc[1]; xch[128 + lane] = acc[2]; xch[192 + lane] = acc[3]; xch[256 + lane] = ss; }
            __syncthreads();
            if (half == 0) { acc[0] += xch[lane]; acc[1] += xch[64 + lane]; acc[2] += xch[128 + lane]; acc[3] += xch[192 + lane]; ss += xch[256 + lane];
                ss += __shfl_xor(ss, 16); ss += __shfl_xor(ss, 32);
                const float r1 = 1.0f / sqrtf(ss * (1.0f / 1024.0f) + EPS);
#pragma unroll
                for (int j = 0; j < 4; ++j) { const float rr = __shfl(r1, 4 * fq + j); PA[(size_t)(tile * 16 + 4 * fq + j) * 16 + fr] = acc[j] * rr; }
                if (fq == 0) R1[row] = r1; }
            __syncthreads();
          } }
        __syncthreads();
    }
    TS(41);
    SYNC(0); TS(1);
    if (bx == 0 && tid == 0 && a.ph_lo == 0) __hip_atomic_store((unsigned*)(ws + WS_BAR) + 4064, 0u, __ATOMIC_RELAXED, __HIP_MEMORY_SCOPE_AGENT);

    for (int bq = 0; bq < 2; ++bq) {
        int b = bq; LAUNDER(b);
        const int p1 = 1 + 3 * b;
        if (IN(p1)) for (int rep_ = 0; rep_ < NREP(1); ++rep_) {
            pg8::Gemm g{XB + (size_t)b * SEQ * DM, WIN, SEQ, N1, DM}; pg8::StaticOrder S; S.init(SEQ, N1, G, bx);
            pg8::EpiProj E{PROJ, VT, GATES + (size_t)b * SEQ * 2048, R1 + b * SEQ, bgate_bias};
            pg8::gemm_phase<pg8::EpiProj, pg8::StaticOrder, true, true>(lds, g, S, E);
        }
        SYNC(p1); TS(p1 + 1);
        int tid_ = threadIdx.x; asm volatile("" : "+v"(tid_)); const int lane_ = tid_ & 63; const int wave_ = __builtin_amdgcn_readfirstlane(tid_ >> 6); int bx_ = bx; LAUNDER(bx_);
        const float* gate_up_ = gate_up; const float* gate_bias_ = gate_bias; const float* PA_ = PA; const bf16* PROJ_ = PROJ; const bf16* VT_ = VT; bf16* A1_ = A1; bf16* A2_ = A2; const float* gq_ = gq; const float* gk_ = gk;
        float* SBUF_ = (float*)(ws + WS_XB); float* DBUF_ = (float*)(ws + WS_MISC + 2 * MiB); float* ML_ = (float*)(ws + WS_MISC);
        bf16* SB16_ = (b == 0) ? (A2 + (size_t)SEQ * DM) : (XB + (size_t)SEQ * DM);
        LAUNDER(SB16_);
        bf16* QGS_ = (b == 0) ? (A1 + (size_t)SEQ * 512) : (bf16*)(ws + 247 * MiB);
        LAUNDER(QGS_);
        LAUNDER(gate_up_); LAUNDER(gate_bias_); LAUNDER(PA_); LAUNDER(PROJ_); LAUNDER(VT_); LAUNDER(A1_); LAUNDER(A2_); LAUNDER(gq_); LAUNDER(gk_); LAUNDER(SBUF_); LAUNDER(DBUF_); LAUNDER(ML_);
        if (IN(p1 + 1)) {
            if (bx_ < 128) { for (int rep_ = 0; rep_ < NREP(2); ++rep_) { gla_local(lds, b, bx_, PROJ_, VT_, PA_, gate_up_, gate_bias_, SBUF_, DBUF_, A2_, QGS_, tid_, wave_, lane_); }
                if (b == 0) TS(20);
                asm volatile("s_waitcnt vmcnt(0) lgkmcnt(0)" ::: "memory"); __syncthreads();
                if (tid_ == 0) { unsigned* cw = (unsigned*)(ws + WS_BAR) + 3520 + 64 * b;
                    __builtin_amdgcn_fence(__ATOMIC_RELEASE, "agent"); asm volatile("s_waitcnt vmcnt(0)" ::: "memory");
                    (void)xb_add(cw, 1u); }
            }
            if (b == 0) TS(21);
            {
                float gkr[8], gqr[16];
#pragma unroll
                for (int i = 0; i < 8; ++i) gkr[i] = gk_[(tid_ & 7) * 8 + i];
#pragma unroll
                for (int i = 0; i < 8; ++i) { gqr[i] = gq_[8 * (lane_ >> 4) + i]; gqr[8 + i] = gq_[32 + 8 * (lane_ >> 4) + i]; }
                bf16* PROJW = (bf16*)PROJ_;
                asm volatile("" :: "v"(gkr[7]), "v"(gqr[15]));
                const int first = bx_, cnt = bx_ < 128 ? 1 : 5;
                const int nrep_ = NREP(7);
                for (int rep_ = 0; rep_ < nrep_; ++rep_) {
                    AttnKQ R; v4u Vr[6]; attn_load_kq(R, PROJ_, first, tid_, wave_, lane_); attn_load_v(Vr, PROJ_, first, tid_);
                    for (int k = 0; k < cnt; ++k) { const int it = first + 128 * k;
                        LDS_BARRIER();
                        attn_stage_k(R, lds, gkr, tid_); attn_stage_v(Vr, lds, tid_);
                        const v4u q0 = R.q[0], q1 = R.q[1], q2 = R.q[2], q3 = R.q[3];
                        LDS_BARRIER();
                        if (k + 1 < cnt) { attn_load_kq(R, PROJ_, it + 128, tid_, wave_, lane_); attn_load_v(Vr, PROJ_, it + 128, tid_); }
                        { f32x4 sc[9]; float mx, den; attn_scores(sc, mx, den, q0, q1, lds, gqr, 0, it_first_block(it), wave_, lane_);
                          attn_pv(sc, mx, den, lds, PROJW, ML_, it, 0, wave_, lane_, rep_ == nrep_ - 1); }
                        { f32x4 sc[9]; float mx, den; attn_scores(sc, mx, den, q2, q3, lds, gqr, 8, false, wave_, lane_);
                          attn_pv(sc, mx, den, lds, PROJW, ML_, it, 8, wave_, lane_, rep_ == nrep_ - 1); }
                    }
                }
            }
        }
        if (IN(p1 + 1)) {
            if (tid_ == 0) { unsigned* cw = (unsigned*)(ws + WS_BAR) + 3520 + 64 * b; unsigned sp_ = 0;
                while (xb_ld(cw) < 128u) { __builtin_amdgcn_s_sleep(1); if (++sp_ > (1u << 22)) break; }
                __builtin_amdgcn_fence(__ATOMIC_ACQUIRE, "agent"); asm volatile("s_waitcnt vmcnt(0)" ::: "memory"); }
            __syncthreads();
            { const int gid = bx_ * NTHREADS + tid_; const int h = gid >> 15, r = (gid >> 9) & 63, tl = gid & 511; const int kdr = 16 * (r >> 3) + 4 * ((tl & 63) >> 4) + (r & 3);
              float loc[32], dec[32];
#pragma unroll
              for (int sg = 0; sg < 32; ++sg) { loc[sg] = ((const GAS float*)SBUF_)[((size_t)(h * 32 + sg) * 64 + r) * 512 + tl]; dec[sg] = ((const GAS float*)DBUF_)[(h * 32 + sg) * 128 + kdr]; }
              float cur = 0.f;
#pragma unroll
              for (int sg = 0; sg < 32; ++sg) { ((GAS unsigned short*)SB16_)[((size_t)(h * 32 + sg) * 64 + r) * 512 + tl] = (unsigned short)f2bf(cur); cur = dec[sg] * cur + loc[sg]; } }
        }
        SYNC(p1 + 1); TS(p1 + 2);
        if (IN(p1 + 2)) {
            for (int rep_ = 0; rep_ < NREP(3); ++rep_) { gla_fix(lds, b, bx_, PROJ_, SB16_, A2_, QGS_, tid_, wave_, lane_); }
            {
            for (int rep_ = 0; rep_ < NREP(9); ++rep_) {
                for (int idx = bx_ * NTHREADS + tid_; idx < SEQ * 64; idx += G * NTHREADS) {
                    const int t = idx >> 6, slot = (idx >> 3) & 7, c8 = idx & 7;
                    float m[3], dn[3];
#pragma unroll
                    for (int g = 0; g < 3; ++g) { const GAS float* mp = (const GAS float*)ML_ + (size_t)t * 48 + (g * 8 + slot) * 2; m[g] = mp[0]; dn[g] = mp[1]; }
                    const float M = fmaxf(m[0], fmaxf(m[1], m[2])); float D = 0.f; float acc[8];
#pragma unroll
                    for (int i = 0; i < 8; ++i) acc[i] = 0.f;
#pragma unroll
                    for (int g = 0; g < 3; ++g) { const float wg = __builtin_amdgcn_exp2f(m[g] - M); D += wg * dn[g]; float f[8];
                        pg8::unpack8(*(const GAS v4u*)((const GAS bf16*)PROJ_ + (size_t)t * PLD + (g * 8 + slot) * 64 + c8 * 8), f);
#pragma unroll
                        for (int i = 0; i < 8; ++i) acc[i] += wg * f[i]; }
                    const float inv = 1.0f / D;
#pragma unroll
                    for (int i = 0; i < 8; ++i) acc[i] *= inv;
                    *(GAS v4u*)((GAS bf16*)A1_ + (size_t)(b * SEQ + t) * 512 + slot * 64 + c8 * 8) = pg8::pack8(acc);
                }
            }
            }
        }
        SYNC(p1 + 2); TS(p1 + 3);
    }
    if (IN(7)) for (int rep_ = 0; rep_ < NREP(4); ++rep_) {
#pragma unroll 1
        for (int pass = 0; pass < 2; ++pass) {
            const bool useB = (((bx & 1) != 0) != (pass == 1));
            pg8::Gemm g{useB ? A2 : A1, useB ? WB : WA, MTOK, DM, useB ? 1024 : 512}; pg8::StaticOrder S; S.init(MTOK, DM, G, bx); pg8::EpiBranch E{MIXED, GATES, useB ? 1024 : 0, pass};
            pg8::gemm_phase<pg8::EpiBranch, pg8::StaticOrder, true, true>(lds, g, S, E);
            __syncthreads();
        }
    }
    SYNC(7); TS(8);
    if (IN(8)) for (int rep_ = 0; rep_ < NREP(5); ++rep_) { pg8::Gemm g{MIXED, WO, MTOK, DM, 1024}; pg8::StaticOrder S; S.init(MTOK, DM, G, bx); pg8::EpiOut1 E{x, a.out, XB, SS2};
        pg8::gemm_phase<pg8::EpiOut1, pg8::StaticOrder, true, true>(lds, g, S, E); }
    SYNC(8); TS(9);
    if (IN(9)) for (int rep_ = 0; rep_ < NREP(6); ++rep_) { pg8::Gemm g{XB, WUP, MTOK, FF, 1024}; pg8::StaticOrder S; S.init(MTOK, FF, G, bx); pg8::EpiUp E{UB, SS2};
        pg8::gemm_phase<pg8::EpiUp, pg8::StaticOrder, true, true>(lds, g, S, E); }
    SYNC(9); TS(10);
    if (IN(10)) for (int rep_ = 0; rep_ < NREP(10); ++rep_) { pg8::Gemm g{UB, WDN, MTOK, DM, FF}; pg8::StaticOrder S; S.init(MTOK, DM, G, bx); pg8::EpiDown E{a.out, rep_ == NREP(10) - 1};
        pg8::gemm_phase<pg8::EpiDown, pg8::StaticOrder, true, true>(lds, g, S, E); }
    TS(11);
    if (TPROBE >= 0 && bx == TPBLK && tid == 0) { const LAS unsigned long long* tsp = (const LAS unsigned long long*)(lds + LDS_BARST + 16); const unsigned long long dt = tsp[1] - tsp[0];
        const unsigned long long tend = __builtin_amdgcn_s_memrealtime() + 4ull * dt; while (__builtin_amdgcn_s_memrealtime() < tend) __builtin_amdgcn_s_sleep(8); }
#undef IN
#undef SYNC
}

extern "C" void kernel_launch(void* const* d_in, const int* in_sizes, int n_in, void* d_out, int out_size, void* d_ws, size_t ws_size, hipStream_t stream) {
    static int grid = 0;
    if (grid == 0) {
        if (n_in != 15 || out_size != MTOK * DM || ws_size < WS_END) { fprintf(stderr, "kernel_launch: unexpected shapes (n_in %d, out %d, ws %zu)\n", n_in, out_size, ws_size); grid = -1; return; }
        int dev = 0, cus = 0, per_cu = 0;
        hipGetDevice(&dev); hipDeviceGetAttribute(&cus, hipDeviceAttributeMultiprocessorCount, dev);
        if (hipFuncSetAttribute((const void*)fwd_kernel, hipFuncAttributeMaxDynamicSharedMemorySize, LDS_BYTES) != hipSuccess) { fprintf(stderr, "kernel_launch: hipFuncSetAttribute failed\n"); grid = -1; return; }
        if (hipOccupancyMaxActiveBlocksPerMultiprocessor(&per_cu, (const void*)fwd_kernel, NTHREADS, LDS_BYTES) != hipSuccess || per_cu < 1) per_cu = 1;
        (void)hipGetLastError();
        grid = cus * per_cu;
        fprintf(stderr, "kernel_launch: grid %d (cus %d x %d)\n", grid, cus, per_cu);
    }
    if (grid < 0) return;
    Args a{};
    for (int i = 0; i < 15; ++i) a.in[i] = (const float*)d_in[i];
    a.out = (float*)d_out; a.ws = (unsigned char*)d_ws; a.ph_lo = 0; a.ph_hi = 11; a.rep = REPMASK; a.pad = 0;
    void* args[] = {&a};
    hipError_t e = hipLaunchCooperativeKernel((const void*)fwd_kernel, dim3(grid), dim3(NTHREADS), args, LDS_BYTES, stream);
    if (e != hipSuccess) fprintf(stderr, "cooperative launch failed: %s (grid %d)\n", hipGetErrorString(e), grid);
}
```

```cpp
#include <hip/hip_runtime.h>
#include <hip/hip_cooperative_groups.h>
#include <cstdio>
#include <cstdint>
#include <cmath>
namespace cg = cooperative_groups;
namespace pg8 {
#define PG8_LAS __attribute__((address_space(3)))
typedef unsigned short bf16_t;
typedef short bf16x8 __attribute__((ext_vector_type(8)));
typedef float f32x4 __attribute__((ext_vector_type(4)));
typedef unsigned u32x4 __attribute__((ext_vector_type(4)));
constexpr int BM = 256, BK = 64, HALF = 128, HTB = HALF * BK * 2  , STAGE_BYTES = 8 * HTB, NXCD = 8, WGM = 8;

__host__ __device__ __forceinline__ int lds_byte(int r, int c) { const int st = (r >> 4) * 2 + (c >> 5), rr = r & 15, cc = c & 31, ob = rr * 64 + cc * 2; return st * 1024 + (ob ^ (((ob >> 9) & 1) << 5)); }
__host__ __device__ __forceinline__ void stage_rc(int b, int& R, int& C) { const int st = b / 1024, sb = b % 1024, swz = sb ^ (((sb >> 9) & 1) << 5); R = (st >> 1) * 16 + swz / 64; C = (st & 1) * 32 + (swz % 64) / 2; }
__host__ __device__ __forceinline__ int perm32(int rho) { const int n = rho >> 4, i = rho & 15; return 8 * (i >> 2) + 4 * n + (i & 3); }

struct Unit { int pm, pn; };
struct Gemm { const bf16_t* A; const bf16_t* Bt; int M, N, K; };

struct StaticOrder {
    int nM, nN, nwg, G, c;
    __host__ __device__ void init(int M, int N, int G_, int c_) { nM = M / BM; nN = N / BM; nwg = nM * nN; G = G_; c = c_; }
    __host__ __device__ bool next(int i, Unit& u) const {
        const long L = (long)i * G + c; if (L >= nwg) return false;
        int wgid = (int)L; { const int q = nwg / NXCD, r = nwg % NXCD, xcd = wgid % NXCD, off = wgid / NXCD; wgid = (xcd < r ? xcd * (q + 1) : r * (q + 1) + (xcd - r) * q) + off; }
        const int nig = WGM * nN, gid = wgid / nig, fm = gid * WGM, gsz = (nM - fm) < WGM ? (nM - fm) : WGM;
        u.pm = fm + ((wgid % nig) % gsz); u.pn = (wgid % nig) / gsz; return true;
    }
    __device__ __forceinline__ void a_ready(const Unit&) const {}
    __device__ __forceinline__ void done(const Unit&) const {}
};
typedef float f32x2 __attribute__((ext_vector_type(2)));
typedef __bf16 bf16x2_cv __attribute__((ext_vector_type(2)));
__device__ __forceinline__ unsigned cvt_pk_bf16(float lo, float hi) { const f32x2 v = {lo, hi}; const bf16x2_cv b = __builtin_convertvector(v, bf16x2_cv); return __builtin_bit_cast(unsigned, b); }
__device__ __forceinline__ float bflo(unsigned w) { return __uint_as_float(w << 16); }
__device__ __forceinline__ float bfhi(unsigned w) { return __uint_as_float(w & 0xffff0000u); }
__device__ __forceinline__ void unpack8(const u32x4 w, float (&f)[8]) { f[0] = bflo(w.x); f[1] = bfhi(w.x); f[2] = bflo(w.y); f[3] = bfhi(w.y); f[4] = bflo(w.z); f[5] = bfhi(w.z); f[6] = bflo(w.w); f[7] = bfhi(w.w); }
__device__ __forceinline__ u32x4 pack8(const float (&v)[8]) { u32x4 w; w.x = cvt_pk_bf16(v[0], v[1]); w.y = cvt_pk_bf16(v[2], v[3]); w.z = cvt_pk_bf16(v[4], v[5]); w.w = cvt_pk_bf16(v[6], v[7]); return w; }
__device__ __forceinline__ float fsigmoid(float x) { return __builtin_amdgcn_rcpf(1.0f + __builtin_amdgcn_exp2f(x * -1.4426950408889634f)); }

struct EpiProj {
    static constexpr bool PERM = true, AFTER_DRAIN = false;
    bf16_t* proj; bf16_t* vt; bf16_t* gates; const float* r1; const float* gbias;
    __device__ __forceinline__ void operator()(const f32x4 (&acc)[2][2][4][2], const Unit& u, int wr, int wc, int fr_in, int fq_in) const {
        int fr = fr_in, fq = fq_in; asm volatile("" : "+v"(fr), "+v"(fq));
        const int ct = u.pn; const int row0 = u.pm * BM + wr * 64 + fr; const int cl = wc * 32 + 8 * fq;
        float rsv[2][4];
#pragma unroll
        for (int ai = 0; ai < 2; ++ai)
#pragma unroll
            for (int m = 0; m < 4; ++m) rsv[ai][m] = r1[row0 + ai * HALF + m * 16];
        f32x4 gb[2][2];
        if (ct >= 30) {
#pragma unroll
            for (int bj = 0; bj < 2; ++bj) { const int gc = (ct - 30) * 256 + cl + bj * HALF; gb[bj][0] = *(const f32x4*)(gbias + gc); gb[bj][1] = *(const f32x4*)(gbias + gc + 4); } }
        else { gb[0][0] = gb[0][1] = gb[1][0] = gb[1][1] = (f32x4){0.f, 0.f, 0.f, 0.f}; }
#pragma unroll
        for (int ai = 0; ai < 2; ++ai)
#pragma unroll
            for (int m = 0; m < 4; ++m) {
                const int row = row0 + ai * HALF + m * 16; const float rs = rsv[ai][m];
#pragma unroll
                for (int bj = 0; bj < 2; ++bj) {
                    const f32x4 v0 = acc[ai][bj][m][0] * rs, v1 = acc[ai][bj][m][1] * rs;
                    float v[8] = {v0[0], v0[1], v0[2], v0[3], v1[0], v1[1], v1[2], v1[3]};
                    const int c = cl + bj * HALF;
                    if (ct < 22) { *(u32x4*)(proj + (size_t)row * 6656 + ct * 256 + c) = pack8(v); }
                    else if (ct < 26) { const u32x4 w = pack8(v); bf16_t* p = vt + (size_t)((ct - 22) * 256 + c) * 8192 + row;
                        p[0] = (bf16_t)(w.x & 0xffffu); p[8192] = (bf16_t)(w.x >> 16); p[2 * 8192] = (bf16_t)(w.y & 0xffffu); p[3 * 8192] = (bf16_t)(w.y >> 16);
                        p[4 * 8192] = (bf16_t)(w.z & 0xffffu); p[5 * 8192] = (bf16_t)(w.z >> 16); p[6 * 8192] = (bf16_t)(w.w & 0xffffu); p[7 * 8192] = (bf16_t)(w.w >> 16); }
                    else if (ct < 30) {
#pragma unroll
                        for (int i = 0; i < 8; ++i) v[i] = v[i] * fsigmoid(v[i]);
                        *(u32x4*)(proj + (size_t)row * 6656 + (ct - 4) * 256 + c) = pack8(v); }
                    else { const int gc = (ct - 30) * 256 + c; const float bb[8] = {gb[bj][0][0], gb[bj][0][1], gb[bj][0][2], gb[bj][0][3], gb[bj][1][0], gb[bj][1][1], gb[bj][1][2], gb[bj][1][3]};
#pragma unroll
                        for (int i = 0; i < 8; ++i) v[i] = fsigmoid(v[i] + bb[i]);
                        __builtin_nontemporal_store(pack8(v), (u32x4*)(gates + (size_t)row * 2048 + gc)); }
                }
            }
    }
};
struct EpiBranch {
    static constexpr bool PERM = true, AFTER_DRAIN = false;
    bf16_t* mixed; const bf16_t* gates; int goff; int add;
    __device__ __forceinline__ void operator()(const f32x4 (&acc)[2][2][4][2], const Unit& u, int wr, int wc, int fr_in, int fq_in) const {
        int fr = fr_in, fq = fq_in; asm volatile("" : "+v"(fr), "+v"(fq));
        const int row0 = u.pm * BM + wr * 64 + fr; const int cl = u.pn * BM + wc * 32 + 8 * fq;
#pragma unroll
        for (int ai = 0; ai < 2; ++ai) {
            u32x4 gw[4][2], tw[4][2];
#pragma unroll
            for (int m = 0; m < 4; ++m)
#pragma unroll
                for (int bj = 0; bj < 2; ++bj) { const int row = row0 + ai * HALF + m * 16, c = cl + bj * HALF;
                    gw[m][bj] = *(const u32x4*)(gates + (size_t)row * 2048 + goff + c);
                    tw[m][bj] = add ? *(const u32x4*)(mixed + (size_t)row * 1024 + c) : (u32x4){0u, 0u, 0u, 0u}; }
#pragma unroll
            for (int m = 0; m < 4; ++m)
#pragma unroll
                for (int bj = 0; bj < 2; ++bj) { const int row = row0 + ai * HALF + m * 16, c = cl + bj * HALF; float g[8], t[8], v[8];
                    unpack8(gw[m][bj], g); unpack8(tw[m][bj], t);
                    const f32x4 v0 = acc[ai][bj][m][0], v1 = acc[ai][bj][m][1];
                    v[0] = v0[0] * g[0] + t[0]; v[1] = v0[1] * g[1] + t[1]; v[2] = v0[2] * g[2] + t[2]; v[3] = v0[3] * g[3] + t[3];
                    v[4] = v1[0] * g[4] + t[4]; v[5] = v1[1] * g[5] + t[5]; v[6] = v1[2] * g[6] + t[6]; v[7] = v1[3] * g[7] + t[7];
                    *(u32x4*)(mixed + (size_t)row * 1024 + c) = pack8(v); }
        }
    }
};
struct EpiOut1 {
    static constexpr bool PERM = true, AFTER_DRAIN = false;
    const float* x; float* out; bf16_t* x1b; float* ss2;
    __device__ __forceinline__ void operator()(const f32x4 (&acc)[2][2][4][2], const Unit& u, int wr, int wc, int fr_in, int fq_in) const {
        int fr = fr_in, fq = fq_in; asm volatile("" : "+v"(fr), "+v"(fq));
        const int row0 = u.pm * BM + wr * 64 + fr; const int cl = u.pn * BM + wc * 32 + 8 * fq;
#pragma unroll
        for (int ai = 0; ai < 2; ++ai) {
            f32x4 xv[4][2][2];
#pragma unroll
            for (int m = 0; m < 4; ++m)
#pragma unroll
                for (int bj = 0; bj < 2; ++bj) { const size_t off = (size_t)(row0 + ai * HALF + m * 16) * 1024 + cl + bj * HALF; xv[m][bj][0] = *(const f32x4*)(x + off); xv[m][bj][1] = *(const f32x4*)(x + off + 4); }
#pragma unroll
            for (int m = 0; m < 4; ++m) {
                const int row = row0 + ai * HALF + m * 16; float ssq = 0.f;
#pragma unroll
                for (int bj = 0; bj < 2; ++bj) {
                    const size_t off = (size_t)row * 1024 + cl + bj * HALF;
                    const f32x4 o0 = xv[m][bj][0] + acc[ai][bj][m][0], o1 = xv[m][bj][1] + acc[ai][bj][m][1];
                    *(f32x4*)(out + off) = o0; *(f32x4*)(out + off + 4) = o1;
                    const float v[8] = {o0[0], o0[1], o0[2], o0[3], o1[0], o1[1], o1[2], o1[3]};
                    *(u32x4*)(x1b + off) = pack8(v);
#pragma unroll
                    for (int i = 0; i < 8; ++i) ssq += v[i] * v[i];
                }
                ssq += __shfl_xor(ssq, 16); ssq += __shfl_xor(ssq, 32);
                if (fq == 0) ss2[(size_t)row * 16 + u.pn * 4 + wc] = ssq;
            }
        }
    }
};
struct EpiUp {
    static constexpr bool PERM = true, AFTER_DRAIN = false;
    bf16_t* U; const float* ss2;
    __device__ __forceinline__ void operator()(const f32x4 (&acc)[2][2][4][2], const Unit& u, int wr, int wc, int fr_in, int fq_in) const {
        int fr = fr_in, fq = fq_in; asm volatile("" : "+v"(fr), "+v"(fq));
        const int row0 = u.pm * BM + wr * 64 + fr; const int cl = u.pn * BM + wc * 32 + 8 * fq;
        float rsv[2][4];
#pragma unroll
        for (int ai = 0; ai < 2; ++ai) { f32x4 sv[4][4];
#pragma unroll
            for (int m = 0; m < 4; ++m) { const f32x4* sp = (const f32x4*)(ss2 + (size_t)(row0 + ai * HALF + m * 16) * 16); sv[m][0] = sp[0]; sv[m][1] = sp[1]; sv[m][2] = sp[2]; sv[m][3] = sp[3]; }
#pragma unroll
            for (int m = 0; m < 4; ++m) { const f32x4 t = (sv[m][0] + sv[m][1]) + (sv[m][2] + sv[m][3]); const float sum = (t[0] + t[1]) + (t[2] + t[3]);
                rsv[ai][m] = __builtin_amdgcn_rsqf(sum * (1.0f / 1024.0f) + 1e-6f); } }
#pragma unroll
        for (int ai = 0; ai < 2; ++ai)
#pragma unroll
            for (int m = 0; m < 4; ++m) {
                const int row = row0 + ai * HALF + m * 16; const float rs = rsv[ai][m];
#pragma unroll
                for (int bj = 0; bj < 2; ++bj) {
                    const f32x4 v0 = acc[ai][bj][m][0] * rs, v1 = acc[ai][bj][m][1] * rs;
                    float v[8] = {v0[0], v0[1], v0[2], v0[3], v1[0], v1[1], v1[2], v1[3]};
#pragma unroll
                    for (int i = 0; i < 8; ++i) { const float r = fmaxf(v[i], 0.f); v[i] = r * r; }
                    *(u32x4*)(U + (size_t)row * 4096 + cl + bj * HALF) = pack8(v);
                }
            }
    }
};
struct EpiDown {
    static constexpr bool PERM = true, AFTER_DRAIN = false;
    float* out; int store;
    __device__ __forceinline__ void operator()(const f32x4 (&acc)[2][2][4][2], const Unit& u, int wr, int wc, int fr_in, int fq_in) const {
        int fr = fr_in, fq = fq_in; asm volatile("" : "+v"(fr), "+v"(fq));
        const int row0 = u.pm * BM + wr * 64 + fr; const int cl = u.pn * BM + wc * 32 + 8 * fq;
#pragma unroll
        for (int ai = 0; ai < 2; ++ai) {
            f32x4 xv[4][2][2];
#pragma unroll
            for (int m = 0; m < 4; ++m)
#pragma unroll
                for (int bj = 0; bj < 2; ++bj) { const size_t off = (size_t)(row0 + ai * HALF + m * 16) * 1024 + cl + bj * HALF; xv[m][bj][0] = *(const f32x4*)(out + off); xv[m][bj][1] = *(const f32x4*)(out + off + 4); }
#pragma unroll
            for (int m = 0; m < 4; ++m)
#pragma unroll
                for (int bj = 0; bj < 2; ++bj) {
                    const size_t off = (size_t)(row0 + ai * HALF + m * 16) * 1024 + cl + bj * HALF;
                    const f32x4 o0 = xv[m][bj][0] + acc[ai][bj][m][0], o1 = xv[m][bj][1] + acc[ai][bj][m][1];
                    if (store) { *(f32x4*)(out + off) = o0; *(f32x4*)(out + off + 4) = o1; }
                }
        }
    }
};
template <class Epi, class Sched, bool ALIGN_EPI = false, bool SP2 = false>
__device__ __forceinline__ void gemm_phase(PG8_LAS unsigned char* lds, const Gemm g, const Sched& S, const Epi& E) {
    int tid_l = threadIdx.x; asm volatile("" : "+v"(tid_l));
    const int tid = tid_l, wid = __builtin_amdgcn_readfirstlane(tid >> 6), lane = tid & 63, wr = wid >> 2, wc = wid & 3, fr = lane & 15, fq = lane >> 4;
    const int K = g.K, nt = K / BK;
    unsigned voffA[2], voffB[2];
#pragma unroll
    for (int i = 0; i < 2; ++i) { int R, C; stage_rc(tid * 16 + i * 8192, R, C); const int Rb = Epi::PERM ? ((R & ~31) + perm32(R & 31)) : R;
        voffA[i] = (unsigned)(R * K + C) * 2u; voffB[i] = (unsigned)(Rb * K + C) * 2u; }
    const size_t kstep = (size_t)(BK * 2);
    const size_t hstep = (size_t)HALF * K * 2;
    const size_t tstep = 2 * hstep;
    const unsigned ldsw = (unsigned)wid * 1024u;
    const int aoff = lds_byte(wr * 64 + fr, fq * 8), boff = lds_byte(wc * 32 + fr, fq * 8);
#define PG8_SA(b, h) (((b) * 2 + (h)) * HTB)
#define PG8_SB(b, h) ((4 + (b) * 2 + (h)) * HTB)
#define PG8_STAGE(bufoff, gbase, voff) do { _Pragma("unroll") for (int _i = 0; _i < 2; ++_i) \
        __builtin_amdgcn_global_load_lds((const unsigned*)((const char*)(gbase) + (voff)[_i]), (PG8_LAS unsigned*)(lds + (bufoff) + ldsw + _i * 8192), 16, 0, 0); } while (0)
#define PG8_LDA(dst, b, h) do { _Pragma("unroll") for (int m = 0; m < 4; ++m) _Pragma("unroll") for (int k = 0; k < 2; ++k) dst[m][k] = *(const PG8_LAS bf16x8*)(lds + PG8_SA(b, h) + aoff + m * 2048 + k * 1024); } while (0)
#define PG8_LDB(dst, b, h) do { _Pragma("unroll") for (int n = 0; n < 2; ++n) _Pragma("unroll") for (int k = 0; k < 2; ++k) dst[n][k] = *(const PG8_LAS bf16x8*)(lds + PG8_SB(b, h) + boff + n * 2048 + k * 1024); } while (0)
#define PG8_MMA(ai, bj, At, Bt) do { __builtin_amdgcn_s_setprio(1); _Pragma("unroll") for (int m = 0; m < 4; ++m) _Pragma("unroll") for (int n = 0; n < 2; ++n) _Pragma("unroll") for (int k = 0; k < 2; ++k) \
        acc[ai][bj][m][n] = __builtin_amdgcn_mfma_f32_16x16x32_bf16(Bt[n][k], At[m][k], acc[ai][bj][m][n], 0, 0, 0); __builtin_amdgcn_s_setprio(0); } while (0)
#define PG8_WAIT_V(n) asm volatile("s_waitcnt vmcnt(" #n ")" ::: "memory")
#define PG8_WAIT_L(n) asm volatile("s_waitcnt lgkmcnt(" #n ")" ::: "memory")
#define PG8_BAR __builtin_amdgcn_s_barrier()
#define PG8_SCHED __builtin_amdgcn_sched_barrier(0)
    Unit cur, nxt; int ui = 0;
    if (!S.next(0, cur)) return;
    f32x4 acc[2][2][4][2];
#pragma unroll
    for (int a = 0; a < 2; ++a)
#pragma unroll
        for (int b = 0; b < 2; ++b)
#pragma unroll
            for (int m = 0; m < 4; ++m)
#pragma unroll
                for (int n = 0; n < 2; ++n) acc[a][b][m][n] = (f32x4){0.f, 0.f, 0.f, 0.f};
    bf16x8 At[4][2], B0[2][2], B1[2][2];
    const char* cA = (const char*)g.A + (size_t)cur.pm * tstep; const char* cB = (const char*)g.Bt + (size_t)cur.pn * tstep;
    S.a_ready(cur);
    if constexpr (SP2) {
        PG8_STAGE(PG8_SB(0, 0), cB, voffB); PG8_STAGE(PG8_SB(0, 1), cB + hstep, voffB); PG8_STAGE(PG8_SA(0, 0), cA, voffA); PG8_STAGE(PG8_SA(0, 1), cA + hstep, voffA);
        if (wr == 1) PG8_BAR;
        PG8_WAIT_V(2); PG8_BAR;
        PG8_STAGE(PG8_SB(1, 0), cB + kstep, voffB); PG8_STAGE(PG8_SA(1, 0), cA + kstep, voffA); PG8_STAGE(PG8_SB(1, 1), cB + hstep + kstep, voffB);
        PG8_WAIT_V(6); PG8_BAR;
    } else {
        PG8_STAGE(PG8_SB(0, 0), cB, voffB); PG8_STAGE(PG8_SA(0, 0), cA, voffA); PG8_STAGE(PG8_SB(0, 1), cB + hstep, voffB); PG8_STAGE(PG8_SA(0, 1), cA + hstep, voffA);
        if (wr == 1) PG8_BAR;
        PG8_WAIT_V(4); PG8_BAR;
        PG8_STAGE(PG8_SB(1, 0), cB + kstep, voffB); PG8_STAGE(PG8_SA(1, 0), cA + kstep, voffA); PG8_STAGE(PG8_SB(1, 1), cB + hstep + kstep, voffB);
        PG8_WAIT_V(6); PG8_BAR;
    }
    for (;;) {
        const bool has_next = S.next(ui + 1, nxt);
        const char* nA = has_next ? (const char*)g.A + (size_t)nxt.pm * tstep : cA; const char* nB = has_next ? (const char*)g.Bt + (size_t)nxt.pn * tstep : cB;
        for (int t = 0; t < nt; t += 2) {
            const bool last = (t == nt - 2);
            const char* a1 = cA + (size_t)(t + 1) * kstep;
            const char* a2 = last ? nA : cA + (size_t)(t + 2) * kstep; const char* b2 = last ? nB : cB + (size_t)(t + 2) * kstep;
            const char* a3 = a2 + kstep; const char* b3 = b2 + kstep;
            if (last && has_next) S.a_ready(nxt);
            if constexpr (SP2) {
            PG8_LDB(B0, 0, 0); PG8_LDB(B1, 0, 1); PG8_SCHED; PG8_LDA(At, 0, 0); PG8_STAGE(PG8_SA(1, 1), a1 + hstep, voffA);
            PG8_WAIT_V(8); PG8_WAIT_L(0); PG8_BAR; PG8_MMA(0, 0, At, B0); PG8_MMA(0, 1, At, B1); PG8_BAR; PG8_SCHED;
            PG8_LDA(At, 0, 1); PG8_STAGE(PG8_SB(0, 0), b2, voffB); PG8_STAGE(PG8_SB(0, 1), b2 + hstep, voffB); PG8_STAGE(PG8_SA(0, 0), a2, voffA);
            PG8_WAIT_V(8); PG8_WAIT_L(0); PG8_BAR; PG8_MMA(1, 0, At, B0); PG8_MMA(1, 1, At, B1); PG8_BAR; PG8_SCHED;
            PG8_LDB(B0, 1, 0); PG8_LDB(B1, 1, 1); PG8_SCHED; PG8_LDA(At, 1, 0); PG8_STAGE(PG8_SA(0, 1), a2 + hstep, voffA);
            PG8_WAIT_V(8); PG8_WAIT_L(0); PG8_BAR; PG8_MMA(0, 0, At, B0); PG8_MMA(0, 1, At, B1); PG8_BAR; PG8_SCHED;
            PG8_LDA(At, 1, 1); PG8_STAGE(PG8_SB(1, 0), b3, voffB); PG8_STAGE(PG8_SB(1, 1), b3 + hstep, voffB); PG8_STAGE(PG8_SA(1, 0), a3, voffA);
            PG8_WAIT_V(8); PG8_WAIT_L(0); PG8_BAR; PG8_MMA(1, 0, At, B0); PG8_MMA(1, 1, At, B1); PG8_BAR; PG8_SCHED;
            } else {
            PG8_LDB(B0, 0, 0); PG8_SCHED; PG8_LDA(At, 0, 0); PG8_STAGE(PG8_SA(1, 1), a1 + hstep, voffA);
            PG8_WAIT_L(8); PG8_BAR; PG8_WAIT_L(0); PG8_MMA(0, 0, At, B0); PG8_BAR; PG8_SCHED;
            PG8_LDB(B1, 0, 1); PG8_STAGE(PG8_SB(0, 0), b2, voffB);
            PG8_BAR; PG8_WAIT_L(0); PG8_MMA(0, 1, At, B1); PG8_BAR;
            PG8_LDA(At, 0, 1); PG8_STAGE(PG8_SA(0, 0), a2, voffA);
            PG8_BAR; PG8_WAIT_L(0); PG8_MMA(1, 0, At, B0); PG8_BAR; PG8_SCHED;
            PG8_STAGE(PG8_SB(0, 1), b2 + hstep, voffB);
            PG8_WAIT_V(6); PG8_BAR; PG8_MMA(1, 1, At, B1); PG8_BAR;
            PG8_LDB(B0, 1, 0); PG8_SCHED; PG8_LDA(At, 1, 0); PG8_STAGE(PG8_SA(0, 1), a2 + hstep, voffA);
            PG8_WAIT_L(8); PG8_BAR; PG8_WAIT_L(0); PG8_MMA(0, 0, At, B0); PG8_BAR; PG8_SCHED;
            PG8_LDB(B1, 1, 1); PG8_STAGE(PG8_SB(1, 0), b3, voffB);
            PG8_BAR; PG8_WAIT_L(0); PG8_MMA(0, 1, At, B1); PG8_BAR;
            PG8_LDA(At, 1, 1); PG8_STAGE(PG8_SA(1, 0), a3, voffA);
            PG8_BAR; PG8_WAIT_L(0); PG8_MMA(1, 0, At, B0); PG8_BAR; PG8_SCHED;
            PG8_STAGE(PG8_SB(1, 1), b3 + hstep, voffB);
            PG8_WAIT_V(6); PG8_BAR; PG8_MMA(1, 1, At, B1); PG8_BAR;
            }
        }
        if constexpr (ALIGN_EPI) { if (wr == 0) PG8_BAR; }
        if constexpr (!Epi::AFTER_DRAIN) { E(acc, cur, wr, wc, fr, fq); S.done(cur); }
        if (!has_next) break;
#pragma unroll
        for (int a = 0; a < 2; ++a)
#pragma unroll
            for (int b = 0; b < 2; ++b)
#pragma unroll
                for (int m = 0; m < 4; ++m)
#pragma unroll
                    for (int n = 0; n < 2; ++n) acc[a][b][m][n] = (f32x4){0.f, 0.f, 0.f, 0.f};
        cur = nxt; cA = nA; cB = nB; ++ui;
        if constexpr (ALIGN_EPI) { if (wr == 1) PG8_BAR; }
    }
    PG8_WAIT_V(0);
    if constexpr (!ALIGN_EPI) { if (wr == 0) PG8_BAR; }
    PG8_BAR;
    if constexpr (Epi::AFTER_DRAIN) { E.fused(acc, cur, wr, wc, fr, fq, lds, wid, lane); S.done(cur); }
#undef PG8_SA
#undef PG8_SB
#undef PG8_STAGE
#undef PG8_LDA
#undef PG8_LDB
#undef PG8_MMA
#undef PG8_WAIT_V
#undef PG8_WAIT_L
#undef PG8_BAR
#undef PG8_SCHED
}
}
#define LAS __attribute__((address_space(3)))
#define GAS __attribute__((address_space(1)))
#define LDS_BARRIER() do { asm volatile("s_waitcnt lgkmcnt(0)" ::: "memory"); __builtin_amdgcn_s_barrier(); asm volatile("" ::: "memory"); } while (0)
typedef unsigned short bf16;
typedef unsigned v4u __attribute__((ext_vector_type(4)));
typedef float f32x4 __attribute__((ext_vector_type(4)));
constexpr int NWAVES = 8, NTHREADS = 512;
constexpr int SEQ = 8192, DM = 1024, MTOK = 16384, DIN = 9744, N1 = 9728, PLD = 6656, FF = 4096;
constexpr float EPS = 1e-6f;
constexpr size_t MiB = 1u << 20;
constexpr size_t WS_WIN = 1 * MiB, WS_WA = 20 * MiB, WS_WB = 21 * MiB, WS_WO = 23 * MiB, WS_WUP = 25 * MiB, WS_WDN = 33 * MiB;
constexpr size_t WS_XB = 41 * MiB, WS_PROJ = 73 * MiB, WS_VT = 177 * MiB, WS_A1 = 193 * MiB, WS_A2 = 209 * MiB;
constexpr size_t WS_R1 = 241 * MiB, WS_PA = 242 * MiB, WS_SS2 = 243 * MiB, WS_MISC = 244 * MiB;
constexpr size_t WS_MIXED = 73 * MiB, WS_U = 73 * MiB, WS_END = 256 * MiB;
constexpr int LDS_BYTES = 155648, LDS_BARST = 155584;
constexpr size_t WS_BAR = 0;

__device__ __forceinline__ float bf2f(bf16 h) { return __uint_as_float(((unsigned)h) << 16); }
__device__ __forceinline__ unsigned f2bf(float f) { unsigned u = __builtin_bit_cast(unsigned, f); return (u + 0x7fffu + ((u >> 16) & 1u)) >> 16; }
__device__ __forceinline__ unsigned pk2(float lo, float hi) { return f2bf(lo) | (f2bf(hi) << 16); }
__device__ __forceinline__ float wave_sum(float v) {
#pragma unroll
    for (int o = 1; o < 64; o <<= 1) v += __shfl_xor(v, o);
    return v;
}
__device__ __forceinline__ float log_sigmoid(float x) { return fminf(x, 0.f) - log1pf(__expf(-fabsf(x))); }

#ifndef TPROBE
#define TPROBE -1
#endif
#ifndef TPBLK
#define TPBLK 0
#endif
#ifndef TPB
#define TPB (TPROBE + 1)
#endif
#ifndef REPMASK
#define REPMASK 0
#endif
struct Args { const float* in[15]; float* out; unsigned char* ws; int ph_lo, ph_hi, rep, pad; };

__device__ __forceinline__ void p0_transpose_item(const float* W, int ldw, int srccol0, const float* kscale, int kmask, float cscale,
                                                  bf16* WT, int K, int dstrow0, int k0, LAS float* scr, int lane) {
    float v[64];
    const GAS float* wp = (const GAS float*)W + (size_t)k0 * ldw + srccol0 + lane;
#pragma unroll
    for (int i = 0; i < 64; ++i) v[i] = __builtin_nontemporal_load(wp + (size_t)i * ldw);
    const int c = lane & 7;
    f32x4 s0 = (f32x4){cscale, cscale, cscale, cscale}, s1 = s0;
    if (kscale) { const int kb = (k0 + 8 * c) & kmask; s0 = *(const GAS f32x4*)((const GAS float*)kscale + kb) * cscale; s1 = *(const GAS f32x4*)((const GAS float*)kscale + kb + 4) * cscale; }
#pragma unroll
    for (int i = 0; i < 64; ++i) scr[i * 65 + lane] = v[i];
    asm volatile("s_waitcnt lgkmcnt(0)" ::: "memory");
#pragma unroll
    for (int j = 0; j < 8; ++j) { const int n = (lane >> 3) + 8 * j; const LAS float* s = scr + (8 * c) * 65 + n;
        v4u o; o.x = pk2(s[0 * 65] * s0[0], s[1 * 65] * s0[1]); o.y = pk2(s[2 * 65] * s0[2], s[3 * 65] * s0[3]); o.z = pk2(s[4 * 65] * s1[0], s[5 * 65] * s1[1]); o.w = pk2(s[6 * 65] * s1[2], s[7 * 65] * s1[3]);
        GAS v4u* dp = (GAS v4u*)((GAS bf16*)WT + (size_t)(dstrow0 + n) * K + k0 + 8 * c);
        if (ldw == DIN) *dp = o; else __builtin_nontemporal_store(o, dp); }
    asm volatile("s_waitcnt lgkmcnt(0)" ::: "memory");
}

#define XB_TMO      128
#define XB_XCNT(j)  (256  + 64 * (j))
#define XB_XSUB(j)  (1280 + 64 * (j))
#define XB_XGEN(j)  (2304 + 64 * (j))
#define XB_TOP      3328
#define XB_TOPGEN   3392
#define XCD_BAR_WORDS 3456
#define XB_SPIN_CAP (1u << 18)

__device__ __forceinline__ unsigned xb_ld(unsigned* p)              { return __hip_atomic_load(p, __ATOMIC_RELAXED, __HIP_MEMORY_SCOPE_AGENT); }
__device__ __forceinline__ unsigned xb_add(unsigned* p, unsigned v) { return __hip_atomic_fetch_add(p, v, __ATOMIC_RELAXED, __HIP_MEMORY_SCOPE_AGENT); }
__device__ __forceinline__ unsigned xb_xcc_id() { return (unsigned)__builtin_amdgcn_s_getreg((3 << 11) | 20) & 0xFu; }
#define XB_SPIN(cond, bar) do { unsigned _sp = 0; while (cond) { __builtin_amdgcn_s_sleep(1); \
    if ((++_sp & 255u) == 0u) { if (xb_ld(&(bar)[XB_TMO])) break; if (_sp > XB_SPIN_CAP) { atomicAdd(&(bar)[XB_TMO], 1u); break; } } } } while (0)

struct XcdBarrier {
    unsigned* bar; unsigned x;
    volatile LAS unsigned* st;
};

__device__ __forceinline__ XcdBarrier xcd_barrier_post(unsigned* bar, volatile LAS unsigned* st) {
    XcdBarrier b; b.bar = bar; b.x = xb_xcc_id(); b.st = st;
    if (threadIdx.x == 0) (void)xb_add(&bar[XB_XCNT(b.x)], 1u);
    return b;
}
__device__ __forceinline__ void xcd_barrier_complete(unsigned* bar, unsigned x, unsigned& nloc, unsigned& nx) {
    const unsigned G = gridDim.x * gridDim.y * gridDim.z;
    unsigned sum, cnt, mine, sp = 0u;
    for (;;) {
        sum = 0u; cnt = 0u; mine = 0u;
#pragma unroll
        for (unsigned j = 0; j < 16; ++j) { const unsigned c = xb_ld(&bar[XB_XCNT(j)]); sum += c; cnt += (c > 0u) ? 1u : 0u; mine = (j == x) ? c : mine; }
        if (sum == G) break;
        __builtin_amdgcn_s_sleep(1);
        if ((++sp & 255u) == 0u) { if (xb_ld(&bar[XB_TMO])) break; if (sp > XB_SPIN_CAP) { atomicAdd(&bar[XB_TMO], 1u); break; } }
    }
    nloc = mine > 0u ? mine : 1u; nx = cnt > 0u ? cnt : 1u;
}

__device__ __forceinline__ void xcd_barrier(const XcdBarrier& b) {
    asm volatile("s_waitcnt vmcnt(0)" ::: "memory");
    __syncthreads();
    if (threadIdx.x == 0) {
        unsigned* bar = b.bar;
        __builtin_amdgcn_s_waitcnt(0);
        unsigned nloc = b.st[0], nx = b.st[1];
        if (nloc == 0u) { xcd_barrier_complete(bar, b.x, nloc, nx); b.st[0] = nloc; b.st[1] = nx; }
        const unsigned old = xb_add(&bar[XB_XSUB(b.x)], 1u);
        const unsigned gen = old / nloc;
        if (old + 1u == (gen + 1u) * nloc) {
            __builtin_amdgcn_fence(__ATOMIC_RELEASE, "agent");
            asm volatile("s_waitcnt vmcnt(0)" ::: "memory");
            const unsigned og = xb_add(&bar[XB_TOP], 1u);
            const unsigned tg = og / nx;
            if (og + 1u == (tg + 1u) * nx) xb_add(&bar[XB_TOPGEN], 1u);
            else XB_SPIN(xb_ld(&bar[XB_TOPGEN]) == tg, bar);
            __builtin_amdgcn_fence(__ATOMIC_ACQUIRE, "agent");
            xb_add(&bar[XB_XGEN(b.x)], 1u);
            asm volatile("s_waitcnt vmcnt(0)" ::: "memory");
        } else {
            XB_SPIN(xb_ld(&bar[XB_XGEN(b.x)]) == gen, bar);
            __builtin_amdgcn_fence(__ATOMIC_ACQUIRE, "agent");
            asm volatile("s_waitcnt vmcnt(0)" ::: "memory");
        }
    }
    __syncthreads();
}

typedef short bf16x8_t __attribute__((ext_vector_type(8)));
typedef short s16x4_t __attribute__((ext_vector_type(4)));
constexpr int AT_PITCH = 144;
constexpr int AT_KL = 0, AT_VL = 384 * AT_PITCH;
constexpr int N_ATT_ITEMS = 768;
constexpr int AT_ROWS = 384;
struct AttnKQ { v4u k[6], q[4]; };
__device__ __forceinline__ void attn_decode(int it2, int& g, int& slot, int& d, int& r, int& n) {
    g = it2 >> 8; const int rem = it2 & 255; slot = rem & 7; const int rest = rem >> 3; const int sh = 2 * g; d = 1 << sh; r = rest >> (5 - sh); n = 2 * (rest & ((32 >> sh) - 1));
}
__device__ __forceinline__ bool it_first_block(int it2) { int g, slot, d, r, n; attn_decode(it2, g, slot, d, r, n); return n == 0; }
__device__ __forceinline__ void attn_load_kq(AttnKQ& R, const bf16* PROJ_, int it, int tid, int wave, int lane) {
    int g, slot, d, r, n; attn_decode(it, g, slot, d, r, n); const int hd = g * 8 + slot; const int c = tid & 7;
#pragma unroll
    for (int p = 0; p < 6; ++p) { const int row = p * 64 + (tid >> 3); const int sp = (n - 1) * 128 + row;
        if (n > 0 || p >= 2) R.k[p] = *(const GAS v4u*)((const GAS bf16*)PROJ_ + (size_t)(sp * d + r) * PLD + 1536 + hd * 64 + c * 8);
        else R.k[p] = (v4u){0u, 0u, 0u, 0u}; }
    const int fr = lane & 15, fq = lane >> 4; const GAS bf16* qb = (const GAS bf16*)PROJ_ + (size_t)((n * 128 + 16 * wave + fr) * d + r) * PLD + hd * 64 + 8 * fq;
    R.q[0] = *(const GAS v4u*)(qb); R.q[1] = *(const GAS v4u*)(qb + 32);
    const GAS bf16* qb2 = qb + (size_t)128 * d * PLD; R.q[2] = *(const GAS v4u*)(qb2); R.q[3] = *(const GAS v4u*)(qb2 + 32);
}
__device__ __forceinline__ void attn_load_v(v4u (&V)[6], const bf16* PROJ_, int it, int tid) {
    int g, slot, d, r, n; attn_decode(it, g, slot, d, r, n); const int hd = g * 8 + slot; const int c = tid & 7;
#pragma unroll
    for (int p = 0; p < 6; ++p) { const int row = p * 64 + (tid >> 3); const int sp = (n - 1) * 128 + row;
        if (n > 0 || p >= 2) V[p] = *(const GAS v4u*)((const GAS bf16*)PROJ_ + (size_t)(sp * d + r) * PLD + 3072 + hd * 64 + c * 8);
        else V[p] = (v4u){0u, 0u, 0u, 0u}; }
}
__device__ __forceinline__ void attn_stage_k(const AttnKQ& R, LAS unsigned char* lds, const float (&gkr)[8], int tid) {
    const int c = tid & 7;
#pragma unroll
    for (int p = 0; p < 6; ++p) { const int row = p * 64 + (tid >> 3); float f[8]; pg8::unpack8(R.k[p], f); float ss = 0.f;
#pragma unroll
        for (int i = 0; i < 8; ++i) ss += f[i] * f[i];
        ss += __shfl_xor(ss, 1); ss += __shfl_xor(ss, 2); ss += __shfl_xor(ss, 4);
        const float rs = __builtin_amdgcn_rsqf(ss * (1.0f / 64.0f) + EPS);
#pragma unroll
        for (int i = 0; i < 8; ++i) f[i] = f[i] * (rs * gkr[i]);
        *(LAS v4u*)(lds + AT_KL + row * AT_PITCH + c * 16) = pg8::pack8(f); }
}
__device__ __forceinline__ void attn_stage_v(const v4u (&V)[6], LAS unsigned char* lds, int tid) {
    const int c = tid & 7;
#pragma unroll
    for (int p = 0; p < 6; ++p) { const int row = p * 64 + (tid >> 3); *(LAS v4u*)(lds + AT_VL + row * AT_PITCH + c * 16) = V[p]; }
}
__device__ __forceinline__ void attn_scores(f32x4 (&sc)[9], float& mx, float& den, v4u q0, v4u q1, LAS unsigned char* lds, const float (&gqr)[16], int koff, bool firstblk, int wave, int lane) {
    const int fr = lane & 15, fq = lane >> 4, w = wave;
    float qf[16]; { float t0[8], t1[8]; pg8::unpack8(q0, t0); pg8::unpack8(q1, t1);
#pragma unroll
        for (int i = 0; i < 8; ++i) { qf[i] = t0[i]; qf[8 + i] = t1[i]; } }
    float ss = 0.f;
#pragma unroll
    for (int i = 0; i < 16; ++i) ss += qf[i] * qf[i];
    ss += __shfl_xor(ss, 16); ss += __shfl_xor(ss, 32);
    const float qs = __builtin_amdgcn_rsqf(ss * (1.0f / 64.0f) + EPS) * (0.125f * 1.4426950408889634f);
    bf16x8_t qa[2];
    { float t0[8], t1[8];
#pragma unroll
      for (int i = 0; i < 8; ++i) { t0[i] = qf[i] * (qs * gqr[i]); t1[i] = qf[8 + i] * (qs * gqr[8 + i]); }
      qa[0] = __builtin_bit_cast(bf16x8_t, pg8::pack8(t0)); qa[1] = __builtin_bit_cast(bf16x8_t, pg8::pack8(t1)); }
#pragma unroll
    for (int kti = 0; kti < 9; ++kti) { f32x4 acc = (f32x4){0.f, 0.f, 0.f, 0.f}; const LAS unsigned char* kp = lds + AT_KL + ((koff + w + kti) * 16 + fr) * AT_PITCH + fq * 16;
#pragma unroll
        for (int ks = 0; ks < 2; ++ks) { const bf16x8_t kf = *(const LAS bf16x8_t*)(kp + ks * 64); acc = __builtin_amdgcn_mfma_f32_16x16x32_bf16(kf, qa[ks], acc, 0, 0, 0); }
        sc[kti] = acc; if (kti % 3 == 2) __builtin_amdgcn_sched_barrier(0); }
    mx = -INFINITY;
#pragma unroll
    for (int j = 0; j < 4; ++j) { if (4 * fq + j < fr) sc[0][j] = -INFINITY; if (4 * fq + j > fr) sc[8][j] = -INFINITY; }
    if (firstblk) {
#pragma unroll
        for (int kti = 0; kti < 9; ++kti) if (w + kti < 8) sc[kti] = (f32x4){-INFINITY, -INFINITY, -INFINITY, -INFINITY}; }
#pragma unroll
    for (int kti = 0; kti < 9; ++kti)
#pragma unroll
        for (int j = 0; j < 4; ++j) mx = fmaxf(mx, sc[kti][j]);
    mx = fmaxf(mx, __shfl_xor(mx, 16)); mx = fmaxf(mx, __shfl_xor(mx, 32));
    den = 0.f;
#pragma unroll
    for (int kti = 0; kti < 9; ++kti)
#pragma unroll
        for (int j = 0; j < 4; ++j) { const float pv = __builtin_amdgcn_exp2f(sc[kti][j] - mx); sc[kti][j] = pv; den += pv; }
    den += __shfl_xor(den, 16); den += __shfl_xor(den, 32);
    __builtin_amdgcn_sched_barrier(0);
}
__device__ __forceinline__ void attn_pv(const f32x4 (&sc)[9], float mx, float den, LAS unsigned char* lds, bf16* PROJ_, float* ML_, int it, int koff, int wave, int lane, bool do_store) {
    int g, slot, d, r, n; attn_decode(it, g, slot, d, r, n); const int hd = g * 8 + slot; n += koff >> 3;
    const int fr = lane & 15, fq = lane >> 4, w = wave;
    f32x4 o[4];
#pragma unroll
    for (int et = 0; et < 4; ++et) o[et] = (f32x4){0.f, 0.f, 0.f, 0.f};
    const int q_ = (lane >> 2) & 3, p_ = lane & 3;
#pragma unroll
    for (int kk = 0; kk < 5; ++kk) { const int kt0 = koff + w + 2 * kk, kt1 = (kk < 4) ? kt0 + 1 : kt0;
        v4u aw; aw.x = pg8::cvt_pk_bf16(sc[2 * kk][0], sc[2 * kk][1]); aw.y = pg8::cvt_pk_bf16(sc[2 * kk][2], sc[2 * kk][3]);
        if (kk < 4) { aw.z = pg8::cvt_pk_bf16(sc[(kk < 4) ? 2 * kk + 1 : 0][0], sc[(kk < 4) ? 2 * kk + 1 : 0][1]); aw.w = pg8::cvt_pk_bf16(sc[(kk < 4) ? 2 * kk + 1 : 0][2], sc[(kk < 4) ? 2 * kk + 1 : 0][3]); } else { aw.z = 0u; aw.w = 0u; }
        const bf16x8_t af = __builtin_bit_cast(bf16x8_t, aw);
        const LAS unsigned char* v0 = lds + AT_VL + (kt0 * 16 + 4 * fq + q_) * AT_PITCH + p_ * 8; const LAS unsigned char* v1 = lds + AT_VL + (kt1 * 16 + 4 * fq + q_) * AT_PITCH + p_ * 8;
#pragma unroll
        for (int et = 0; et < 4; ++et) {
            const s16x4_t lo = __builtin_bit_cast(s16x4_t, __builtin_amdgcn_ds_read_tr16_b64_v4i16((LAS s16x4_t*)(v0 + et * 32)));
            const s16x4_t hi = __builtin_bit_cast(s16x4_t, __builtin_amdgcn_ds_read_tr16_b64_v4i16((LAS s16x4_t*)(v1 + et * 32)));
            const bf16x8_t bfr = (bf16x8_t){lo[0], lo[1], lo[2], lo[3], hi[0], hi[1], hi[2], hi[3]};
            o[et] = __builtin_amdgcn_mfma_f32_16x16x32_bf16(af, bfr, o[et], 0, 0, 0); }
        __builtin_amdgcn_sched_barrier(0); }
    if (do_store)
#pragma unroll
    for (int j = 0; j < 4; j += 2) { GAS bf16* op0 = (GAS bf16*)PROJ_ + (size_t)((n * 128 + 16 * w + 4 * fq + j) * d + r) * PLD + hd * 64 + fr; GAS bf16* op1 = op0 + (size_t)d * PLD;
#pragma unroll
        for (int et = 0; et < 4; ++et) { const unsigned wv = pg8::cvt_pk_bf16(o[et][j], o[et][j + 1]); op0[et * 16] = (bf16)(wv & 0xffffu); op1[et * 16] = (bf16)(wv >> 16); } }
    if (fq == 0) { GAS float* mp = (GAS float*)ML_ + (size_t)((n * 128 + 16 * w + fr) * d + r) * 48 + (g * 8 + slot) * 2; mp[0] = mx; mp[1] = den; }
}

constexpr int GL_QG = 0, GL_KG = 17408, GL_KDT = 34816, GL_VTL = 53248, GL_PL = 90112, GL_EB = 99328, GL_PAL = 99840, GL_GT = 103936, GL_SSQ = 105984, GL_RS = 108032, GL_QR = 108544, GL_KR = 124928, GL_UP = 141312;
typedef unsigned u32x2_t __attribute__((ext_vector_type(2)));
struct GlaLd { v4u vt[4], q[2], k[2]; float pa[2]; };
__device__ __forceinline__ void gla_load(GlaLd& L, int b, int h, int tok0, const bf16* PROJ_, const bf16* VT_, const float* PA_, int tid) {
    const GAS float* pap = (const GAS float*)PA_ + (size_t)(b * SEQ + tok0) * 16; L.pa[0] = pap[tid]; L.pa[1] = pap[tid + 512];
#pragma unroll
    for (int i = 0; i < 4; ++i) { const int piece = tid + 512 * i, v = piece >> 3, cc = piece & 7; L.vt[i] = *(const GAS v4u*)((const GAS bf16*)VT_ + (size_t)(h * 256 + v) * SEQ + tok0 + cc * 8); }
#pragma unroll
    for (int i = 0; i < 2; ++i) { const int piece = tid + 512 * i, row = piece >> 4, c16 = piece & 15; const GAS bf16* rp = (const GAS bf16*)PROJ_ + (size_t)(tok0 + row) * PLD + h * 128 + c16 * 8;
        L.k[i] = *(const GAS v4u*)(rp + 5120); L.q[i] = *(const GAS v4u*)(rp + 4608); }
}
__device__ __forceinline__ void gla_stage(const GlaLd& L, LAS unsigned char* lds, int tid) {
    LAS float* PAL = (LAS float*)(lds + GL_PAL); PAL[tid] = L.pa[0]; PAL[tid + 512] = L.pa[1];
#pragma unroll
    for (int i = 0; i < 4; ++i) { const int piece = tid + 512 * i, v = piece >> 3, cc = piece & 7; *(LAS v4u*)(lds + GL_VTL + v * 144 + cc * 16) = L.vt[i]; }
#pragma unroll
    for (int i = 0; i < 2; ++i) { const int piece = tid + 512 * i; *(LAS v4u*)(lds + GL_KR + piece * 16) = L.k[i]; *(LAS v4u*)(lds + GL_QR + piece * 16) = L.q[i]; }
}
__device__ __forceinline__ float fexp(float x) { return __builtin_amdgcn_exp2f(x * 1.4426950408889634f); }
__device__ __forceinline__ float log_sigmoid_fast(float x) { return fminf(x, 0.f) - 0.6931471805599453f * __builtin_amdgcn_logf(1.0f + __builtin_amdgcn_exp2f(fabsf(x) * -1.4426950408889634f)); }
__device__ __forceinline__ void gla_local(LAS unsigned char* lds, int b, int item, const bf16* PROJ_, const bf16* VT_, const float* PA_, const float* gate_up_, const float* gate_bias_,
                                          float* SBUF_, float* DBUF_, bf16* A2_, bf16* QGS_, int tid_in, int wave, int lane_in) {
    int tid = tid_in, lane = lane_in; asm volatile("" : "+v"(tid), "+v"(lane));
    const int h = item >> 5, seg = item & 31;
    const int w = wave;
    GlaLd L; gla_load(L, b, h, seg * 256, PROJ_, VT_, PA_, tid);
    { LAS float* UP = (LAS float*)(lds + GL_UP);
#pragma unroll
      for (int i = 0; i < 4; ++i) { const int idx = tid + 512 * i, r = idx >> 7, k2 = idx & 127; UP[k2 * 20 + r] = gate_up_[r * 512 + h * 128 + k2]; } }
    const float bk = gate_bias_[h * 128 + (tid & 127)];
    f32x4 S[8][2];
#pragma unroll
    for (int mtk = 0; mtk < 8; ++mtk) { S[mtk][0] = (f32x4){0.f, 0.f, 0.f, 0.f}; S[mtk][1] = (f32x4){0.f, 0.f, 0.f, 0.f}; }
    float segsum = 0.f;
    asm volatile("" :: "v"(bk), "v"(L.k[1]));
    const int tid_item = tid, lane_item = lane;
    for (int c = 0; c < 4; ++c) {
        const int tok0 = seg * 256 + c * 64;
        int tid = tid_item, lane = lane_item; asm volatile("" : "+v"(tid), "+v"(lane));
        const int kd = tid & 127, tq = tid >> 7, fr = lane & 15, fq = lane >> 4;
        gla_stage(L, lds, tid);
        LDS_BARRIER();
        if (c < 3) gla_load(L, b, h, tok0 + 64, PROJ_, VT_, PA_, tid);
        { const LAS float* pal = (const LAS float*)(lds + GL_PAL); const LAS float* upl = (const LAS float*)(lds + GL_UP) + (16 * w + fr) * 20 + fq;
          const float ub0 = upl[0], ub1 = upl[4], ub2 = upl[8], ub3 = upl[12];
#pragma unroll
          for (int mt = 0; mt < 4; ++mt) { const LAS float* pa4 = pal + (16 * mt + fr) * 16 + fq; f32x4 lacc = (f32x4){0.f, 0.f, 0.f, 0.f};
              lacc = __builtin_amdgcn_mfma_f32_16x16x4f32(pa4[0], ub0, lacc, 0, 0, 0); lacc = __builtin_amdgcn_mfma_f32_16x16x4f32(pa4[4], ub1, lacc, 0, 0, 0);
              lacc = __builtin_amdgcn_mfma_f32_16x16x4f32(pa4[8], ub2, lacc, 0, 0, 0); lacc = __builtin_amdgcn_mfma_f32_16x16x4f32(pa4[12], ub3, lacc, 0, 0, 0);
#pragma unroll
              for (int j = 0; j < 4; ++j) ((LAS float*)lds)[(16 * mt + 4 * fq + j) * 128 + 16 * w + fr] = lacc[j]; } }
        LDS_BARRIER();
        float cb[16];
        { float run = 0.f;
#pragma unroll
          for (int i = 0; i < 16; ++i) { const int t = 16 * tq + i; const float lg = bk + ((const LAS float*)lds)[t * 128 + kd];
              run += log_sigmoid_fast(lg) * (1.0f / 16.0f); cb[i] = run; } }
        { LAS float* GT = (LAS float*)(lds + GL_GT); GT[tq * 128 + kd] = cb[15]; }
        LDS_BARRIER();
        float off = 0.f, tot = 0.f;
        { const LAS float* GT = (const LAS float*)(lds + GL_GT);
#pragma unroll
          for (int q = 0; q < 4; ++q) { const float gv = GT[q * 128 + kd]; tot += gv; off += (q < tq) ? gv : 0.f; } }
        const float etot = fexp(tot), eseg = fexp(segsum);
        { float kdv[16];
          GAS bf16* qgs = (GAS bf16*)QGS_ + (size_t)(tok0 + 16 * tq) * 512 + h * 128 + kd;
#pragma unroll
          for (int i = 0; i < 16; i += 2) { const int t = 16 * tq + i; const float bc0 = cb[i] + off, bc1 = cb[i + 1] + off;
              const float kf0 = bf2f(*(const LAS unsigned short*)(lds + GL_KR + t * 256 + kd * 2)), kf1 = bf2f(*(const LAS unsigned short*)(lds + GL_KR + (t + 1) * 256 + kd * 2));
              const float en0 = fexp(-bc0), en1 = fexp(-bc1);
              const float kg0 = kf0 * en0, kg1 = kf1 * en1; kdv[i] = kg0 * etot; kdv[i + 1] = kg1 * etot;
              const float qf0 = bf2f(*(const LAS unsigned short*)(lds + GL_QR + t * 256 + kd * 2)), qf1 = bf2f(*(const LAS unsigned short*)(lds + GL_QR + (t + 1) * 256 + kd * 2));
              const float qg0 = qf0 * fexp(bc0), qg1 = qf1 * fexp(bc1);
              const unsigned qw = pg8::cvt_pk_bf16(qg0, qg1), kw = pg8::cvt_pk_bf16(kg0, kg1), sw = pg8::cvt_pk_bf16(qg0 * eseg, qg1 * eseg);
              *(LAS unsigned short*)(lds + GL_QG + t * 272 + kd * 2) = (unsigned short)(qw & 0xffffu); *(LAS unsigned short*)(lds + GL_QG + (t + 1) * 272 + kd * 2) = (unsigned short)(qw >> 16);
              *(LAS unsigned short*)(lds + GL_KG + t * 272 + kd * 2) = (unsigned short)(kw & 0xffffu); *(LAS unsigned short*)(lds + GL_KG + (t + 1) * 272 + kd * 2) = (unsigned short)(kw >> 16);
              qgs[(size_t)i * 512] = (bf16)(sw & 0xffffu); qgs[(size_t)(i + 1) * 512] = (bf16)(sw >> 16); }
          float lo8[8], hi8[8];
#pragma unroll
          for (int i = 0; i < 8; ++i) { lo8[i] = kdv[i]; hi8[i] = kdv[8 + i]; }
          *(LAS v4u*)(lds + GL_KDT + kd * 144 + tq * 32) = pg8::pack8(lo8); *(LAS v4u*)(lds + GL_KDT + kd * 144 + tq * 32 + 16) = pg8::pack8(hi8); }
        if (tq == 0) ((LAS float*)(lds + GL_EB))[kd] = etot;
        segsum += tot;
        LDS_BARRIER();
        {
            const int mt = w >> 1;
#pragma unroll
            for (int sti = 0; sti < 2; ++sti) { const int st = 2 * (w & 1) + sti; f32x4 acc = (f32x4){0.f, 0.f, 0.f, 0.f};
                if (st <= mt) {
#pragma unroll
                    for (int ks = 0; ks < 4; ++ks) { const bf16x8_t kf = *(const LAS bf16x8_t*)(lds + GL_KG + (16 * st + fr) * 272 + (32 * ks + 8 * fq) * 2);
                        const bf16x8_t qf = *(const LAS bf16x8_t*)(lds + GL_QG + (16 * mt + fr) * 272 + (32 * ks + 8 * fq) * 2);
                        acc = __builtin_amdgcn_mfma_f32_16x16x32_bf16(kf, qf, acc, 0, 0, 0); }
                    if (st == mt) {
#pragma unroll
                        for (int j = 0; j < 4; ++j) if (4 * fq + j > fr) acc[j] = 0.f; } }
                u32x2_t wv; wv.x = pg8::cvt_pk_bf16(acc[0], acc[1]); wv.y = pg8::cvt_pk_bf16(acc[2], acc[3]);
                *(LAS u32x2_t*)(lds + GL_PL + (16 * mt + fr) * 144 + (16 * st + 4 * fq) * 2) = wv; }
            LDS_BARRIER();
        }
        bf16x8_t vf[2][2];
#pragma unroll
        for (int ks2 = 0; ks2 < 2; ++ks2)
#pragma unroll
            for (int nt = 0; nt < 2; ++nt) vf[ks2][nt] = *(const LAS bf16x8_t*)(lds + GL_VTL + (32 * w + 16 * nt + fr) * 144 + (32 * ks2 + 8 * fq) * 2);
        f32x4 o[4][2];
#pragma unroll
        for (int mt = 0; mt < 4; ++mt) { o[mt][0] = (f32x4){0.f, 0.f, 0.f, 0.f}; o[mt][1] = (f32x4){0.f, 0.f, 0.f, 0.f}; }
#pragma unroll
        for (int ks = 0; ks < 4; ++ks) { bf16x8_t bfr[2];
#pragma unroll
            for (int nt = 0; nt < 2; ++nt) { v4u wv; wv.x = pg8::cvt_pk_bf16(S[2 * ks][nt][0], S[2 * ks][nt][1]); wv.y = pg8::cvt_pk_bf16(S[2 * ks][nt][2], S[2 * ks][nt][3]);
                wv.z = pg8::cvt_pk_bf16(S[2 * ks + 1][nt][0], S[2 * ks + 1][nt][1]); wv.w = pg8::cvt_pk_bf16(S[2 * ks + 1][nt][2], S[2 * ks + 1][nt][3]); bfr[nt] = __builtin_bit_cast(bf16x8_t, wv); }
#pragma unroll
            for (int mt = 0; mt < 4; ++mt) { const u32x2_t a0 = *(const LAS u32x2_t*)(lds + GL_QG + (16 * mt + fr) * 272 + (32 * ks + 4 * fq) * 2), a1 = *(const LAS u32x2_t*)(lds + GL_QG + (16 * mt + fr) * 272 + (32 * ks + 16 + 4 * fq) * 2);
                const v4u aw = (v4u){a0.x, a0.y, a1.x, a1.y}; const bf16x8_t af = __builtin_bit_cast(bf16x8_t, aw);
                o[mt][0] = __builtin_amdgcn_mfma_f32_16x16x32_bf16(bfr[0], af, o[mt][0], 0, 0, 0); o[mt][1] = __builtin_amdgcn_mfma_f32_16x16x32_bf16(bfr[1], af, o[mt][1], 0, 0, 0); } }
#pragma unroll
        for (int ks2 = 0; ks2 < 2; ++ks2)
#pragma unroll
            for (int mt = 0; mt < 4; ++mt) { const bf16x8_t pf = *(const LAS bf16x8_t*)(lds + GL_PL + (16 * mt + fr) * 144 + (32 * ks2 + 8 * fq) * 2);
                o[mt][0] = __builtin_amdgcn_mfma_f32_16x16x32_bf16(vf[ks2][0], pf, o[mt][0], 0, 0, 0); o[mt][1] = __builtin_amdgcn_mfma_f32_16x16x32_bf16(vf[ks2][1], pf, o[mt][1], 0, 0, 0); }
#pragma unroll
        for (int mtk = 0; mtk < 8; ++mtk) { const f32x4 eb = *(const LAS f32x4*)(lds + GL_EB + (16 * mtk + 4 * fq) * 4);
            S[mtk][0] = S[mtk][0] * eb; S[mtk][1] = S[mtk][1] * eb;
#pragma unroll
            for (int ks2 = 0; ks2 < 2; ++ks2) { const bf16x8_t kf = *(const LAS bf16x8_t*)(lds + GL_KDT + (16 * mtk + fr) * 144 + (32 * ks2 + 8 * fq) * 2);
                S[mtk][0] = __builtin_amdgcn_mfma_f32_16x16x32_bf16(kf, vf[ks2][0], S[mtk][0], 0, 0, 0); S[mtk][1] = __builtin_amdgcn_mfma_f32_16x16x32_bf16(kf, vf[ks2][1], S[mtk][1], 0, 0, 0); } }
        LDS_BARRIER();
#pragma unroll
        for (int mt = 0; mt < 4; ++mt)
#pragma unroll
            for (int nt = 0; nt < 2; ++nt) { u32x2_t wv; wv.x = pg8::cvt_pk_bf16(o[mt][nt][0], o[mt][nt][1]); wv.y = pg8::cvt_pk_bf16(o[mt][nt][2], o[mt][nt][3]);
                *(LAS u32x2_t*)(lds + (16 * mt + fr) * 528 + (32 * w + 16 * nt + 4 * fq) * 2) = wv; }
        LDS_BARRIER();
#pragma unroll
        for (int i = 0; i < 4; ++i) { const int piece = tid + 512 * i, t = piece >> 5, c8 = piece & 31;
            *(GAS v4u*)((GAS bf16*)A2_ + (size_t)(b * SEQ + tok0 + t) * DM + h * 256 + c8 * 8) = *(const LAS v4u*)(lds + t * 528 + c8 * 16); }
    }
#pragma unroll
    for (int mtk = 0; mtk < 8; ++mtk)
#pragma unroll
        for (int nt = 0; nt < 2; ++nt)
#pragma unroll
            for (int j = 0; j < 4; ++j) ((GAS float*)SBUF_)[((size_t)item * 64 + (mtk * 2 + nt) * 4 + j) * 512 + tid] = S[mtk][nt][j];
    if ((tid >> 7) == 0) ((GAS float*)DBUF_)[item * 128 + (tid & 127)] = fexp(segsum);
    LDS_BARRIER();
}
constexpr int GF_QG = 0, GF_OL = 17408, GF_SSQ = 51200, GF_RS = 53248;
__device__ __forceinline__ void gla_fix(LAS unsigned char* lds, int b, int unit, const bf16* PROJ_, const bf16* SB16_, bf16* A2_, const bf16* QGS_, int tid_in, int wave, int lane_in) {
    int tid = tid_in, lane = lane_in; asm volatile("" : "+v"(tid), "+v"(lane));
    const int item = unit >> 1, half = unit & 1, h = item >> 5, seg = item & 31, w = wave, fr = lane & 15, fq = lane >> 4;
    bf16x8_t bfr[4][2];
#pragma unroll
    for (int ks = 0; ks < 4; ++ks)
#pragma unroll
        for (int nt = 0; nt < 2; ++nt) { unsigned hv[8];
#pragma unroll
            for (int j = 0; j < 4; ++j) { hv[j] = ((const GAS unsigned short*)SB16_)[((size_t)item * 64 + ((2 * ks) * 2 + nt) * 4 + j) * 512 + tid]; hv[4 + j] = ((const GAS unsigned short*)SB16_)[((size_t)item * 64 + ((2 * ks + 1) * 2 + nt) * 4 + j) * 512 + tid]; }
            const v4u wv = (v4u){hv[0] | (hv[1] << 16), hv[2] | (hv[3] << 16), hv[4] | (hv[5] << 16), hv[6] | (hv[7] << 16)};
            bfr[ks][nt] = __builtin_bit_cast(bf16x8_t, wv); }
    for (int cc = 0; cc < 2; ++cc) {
        const int tok0 = seg * 256 + (2 * half + cc) * 64;
        v4u rg[4], ol[4], qg[2];
#pragma unroll
        for (int i = 0; i < 4; ++i) { const int piece = tid + 512 * i, t = piece >> 5, c8 = piece & 31;
            rg[i] = *(const GAS v4u*)((const GAS bf16*)PROJ_ + (size_t)(tok0 + t) * PLD + 5632 + h * 256 + c8 * 8);
            ol[i] = *(const GAS v4u*)((const GAS bf16*)A2_ + (size_t)(b * SEQ + tok0 + t) * DM + h * 256 + c8 * 8); }
#pragma unroll
        for (int i = 0; i < 2; ++i) { const int piece = tid + 512 * i, t = piece >> 4, c16 = piece & 15; qg[i] = *(const GAS v4u*)((const GAS bf16*)QGS_ + (size_t)(tok0 + t) * 512 + h * 128 + c16 * 8); }
        LDS_BARRIER();
#pragma unroll
        for (int i = 0; i < 4; ++i) { const int piece = tid + 512 * i, t = piece >> 5, c8 = piece & 31; *(LAS v4u*)(lds + GF_OL + t * 528 + c8 * 16) = ol[i]; }
#pragma unroll
        for (int i = 0; i < 2; ++i) { const int piece = tid + 512 * i, t = piece >> 4, c16 = piece & 15; *(LAS v4u*)(lds + GF_QG + t * 272 + c16 * 16) = qg[i]; }
        LDS_BARRIER();
        f32x4 o[4][2];
#pragma unroll
        for (int mt = 0; mt < 4; ++mt)
#pragma unroll
            for (int nt = 0; nt < 2; ++nt) { const u32x2_t wv = *(const LAS u32x2_t*)(lds + GF_OL + (16 * mt + fr) * 528 + (32 * w + 16 * nt + 4 * fq) * 2);
                o[mt][nt] = (f32x4){pg8::bflo(wv.x), pg8::bfhi(wv.x), pg8::bflo(wv.y), pg8::bfhi(wv.y)}; }
#pragma unroll
        for (int ks = 0; ks < 4; ++ks)
#pragma unroll
            for (int mt = 0; mt < 4; ++mt) { const u32x2_t a0 = *(const LAS u32x2_t*)(lds + GF_QG + (16 * mt + fr) * 272 + (32 * ks + 4 * fq) * 2), a1 = *(const LAS u32x2_t*)(lds + GF_QG + (16 * mt + fr) * 272 + (32 * ks + 16 + 4 * fq) * 2);
                const v4u aw = (v4u){a0.x, a0.y, a1.x, a1.y}; const bf16x8_t af = __builtin_bit_cast(bf16x8_t, aw);
                o[mt][0] = __builtin_amdgcn_mfma_f32_16x16x32_bf16(bfr[ks][0], af, o[mt][0], 0, 0, 0); o[mt][1] = __builtin_amdgcn_mfma_f32_16x16x32_bf16(bfr[ks][1], af, o[mt][1], 0, 0, 0); }
#pragma unroll
        for (int mt = 0; mt < 4; ++mt) { float sq = 0.f;
#pragma unroll
            for (int j = 0; j < 4; ++j) sq += o[mt][0][j] * o[mt][0][j] + o[mt][1][j] * o[mt][1][j];
            sq += __shfl_xor(sq, 16); sq += __shfl_xor(sq, 32);
            if (fq == 0) ((LAS float*)(lds + GF_SSQ))[w * 64 + 16 * mt + fr] = sq; }
        LDS_BARRIER();
        if (tid < 64) { const LAS float* sp = (const LAS float*)(lds + GF_SSQ); float tsum = 0.f;
#pragma unroll
            for (int q = 0; q < 8; ++q) tsum += sp[q * 64 + tid];
            ((LAS float*)(lds + GF_RS))[tid] = 1.0f / sqrtf(tsum * (1.0f / 256.0f) + EPS); }
        LDS_BARRIER();
#pragma unroll
        for (int mt = 0; mt < 4; ++mt) { const float rs = ((const LAS float*)(lds + GF_RS))[16 * mt + fr];
#pragma unroll
            for (int nt = 0; nt < 2; ++nt) { u32x2_t wv; wv.x = pg8::cvt_pk_bf16(o[mt][nt][0] * rs, o[mt][nt][1] * rs); wv.y = pg8::cvt_pk_bf16(o[mt][nt][2] * rs, o[mt][nt][3] * rs);
                *(LAS u32x2_t*)(lds + GF_OL + (16 * mt + fr) * 528 + (32 * w + 16 * nt + 4 * fq) * 2) = wv; } }
        LDS_BARRIER();
#pragma unroll
        for (int i = 0; i < 4; ++i) { const int piece = tid + 512 * i, t = piece >> 5, c8 = piece & 31; float ov[8], rv[8];
            pg8::unpack8(*(const LAS v4u*)(lds + GF_OL + t * 528 + c8 * 16), ov); pg8::unpack8(rg[i], rv);
#pragma unroll
            for (int e2 = 0; e2 < 8; ++e2) ov[e2] *= rv[e2];
            *(GAS v4u*)((GAS bf16*)A2_ + (size_t)(b * SEQ + tok0 + t) * DM + h * 256 + c8 * 8) = pg8::pack8(ov); }
    }
    LDS_BARRIER();
}

__global__ void __launch_bounds__(NTHREADS, 2) fwd_kernel(Args a) {
    extern __shared__ __attribute__((aligned(16))) unsigned char lds_raw[];
    LAS unsigned char* lds = (LAS unsigned char*)lds_raw;
    cg::grid_group grid = cg::this_grid();
    const int tid = threadIdx.x, lane = tid & 63, wave = __builtin_amdgcn_readfirstlane(tid >> 6);
    const int G = gridDim.x, bx = blockIdx.x;
    const int gw = bx * NWAVES + wave, NGW = G * NWAVES;
    unsigned char* ws = a.ws;
    const float* x = a.in[0]; const float* g1 = a.in[1]; const float* w_in = a.in[2]; const float* gq = a.in[3]; const float* gk = a.in[4];
    const float* gate_up = a.in[5]; const float* gate_bias = a.in[6]; const float* gla_g = a.in[7]; const float* bgate_bias = a.in[8];
    const float* w_ab = a.in[9]; const float* w_gb = a.in[10]; const float* w_out = a.in[11]; const float* g2 = a.in[12]; const float* w_up = a.in[13]; const float* w_dn = a.in[14];
    bf16* WIN = (bf16*)(ws + WS_WIN); bf16* WA = (bf16*)(ws + WS_WA); bf16* WB = (bf16*)(ws + WS_WB); bf16* WO = (bf16*)(ws + WS_WO);
    bf16* WUP = (bf16*)(ws + WS_WUP); bf16* WDN = (bf16*)(ws + WS_WDN); bf16* XB = (bf16*)(ws + WS_XB); bf16* PROJ = (bf16*)(ws + WS_PROJ);
    bf16* VT = (bf16*)(ws + WS_VT); bf16* A1 = (bf16*)(ws + WS_A1); bf16* A2 = (bf16*)(ws + WS_A2);
    float* R1 = (float*)(ws + WS_R1); float* PA = (float*)(ws + WS_PA); float* SS2 = (float*)(ws + WS_SS2);
    bf16* MIXED = (bf16*)(ws + WS_MIXED); bf16* UB = (bf16*)(ws + WS_U); bf16* GATES = (bf16*)a.out;
    const int lo = a.ph_lo, hi = a.ph_hi; const int repm = a.rep;
    if (tid < 16) ((LAS unsigned*)(lds + LDS_BARST))[tid] = 0u;
    __syncthreads();
#define TS(i) do { if (TPROBE >= 0 && bx == TPBLK && tid == 0) ((LAS unsigned long long*)(lds + LDS_BARST + 16))[0 + ((i) == TPROBE ? 0 : ((i) == TPB ? 1 : 2))] = __builtin_amdgcn_s_memrealtime(); } while (0)
    TS(0);
    if (a.ph_lo < 0) grid.sync();
    if (a.ph_lo == 0) {
        unsigned* bw = (unsigned*)(ws + WS_BAR);
        if (bx == 0) { for (int i = tid; i < 4032; i += NTHREADS) bw[i] = 0u;
            asm volatile("s_waitcnt vmcnt(0)" ::: "memory"); __syncthreads();
            if (tid == 0) { __builtin_amdgcn_fence(__ATOMIC_RELEASE, "agent"); asm volatile("s_waitcnt vmcnt(0)" ::: "memory"); __hip_atomic_store(bw + 4064, 0x600DBA55u, __ATOMIC_RELAXED, __HIP_MEMORY_SCOPE_AGENT); } }
        if (tid == 0) { unsigned sp_ = 0; while (xb_ld(bw + 4064) != 0x600DBA55u) { __builtin_amdgcn_s_sleep(1); if (++sp_ > (1u << 22)) break; }
            __builtin_amdgcn_fence(__ATOMIC_ACQUIRE, "agent"); asm volatile("s_waitcnt vmcnt(0)" ::: "memory");
            (void)xb_add(bw + XB_XCNT(xb_xcc_id()), 1u); }
        __syncthreads();
    }
#define NREP(bit) (REPMASK ? (((repm >> (bit)) & 1) + 1) : 1)
#define IN(k) (lo <= (k) && (k) < hi)
#define LAUNDER(p) asm volatile("" : "+s"(p))
#define XBAR_OBJ(bb) XcdBarrier bb; bb.bar = (unsigned*)(ws + WS_BAR); bb.x = xb_xcc_id(); bb.st = (volatile LAS unsigned*)(lds + LDS_BARST)
#define SYNC(k) do { if (IN(k) && IN((k) + 1)) { asm volatile("s_waitcnt vmcnt(0) lgkmcnt(0)" ::: "memory"); \
        XBAR_OBJ(bb_); for (int rs_ = 0; rs_ < NREP(8); ++rs_) xcd_barrier(bb_); } } while (0)

    TS(39);
    if (IN(0)) for (int rep_ = 0; rep_ < NREP(0); ++rep_) {
        LAS float* scr = (LAS float*)(lds + wave * 16640);
        constexpr int I_IN = 16 * 152, I_A = 8 * 16, I_B = 16 * 16, I_O = 16 * 16, I_UP = 16 * 64, I_DN = 64 * 16;
        constexpr int NITEMS = I_IN + I_A + I_B + I_O + I_UP + I_DN;
        for (int it = wave * G + bx; it < NITEMS; it += NGW) {
            int r = it;
            if (r < I_IN) { const int kb = r / 152, nb = r % 152; const int n0 = nb * 64; const int src = n0 < 7680 ? n0 : n0 + 16;
                const float cs = (n0 >= 4608 && n0 < 5120) ? 0.08838834764831845f : 1.0f;
                p0_transpose_item(w_in, DIN, src, g1, 1023, cs, WIN, 1024, n0, kb * 64, scr, lane); continue; } r -= I_IN;
            if (r < I_A) { const int kb = r / 16, nb = r % 16; p0_transpose_item(w_ab, 1024, nb * 64, nullptr, 0, 1.0f, WA, 512, nb * 64, kb * 64, scr, lane); continue; } r -= I_A;
            if (r < I_B) { const int kb = r / 16, nb = r % 16; p0_transpose_item(w_gb, 1024, nb * 64, gla_g, 255, 1.0f, WB, 1024, nb * 64, kb * 64, scr, lane); continue; } r -= I_B;
            if (r < I_O) { const int kb = r / 16, nb = r % 16; p0_transpose_item(w_out, 1024, nb * 64, nullptr, 0, 1.0f, WO, 1024, nb * 64, kb * 64, scr, lane); continue; } r -= I_O;
            if (r < I_UP) { const int kb = r / 64, nb = r % 64; p0_transpose_item(w_up, 4096, nb * 64, g2, 1023, 1.0f, WUP, 1024, nb * 64, kb * 64, scr, lane); continue; } r -= I_UP;
            { const int kb = r / 16, nb = r % 16; p0_transpose_item(w_dn, 1024, nb * 64, nullptr, 0, 1.0f, WDN, 4096, nb * 64, kb * 64, scr, lane); }
        }
        __syncthreads();
        TS(40);
        LAS float* WAl = (LAS float*)lds;
        for (int idx = tid; idx < 1024 * 16; idx += NTHREADS) { const int k = idx >> 4, r = idx & 15; WAl[k * 20 + r] = w_in[(size_t)k * DIN + 7680 + r] * g1[k]; }
        __syncthreads();
        { const int fr = lane & 15, fq = lane >> 4, half = wave & 1; LAS float* xch = (LAS float*)(lds + 86016) + (wave >> 1) * 320;
          for (int tile = bx * 4 + (wave >> 1); tile < MTOK / 16; tile += G * 4) {
            asm volatile("" ::: "memory");
            const int row = tile * 16 + fr;
            const GAS f32x4* xr = (const GAS f32x4*)(x + (size_t)row * DM) + 2 * fq;
            GAS v4u* xo = (GAS v4u*)(XB + (size_t)row * DM) + fq;
            f32x4 acc = (f32x4){0.f, 0.f, 0.f, 0.f}; float ss = 0.f;
#pragma unroll 1
            for (int jb = 16 * half; jb < 16 * half + 16; jb += 8) {
                f32x4 v[8][2];
#pragma unroll
                for (int u = 0; u < 8; ++u) { v[u][0] = __builtin_nontemporal_load(xr + (jb + u) * 8); v[u][1] = __builtin_nontemporal_load(xr + (jb + u) * 8 + 1); }
#pragma unroll
                for (int u = 0; u < 8; ++u) { const int j = jb + u; const f32x4 a0 = v[u][0], a1 = v[u][1];
                    ss += ((a0[0] * a0[0] + a0[1] * a0[1]) + (a0[2] * a0[2] + a0[3] * a0[3])) + ((a1[0] * a1[0] + a1[1] * a1[1]) + (a1[2] * a1[2] + a1[3] * a1[3]));
                    v4u o; o.x = pk2(a0[0], a0[1]); o.y = pk2(a0[2], a0[3]); o.z = pk2(a1[0], a1[1]); o.w = pk2(a1[2], a1[3]); xo[j * 4] = o;
                    const LAS float* wp = WAl + (32 * j + 8 * fq) * 20 + fr;
                    acc = __builtin_amdgcn_mfma_f32_16x16x4f32(a0[0], wp[0], acc, 0, 0, 0); acc = __builtin_amdgcn_mfma_f32_16x16x4f32(a0[1], wp[20], acc, 0, 0, 0);
                    acc = __builtin_amdgcn_mfma_f32_16x16x4f32(a0[2], wp[40], acc, 0, 0, 0); acc = __builtin_amdgcn_mfma_f32_16x16x4f32(a0[3], wp[60], acc, 0, 0, 0);
                    acc = __builtin_amdgcn_mfma_f32_16x16x4f32(a1[0], wp[80], acc, 0, 0, 0); acc = __builtin_amdgcn_mfma_f32_16x16x4f32(a1[1], wp[100], acc, 0, 0, 0);
                    acc = __builtin_amdgcn_mfma_f32_16x16x4f32(a1[2], wp[120], acc, 0, 0, 0); acc = __builtin_amdgcn_mfma_f32_16x16x4f32(a1[3], wp[140], acc, 0, 0, 0); }
            }
            if (half == 1) { xch[lane] = acc[0]; xch[64 + lane] = acc[1]; xch[128 + lane] = acc[2]; xch[192 + lane] = acc[3]; xch[256 + lane] = ss; }
            __syncthreads();
            if (half == 0) { acc[0] += xch[lane]; acc[1] += xch[64 + lane]; acc[2] += xch[128 + lane]; acc[3] += xch[192 + lane]; ss += xch[256 + lane];
                ss += __shfl_xor(ss, 16); ss += __shfl_xor(ss, 32);
                const float r1 = 1.0f / sqrtf(ss * (1.0f / 1024.0f) + EPS);
#pragma unroll
                for (int j = 0; j < 4; ++j) { const float rr = __shfl(r1, 4 * fq + j); PA[(size_t)(tile * 16 + 4 * fq + j) * 16 + fr] = acc[j] * rr; }
                if (fq == 0) R1[row] = r1; }
            __syncthreads();
          } }
        __syncthreads();
    }
    TS(41);
    SYNC(0); TS(1);
    if (bx == 0 && tid == 0 && a.ph_lo == 0) __hip_atomic_store((unsigned*)(ws + WS_BAR) + 4064, 0u, __ATOMIC_RELAXED, __HIP_MEMORY_SCOPE_AGENT);

    for (int bq = 0; bq < 2; ++bq) {
        int b = bq; LAUNDER(b);
        const int p1 = 1 + 3 * b;
        if (IN(p1)) for (int rep_ = 0; rep_ < NREP(1); ++rep_) {
            pg8::Gemm g{XB + (size_t)b * SEQ * DM, WIN, SEQ, N1, DM}; pg8::StaticOrder S; S.init(SEQ, N1, G, bx);
            pg8::EpiProj E{PROJ, VT, GATES + (size_t)b * SEQ * 2048, R1 + b * SEQ, bgate_bias};
            pg8::gemm_phase<pg8::EpiProj, pg8::StaticOrder, true, true>(lds, g, S, E);
        }
        SYNC(p1); TS(p1 + 1);
        int tid_ = threadIdx.x; asm volatile("" : "+v"(tid_)); const int lane_ = tid_ & 63; const int wave_ = __builtin_amdgcn_readfirstlane(tid_ >> 6); int bx_ = bx; LAUNDER(bx_);
        const float* gate_up_ = gate_up; const float* gate_bias_ = gate_bias; const float* PA_ = PA; const bf16* PROJ_ = PROJ; const bf16* VT_ = VT; bf16* A1_ = A1; bf16* A2_ = A2; const float* gq_ = gq; const float* gk_ = gk;
        float* SBUF_ = (float*)(ws + WS_XB); float* DBUF_ = (float*)(ws + WS_MISC + 2 * MiB); float* ML_ = (float*)(ws + WS_MISC);
        bf16* SB16_ = (b == 0) ? (A2 + (size_t)SEQ * DM) : (XB + (size_t)SEQ * DM);
        LAUNDER(SB16_);
        bf16* QGS_ = (b == 0) ? (A1 + (size_t)SEQ * 512) : (bf16*)(ws + 247 * MiB);
        LAUNDER(QGS_);
        LAUNDER(gate_up_); LAUNDER(gate_bias_); LAUNDER(PA_); LAUNDER(PROJ_); LAUNDER(VT_); LAUNDER(A1_); LAUNDER(A2_); LAUNDER(gq_); LAUNDER(gk_); LAUNDER(SBUF_); LAUNDER(DBUF_); LAUNDER(ML_);
        if (IN(p1 + 1)) {
            if (bx_ < 128) { for (int rep_ = 0; rep_ < NREP(2); ++rep_) { gla_local(lds, b, bx_, PROJ_, VT_, PA_, gate_up_, gate_bias_, SBUF_, DBUF_, A2_, QGS_, tid_, wave_, lane_); }
                if (b == 0) TS(20);
                asm volatile("s_waitcnt vmcnt(0) lgkmcnt(0)" ::: "memory"); __syncthreads();
                if (tid_ == 0) { unsigned* cw = (unsigned*)(ws + WS_BAR) + 3520 + 64 * b;
                    __builtin_amdgcn_fence(__ATOMIC_RELEASE, "agent"); asm volatile("s_waitcnt vmcnt(0)" ::: "memory");
                    (void)xb_add(cw, 1u); }
            }
            if (b == 0) TS(21);
            {
                float gkr[8], gqr[16];
#pragma unroll
                for (int i = 0; i < 8; ++i) gkr[i] = gk_[(tid_ & 7) * 8 + i];
#pragma unroll
                for (int i = 0; i < 8; ++i) { gqr[i] = gq_[8 * (lane_ >> 4) + i]; gqr[8 + i] = gq_[32 + 8 * (lane_ >> 4) + i]; }
                bf16* PROJW = (bf16*)PROJ_;
                asm volatile("" :: "v"(gkr[7]), "v"(gqr[15]));
                const int first = bx_, cnt = bx_ < 128 ? 1 : 5;
                const int nrep_ = NREP(7);
                for (int rep_ = 0; rep_ < nrep_; ++rep_) {
                    AttnKQ R; v4u Vr[6]; attn_load_kq(R, PROJ_, first, tid_, wave_, lane_); attn_load_v(Vr, PROJ_, first, tid_);
                    for (int k = 0; k < cnt; ++k) { const int it = first + 128 * k;
                        LDS_BARRIER();
                        attn_stage_k(R, lds, gkr, tid_); attn_stage_v(Vr, lds, tid_);
                        const v4u q0 = R.q[0], q1 = R.q[1], q2 = R.q[2], q3 = R.q[3];
                        LDS_BARRIER();
                        if (k + 1 < cnt) { attn_load_kq(R, PROJ_, it + 128, tid_, wave_, lane_); attn_load_v(Vr, PROJ_, it + 128, tid_); }
                        { f32x4 sc[9]; float mx, den; attn_scores(sc, mx, den, q0, q1, lds, gqr, 0, it_first_block(it), wave_, lane_);
                          attn_pv(sc, mx, den, lds, PROJW, ML_, it, 0, wave_, lane_, rep_ == nrep_ - 1); }
                        { f32x4 sc[9]; float mx, den; attn_scores(sc, mx, den, q2, q3, lds, gqr, 8, false, wave_, lane_);
                          attn_pv(sc, mx, den, lds, PROJW, ML_, it, 8, wave_, lane_, rep_ == nrep_ - 1); }
                    }
                }
            }
        }
        if (IN(p1 + 1)) {
            if (tid_ == 0) { unsigned* cw = (unsigned*)(ws + WS_BAR) + 3520 + 64 * b; unsigned sp_ = 0;
                while (xb_ld(cw) < 128u) { __builtin_amdgcn_s_sleep(1); if (++sp_ > (1u << 22)) break; }
                __builtin_amdgcn_fence(__ATOMIC_ACQUIRE, "agent"); asm volatile("s_waitcnt vmcnt(0)" ::: "memory"); }
            __syncthreads();
            { const int gid = bx_ * NTHREADS + tid_; const int h = gid >> 15, r = (gid >> 9) & 63, tl = gid & 511; const int kdr = 16 * (r >> 3) + 4 * ((tl & 63) >> 4) + (r & 3);
              float loc[32], dec[32];
#pragma unroll
              for (int sg = 0; sg < 32; ++sg) { loc[sg] = ((const GAS float*)SBUF_)[((size_t)(h * 32 + sg) * 64 + r) * 512 + tl]; dec[sg] = ((const GAS float*)DBUF_)[(h * 32 + sg) * 128 + kdr]; }
              float cur = 0.f;
#pragma unroll
              for (int sg = 0; sg < 32; ++sg) { ((GAS unsigned short*)SB16_)[((size_t)(h * 32 + sg) * 64 + r) * 512 + tl] = (unsigned short)f2bf(cur); cur = dec[sg] * cur + loc[sg]; } }
        }
        SYNC(p1 + 1); TS(p1 + 2);
        if (IN(p1 + 2)) {
            for (int rep_ = 0; rep_ < NREP(3); ++rep_) { gla_fix(lds, b, bx_, PROJ_, SB16_, A2_, QGS_, tid_, wave_, lane_); }
            {
            for (int rep_ = 0; rep_ < NREP(9); ++rep_) {
                for (int idx = bx_ * NTHREADS + tid_; idx < SEQ * 64; idx += G * NTHREADS) {
                    const int t = idx >> 6, slot = (idx >> 3) & 7, c8 = idx & 7;
                    float m[3], dn[3];
#pragma unroll
                    for (int g = 0; g < 3; ++g) { const GAS float* mp = (const GAS float*)ML_ + (size_t)t * 48 + (g * 8 + slot) * 2; m[g] = mp[0]; dn[g] = mp[1]; }
                    const float M = fmaxf(m[0], fmaxf(m[1], m[2])); float D = 0.f; float acc[8];
#pragma unroll
                    for (int i = 0; i < 8; ++i) acc[i] = 0.f;
#pragma unroll
                    for (int g = 0; g < 3; ++g) { const float wg = __builtin_amdgcn_exp2f(m[g] - M); D += wg * dn[g]; float f[8];
                        pg8::unpack8(*(const GAS v4u*)((const GAS bf16*)PROJ_ + (size_t)t * PLD + (g * 8 + slot) * 64 + c8 * 8), f);
#pragma unroll
                        for (int i = 0; i < 8; ++i) acc[i] += wg * f[i]; }
                    const float inv = 1.0f / D;
#pragma unroll
                    for (int i = 0; i < 8; ++i) acc[i] *= inv;
                    *(GAS v4u*)((GAS bf16*)A1_ + (size_t)(b * SEQ + t) * 512 + slot * 64 + c8 * 8) = pg8::pack8(acc);
                }
            }
            }
        }
        SYNC(p1 + 2); TS(p1 + 3);
    }
    if (IN(7)) for (int rep_ = 0; rep_ < NREP(4); ++rep_) {
#pragma unroll 1
        for (int pass = 0; pass < 2; ++pass) {
            const bool useB = (((bx & 1) != 0) != (pass == 1));
            pg8::Gemm g{useB ? A2 : A1, useB ? WB : WA, MTOK, DM, useB ? 1024 : 512}; pg8::StaticOrder S; S.init(MTOK, DM, G, bx); pg8::EpiBranch E{MIXED, GATES, useB ? 1024 : 0, pass};
            pg8::gemm_phase<pg8::EpiBranch, pg8::StaticOrder, true, true>(lds, g, S, E);
            __syncthreads();
        }
    }
    SYNC(7); TS(8);
    if (IN(8)) for (int rep_ = 0; rep_ < NREP(5); ++rep_) { pg8::Gemm g{MIXED, WO, MTOK, DM, 1024}; pg8::StaticOrder S; S.init(MTOK, DM, G, bx); pg8::EpiOut1 E{x, a.out, XB, SS2};
        pg8::gemm_phase<pg8::EpiOut1, pg8::StaticOrder, true, true>(lds, g, S, E); }
    SYNC(8); TS(9);
    if (IN(9)) for (int rep_ = 0; rep_ < NREP(6); ++rep_) { pg8::Gemm g{XB, WUP, MTOK, FF, 1024}; pg8::StaticOrder S; S.init(MTOK, FF, G, bx); pg8::EpiUp E{UB, SS2};
        pg8::gemm_phase<pg8::EpiUp, pg8::StaticOrder, true, true>(lds, g, S, E); }
    SYNC(9); TS(10);
    if (IN(10)) for (int rep_ = 0; rep_ < NREP(10); ++rep_) { pg8::Gemm g{UB, WDN, MTOK, DM, FF}; pg8::StaticOrder S; S.init(MTOK, DM, G, bx); pg8::EpiDown E{a.out, rep_ == NREP(10) - 1};
        pg8::gemm_phase<pg8::EpiDown, pg8::StaticOrder, true, true>(lds, g, S, E); }
    TS(11);
    if (TPROBE >= 0 && bx == TPBLK && tid == 0) { const LAS unsigned long long* tsp = (const LAS unsigned long long*)(lds + LDS_BARST + 16); const unsigned long long dt = tsp[1] - tsp[0];
        const unsigned long long tend = __builtin_amdgcn_s_memrealtime() + 4ull * dt; while (__builtin_amdgcn_s_memrealtime() < tend) __builtin_amdgcn_s_sleep(8); }
#undef IN
#undef SYNC
}

extern "C" void kernel_launch(void* const* d_in, const int* in_sizes, int n_in, void* d_out, int out_size, void* d_ws, size_t ws_size, hipStream_t stream) {
    static int grid = 0;
    if (grid == 0) {
        if (n_in != 15 || out_size != MTOK * DM || ws_size < WS_END) { fprintf(stderr, "kernel_launch: unexpected shapes (n_in %d, out %d, ws %zu)\n", n_in, out_size, ws_size); grid = -1; return; }
        int dev = 0, cus = 0, per_cu = 0;
        hipGetDevice(&dev); hipDeviceGetAttribute(&cus, hipDeviceAttributeMultiprocessorCount, dev);
        if (hipFuncSetAttribute((const void*)fwd_kernel, hipFuncAttributeMaxDynamicSharedMemorySize, LDS_BYTES) != hipSuccess) { fprintf(stderr, "kernel_launch: hipFuncSetAttribute failed\n"); grid = -1; return; }
        if (hipOccupancyMaxActiveBlocksPerMultiprocessor(&per_cu, (const void*)fwd_kernel, NTHREADS, LDS_BYTES) != hipSuccess || per_cu < 1) per_cu = 1;
        (void)hipGetLastError();
        grid = cus * per_cu;
        fprintf(stderr, "kernel_launch: grid %d (cus %d x %d)\n", grid, cus, per_cu);
    }
    if (grid < 0) return;
    Args a{};
    for (int i = 0; i < 15; ++i) a.in[i] = (const float*)d_in[i];
    a.out = (float*)d_out; a.ws = (unsigned char*)d_ws; a.ph_lo = 0; a.ph_hi = 11; a.rep = REPMASK; a.pad = 0;
    void* args[] = {&a};
    hipError_t e = hipLaunchCooperativeKernel((const void*)fwd_kernel, dim3(grid), dim3(NTHREADS), args, LDS_BYTES, stream);
    if (e != hipSuccess) fprintf(stderr, "cooperative launch failed: %s (grid %d)\n", hipGetErrorString(e), grid);
}
```

```cpp
#include <hip/hip_runtime.h>
#include <hip/hip_cooperative_groups.h>
#include <cstdio>
#include <cstdint>
#include <cmath>
namespace cg = cooperative_groups;
namespace pg8 {
#define PG8_LAS __attribute__((address_space(3)))
typedef unsigned short bf16_t;
typedef short bf16x8 __attribute__((ext_vector_type(8)));
typedef float f32x4 __attribute__((ext_vector_type(4)));
typedef unsigned u32x4 __attribute__((ext_vector_type(4)));
constexpr int BM = 256, BK = 64, HALF = 128, HTB = HALF * BK * 2  , STAGE_BYTES = 8 * HTB, NXCD = 8, WGM = 8;

__host__ __device__ __forceinline__ int lds_byte(int r, int c) { const int st = (r >> 4) * 2 + (c >> 5), rr = r & 15, cc = c & 31, ob = rr * 64 + cc * 2; return st * 1024 + (ob ^ (((ob >> 9) & 1) << 5)); }
__host__ __device__ __forceinline__ void stage_rc(int b, int& R, int& C) { const int st = b / 1024, sb = b % 1024, swz = sb ^ (((sb >> 9) & 1) << 5); R = (st >> 1) * 16 + swz / 64; C = (st & 1) * 32 + (swz % 64) / 2; }
__host__ __device__ __forceinline__ int perm32(int rho) { const int n = rho >> 4, i = rho & 15; return 8 * (i >> 2) + 4 * n + (i & 3); }

struct Unit { int pm, pn; };
struct Gemm { const bf16_t* A; const bf16_t* Bt; int M, N, K; };

struct StaticOrder {
    int nM, nN, nwg, G, c;
    __host__ __device__ void init(int M, int N, int G_, int c_) { nM = M / BM; nN = N / BM; nwg = nM * nN; G = G_; c = c_; }
    __host__ __device__ bool next(int i, Unit& u) const {
        const long L = (long)i * G + c; if (L >= nwg) return false;
        int wgid = (int)L; { const int q = nwg / NXCD, r = nwg % NXCD, xcd = wgid % NXCD, off = wgid / NXCD; wgid = (xcd < r ? xcd * (q + 1) : r * (q + 1) + (xcd - r) * q) + off; }
        const int nig = WGM * nN, gid = wgid / nig, fm = gid * WGM, gsz = (nM - fm) < WGM ? (nM - fm) : WGM;
        u.pm = fm + ((wgid % nig) % gsz); u.pn = (wgid % nig) / gsz; return true;
    }
    __device__ __forceinline__ void a_ready(const Unit&) const {}
    __device__ __forceinline__ void done(const Unit&) const {}
};
typedef float f32x2 __attribute__((ext_vector_type(2)));
typedef __bf16 bf16x2_cv __attribute__((ext_vector_type(2)));
__device__ __forceinline__ unsigned cvt_pk_bf16(float lo, float hi) { const f32x2 v = {lo, hi}; const bf16x2_cv b = __builtin_convertvector(v, bf16x2_cv); return __builtin_bit_cast(unsigned, b); }
__device__ __forceinline__ float bflo(unsigned w) { return __uint_as_float(w << 16); }
__device__ __forceinline__ float bfhi(unsigned w) { return __uint_as_float(w & 0xffff0000u); }
__device__ __forceinline__ void unpack8(const u32x4 w, float (&f)[8]) { f[0] = bflo(w.x); f[1] = bfhi(w.x); f[2] = bflo(w.y); f[3] = bfhi(w.y); f[4] = bflo(w.z); f[5] = bfhi(w.z); f[6] = bflo(w.w); f[7] = bfhi(w.w); }
__device__ __forceinline__ u32x4 pack8(const float (&v)[8]) { u32x4 w; w.x = cvt_pk_bf16(v[0], v[1]); w.y = cvt_pk_bf16(v[2], v[3]); w.z = cvt_pk_bf16(v[4], v[5]); w.w = cvt_pk_bf16(v[6], v[7]); return w; }
__device__ __forceinline__ float fsigmoid(float x) { return __builtin_amdgcn_rcpf(1.0f + __builtin_amdgcn_exp2f(x * -1.4426950408889634f)); }

struct EpiProj {
    static constexpr bool PERM = true, AFTER_DRAIN = false;
    bf16_t* proj; bf16_t* vt; bf16_t* gates; const float* r1; const float* gbias;
    __device__ __forceinline__ void operator()(const f32x4 (&acc)[2][2][4][2], const Unit& u, int wr, int wc, int fr_in, int fq_in) const {
        int fr = fr_in, fq = fq_in; asm volatile("" : "+v"(fr), "+v"(fq));
        const int ct = u.pn; const int row0 = u.pm * BM + wr * 64 + fr; const int cl = wc * 32 + 8 * fq;
        float rsv[2][4];
#pragma unroll
        for (int ai = 0; ai < 2; ++ai)
#pragma unroll
            for (int m = 0; m < 4; ++m) rsv[ai][m] = r1[row0 + ai * HALF + m * 16];
        f32x4 gb[2][2];
        if (ct >= 30) {
#pragma unroll
            for (int bj = 0; bj < 2; ++bj) { const int gc = (ct - 30) * 256 + cl + bj * HALF; gb[bj][0] = *(const f32x4*)(gbias + gc); gb[bj][1] = *(const f32x4*)(gbias + gc + 4); } }
        else { gb[0][0] = gb[0][1] = gb[1][0] = gb[1][1] = (f32x4){0.f, 0.f, 0.f, 0.f}; }
#pragma unroll
        for (int ai = 0; ai < 2; ++ai)
#pragma unroll
            for (int m = 0; m < 4; ++m) {
                const int row = row0 + ai * HALF + m * 16; const float rs = rsv[ai][m];
#pragma unroll
                for (int bj = 0; bj < 2; ++bj) {
                    const f32x4 v0 = acc[ai][bj][m][0] * rs, v1 = acc[ai][bj][m][1] * rs;
                    float v[8] = {v0[0], v0[1], v0[2], v0[3], v1[0], v1[1], v1[2], v1[3]};
                    const int c = cl + bj * HALF;
                    if (ct < 22) { *(u32x4*)(proj + (size_t)row * 6656 + ct * 256 + c) = pack8(v); }
                    else if (ct < 26) { const u32x4 w = pack8(v); bf16_t* p = vt + (size_t)((ct - 22) * 256 + c) * 8192 + row;
                        p[0] = (bf16_t)(w.x & 0xffffu); p[8192] = (bf16_t)(w.x >> 16); p[2 * 8192] = (bf16_t)(w.y & 0xffffu); p[3 * 8192] = (bf16_t)(w.y >> 16);
                        p[4 * 8192] = (bf16_t)(w.z & 0xffffu); p[5 * 8192] = (bf16_t)(w.z >> 16); p[6 * 8192] = (bf16_t)(w.w & 0xffffu); p[7 * 8192] = (bf16_t)(w.w >> 16); }
                    else if (ct < 30) {
#pragma unroll
                        for (int i = 0; i < 8; ++i) v[i] = v[i] * fsigmoid(v[i]);
                        *(u32x4*)(proj + (size_t)row * 6656 + (ct - 4) * 256 + c) = pack8(v); }
                    else { const int gc = (ct - 30) * 256 + c; const float bb[8] = {gb[bj][0][0], gb[bj][0][1], gb[bj][0][2], gb[bj][0][3], gb[bj][1][0], gb[bj][1][1], gb[bj][1][2], gb[bj][1][3]};
#pragma unroll
                        for (int i = 0; i < 8; ++i) v[i] = fsigmoid(v[i] + bb[i]);
                        __builtin_nontemporal_store(pack8(v), (u32x4*)(gates + (size_t)row * 2048 + gc)); }
                }
            }
    }
};
struct EpiBranch {
    static constexpr bool PERM = true, AFTER_DRAIN = false;
    bf16_t* mixed; const bf16_t* gates; int goff; int add;
    __device__ __forceinline__ void operator()(const f32x4 (&acc)[2][2][4][2], const Unit& u, int wr, int wc, int fr_in, int fq_in) const {
        int fr = fr_in, fq = fq_in; asm volatile("" : "+v"(fr), "+v"(fq));
        const int row0 = u.pm * BM + wr * 64 + fr; const int cl = u.pn * BM + wc * 32 + 8 * fq;
#pragma unroll
        for (int ai = 0; ai < 2; ++ai) {
            u32x4 gw[4][2], tw[4][2];
#pragma unroll
            for (int m = 0; m < 4; ++m)
#pragma unroll
                for (int bj = 0; bj < 2; ++bj) { const int row = row0 + ai * HALF + m * 16, c = cl + bj * HALF;
                    gw[m][bj] = *(const u32x4*)(gates + (size_t)row * 2048 + goff + c);
                    tw[m][bj] = add ? *(const u32x4*)(mixed + (size_t)row * 1024 + c) : (u32x4){0u, 0u, 0u, 0u}; }
#pragma unroll
            for (int m = 0; m < 4; ++m)
#pragma unroll
                for (int bj = 0; bj < 2; ++bj) { const int row = row0 + ai * HALF + m * 16, c = cl + bj * HALF; float g[8], t[8], v[8];
                    unpack8(gw[m][bj], g); unpack8(tw[m][bj], t);
                    const f32x4 v0 = acc[ai][bj][m][0], v1 = acc[ai][bj][m][1];
                    v[0] = v0[0] * g[0] + t[0]; v[1] = v0[1] * g[1] + t[1]; v[2] = v0[2] * g[2] + t[2]; v[3] = v0[3] * g[3] + t[3];
                    v[4] = v1[0] * g[4] + t[4]; v[5] = v1[1] * g[5] + t[5]; v[6] = v1[2] * g[6] + t[6]; v[7] = v1[3] * g[7] + t[7];
                    *(u32x4*)(mixed + (size_t)row * 1024 + c) = pack8(v); }
        }
    }
};
struct EpiOut1 {
    static constexpr bool PERM = true, AFTER_DRAIN = false;
    const float* x; float* out; bf16_t* x1b; float* ss2;
    __device__ __forceinline__ void operator()(const f32x4 (&acc)[2][2][4][2], const Unit& u, int wr, int wc, int fr_in, int fq_in) const {
        int fr = fr_in, fq = fq_in; asm volatile("" : "+v"(fr), "+v"(fq));
        const int row0 = u.pm * BM + wr * 64 + fr; const int cl = u.pn * BM + wc * 32 + 8 * fq;
#pragma unroll
        for (int ai = 0; ai < 2; ++ai) {
            f32x4 xv[4][2][2];
#pragma unroll
            for (int m = 0; m < 4; ++m)
#pragma unroll
                for (int bj = 0; bj < 2; ++bj) { const size_t off = (size_t)(row0 + ai * HALF + m * 16) * 1024 + cl + bj * HALF; xv[m][bj][0] = *(const f32x4*)(x + off); xv[m][bj][1] = *(const f32x4*)(x + off + 4); }
#pragma unroll
            for (int m = 0; m < 4; ++m) {
                const int row = row0 + ai * HALF + m * 16; float ssq = 0.f;
#pragma unroll
                for (int bj = 0; bj < 2; ++bj) {
                    const size_t off = (size_t)row * 1024 + cl + bj * HALF;
                    const f32x4 o0 = xv[m][bj][0] + acc[ai][bj][m][0], o1 = xv[m][bj][1] + acc[ai][bj][m][1];
                    __builtin_nontemporal_store(o0, (f32x4*)(out + off)); __builtin_nontemporal_store(o1, (f32x4*)(out + off + 4));
                    const float v[8] = {o0[0], o0[1], o0[2], o0[3], o1[0], o1[1], o1[2], o1[3]};
                    *(u32x4*)(x1b + off) = pack8(v);
#pragma unroll
                    for (int i = 0; i < 8; ++i) ssq += v[i] * v[i];
                }
                ssq += __shfl_xor(ssq, 16); ssq += __shfl_xor(ssq, 32);
                if (fq == 0) ss2[(size_t)row * 16 + u.pn * 4 + wc] = ssq;
            }
        }
    }
};
struct EpiUp {
    static constexpr bool PERM = true, AFTER_DRAIN = false;
    bf16_t* U; const float* ss2;
    __device__ __forceinline__ void operator()(const f32x4 (&acc)[2][2][4][2], const Unit& u, int wr, int wc, int fr_in, int fq_in) const {
        int fr = fr_in, fq = fq_in; asm volatile("" : "+v"(fr), "+v"(fq));
        const int row0 = u.pm * BM + wr * 64 + fr; const int cl = u.pn * BM + wc * 32 + 8 * fq;
        float rsv[2][4];
#pragma unroll
        for (int ai = 0; ai < 2; ++ai) { f32x4 sv[4][4];
#pragma unroll
            for (int m = 0; m < 4; ++m) { const f32x4* sp = (const f32x4*)(ss2 + (size_t)(row0 + ai * HALF + m * 16) * 16); sv[m][0] = sp[0]; sv[m][1] = sp[1]; sv[m][2] = sp[2]; sv[m][3] = sp[3]; }
#pragma unroll
            for (int m = 0; m < 4; ++m) { const f32x4 t = (sv[m][0] + sv[m][1]) + (sv[m][2] + sv[m][3]); const float sum = (t[0] + t[1]) + (t[2] + t[3]);
                rsv[ai][m] = __builtin_amdgcn_rsqf(sum * (1.0f / 1024.0f) + 1e-6f); } }
#pragma unroll
        for (int ai = 0; ai < 2; ++ai)
#pragma unroll
            for (int m = 0; m < 4; ++m) {
                const int row = row0 + ai * HALF + m * 16; const float rs = rsv[ai][m];
#pragma unroll
                for (int bj = 0; bj < 2; ++bj) {
                    const f32x4 v0 = acc[ai][bj][m][0] * rs, v1 = acc[ai][bj][m][1] * rs;
                    float v[8] = {v0[0], v0[1], v0[2], v0[3], v1[0], v1[1], v1[2], v1[3]};
#pragma unroll
                    for (int i = 0; i < 8; ++i) { const float r = fmaxf(v[i], 0.f); v[i] = r * r; }
                    *(u32x4*)(U + (size_t)row * 4096 + cl + bj * HALF) = pack8(v);
                }
            }
    }
};
struct EpiDown {
    static constexpr bool PERM = true, AFTER_DRAIN = false;
    float* out; int store;
    __device__ __forceinline__ void operator()(const f32x4 (&acc)[2][2][4][2], const Unit& u, int wr, int wc, int fr_in, int fq_in) const {
        int fr = fr_in, fq = fq_in; asm volatile("" : "+v"(fr), "+v"(fq));
        const int row0 = u.pm * BM + wr * 64 + fr; const int cl = u.pn * BM + wc * 32 + 8 * fq;
#pragma unroll
        for (int ai = 0; ai < 2; ++ai) {
            f32x4 xv[4][2][2];
#pragma unroll
            for (int m = 0; m < 4; ++m)
#pragma unroll
                for (int bj = 0; bj < 2; ++bj) { const size_t off = (size_t)(row0 + ai * HALF + m * 16) * 1024 + cl + bj * HALF; xv[m][bj][0] = *(const f32x4*)(out + off); xv[m][bj][1] = *(const f32x4*)(out + off + 4); }
#pragma unroll
            for (int m = 0; m < 4; ++m)
#pragma unroll
                for (int bj = 0; bj < 2; ++bj) {
                    const size_t off = (size_t)(row0 + ai * HALF + m * 16) * 1024 + cl + bj * HALF;
                    const f32x4 o0 = xv[m][bj][0] + acc[ai][bj][m][0], o1 = xv[m][bj][1] + acc[ai][bj][m][1];
                    if (store) { __builtin_nontemporal_store(o0, (f32x4*)(out + off)); __builtin_nontemporal_store(o1, (f32x4*)(out + off + 4)); }
                }
        }
    }
};
template <class Epi, class Sched, bool ALIGN_EPI = false, bool SP2 = false>
__device__ __forceinline__ void gemm_phase(PG8_LAS unsigned char* lds, const Gemm g, const Sched& S, const Epi& E) {
    int tid_l = threadIdx.x; asm volatile("" : "+v"(tid_l));
    const int tid = tid_l, wid = __builtin_amdgcn_readfirstlane(tid >> 6), lane = tid & 63, wr = wid >> 2, wc = wid & 3, fr = lane & 15, fq = lane >> 4;
    const int K = g.K, nt = K / BK;
    unsigned voffA[2], voffB[2];
#pragma unroll
    for (int i = 0; i < 2; ++i) { int R, C; stage_rc(tid * 16 + i * 8192, R, C); const int Rb = Epi::PERM ? ((R & ~31) + perm32(R & 31)) : R;
        voffA[i] = (unsigned)(R * K + C) * 2u; voffB[i] = (unsigned)(Rb * K + C) * 2u; }
    const size_t kstep = (size_t)(BK * 2);
    const size_t hstep = (size_t)HALF * K * 2;
    const size_t tstep = 2 * hstep;
    const unsigned ldsw = (unsigned)wid * 1024u;
    const int aoff = lds_byte(wr * 64 + fr, fq * 8), boff = lds_byte(wc * 32 + fr, fq * 8);
#define PG8_SA(b, h) (((b) * 2 + (h)) * HTB)
#define PG8_SB(b, h) ((4 + (b) * 2 + (h)) * HTB)
#define PG8_STAGE(bufoff, gbase, voff) do { _Pragma("unroll") for (int _i = 0; _i < 2; ++_i) \
        __builtin_amdgcn_global_load_lds((const unsigned*)((const char*)(gbase) + (voff)[_i]), (PG8_LAS unsigned*)(lds + (bufoff) + ldsw + _i * 8192), 16, 0, 0); } while (0)
#define PG8_LDA(dst, b, h) do { _Pragma("unroll") for (int m = 0; m < 4; ++m) _Pragma("unroll") for (int k = 0; k < 2; ++k) dst[m][k] = *(const PG8_LAS bf16x8*)(lds + PG8_SA(b, h) + aoff + m * 2048 + k * 1024); } while (0)
#define PG8_LDB(dst, b, h) do { _Pragma("unroll") for (int n = 0; n < 2; ++n) _Pragma("unroll") for (int k = 0; k < 2; ++k) dst[n][k] = *(const PG8_LAS bf16x8*)(lds + PG8_SB(b, h) + boff + n * 2048 + k * 1024); } while (0)
#define PG8_MMA(ai, bj, At, Bt) do { __builtin_amdgcn_s_setprio(1); _Pragma("unroll") for (int m = 0; m < 4; ++m) _Pragma("unroll") for (int n = 0; n < 2; ++n) _Pragma("unroll") for (int k = 0; k < 2; ++k) \
        acc[ai][bj][m][n] = __builtin_amdgcn_mfma_f32_16x16x32_bf16(Bt[n][k], At[m][k], acc[ai][bj][m][n], 0, 0, 0); __builtin_amdgcn_s_setprio(0); } while (0)
#define PG8_WAIT_V(n) asm volatile("s_waitcnt vmcnt(" #n ")" ::: "memory")
#define PG8_WAIT_L(n) asm volatile("s_waitcnt lgkmcnt(" #n ")" ::: "memory")
#define PG8_BAR __builtin_amdgcn_s_barrier()
#define PG8_SCHED __builtin_amdgcn_sched_barrier(0)
    Unit cur, nxt; int ui = 0;
    if (!S.next(0, cur)) return;
    f32x4 acc[2][2][4][2];
#pragma unroll
    for (int a = 0; a < 2; ++a)
#pragma unroll
        for (int b = 0; b < 2; ++b)
#pragma unroll
            for (int m = 0; m < 4; ++m)
#pragma unroll
                for (int n = 0; n < 2; ++n) acc[a][b][m][n] = (f32x4){0.f, 0.f, 0.f, 0.f};
    bf16x8 At[4][2], B0[2][2], B1[2][2];
    const char* cA = (const char*)g.A + (size_t)cur.pm * tstep; const char* cB = (const char*)g.Bt + (size_t)cur.pn * tstep;
    S.a_ready(cur);
    if constexpr (SP2) {
        PG8_STAGE(PG8_SB(0, 0), cB, voffB); PG8_STAGE(PG8_SB(0, 1), cB + hstep, voffB); PG8_STAGE(PG8_SA(0, 0), cA, voffA); PG8_STAGE(PG8_SA(0, 1), cA + hstep, voffA);
        if (wr == 1) PG8_BAR;
        PG8_WAIT_V(2); PG8_BAR;
        PG8_STAGE(PG8_SB(1, 0), cB + kstep, voffB); PG8_STAGE(PG8_SA(1, 0), cA + kstep, voffA); PG8_STAGE(PG8_SB(1, 1), cB + hstep + kstep, voffB);
        PG8_WAIT_V(6); PG8_BAR;
    } else {
        PG8_STAGE(PG8_SB(0, 0), cB, voffB); PG8_STAGE(PG8_SA(0, 0), cA, voffA); PG8_STAGE(PG8_SB(0, 1), cB + hstep, voffB); PG8_STAGE(PG8_SA(0, 1), cA + hstep, voffA);
        if (wr == 1) PG8_BAR;
        PG8_WAIT_V(4); PG8_BAR;
        PG8_STAGE(PG8_SB(1, 0), cB + kstep, voffB); PG8_STAGE(PG8_SA(1, 0), cA + kstep, voffA); PG8_STAGE(PG8_SB(1, 1), cB + hstep + kstep, voffB);
        PG8_WAIT_V(6); PG8_BAR;
    }
    for (;;) {
        const bool has_next = S.next(ui + 1, nxt);
        const char* nA = has_next ? (const char*)g.A + (size_t)nxt.pm * tstep : cA; const char* nB = has_next ? (const char*)g.Bt + (size_t)nxt.pn * tstep : cB;
        for (int t = 0; t < nt; t += 2) {
            const bool last = (t == nt - 2);
            const char* a1 = cA + (size_t)(t + 1) * kstep;
            const char* a2 = last ? nA : cA + (size_t)(t + 2) * kstep; const char* b2 = last ? nB : cB + (size_t)(t + 2) * kstep;
            const char* a3 = a2 + kstep; const char* b3 = b2 + kstep;
            if (last && has_next) S.a_ready(nxt);
            if constexpr (SP2) {
            PG8_LDB(B0, 0, 0); PG8_LDB(B1, 0, 1); PG8_SCHED; PG8_LDA(At, 0, 0); PG8_STAGE(PG8_SA(1, 1), a1 + hstep, voffA);
            PG8_WAIT_V(8); PG8_WAIT_L(0); PG8_BAR; PG8_MMA(0, 0, At, B0); PG8_MMA(0, 1, At, B1); PG8_BAR; PG8_SCHED;
            PG8_LDA(At, 0, 1); PG8_STAGE(PG8_SB(0, 0), b2, voffB); PG8_STAGE(PG8_SB(0, 1), b2 + hstep, voffB); PG8_STAGE(PG8_SA(0, 0), a2, voffA);
            PG8_WAIT_V(8); PG8_WAIT_L(0); PG8_BAR; PG8_MMA(1, 0, At, B0); PG8_MMA(1, 1, At, B1); PG8_BAR; PG8_SCHED;
            PG8_LDB(B0, 1, 0); PG8_LDB(B1, 1, 1); PG8_SCHED; PG8_LDA(At, 1, 0); PG8_STAGE(PG8_SA(0, 1), a2 + hstep, voffA);
            PG8_WAIT_V(8); PG8_WAIT_L(0); PG8_BAR; PG8_MMA(0, 0, At, B0); PG8_MMA(0, 1, At, B1); PG8_BAR; PG8_SCHED;
            PG8_LDA(At, 1, 1); PG8_STAGE(PG8_SB(1, 0), b3, voffB); PG8_STAGE(PG8_SB(1, 1), b3 + hstep, voffB); PG8_STAGE(PG8_SA(1, 0), a3, voffA);
            PG8_WAIT_V(8); PG8_WAIT_L(0); PG8_BAR; PG8_MMA(1, 0, At, B0); PG8_MMA(1, 1, At, B1); PG8_BAR; PG8_SCHED;
            } else {
            PG8_LDB(B0, 0, 0); PG8_SCHED; PG8_LDA(At, 0, 0); PG8_STAGE(PG8_SA(1, 1), a1 + hstep, voffA);
            PG8_WAIT_L(8); PG8_BAR; PG8_WAIT_L(0); PG8_MMA(0, 0, At, B0); PG8_BAR; PG8_SCHED;
            PG8_LDB(B1, 0, 1); PG8_STAGE(PG8_SB(0, 0), b2, voffB);
            PG8_BAR; PG8_WAIT_L(0); PG8_MMA(0, 1, At, B1); PG8_BAR;
            PG8_LDA(At, 0, 1); PG8_STAGE(PG8_SA(0, 0), a2, voffA);
            PG8_BAR; PG8_WAIT_L(0); PG8_MMA(1, 0, At, B0); PG8_BAR; PG8_SCHED;
            PG8_STAGE(PG8_SB(0, 1), b2 + hstep, voffB);
            PG8_WAIT_V(6); PG8_BAR; PG8_MMA(1, 1, At, B1); PG8_BAR;
            PG8_LDB(B0, 1, 0); PG8_SCHED; PG8_LDA(At, 1, 0); PG8_STAGE(PG8_SA(0, 1), a2 + hstep, voffA);
            PG8_WAIT_L(8); PG8_BAR; PG8_WAIT_L(0); PG8_MMA(0, 0, At, B0); PG8_BAR; PG8_SCHED;
            PG8_LDB(B1, 1, 1); PG8_STAGE(PG8_SB(1, 0), b3, voffB);
            PG8_BAR; PG8_WAIT_L(0); PG8_MMA(0, 1, At, B1); PG8_BAR;
            PG8_LDA(At, 1, 1); PG8_STAGE(PG8_SA(1, 0), a3, voffA);
            PG8_BAR; PG8_WAIT_L(0); PG8_MMA(1, 0, At, B0); PG8_BAR; PG8_SCHED;
            PG8_STAGE(PG8_SB(1, 1), b3 + hstep, voffB);
            PG8_WAIT_V(6); PG8_BAR; PG8_MMA(1, 1, At, B1); PG8_BAR;
            }
        }
        if constexpr (ALIGN_EPI) { if (wr == 0) PG8_BAR; }
        if constexpr (!Epi::AFTER_DRAIN) { E(acc, cur, wr, wc, fr, fq); S.done(cur); }
        if (!has_next) break;
#pragma unroll
        for (int a = 0; a < 2; ++a)
#pragma unroll
            for (int b = 0; b < 2; ++b)
#pragma unroll
                for (int m = 0; m < 4; ++m)
#pragma unroll
                    for (int n = 0; n < 2; ++n) acc[a][b][m][n] = (f32x4){0.f, 0.f, 0.f, 0.f};
        cur = nxt; cA = nA; cB = nB; ++ui;
        if constexpr (ALIGN_EPI) { if (wr == 1) PG8_BAR; }
    }
    PG8_WAIT_V(0);
    if constexpr (!ALIGN_EPI) { if (wr == 0) PG8_BAR; }
    PG8_BAR;
    if constexpr (Epi::AFTER_DRAIN) { E.fused(acc, cur, wr, wc, fr, fq, lds, wid, lane); S.done(cur); }
#undef PG8_SA
#undef PG8_SB
#undef PG8_STAGE
#undef PG8_LDA
#undef PG8_LDB
#undef PG8_MMA
#undef PG8_WAIT_V
#undef PG8_WAIT_L
#undef PG8_BAR
#undef PG8_SCHED
}
}
#define LAS __attribute__((address_space(3)))
#define GAS __attribute__((address_space(1)))
#define LDS_BARRIER() do { asm volatile("s_waitcnt lgkmcnt(0)" ::: "memory"); __builtin_amdgcn_s_barrier(); asm volatile("" ::: "memory"); } while (0)
typedef unsigned short bf16;
typedef unsigned v4u __attribute__((ext_vector_type(4)));
typedef float f32x4 __attribute__((ext_vector_type(4)));
constexpr int NWAVES = 8, NTHREADS = 512;
constexpr int SEQ = 8192, DM = 1024, MTOK = 16384, DIN = 9744, N1 = 9728, PLD = 6656, FF = 4096;
constexpr float EPS = 1e-6f;
constexpr size_t MiB = 1u << 20;
constexpr size_t WS_WIN = 1 * MiB, WS_WA = 20 * MiB, WS_WB = 21 * MiB, WS_WO = 23 * MiB, WS_WUP = 25 * MiB, WS_WDN = 33 * MiB;
constexpr size_t WS_XB = 41 * MiB, WS_PROJ = 73 * MiB, WS_VT = 177 * MiB, WS_A1 = 193 * MiB, WS_A2 = 209 * MiB;
constexpr size_t WS_R1 = 241 * MiB, WS_PA = 242 * MiB, WS_SS2 = 243 * MiB, WS_MISC = 244 * MiB;
constexpr size_t WS_MIXED = 73 * MiB, WS_U = 73 * MiB, WS_END = 256 * MiB;
constexpr int LDS_BYTES = 155648, LDS_BARST = 155584;
constexpr size_t WS_BAR = 0;

__device__ __forceinline__ float bf2f(bf16 h) { return __uint_as_float(((unsigned)h) << 16); }
__device__ __forceinline__ unsigned f2bf(float f) { unsigned u = __builtin_bit_cast(unsigned, f); return (u + 0x7fffu + ((u >> 16) & 1u)) >> 16; }
__device__ __forceinline__ unsigned pk2(float lo, float hi) { return f2bf(lo) | (f2bf(hi) << 16); }
__device__ __forceinline__ float wave_sum(float v) {
#pragma unroll
    for (int o = 1; o < 64; o <<= 1) v += __shfl_xor(v, o);
    return v;
}
__device__ __forceinline__ float log_sigmoid(float x) { return fminf(x, 0.f) - log1pf(__expf(-fabsf(x))); }

#ifndef TPROBE
#define TPROBE -1
#endif
#ifndef TPBLK
#define TPBLK 0
#endif
#ifndef TPB
#define TPB (TPROBE + 1)
#endif
#ifndef REPMASK
#define REPMASK 0
#endif
struct Args { const float* in[15]; float* out; unsigned char* ws; int ph_lo, ph_hi, rep, pad; };

__device__ __forceinline__ void p0_transpose_item(const float* W, int ldw, int srccol0, const float* kscale, int kmask, float cscale,
                                                  bf16* WT, int K, int dstrow0, int k0, LAS float* scr, int lane) {
    float v[64];
    const GAS float* wp = (const GAS float*)W + (size_t)k0 * ldw + srccol0 + lane;
#pragma unroll
    for (int i = 0; i < 64; ++i) v[i] = __builtin_nontemporal_load(wp + (size_t)i * ldw);
    const int c = lane & 7;
    f32x4 s0 = (f32x4){cscale, cscale, cscale, cscale}, s1 = s0;
    if (kscale) { const int kb = (k0 + 8 * c) & kmask; s0 = *(const GAS f32x4*)((const GAS float*)kscale + kb) * cscale; s1 = *(const GAS f32x4*)((const GAS float*)kscale + kb + 4) * cscale; }
#pragma unroll
    for (int i = 0; i < 64; ++i) scr[i * 65 + lane] = v[i];
    asm volatile("s_waitcnt lgkmcnt(0)" ::: "memory");
#pragma unroll
    for (int j = 0; j < 8; ++j) { const int n = (lane >> 3) + 8 * j; const LAS float* s = scr + (8 * c) * 65 + n;
        v4u o; o.x = pk2(s[0 * 65] * s0[0], s[1 * 65] * s0[1]); o.y = pk2(s[2 * 65] * s0[2], s[3 * 65] * s0[3]); o.z = pk2(s[4 * 65] * s1[0], s[5 * 65] * s1[1]); o.w = pk2(s[6 * 65] * s1[2], s[7 * 65] * s1[3]);
        GAS v4u* dp = (GAS v4u*)((GAS bf16*)WT + (size_t)(dstrow0 + n) * K + k0 + 8 * c);
        if (ldw == DIN) *dp = o; else __builtin_nontemporal_store(o, dp); }
    asm volatile("s_waitcnt lgkmcnt(0)" ::: "memory");
}

#define XB_TMO      128
#define XB_XCNT(j)  (256  + 64 * (j))
#define XB_XSUB(j)  (1280 + 64 * (j))
#define XB_XGEN(j)  (2304 + 64 * (j))
#define XB_TOP      3328
#define XB_TOPGEN   3392
#define XCD_BAR_WORDS 3456
#define XB_SPIN_CAP (1u << 18)

__device__ __forceinline__ unsigned xb_ld(unsigned* p)              { return __hip_atomic_load(p, __ATOMIC_RELAXED, __HIP_MEMORY_SCOPE_AGENT); }
__device__ __forceinline__ unsigned xb_add(unsigned* p, unsigned v) { return __hip_atomic_fetch_add(p, v, __ATOMIC_RELAXED, __HIP_MEMORY_SCOPE_AGENT); }
__device__ __forceinline__ unsigned xb_xcc_id() { return (unsigned)__builtin_amdgcn_s_getreg((3 << 11) | 20) & 0xFu; }
#define XB_SPIN(cond, bar) do { unsigned _sp = 0; while (cond) { __builtin_amdgcn_s_sleep(1); \
    if ((++_sp & 255u) == 0u) { if (xb_ld(&(bar)[XB_TMO])) break; if (_sp > XB_SPIN_CAP) { atomicAdd(&(bar)[XB_TMO], 1u); break; } } } } while (0)

struct XcdBarrier {
    unsigned* bar; unsigned x;
    volatile LAS unsigned* st;
};

__device__ __forceinline__ XcdBarrier xcd_barrier_post(unsigned* bar, volatile LAS unsigned* st) {
    XcdBarrier b; b.bar = bar; b.x = xb_xcc_id(); b.st = st;
    if (threadIdx.x == 0) (void)xb_add(&bar[XB_XCNT(b.x)], 1u);
    return b;
}
__device__ __forceinline__ void xcd_barrier_complete(unsigned* bar, unsigned x, unsigned& nloc, unsigned& nx) {
    const unsigned G = gridDim.x * gridDim.y * gridDim.z;
    unsigned sum, cnt, mine, sp = 0u;
    for (;;) {
        sum = 0u; cnt = 0u; mine = 0u;
#pragma unroll
        for (unsigned j = 0; j < 16; ++j) { const unsigned c = xb_ld(&bar[XB_XCNT(j)]); sum += c; cnt += (c > 0u) ? 1u : 0u; mine = (j == x) ? c : mine; }
        if (sum == G) break;
        __builtin_amdgcn_s_sleep(1);
        if ((++sp & 255u) == 0u) { if (xb_ld(&bar[XB_TMO])) break; if (sp > XB_SPIN_CAP) { atomicAdd(&bar[XB_TMO], 1u); break; } }
    }
    nloc = mine > 0u ? mine : 1u; nx = cnt > 0u ? cnt : 1u;
}

__device__ __forceinline__ void xcd_barrier(const XcdBarrier& b) {
    asm volatile("s_waitcnt vmcnt(0)" ::: "memory");
    __syncthreads();
    if (threadIdx.x == 0) {
        unsigned* bar = b.bar;
        __builtin_amdgcn_s_waitcnt(0);
        unsigned nloc = b.st[0], nx = b.st[1];
        if (nloc == 0u) { xcd_barrier_complete(bar, b.x, nloc, nx); b.st[0] = nloc; b.st[1] = nx; }
        const unsigned old = xb_add(&bar[XB_XSUB(b.x)], 1u);
        const unsigned gen = old / nloc;
        if (old + 1u == (gen + 1u) * nloc) {
            __builtin_amdgcn_fence(__ATOMIC_RELEASE, "agent");
            asm volatile("s_waitcnt vmcnt(0)" ::: "memory");
            const unsigned og = xb_add(&bar[XB_TOP], 1u);
            const unsigned tg = og / nx;
            if (og + 1u == (tg + 1u) * nx) xb_add(&bar[XB_TOPGEN], 1u);
            else XB_SPIN(xb_ld(&bar[XB_TOPGEN]) == tg, bar);
            __builtin_amdgcn_fence(__ATOMIC_ACQUIRE, "agent");
            xb_add(&bar[XB_XGEN(b.x)], 1u);
            asm volatile("s_waitcnt vmcnt(0)" ::: "memory");
        } else {
            XB_SPIN(xb_ld(&bar[XB_XGEN(b.x)]) == gen, bar);
            __builtin_amdgcn_fence(__ATOMIC_ACQUIRE, "agent");
            asm volatile("s_waitcnt vmcnt(0)" ::: "memory");
        }
    }
    __syncthreads();
}

typedef short bf16x8_t __attribute__((ext_vector_type(8)));
typedef short s16x4_t __attribute__((ext_vector_type(4)));
constexpr int AT_PITCH = 144;
constexpr int AT_KL = 0, AT_VL = 384 * AT_PITCH;
constexpr int N_ATT_ITEMS = 768;
constexpr int AT_ROWS = 384;
struct AttnKQ { v4u k[6], q[4]; };
__device__ __forceinline__ void attn_decode(int it2, int& g, int& slot, int& d, int& r, int& n) {
    g = it2 >> 8; const int rem = it2 & 255; slot = rem & 7; const int rest = rem >> 3; const int sh = 2 * g; d = 1 << sh; r = rest >> (5 - sh); n = 2 * (rest & ((32 >> sh) - 1));
}
__device__ __forceinline__ bool it_first_block(int it2) { int g, slot, d, r, n; attn_decode(it2, g, slot, d, r, n); return n == 0; }
__device__ __forceinline__ void attn_load_kq(AttnKQ& R, const bf16* PROJ_, int it, int tid, int wave, int lane) {
    int g, slot, d, r, n; attn_decode(it, g, slot, d, r, n); const int hd = g * 8 + slot; const int c = tid & 7;
#pragma unroll
    for (int p = 0; p < 6; ++p) { const int row = p * 64 + (tid >> 3); const int sp = (n - 1) * 128 + row;
        if (n > 0 || p >= 2) R.k[p] = *(const GAS v4u*)((const GAS bf16*)PROJ_ + (size_t)(sp * d + r) * PLD + 1536 + hd * 64 + c * 8);
        else R.k[p] = (v4u){0u, 0u, 0u, 0u}; }
    const int fr = lane & 15, fq = lane >> 4; const GAS bf16* qb = (const GAS bf16*)PROJ_ + (size_t)((n * 128 + 16 * wave + fr) * d + r) * PLD + hd * 64 + 8 * fq;
    R.q[0] = *(const GAS v4u*)(qb); R.q[1] = *(const GAS v4u*)(qb + 32);
    const GAS bf16* qb2 = qb + (size_t)128 * d * PLD; R.q[2] = *(const GAS v4u*)(qb2); R.q[3] = *(const GAS v4u*)(qb2 + 32);
}
__device__ __forceinline__ void attn_load_v(v4u (&V)[6], const bf16* PROJ_, int it, int tid) {
    int g, slot, d, r, n; attn_decode(it, g, slot, d, r, n); const int hd = g * 8 + slot; const int c = tid & 7;
#pragma unroll
    for (int p = 0; p < 6; ++p) { const int row = p * 64 + (tid >> 3); const int sp = (n - 1) * 128 + row;
        if (n > 0 || p >= 2) V[p] = *(const GAS v4u*)((const GAS bf16*)PROJ_ + (size_t)(sp * d + r) * PLD + 3072 + hd * 64 + c * 8);
        else V[p] = (v4u){0u, 0u, 0u, 0u}; }
}
__device__ __forceinline__ void attn_stage_k(const AttnKQ& R, LAS unsigned char* lds, const float (&gkr)[8], int tid) {
    const int c = tid & 7;
#pragma unroll
    for (int p = 0; p < 6; ++p) { const int row = p * 64 + (tid >> 3); float f[8]; pg8::unpack8(R.k[p], f); float ss = 0.f;
#pragma unroll
        for (int i = 0; i < 8; ++i) ss += f[i] * f[i];
        ss += __shfl_xor(ss, 1); ss += __shfl_xor(ss, 2); ss += __shfl_xor(ss, 4);
        const float rs = __builtin_amdgcn_rsqf(ss * (1.0f / 64.0f) + EPS);
#pragma unroll
        for (int i = 0; i < 8; ++i) f[i] = f[i] * (rs * gkr[i]);
        *(LAS v4u*)(lds + AT_KL + row * AT_PITCH + c * 16) = pg8::pack8(f); }
}
__device__ __forceinline__ void attn_stage_v(const v4u (&V)[6], LAS unsigned char* lds, int tid) {
    const int c = tid & 7;
#pragma unroll
    for (int p = 0; p < 6; ++p) { const int row = p * 64 + (tid >> 3); *(LAS v4u*)(lds + AT_VL + row * AT_PITCH + c * 16) = V[p]; }
}
__device__ __forceinline__ void attn_scores(f32x4 (&sc)[9], float& mx, float& den, v4u q0, v4u q1, LAS unsigned char* lds, const float (&gqr)[16], int koff, bool firstblk, int wave, int lane) {
    const int fr = lane & 15, fq = lane >> 4, w = wave;
    float qf[16]; { float t0[8], t1[8]; pg8::unpack8(q0, t0); pg8::unpack8(q1, t1);
#pragma unroll
        for (int i = 0; i < 8; ++i) { qf[i] = t0[i]; qf[8 + i] = t1[i]; } }
    float ss = 0.f;
#pragma unroll
    for (int i = 0; i < 16; ++i) ss += qf[i] * qf[i];
    ss += __shfl_xor(ss, 16); ss += __shfl_xor(ss, 32);
    const float qs = __builtin_amdgcn_rsqf(ss * (1.0f / 64.0f) + EPS) * (0.125f * 1.4426950408889634f);
    bf16x8_t qa[2];
    { float t0[8], t1[8];
#pragma unroll
      for (int i = 0; i < 8; ++i) { t0[i] = qf[i] * (qs * gqr[i]); t1[i] = qf[8 + i] * (qs * gqr[8 + i]); }
      qa[0] = __builtin_bit_cast(bf16x8_t, pg8::pack8(t0)); qa[1] = __builtin_bit_cast(bf16x8_t, pg8::pack8(t1)); }
#pragma unroll
    for (int kti = 0; kti < 9; ++kti) { f32x4 acc = (f32x4){0.f, 0.f, 0.f, 0.f}; const LAS unsigned char* kp = lds + AT_KL + ((koff + w + kti) * 16 + fr) * AT_PITCH + fq * 16;
#pragma unroll
        for (int ks = 0; ks < 2; ++ks) { const bf16x8_t kf = *(const LAS bf16x8_t*)(kp + ks * 64); acc = __builtin_amdgcn_mfma_f32_16x16x32_bf16(kf, qa[ks], acc, 0, 0, 0); }
        sc[kti] = acc; if (kti % 3 == 2) __builtin_amdgcn_sched_barrier(0); }
    mx = -INFINITY;
#pragma unroll
    for (int j = 0; j < 4; ++j) { if (4 * fq + j < fr) sc[0][j] = -INFINITY; if (4 * fq + j > fr) sc[8][j] = -INFINITY; }
    if (firstblk) {
#pragma unroll
        for (int kti = 0; kti < 9; ++kti) if (w + kti < 8) sc[kti] = (f32x4){-INFINITY, -INFINITY, -INFINITY, -INFINITY}; }
#pragma unroll
    for (int kti = 0; kti < 9; ++kti)
#pragma unroll
        for (int j = 0; j < 4; ++j) mx = fmaxf(mx, sc[kti][j]);
    mx = fmaxf(mx, __shfl_xor(mx, 16)); mx = fmaxf(mx, __shfl_xor(mx, 32));
    den = 0.f;
#pragma unroll
    for (int kti = 0; kti < 9; ++kti)
#pragma unroll
        for (int j = 0; j < 4; ++j) { const float pv = __builtin_amdgcn_exp2f(sc[kti][j] - mx); sc[kti][j] = pv; den += pv; }
    den += __shfl_xor(den, 16); den += __shfl_xor(den, 32);
    __builtin_amdgcn_sched_barrier(0);
}
__device__ __forceinline__ void attn_pv(const f32x4 (&sc)[9], float mx, float den, LAS unsigned char* lds, bf16* PROJ_, float* ML_, int it, int koff, int wave, int lane, bool do_store) {
    int g, slot, d, r, n; attn_decode(it, g, slot, d, r, n); const int hd = g * 8 + slot; n += koff >> 3;
    const int fr = lane & 15, fq = lane >> 4, w = wave;
    f32x4 o[4];
#pragma unroll
    for (int et = 0; et < 4; ++et) o[et] = (f32x4){0.f, 0.f, 0.f, 0.f};
    const int q_ = (lane >> 2) & 3, p_ = lane & 3;
#pragma unroll
    for (int kk = 0; kk < 5; ++kk) { const int kt0 = koff + w + 2 * kk, kt1 = (kk < 4) ? kt0 + 1 : kt0;
        v4u aw; aw.x = pg8::cvt_pk_bf16(sc[2 * kk][0], sc[2 * kk][1]); aw.y = pg8::cvt_pk_bf16(sc[2 * kk][2], sc[2 * kk][3]);
        if (kk < 4) { aw.z = pg8::cvt_pk_bf16(sc[(kk < 4) ? 2 * kk + 1 : 0][0], sc[(kk < 4) ? 2 * kk + 1 : 0][1]); aw.w = pg8::cvt_pk_bf16(sc[(kk < 4) ? 2 * kk + 1 : 0][2], sc[(kk < 4) ? 2 * kk + 1 : 0][3]); } else { aw.z = 0u; aw.w = 0u; }
        const bf16x8_t af = __builtin_bit_cast(bf16x8_t, aw);
        const LAS unsigned char* v0 = lds + AT_VL + (kt0 * 16 + 4 * fq + q_) * AT_PITCH + p_ * 8; const LAS unsigned char* v1 = lds + AT_VL + (kt1 * 16 + 4 * fq + q_) * AT_PITCH + p_ * 8;
#pragma unroll
        for (int et = 0; et < 4; ++et) {
            const s16x4_t lo = __builtin_bit_cast(s16x4_t, __builtin_amdgcn_ds_read_tr16_b64_v4i16((LAS s16x4_t*)(v0 + et * 32)));
            const s16x4_t hi = __builtin_bit_cast(s16x4_t, __builtin_amdgcn_ds_read_tr16_b64_v4i16((LAS s16x4_t*)(v1 + et * 32)));
            const bf16x8_t bfr = (bf16x8_t){lo[0], lo[1], lo[2], lo[3], hi[0], hi[1], hi[2], hi[3]};
            o[et] = __builtin_amdgcn_mfma_f32_16x16x32_bf16(af, bfr, o[et], 0, 0, 0); }
        __builtin_amdgcn_sched_barrier(0); }
    if (do_store)
#pragma unroll
    for (int j = 0; j < 4; j += 2) { GAS bf16* op0 = (GAS bf16*)PROJ_ + (size_t)((n * 128 + 16 * w + 4 * fq + j) * d + r) * PLD + hd * 64 + fr; GAS bf16* op1 = op0 + (size_t)d * PLD;
#pragma unroll
        for (int et = 0; et < 4; ++et) { const unsigned wv = pg8::cvt_pk_bf16(o[et][j], o[et][j + 1]); op0[et * 16] = (bf16)(wv & 0xffffu); op1[et * 16] = (bf16)(wv >> 16); } }
    if (fq == 0) { GAS float* mp = (GAS float*)ML_ + (size_t)((n * 128 + 16 * w + fr) * d + r) * 48 + (g * 8 + slot) * 2; mp[0] = mx; mp[1] = den; }
}

constexpr int GL_QG = 0, GL_KG = 17408, GL_KDT = 34816, GL_VTL = 53248, GL_PL = 90112, GL_EB = 99328, GL_PAL = 99840, GL_GT = 103936, GL_SSQ = 105984, GL_RS = 108032, GL_QR = 108544, GL_KR = 124928, GL_UP = 141312;
typedef unsigned u32x2_t __attribute__((ext_vector_type(2)));
struct GlaLd { v4u vt[4], q[2], k[2]; float pa[2]; };
__device__ __forceinline__ void gla_load(GlaLd& L, int b, int h, int tok0, const bf16* PROJ_, const bf16* VT_, const float* PA_, int tid) {
    const GAS float* pap = (const GAS float*)PA_ + (size_t)(b * SEQ + tok0) * 16; L.pa[0] = pap[tid]; L.pa[1] = pap[tid + 512];
#pragma unroll
    for (int i = 0; i < 4; ++i) { const int piece = tid + 512 * i, v = piece >> 3, cc = piece & 7; L.vt[i] = *(const GAS v4u*)((const GAS bf16*)VT_ + (size_t)(h * 256 + v) * SEQ + tok0 + cc * 8); }
#pragma unroll
    for (int i = 0; i < 2; ++i) { const int piece = tid + 512 * i, row = piece >> 4, c16 = piece & 15; const GAS bf16* rp = (const GAS bf16*)PROJ_ + (size_t)(tok0 + row) * PLD + h * 128 + c16 * 8;
        L.k[i] = *(const GAS v4u*)(rp + 5120); L.q[i] = *(const GAS v4u*)(rp + 4608); }
}
__device__ __forceinline__ void gla_stage(const GlaLd& L, LAS unsigned char* lds, int tid) {
    LAS float* PAL = (LAS float*)(lds + GL_PAL); PAL[tid] = L.pa[0]; PAL[tid + 512] = L.pa[1];
#pragma unroll
    for (int i = 0; i < 4; ++i) { const int piece = tid + 512 * i, v = piece >> 3, cc = piece & 7; *(LAS v4u*)(lds + GL_VTL + v * 144 + cc * 16) = L.vt[i]; }
#pragma unroll
    for (int i = 0; i < 2; ++i) { const int piece = tid + 512 * i; *(LAS v4u*)(lds + GL_KR + piece * 16) = L.k[i]; *(LAS v4u*)(lds + GL_QR + piece * 16) = L.q[i]; }
}
__device__ __forceinline__ float fexp(float x) { return __builtin_amdgcn_exp2f(x * 1.4426950408889634f); }
__device__ __forceinline__ float log_sigmoid_fast(float x) { return fminf(x, 0.f) - 0.6931471805599453f * __builtin_amdgcn_logf(1.0f + __builtin_amdgcn_exp2f(fabsf(x) * -1.4426950408889634f)); }
__device__ __forceinline__ void gla_local(LAS unsigned char* lds, int b, int item, const bf16* PROJ_, const bf16* VT_, const float* PA_, const float* gate_up_, const float* gate_bias_,
                                          float* SBUF_, float* DBUF_, bf16* A2_, bf16* QGS_, int tid_in, int wave, int lane_in) {
    int tid = tid_in, lane = lane_in; asm volatile("" : "+v"(tid), "+v"(lane));
    const int h = item >> 5, seg = item & 31;
    const int w = wave;
    GlaLd L; gla_load(L, b, h, seg * 256, PROJ_, VT_, PA_, tid);
    { LAS float* UP = (LAS float*)(lds + GL_UP);
#pragma unroll
      for (int i = 0; i < 4; ++i) { const int idx = tid + 512 * i, r = idx >> 7, k2 = idx & 127; UP[k2 * 20 + r] = gate_up_[r * 512 + h * 128 + k2]; } }
    const float bk = gate_bias_[h * 128 + (tid & 127)];
    f32x4 S[8][2];
#pragma unroll
    for (int mtk = 0; mtk < 8; ++mtk) { S[mtk][0] = (f32x4){0.f, 0.f, 0.f, 0.f}; S[mtk][1] = (f32x4){0.f, 0.f, 0.f, 0.f}; }
    float segsum = 0.f;
    asm volatile("" :: "v"(bk), "v"(L.k[1]));
    const int tid_item = tid, lane_item = lane;
    for (int c = 0; c < 4; ++c) {
        const int tok0 = seg * 256 + c * 64;
        int tid = tid_item, lane = lane_item; asm volatile("" : "+v"(tid), "+v"(lane));
        const int kd = tid & 127, tq = tid >> 7, fr = lane & 15, fq = lane >> 4;
        gla_stage(L, lds, tid);
        LDS_BARRIER();
        if (c < 3) gla_load(L, b, h, tok0 + 64, PROJ_, VT_, PA_, tid);
        { const LAS float* pal = (const LAS float*)(lds + GL_PAL); const LAS float* upl = (const LAS float*)(lds + GL_UP) + (16 * w + fr) * 20 + fq;
          const float ub0 = upl[0], ub1 = upl[4], ub2 = upl[8], ub3 = upl[12];
#pragma unroll
          for (int mt = 0; mt < 4; ++mt) { const LAS float* pa4 = pal + (16 * mt + fr) * 16 + fq; f32x4 lacc = (f32x4){0.f, 0.f, 0.f, 0.f};
              lacc = __builtin_amdgcn_mfma_f32_16x16x4f32(pa4[0], ub0, lacc, 0, 0, 0); lacc = __builtin_amdgcn_mfma_f32_16x16x4f32(pa4[4], ub1, lacc, 0, 0, 0);
              lacc = __builtin_amdgcn_mfma_f32_16x16x4f32(pa4[8], ub2, lacc, 0, 0, 0); lacc = __builtin_amdgcn_mfma_f32_16x16x4f32(pa4[12], ub3, lacc, 0, 0, 0);
#pragma unroll
              for (int j = 0; j < 4; ++j) ((LAS float*)lds)[(16 * mt + 4 * fq + j) * 128 + 16 * w + fr] = lacc[j]; } }
        LDS_BARRIER();
        float cb[16];
        { float run = 0.f;
#pragma unroll
          for (int i = 0; i < 16; ++i) { const int t = 16 * tq + i; const float lg = bk + ((const LAS float*)lds)[t * 128 + kd];
              run += log_sigmoid_fast(lg) * (1.0f / 16.0f); cb[i] = run; } }
        { LAS float* GT = (LAS float*)(lds + GL_GT); GT[tq * 128 + kd] = cb[15]; }
        LDS_BARRIER();
        float off = 0.f, tot = 0.f;
        { const LAS float* GT = (const LAS float*)(lds + GL_GT);
#pragma unroll
          for (int q = 0; q < 4; ++q) { const float gv = GT[q * 128 + kd]; tot += gv; off += (q < tq) ? gv : 0.f; } }
        const float etot = fexp(tot), eseg = fexp(segsum);
        { float kdv[16];
          GAS bf16* qgs = (GAS bf16*)QGS_ + (size_t)(tok0 + 16 * tq) * 512 + h * 128 + kd;
#pragma unroll
          for (int i = 0; i < 16; i += 2) { const int t = 16 * tq + i; const float bc0 = cb[i] + off, bc1 = cb[i + 1] + off;
              const float kf0 = bf2f(*(const LAS unsigned short*)(lds + GL_KR + t * 256 + kd * 2)), kf1 = bf2f(*(const LAS unsigned short*)(lds + GL_KR + (t + 1) * 256 + kd * 2));
              const float en0 = fexp(-bc0), en1 = fexp(-bc1);
              const float kg0 = kf0 * en0, kg1 = kf1 * en1; kdv[i] = kg0 * etot; kdv[i + 1] = kg1 * etot;
              const float qf0 = bf2f(*(const LAS unsigned short*)(lds + GL_QR + t * 256 + kd * 2)), qf1 = bf2f(*(const LAS unsigned short*)(lds + GL_QR + (t + 1) * 256 + kd * 2));
              const float qg0 = qf0 * fexp(bc0), qg1 = qf1 * fexp(bc1);
              const unsigned qw = pg8::cvt_pk_bf16(qg0, qg1), kw = pg8::cvt_pk_bf16(kg0, kg1), sw = pg8::cvt_pk_bf16(qg0 * eseg, qg1 * eseg);
              *(LAS unsigned short*)(lds + GL_QG + t * 272 + kd * 2) = (unsigned short)(qw & 0xffffu); *(LAS unsigned short*)(lds + GL_QG + (t + 1) * 272 + kd * 2) = (unsigned short)(qw >> 16);
              *(LAS unsigned short*)(lds + GL_KG + t * 272 + kd * 2) = (unsigned short)(kw & 0xffffu); *(LAS unsigned short*)(lds + GL_KG + (t + 1) * 272 + kd * 2) = (unsigned short)(kw >> 16);
              qgs[(size_t)i * 512] = (bf16)(sw & 0xffffu); qgs[(size_t)(i + 1) * 512] = (bf16)(sw >> 16); }
          float lo8[8], hi8[8];
#pragma unroll
          for (int i = 0; i < 8; ++i) { lo8[i] = kdv[i]; hi8[i] = kdv[8 + i]; }
          *(LAS v4u*)(lds + GL_KDT + kd * 144 + tq * 32) = pg8::pack8(lo8); *(LAS v4u*)(lds + GL_KDT + kd * 144 + tq * 32 + 16) = pg8::pack8(hi8); }
        if (tq == 0) ((LAS float*)(lds + GL_EB))[kd] = etot;
        segsum += tot;
        LDS_BARRIER();
        {
            const int mt = w >> 1;
#pragma unroll
            for (int sti = 0; sti < 2; ++sti) { const int st = 2 * (w & 1) + sti; f32x4 acc = (f32x4){0.f, 0.f, 0.f, 0.f};
                if (st <= mt) {
#pragma unroll
                    for (int ks = 0; ks < 4; ++ks) { const bf16x8_t kf = *(const LAS bf16x8_t*)(lds + GL_KG + (16 * st + fr) * 272 + (32 * ks + 8 * fq) * 2);
                        const bf16x8_t qf = *(const LAS bf16x8_t*)(lds + GL_QG + (16 * mt + fr) * 272 + (32 * ks + 8 * fq) * 2);
                        acc = __builtin_amdgcn_mfma_f32_16x16x32_bf16(kf, qf, acc, 0, 0, 0); }
                    if (st == mt) {
#pragma unroll
                        for (int j = 0; j < 4; ++j) if (4 * fq + j > fr) acc[j] = 0.f; } }
                u32x2_t wv; wv.x = pg8::cvt_pk_bf16(acc[0], acc[1]); wv.y = pg8::cvt_pk_bf16(acc[2], acc[3]);
                *(LAS u32x2_t*)(lds + GL_PL + (16 * mt + fr) * 144 + (16 * st + 4 * fq) * 2) = wv; }
            LDS_BARRIER();
        }
        bf16x8_t vf[2][2];
#pragma unroll
        for (int ks2 = 0; ks2 < 2; ++ks2)
#pragma unroll
            for (int nt = 0; nt < 2; ++nt) vf[ks2][nt] = *(const LAS bf16x8_t*)(lds + GL_VTL + (32 * w + 16 * nt + fr) * 144 + (32 * ks2 + 8 * fq) * 2);
        f32x4 o[4][2];
#pragma unroll
        for (int mt = 0; mt < 4; ++mt) { o[mt][0] = (f32x4){0.f, 0.f, 0.f, 0.f}; o[mt][1] = (f32x4){0.f, 0.f, 0.f, 0.f}; }
#pragma unroll
        for (int ks = 0; ks < 4; ++ks) { bf16x8_t bfr[2];
#pragma unroll
            for (int nt = 0; nt < 2; ++nt) { v4u wv; wv.x = pg8::cvt_pk_bf16(S[2 * ks][nt][0], S[2 * ks][nt][1]); wv.y = pg8::cvt_pk_bf16(S[2 * ks][nt][2], S[2 * ks][nt][3]);
                wv.z = pg8::cvt_pk_bf16(S[2 * ks + 1][nt][0], S[2 * ks + 1][nt][1]); wv.w = pg8::cvt_pk_bf16(S[2 * ks + 1][nt][2], S[2 * ks + 1][nt][3]); bfr[nt] = __builtin_bit_cast(bf16x8_t, wv); }
#pragma unroll
            for (int mt = 0; mt < 4; ++mt) { const u32x2_t a0 = *(const LAS u32x2_t*)(lds + GL_QG + (16 * mt + fr) * 272 + (32 * ks + 4 * fq) * 2), a1 = *(const LAS u32x2_t*)(lds + GL_QG + (16 * mt + fr) * 272 + (32 * ks + 16 + 4 * fq) * 2);
                const v4u aw = (v4u){a0.x, a0.y, a1.x, a1.y}; const bf16x8_t af = __builtin_bit_cast(bf16x8_t, aw);
                o[mt][0] = __builtin_amdgcn_mfma_f32_16x16x32_bf16(bfr[0], af, o[mt][0], 0, 0, 0); o[mt][1] = __builtin_amdgcn_mfma_f32_16x16x32_bf16(bfr[1], af, o[mt][1], 0, 0, 0); } }
#pragma unroll
        for (int ks2 = 0; ks2 < 2; ++ks2)
#pragma unroll
            for (int mt = 0; mt < 4; ++mt) { const bf16x8_t pf = *(const LAS bf16x8_t*)(lds + GL_PL + (16 * mt + fr) * 144 + (32 * ks2 + 8 * fq) * 2);
                o[mt][0] = __builtin_amdgcn_mfma_f32_16x16x32_bf16(vf[ks2][0], pf, o[mt][0], 0, 0, 0); o[mt][1] = __builtin_amdgcn_mfma_f32_16x16x32_bf16(vf[ks2][1], pf, o[mt][1], 0, 0, 0); }
#pragma unroll
        for (int mtk = 0; mtk < 8; ++mtk) { const f32x4 eb = *(const LAS f32x4*)(lds + GL_EB + (16 * mtk + 4 * fq) * 4);
            S[mtk][0] = S[mtk][0] * eb; S[mtk][1] = S[mtk][1] * eb;
#pragma unroll
            for (int ks2 = 0; ks2 < 2; ++ks2) { const bf16x8_t kf = *(const LAS bf16x8_t*)(lds + GL_KDT + (16 * mtk + fr) * 144 + (32 * ks2 + 8 * fq) * 2);
                S[mtk][0] = __builtin_amdgcn_mfma_f32_16x16x32_bf16(kf, vf[ks2][0], S[mtk][0], 0, 0, 0); S[mtk][1] = __builtin_amdgcn_mfma_f32_16x16x32_bf16(kf, vf[ks2][1], S[mtk][1], 0, 0, 0); } }
        LDS_BARRIER();
#pragma unroll
        for (int mt = 0; mt < 4; ++mt)
#pragma unroll
            for (int nt = 0; nt < 2; ++nt) { u32x2_t wv; wv.x = pg8::cvt_pk_bf16(o[mt][nt][0], o[mt][nt][1]); wv.y = pg8::cvt_pk_bf16(o[mt][nt][2], o[mt][nt][3]);
                *(LAS u32x2_t*)(lds + (16 * mt + fr) * 528 + (32 * w + 16 * nt + 4 * fq) * 2) = wv; }
        LDS_BARRIER();
#pragma unroll
        for (int i = 0; i < 4; ++i) { const int piece = tid + 512 * i, t = piece >> 5, c8 = piece & 31;
            *(GAS v4u*)((GAS bf16*)A2_ + (size_t)(b * SEQ + tok0 + t) * DM + h * 256 + c8 * 8) = *(const LAS v4u*)(lds + t * 528 + c8 * 16); }
    }
#pragma unroll
    for (int mtk = 0; mtk < 8; ++mtk)
#pragma unroll
        for (int nt = 0; nt < 2; ++nt)
#pragma unroll
            for (int j = 0; j < 4; ++j) ((GAS float*)SBUF_)[((size_t)item * 64 + (mtk * 2 + nt) * 4 + j) * 512 + tid] = S[mtk][nt][j];
    if ((tid >> 7) == 0) ((GAS float*)DBUF_)[item * 128 + (tid & 127)] = fexp(segsum);
    LDS_BARRIER();
}
constexpr int GF_QG = 0, GF_OL = 17408, GF_SSQ = 51200, GF_RS = 53248;
__device__ __forceinline__ void gla_fix(LAS unsigned char* lds, int b, int unit, const bf16* PROJ_, const bf16* SB16_, bf16* A2_, const bf16* QGS_, int tid_in, int wave, int lane_in) {
    int tid = tid_in, lane = lane_in; asm volatile("" : "+v"(tid), "+v"(lane));
    const int item = unit >> 1, half = unit & 1, h = item >> 5, seg = item & 31, w = wave, fr = lane & 15, fq = lane >> 4;
    bf16x8_t bfr[4][2];
#pragma unroll
    for (int ks = 0; ks < 4; ++ks)
#pragma unroll
        for (int nt = 0; nt < 2; ++nt) { unsigned hv[8];
#pragma unroll
            for (int j = 0; j < 4; ++j) { hv[j] = ((const GAS unsigned short*)SB16_)[((size_t)item * 64 + ((2 * ks) * 2 + nt) * 4 + j) * 512 + tid]; hv[4 + j] = ((const GAS unsigned short*)SB16_)[((size_t)item * 64 + ((2 * ks + 1) * 2 + nt) * 4 + j) * 512 + tid]; }
            const v4u wv = (v4u){hv[0] | (hv[1] << 16), hv[2] | (hv[3] << 16), hv[4] | (hv[5] << 16), hv[6] | (hv[7] << 16)};
            bfr[ks][nt] = __builtin_bit_cast(bf16x8_t, wv); }
    for (int cc = 0; cc < 2; ++cc) {
        const int tok0 = seg * 256 + (2 * half + cc) * 64;
        v4u rg[4], ol[4], qg[2];
#pragma unroll
        for (int i = 0; i < 4; ++i) { const int piece = tid + 512 * i, t = piece >> 5, c8 = piece & 31;
            rg[i] = *(const GAS v4u*)((const GAS bf16*)PROJ_ + (size_t)(tok0 + t) * PLD + 5632 + h * 256 + c8 * 8);
            ol[i] = *(const GAS v4u*)((const GAS bf16*)A2_ + (size_t)(b * SEQ + tok0 + t) * DM + h * 256 + c8 * 8); }
#pragma unroll
        for (int i = 0; i < 2; ++i) { const int piece = tid + 512 * i, t = piece >> 4, c16 = piece & 15; qg[i] = *(const GAS v4u*)((const GAS bf16*)QGS_ + (size_t)(tok0 + t) * 512 + h * 128 + c16 * 8); }
        LDS_BARRIER();
#pragma unroll
        for (int i = 0; i < 4; ++i) { const int piece = tid + 512 * i, t = piece >> 5, c8 = piece & 31; *(LAS v4u*)(lds + GF_OL + t * 528 + c8 * 16) = ol[i]; }
#pragma unroll
        for (int i = 0; i < 2; ++i) { const int piece = tid + 512 * i, t = piece >> 4, c16 = piece & 15; *(LAS v4u*)(lds + GF_QG + t * 272 + c16 * 16) = qg[i]; }
        LDS_BARRIER();
        f32x4 o[4][2];
#pragma unroll
        for (int mt = 0; mt < 4; ++mt)
#pragma unroll
            for (int nt = 0; nt < 2; ++nt) { const u32x2_t wv = *(const LAS u32x2_t*)(lds + GF_OL + (16 * mt + fr) * 528 + (32 * w + 16 * nt + 4 * fq) * 2);
                o[mt][nt] = (f32x4){pg8::bflo(wv.x), pg8::bfhi(wv.x), pg8::bflo(wv.y), pg8::bfhi(wv.y)}; }
#pragma unroll
        for (int ks = 0; ks < 4; ++ks)
#pragma unroll
            for (int mt = 0; mt < 4; ++mt) { const u32x2_t a0 = *(const LAS u32x2_t*)(lds + GF_QG + (16 * mt + fr) * 272 + (32 * ks + 4 * fq) * 2), a1 = *(const LAS u32x2_t*)(lds + GF_QG + (16 * mt + fr) * 272 + (32 * ks + 16 + 4 * fq) * 2);
                const v4u aw = (v4u){a0.x, a0.y, a1.x, a1.y}; const bf16x8_t af = __builtin_bit_cast(bf16x8_t, aw);
                o[mt][0] = __builtin_amdgcn_mfma_f32_16x16x32_bf16(bfr[ks][0], af, o[mt][0], 0, 0, 0); o[mt][1] = __builtin_amdgcn_mfma_f32_16x16x32_bf16(bfr[ks][1], af, o[mt][1], 0, 0, 0); }
#pragma unroll
        for (int mt = 0; mt < 4; ++mt) { float sq = 0.f;
#pragma unroll
            for (int j = 0; j < 4; ++j) sq += o[mt][0][j] * o[mt][0][j] + o[mt][1][j] * o[mt][1][j];
            sq += __shfl_xor(sq, 16); sq += __shfl_xor(sq, 32);
            if (fq == 0) ((LAS float*)(lds + GF_SSQ))[w * 64 + 16 * mt + fr] = sq; }
        LDS_BARRIER();
        if (tid < 64) { const LAS float* sp = (const LAS float*)(lds + GF_SSQ); float tsum = 0.f;
#pragma unroll
            for (int q = 0; q < 8; ++q) tsum += sp[q * 64 + tid];
            ((LAS float*)(lds + GF_RS))[tid] = 1.0f / sqrtf(tsum * (1.0f / 256.0f) + EPS); }
        LDS_BARRIER();
#pragma unroll
        for (int mt = 0; mt < 4; ++mt) { const float rs = ((const LAS float*)(lds + GF_RS))[16 * mt + fr];
#pragma unroll
            for (int nt = 0; nt < 2; ++nt) { u32x2_t wv; wv.x = pg8::cvt_pk_bf16(o[mt][nt][0] * rs, o[mt][nt][1] * rs); wv.y = pg8::cvt_pk_bf16(o[mt][nt][2] * rs, o[mt][nt][3] * rs);
                *(LAS u32x2_t*)(lds + GF_OL + (16 * mt + fr) * 528 + (32 * w + 16 * nt + 4 * fq) * 2) = wv; } }
        LDS_BARRIER();
#pragma unroll
        for (int i = 0; i < 4; ++i) { const int piece = tid + 512 * i, t = piece >> 5, c8 = piece & 31; float ov[8], rv[8];
            pg8::unpack8(*(const LAS v4u*)(lds + GF_OL + t * 528 + c8 * 16), ov); pg8::unpack8(rg[i], rv);
#pragma unroll
            for (int e2 = 0; e2 < 8; ++e2) ov[e2] *= rv[e2];
            *(GAS v4u*)((GAS bf16*)A2_ + (size_t)(b * SEQ + tok0 + t) * DM + h * 256 + c8 * 8) = pg8::pack8(ov); }
    }
    LDS_BARRIER();
}

__global__ void __launch_bounds__(NTHREADS, 2) fwd_kernel(Args a) {
    extern __shared__ __attribute__((aligned(16))) unsigned char lds_raw[];
    LAS unsigned char* lds = (LAS unsigned char*)lds_raw;
    cg::grid_group grid = cg::this_grid();
    const int tid = threadIdx.x, lane = tid & 63, wave = __builtin_amdgcn_readfirstlane(tid >> 6);
    const int G = gridDim.x, bx = blockIdx.x;
    const int gw = bx * NWAVES + wave, NGW = G * NWAVES;
    unsigned char* ws = a.ws;
    const float* x = a.in[0]; const float* g1 = a.in[1]; const float* w_in = a.in[2]; const float* gq = a.in[3]; const float* gk = a.in[4];
    const float* gate_up = a.in[5]; const float* gate_bias = a.in[6]; const float* gla_g = a.in[7]; const float* bgate_bias = a.in[8];
    const float* w_ab = a.in[9]; const float* w_gb = a.in[10]; const float* w_out = a.in[11]; const float* g2 = a.in[12]; const float* w_up = a.in[13]; const float* w_dn = a.in[14];
    bf16* WIN = (bf16*)(ws + WS_WIN); bf16* WA = (bf16*)(ws + WS_WA); bf16* WB = (bf16*)(ws + WS_WB); bf16* WO = (bf16*)(ws + WS_WO);
    bf16* WUP = (bf16*)(ws + WS_WUP); bf16* WDN = (bf16*)(ws + WS_WDN); bf16* XB = (bf16*)(ws + WS_XB); bf16* PROJ = (bf16*)(ws + WS_PROJ);
    bf16* VT = (bf16*)(ws + WS_VT); bf16* A1 = (bf16*)(ws + WS_A1); bf16* A2 = (bf16*)(ws + WS_A2);
    float* R1 = (float*)(ws + WS_R1); float* PA = (float*)(ws + WS_PA); float* SS2 = (float*)(ws + WS_SS2);
    bf16* MIXED = (bf16*)(ws + WS_MIXED); bf16* UB = (bf16*)(ws + WS_U); bf16* GATES = (bf16*)a.out;
    const int lo = a.ph_lo, hi = a.ph_hi; const int repm = a.rep;
    if (tid < 16) ((LAS unsigned*)(lds + LDS_BARST))[tid] = 0u;
    __syncthreads();
#define TS(i) do { if (TPROBE >= 0 && bx == TPBLK && tid == 0) ((LAS unsigned long long*)(lds + LDS_BARST + 16))[0 + ((i) == TPROBE ? 0 : ((i) == TPB ? 1 : 2))] = __builtin_amdgcn_s_memrealtime(); } while (0)
    TS(0);
    if (a.ph_lo < 0) grid.sync();
    if (a.ph_lo == 0) {
        unsigned* bw = (unsigned*)(ws + WS_BAR);
        if (bx == 0) { for (int i = tid; i < 4032; i += NTHREADS) bw[i] = 0u;
            asm volatile("s_waitcnt vmcnt(0)" ::: "memory"); __syncthreads();
            if (tid == 0) { __builtin_amdgcn_fence(__ATOMIC_RELEASE, "agent"); asm volatile("s_waitcnt vmcnt(0)" ::: "memory"); __hip_atomic_store(bw + 4064, 0x600DBA55u, __ATOMIC_RELAXED, __HIP_MEMORY_SCOPE_AGENT); } }
        if (tid == 0) { unsigned sp_ = 0; while (xb_ld(bw + 4064) != 0x600DBA55u) { __builtin_amdgcn_s_sleep(1); if (++sp_ > (1u << 22)) break; }
            __builtin_amdgcn_fence(__ATOMIC_ACQUIRE, "agent"); asm volatile("s_waitcnt vmcnt(0)" ::: "memory");
            (void)xb_add(bw + XB_XCNT(xb_xcc_id()), 1u); }
        __syncthreads();
    }
#define NREP(bit) (REPMASK ? (((repm >> (bit)) & 1) + 1) : 1)
#define IN(k) (lo <= (k) && (k) < hi)
#define LAUNDER(p) asm volatile("" : "+s"(p))
#define XBAR_OBJ(bb) XcdBarrier bb; bb.bar = (unsigned*)(ws + WS_BAR); bb.x = xb_xcc_id(); bb.st = (volatile LAS unsigned*)(lds + LDS_BARST)
#define SYNC(k) do { if (IN(k) && IN((k) + 1)) { asm volatile("s_waitcnt vmcnt(0) lgkmcnt(0)" ::: "memory"); \
        XBAR_OBJ(bb_); for (int rs_ = 0; rs_ < NREP(8); ++rs_) xcd_barrier(bb_); } } while (0)

    TS(39);
    if (IN(0)) for (int rep_ = 0; rep_ < NREP(0); ++rep_) {
        LAS float* scr = (LAS float*)(lds + wave * 16640);
        constexpr int I_IN = 16 * 152, I_A = 8 * 16, I_B = 16 * 16, I_O = 16 * 16, I_UP = 16 * 64, I_DN = 64 * 16;
        constexpr int NITEMS = I_IN + I_A + I_B + I_O + I_UP + I_DN;
        for (int it = wave * G + bx; it < NITEMS; it += NGW) {
            int r = it;
            if (r < I_IN) { const int kb = r / 152, nb = r % 152; const int n0 = nb * 64; const int src = n0 < 7680 ? n0 : n0 + 16;
                const float cs = (n0 >= 4608 && n0 < 5120) ? 0.08838834764831845f : 1.0f;
                p0_transpose_item(w_in, DIN, src, g1, 1023, cs, WIN, 1024, n0, kb * 64, scr, lane); continue; } r -= I_IN;
            if (r < I_A) { const int kb = r / 16, nb = r % 16; p0_transpose_item(w_ab, 1024, nb * 64, nullptr, 0, 1.0f, WA, 512, nb * 64, kb * 64, scr, lane); continue; } r -= I_A;
            if (r < I_B) { const int kb = r / 16, nb = r % 16; p0_transpose_item(w_gb, 1024, nb * 64, gla_g, 255, 1.0f, WB, 1024, nb * 64, kb * 64, scr, lane); continue; } r -= I_B;
            if (r < I_O) { const int kb = r / 16, nb = r % 16; p0_transpose_item(w_out, 1024, nb * 64, nullptr, 0, 1.0f, WO, 1024, nb * 64, kb * 64, scr, lane); continue; } r -= I_O;
            if (r < I_UP) { const int kb = r / 64, nb = r % 64; p0_transpose_item(w_up, 4096, nb * 64, g2, 1023, 1.0f, WUP, 1024, nb * 64, kb * 64, scr, lane); continue; } r -= I_UP;
            { const int kb = r / 16, nb = r % 16; p0_transpose_item(w_dn, 1024, nb * 64, nullptr, 0, 1.0f, WDN, 4096, nb * 64, kb * 64, scr, lane); }
        }
        __syncthreads();
        TS(40);
        LAS float* WAl = (LAS float*)lds;
        for (int idx = tid; idx < 1024 * 16; idx += NTHREADS) { const int k = idx >> 4, r = idx & 15; WAl[k * 20 + r] = w_in[(size_t)k * DIN + 7680 + r] * g1[k]; }
        __syncthreads();
        { const int fr = lane & 15, fq = lane >> 4, half = wave & 1; LAS float* xch = (LAS float*)(lds + 86016) + (wave >> 1) * 320;
          for (int tile = bx * 4 + (wave >> 1); tile < MTOK / 16; tile += G * 4) {
            asm volatile("" ::: "memory");
            const int row = tile * 16 + fr;
            const GAS f32x4* xr = (const GAS f32x4*)(x + (size_t)row * DM) + 2 * fq;
            GAS v4u* xo = (GAS v4u*)(XB + (size_t)row * DM) + fq;
            f32x4 acc = (f32x4){0.f, 0.f, 0.f, 0.f}; float ss = 0.f;
#pragma unroll 1
            for (int jb = 16 * half; jb < 16 * half + 16; jb += 8) {
                f32x4 v[8][2];
#pragma unroll
                for (int u = 0; u < 8; ++u) { v[u][0] = __builtin_nontemporal_load(xr + (jb + u) * 8); v[u][1] = __builtin_nontemporal_load(xr + (jb + u) * 8 + 1); }
#pragma unroll
                for (int u = 0; u < 8; ++u) { const int j = jb + u; const f32x4 a0 = v[u][0], a1 = v[u][1];
                    ss += ((a0[0] * a0[0] + a0[1] * a0[1]) + (a0[2] * a0[2] + a0[3] * a0[3])) + ((a1[0] * a1[0] + a1[1] * a1[1]) + (a1[2] * a1[2] + a1[3] * a1[3]));
                    v4u o; o.x = pk2(a0[0], a0[1]); o.y = pk2(a0[2], a0[3]); o.z = pk2(a1[0], a1[1]); o.w = pk2(a1[2], a1[3]); xo[j * 4] = o;
                    const LAS float* wp = WAl + (32 * j + 8 * fq) * 20 + fr;
                    acc = __builtin_amdgcn_mfma_f32_16x16x4f32(a0[0], wp[0], acc, 0, 0, 0); acc = __builtin_amdgcn_mfma_f32_16x16x4f32(a0[1], wp[20], acc, 0, 0, 0);
                    acc = __builtin_amdgcn_mfma_f32_16x16x4f32(a0[2], wp[40], acc, 0, 0, 0); acc = __builtin_amdgcn_mfma_f32_16x16x4f32(a0[3], wp[60], acc, 0, 0, 0);
                    acc = __builtin_amdgcn_mfma_f32_16x16x4f32(a1[0], wp[80], acc, 0, 0, 0); acc = __builtin_amdgcn_mfma_f32_16x16x4f32(a1[1], wp[100], acc, 0, 0, 0);
                    acc = __builtin_amdgcn_mfma_f32_16x16x4f32(a1[2], wp[120], acc, 0, 0, 0); acc = __builtin_amdgcn_mfma_f32_16x16x4f32(a1[3], wp[140], acc, 0, 0, 0); }
            }
            if (half == 1) { xch[lane] = acc[0]; xch[64 + lane] = acc[1]; xch[128 + lane] = acc[2]; xch[192 + lane] = acc[3]; xch[256 + lane] = ss; }
            __syncthreads();
            if (half == 0) { acc[0] += xch[lane]; acc[1] += xch[64 + lane]; acc[2] += xch[128 + lane]; acc[3] += xch[192 + lane]; ss += xch[256 + lane];
                ss += __shfl_xor(ss, 16); ss += __shfl_xor(ss, 32);
                const float r1 = 1.0f / sqrtf(ss * (1.0f / 1024.0f) + EPS);
#pragma unroll
                for (int j = 0; j < 4; ++j) { const float rr = __shfl(r1, 4 * fq + j); PA[(size_t)(tile * 16 + 4 * fq + j) * 16 + fr] = acc[j] * rr; }
                if (fq == 0) R1[row] = r1; }
            __syncthreads();
          } }
        __syncthreads();
    }
    TS(41);
    SYNC(0); TS(1);
    if (bx == 0 && tid == 0 && a.ph_lo == 0) __hip_atomic_store((unsigned*)(ws + WS_BAR) + 4064, 0u, __ATOMIC_RELAXED, __HIP_MEMORY_SCOPE_AGENT);

    for (int bq = 0; bq < 2; ++bq) {
        int b = bq; LAUNDER(b);
        const int p1 = 1 + 3 * b;
        if (IN(p1)) for (int rep_ = 0; rep_ < NREP(1); ++rep_) {
            pg8::Gemm g{XB + (size_t)b * SEQ * DM, WIN, SEQ, N1, DM}; pg8::StaticOrder S; S.init(SEQ, N1, G, bx);
            pg8::EpiProj E{PROJ, VT, GATES + (size_t)b * SEQ * 2048, R1 + b * SEQ, bgate_bias};
            pg8::gemm_phase<pg8::EpiProj, pg8::StaticOrder, true, true>(lds, g, S, E);
        }
        SYNC(p1); TS(p1 + 1);
        int tid_ = threadIdx.x; asm volatile("" : "+v"(tid_)); const int lane_ = tid_ & 63; const int wave_ = __builtin_amdgcn_readfirstlane(tid_ >> 6); int bx_ = bx; LAUNDER(bx_);
        const float* gate_up_ = gate_up; const float* gate_bias_ = gate_bias; const float* PA_ = PA; const bf16* PROJ_ = PROJ; const bf16* VT_ = VT; bf16* A1_ = A1; bf16* A2_ = A2; const float* gq_ = gq; const float* gk_ = gk;
        float* SBUF_ = (float*)(ws + WS_XB); float* DBUF_ = (float*)(ws + WS_MISC + 2 * MiB); float* ML_ = (float*)(ws + WS_MISC);
        bf16* SB16_ = (b == 0) ? (A2 + (size_t)SEQ * DM) : (XB + (size_t)SEQ * DM);
        LAUNDER(SB16_);
        bf16* QGS_ = (b == 0) ? (A1 + (size_t)SEQ * 512) : (bf16*)(ws + 247 * MiB);
        LAUNDER(QGS_);
        LAUNDER(gate_up_); LAUNDER(gate_bias_); LAUNDER(PA_); LAUNDER(PROJ_); LAUNDER(VT_); LAUNDER(A1_); LAUNDER(A2_); LAUNDER(gq_); LAUNDER(gk_); LAUNDER(SBUF_); LAUNDER(DBUF_); LAUNDER(ML_);
        if (IN(p1 + 1)) {
            if (bx_ < 128) { for (int rep_ = 0; rep_ < NREP(2); ++rep_) { gla_local(lds, b, bx_, PROJ_, VT_, PA_, gate_up_, gate_bias_, SBUF_, DBUF_, A2_, QGS_, tid_, wave_, lane_); }
                if (b == 0) TS(20);
                asm volatile("s_waitcnt vmcnt(0) lgkmcnt(0)" ::: "memory"); __syncthreads();
                if (tid_ == 0) { unsigned* cw = (unsigned*)(ws + WS_BAR) + 3520 + 64 * b;
                    __builtin_amdgcn_fence(__ATOMIC_RELEASE, "agent"); asm volatile("s_waitcnt vmcnt(0)" ::: "memory");
                    (void)xb_add(cw, 1u); }
            }
            if (b == 0) TS(21);
            {
                float gkr[8], gqr[16];
#pragma unroll
                for (int i = 0; i < 8; ++i) gkr[i] = gk_[(tid_ & 7) * 8 + i];
#pragma unroll
                for (int i = 0; i < 8; ++i) { gqr[i] = gq_[8 * (lane_ >> 4) + i]; gqr[8 + i] = gq_[32 + 8 * (lane_ >> 4) + i]; }
                bf16* PROJW = (bf16*)PROJ_;
                asm volatile("" :: "v"(gkr[7]), "v"(gqr[15]));
                const int first = bx_, cnt = bx_ < 128 ? 1 : 5;
                const int nrep_ = NREP(7);
                for (int rep_ = 0; rep_ < nrep_; ++rep_) {
                    AttnKQ R; v4u Vr[6]; attn_load_kq(R, PROJ_, first, tid_, wave_, lane_); attn_load_v(Vr, PROJ_, first, tid_);
                    for (int k = 0; k < cnt; ++k) { const int it = first + 128 * k;
                        LDS_BARRIER();
                        attn_stage_k(R, lds, gkr, tid_); attn_stage_v(Vr, lds, tid_);
                        const v4u q0 = R.q[0], q1 = R.q[1], q2 = R.q[2], q3 = R.q[3];
                        LDS_BARRIER();
                        if (k + 1 < cnt) { attn_load_kq(R, PROJ_, it + 128, tid_, wave_, lane_); attn_load_v(Vr, PROJ_, it + 128, tid_); }
                        { f32x4 sc[9]; float mx, den; attn_scores(sc, mx, den, q0, q1, lds, gqr, 0, it_first_block(it), wave_, lane_);
                          attn_pv(sc, mx, den, lds, PROJW, ML_, it, 0, wave_, lane_, rep_ == nrep_ - 1); }
                        { f32x4 sc[9]; float mx, den; attn_scores(sc, mx, den, q2, q3, lds, gqr, 8, false, wave_, lane_);
                          attn_pv(sc, mx, den, lds, PROJW, ML_, it, 8, wave_, lane_, rep_ == nrep_ - 1); }
                    }
                }
            }
        }
        if (IN(p1 + 1)) {
            if (tid_ == 0) { unsigned* cw = (unsigned*)(ws + WS_BAR) + 3520 + 64 * b; unsigned sp_ = 0;
                while (xb_ld(cw) < 128u) { __builtin_amdgcn_s_sleep(1); if (++sp_ > (1u << 22)) break; }
                __builtin_amdgcn_fence(__ATOMIC_ACQUIRE, "agent"); asm volatile("s_waitcnt vmcnt(0)" ::: "memory"); }
            __syncthreads();
            { const int gid = bx_ * NTHREADS + tid_; const int h = gid >> 15, r = (gid >> 9) & 63, tl = gid & 511; const int kdr = 16 * (r >> 3) + 4 * ((tl & 63) >> 4) + (r & 3);
              float loc[32], dec[32];
#pragma unroll
              for (int sg = 0; sg < 32; ++sg) { loc[sg] = ((const GAS float*)SBUF_)[((size_t)(h * 32 + sg) * 64 + r) * 512 + tl]; dec[sg] = ((const GAS float*)DBUF_)[(h * 32 + sg) * 128 + kdr]; }
              float cur = 0.f;
#pragma unroll
              for (int sg = 0; sg < 32; ++sg) { ((GAS unsigned short*)SB16_)[((size_t)(h * 32 + sg) * 64 + r) * 512 + tl] = (unsigned short)f2bf(cur); cur = dec[sg] * cur + loc[sg]; } }
        }
        SYNC(p1 + 1); TS(p1 + 2);
        if (IN(p1 + 2)) {
            for (int rep_ = 0; rep_ < NREP(3); ++rep_) { gla_fix(lds, b, bx_, PROJ_, SB16_, A2_, QGS_, tid_, wave_, lane_); }
            {
            for (int rep_ = 0; rep_ < NREP(9); ++rep_) {
                for (int idx = bx_ * NTHREADS + tid_; idx < SEQ * 64; idx += G * NTHREADS) {
                    const int t = idx >> 6, slot = (idx >> 3) & 7, c8 = idx & 7;
                    float m[3], dn[3];
#pragma unroll
                    for (int g = 0; g < 3; ++g) { const GAS float* mp = (const GAS float*)ML_ + (size_t)t * 48 + (g * 8 + slot) * 2; m[g] = mp[0]; dn[g] = mp[1]; }
                    const float M = fmaxf(m[0], fmaxf(m[1], m[2])); float D = 0.f; float acc[8];
#pragma unroll
                    for (int i = 0; i < 8; ++i) acc[i] = 0.f;
#pragma unroll
                    for (int g = 0; g < 3; ++g) { const float wg = __builtin_amdgcn_exp2f(m[g] - M); D += wg * dn[g]; float f[8];
                        pg8::unpack8(*(const GAS v4u*)((const GAS bf16*)PROJ_ + (size_t)t * PLD + (g * 8 + slot) * 64 + c8 * 8), f);
#pragma unroll
                        for (int i = 0; i < 8; ++i) acc[i] += wg * f[i]; }
                    const float inv = 1.0f / D;
#pragma unroll
                    for (int i = 0; i < 8; ++i) acc[i] *= inv;
                    { GAS v4u* ap = (GAS v4u*)((GAS bf16*)A1_ + (size_t)(b * SEQ + t) * 512 + slot * 64 + c8 * 8); if (b == 0) __builtin_nontemporal_store(pg8::pack8(acc), ap); else *ap = pg8::pack8(acc); }
                }
            }
            }
        }
        SYNC(p1 + 2); TS(p1 + 3);
    }
    if (IN(7)) for (int rep_ = 0; rep_ < NREP(4); ++rep_) {
#pragma unroll 1
        for (int pass = 0; pass < 2; ++pass) {
            const bool useB = (((bx & 1) != 0) != (pass == 1));
            pg8::Gemm g{useB ? A2 : A1, useB ? WB : WA, MTOK, DM, useB ? 1024 : 512}; pg8::StaticOrder S; S.init(MTOK, DM, G, bx); pg8::EpiBranch E{MIXED, GATES, useB ? 1024 : 0, pass};
            pg8::gemm_phase<pg8::EpiBranch, pg8::StaticOrder, true, true>(lds, g, S, E);
            __syncthreads();
        }
    }
    SYNC(7); TS(8);
    if (IN(8)) for (int rep_ = 0; rep_ < NREP(5); ++rep_) { pg8::Gemm g{MIXED, WO, MTOK, DM, 1024}; pg8::StaticOrder S; S.init(MTOK, DM, G, bx); pg8::EpiOut1 E{x, a.out, XB, SS2};
        pg8::gemm_phase<pg8::EpiOut1, pg8::StaticOrder, true, true>(lds, g, S, E); }
    SYNC(8); TS(9);
    if (IN(9)) for (int rep_ = 0; rep_ < NREP(6); ++rep_) { pg8::Gemm g{XB, WUP, MTOK, FF, 1024}; pg8::StaticOrder S; S.init(MTOK, FF, G, bx); pg8::EpiUp E{UB, SS2};
        pg8::gemm_phase<pg8::EpiUp, pg8::StaticOrder, true, true>(lds, g, S, E); }
    SYNC(9); TS(10);
    if (IN(10)) for (int rep_ = 0; rep_ < NREP(10); ++rep_) { pg8::Gemm g{UB, WDN, MTOK, DM, FF}; pg8::StaticOrder S; S.init(MTOK, DM, G, bx); pg8::EpiDown E{a.out, rep_ == NREP(10) - 1};
        pg8::gemm_phase<pg8::EpiDown, pg8::StaticOrder, true, true>(lds, g, S, E); }
    TS(11);
    if (TPROBE >= 0 && bx == TPBLK && tid == 0) { const LAS unsigned long long* tsp = (const LAS unsigned long long*)(lds + LDS_BARST + 16); const unsigned long long dt = tsp[1] - tsp[0];
        const unsigned long long tend = __builtin_amdgcn_s_memrealtime() + 4ull * dt; while (__builtin_amdgcn_s_memrealtime() < tend) __builtin_amdgcn_s_sleep(8); }
#undef IN
#undef SYNC
}

extern "C" void kernel_launch(void* const* d_in, const int* in_sizes, int n_in, void* d_out, int out_size, void* d_ws, size_t ws_size, hipStream_t stream) {
    static int grid = 0;
    if (grid == 0) {
        if (n_in != 15 || out_size != MTOK * DM || ws_size < WS_END) { fprintf(stderr, "kernel_launch: unexpected shapes (n_in %d, out %d, ws %zu)\n", n_in, out_size, ws_size); grid = -1; return; }
        int dev = 0, cus = 0, per_cu = 0;
        hipGetDevice(&dev); hipDeviceGetAttribute(&cus, hipDeviceAttributeMultiprocessorCount, dev);
        if (hipFuncSetAttribute((const void*)fwd_kernel, hipFuncAttributeMaxDynamicSharedMemorySize, LDS_BYTES) != hipSuccess) { fprintf(stderr, "kernel_launch: hipFuncSetAttribute failed\n"); grid = -1; return; }
        if (hipOccupancyMaxActiveBlocksPerMultiprocessor(&per_cu, (const void*)fwd_kernel, NTHREADS, LDS_BYTES) != hipSuccess || per_cu < 1) per_cu = 1;
        (void)hipGetLastError();
        grid = cus * per_cu;
        fprintf(stderr, "kernel_launch: grid %d (cus %d x %d)\n", grid, cus, per_cu);
    }
    if (grid < 0) return;
    Args a{};
    for (int i = 0; i < 15; ++i) a.in[i] = (const float*)d_in[i];
    a.out = (float*)d_out; a.ws = (unsigned char*)d_ws; a.ph_lo = 0; a.ph_hi = 11; a.rep = REPMASK; a.pad = 0;
    void* args[] = {&a};
    hipError_t e = hipLaunchCooperativeKernel((const void*)fwd_kernel, dim3(grid), dim3(NTHREADS), args, LDS_BYTES, stream);
    if (e != hipSuccess) fprintf(stderr, "cooperative launch failed: %s (grid %d)\n", hipGetErrorString(e), grid);
}
```

```cpp
#include <hip/hip_runtime.h>
#include <hip/hip_cooperative_groups.h>
#include <cstdio>
#include <cstdint>
#include <cmath>
namespace cg = cooperative_groups;
namespace pg8 {
#define PG8_LAS __attribute__((address_space(3)))
typedef unsigned short bf16_t;
typedef short bf16x8 __attribute__((ext_vector_type(8)));
typedef float f32x4 __attribute__((ext_vector_type(4)));
typedef unsigned u32x4 __attribute__((ext_vector_type(4)));
constexpr int BM = 256, BK = 64, HALF = 128, HTB = HALF * BK * 2  , STAGE_BYTES = 8 * HTB, NXCD = 8, WGM = 8;

__host__ __device__ __forceinline__ int lds_byte(int r, int c) { const int st = (r >> 4) * 2 + (c >> 5), rr = r & 15, cc = c & 31, ob = rr * 64 + cc * 2; return st * 1024 + (ob ^ (((ob >> 9) & 1) << 5)); }
__host__ __device__ __forceinline__ void stage_rc(int b, int& R, int& C) { const int st = b / 1024, sb = b % 1024, swz = sb ^ (((sb >> 9) & 1) << 5); R = (st >> 1) * 16 + swz / 64; C = (st & 1) * 32 + (swz % 64) / 2; }
__host__ __device__ __forceinline__ int perm32(int rho) { const int n = rho >> 4, i = rho & 15; return 8 * (i >> 2) + 4 * n + (i & 3); }

struct Unit { int pm, pn; };
struct Gemm { const bf16_t* A; const bf16_t* Bt; int M, N, K; };

struct StaticOrder {
    int nM, nN, nwg, G, c;
    __host__ __device__ void init(int M, int N, int G_, int c_) { nM = M / BM; nN = N / BM; nwg = nM * nN; G = G_; c = c_; }
    __host__ __device__ bool next(int i, Unit& u) const {
        const long L = (long)i * G + c; if (L >= nwg) return false;
        int wgid = (int)L; { const int q = nwg / NXCD, r = nwg % NXCD, xcd = wgid % NXCD, off = wgid / NXCD; wgid = (xcd < r ? xcd * (q + 1) : r * (q + 1) + (xcd - r) * q) + off; }
        const int nig = WGM * nN, gid = wgid / nig, fm = gid * WGM, gsz = (nM - fm) < WGM ? (nM - fm) : WGM;
        u.pm = fm + ((wgid % nig) % gsz); u.pn = (wgid % nig) / gsz; return true;
    }
    __device__ __forceinline__ void a_ready(const Unit&) const {}
    __device__ __forceinline__ void done(const Unit&) const {}
};
typedef float f32x2 __attribute__((ext_vector_type(2)));
typedef __bf16 bf16x2_cv __attribute__((ext_vector_type(2)));
__device__ __forceinline__ unsigned cvt_pk_bf16(float lo, float hi) { const f32x2 v = {lo, hi}; const bf16x2_cv b = __builtin_convertvector(v, bf16x2_cv); return __builtin_bit_cast(unsigned, b); }
__device__ __forceinline__ float bflo(unsigned w) { return __uint_as_float(w << 16); }
__device__ __forceinline__ float bfhi(unsigned w) { return __uint_as_float(w & 0xffff0000u); }
__device__ __forceinline__ void unpack8(const u32x4 w, float (&f)[8]) { f[0] = bflo(w.x); f[1] = bfhi(w.x); f[2] = bflo(w.y); f[3] = bfhi(w.y); f[4] = bflo(w.z); f[5] = bfhi(w.z); f[6] = bflo(w.w); f[7] = bfhi(w.w); }
__device__ __forceinline__ u32x4 pack8(const float (&v)[8]) { u32x4 w; w.x = cvt_pk_bf16(v[0], v[1]); w.y = cvt_pk_bf16(v[2], v[3]); w.z = cvt_pk_bf16(v[4], v[5]); w.w = cvt_pk_bf16(v[6], v[7]); return w; }
__device__ __forceinline__ float fsigmoid(float x) { return __builtin_amdgcn_rcpf(1.0f + __builtin_amdgcn_exp2f(x * -1.4426950408889634f)); }

struct EpiProj {
    static constexpr bool PERM = true, AFTER_DRAIN = false;
    bf16_t* proj; bf16_t* vt; bf16_t* gates; const float* r1; const float* gbias;
    __device__ __forceinline__ void operator()(const f32x4 (&acc)[2][2][4][2], const Unit& u, int wr, int wc, int fr_in, int fq_in) const {
        int fr = fr_in, fq = fq_in; asm volatile("" : "+v"(fr), "+v"(fq));
        const int ct = u.pn; const int row0 = u.pm * BM + wr * 64 + fr; const int cl = wc * 32 + 8 * fq;
        float rsv[2][4];
#pragma unroll
        for (int ai = 0; ai < 2; ++ai)
#pragma unroll
            for (int m = 0; m < 4; ++m) rsv[ai][m] = r1[row0 + ai * HALF + m * 16];
        f32x4 gb[2][2];
        if (ct >= 30) {
#pragma unroll
            for (int bj = 0; bj < 2; ++bj) { const int gc = (ct - 30) * 256 + cl + bj * HALF; gb[bj][0] = *(const f32x4*)(gbias + gc); gb[bj][1] = *(const f32x4*)(gbias + gc + 4); } }
        else { gb[0][0] = gb[0][1] = gb[1][0] = gb[1][1] = (f32x4){0.f, 0.f, 0.f, 0.f}; }
#pragma unroll
        for (int ai = 0; ai < 2; ++ai)
#pragma unroll
            for (int m = 0; m < 4; ++m) {
                const int row = row0 + ai * HALF + m * 16; const float rs = rsv[ai][m];
#pragma unroll
                for (int bj = 0; bj < 2; ++bj) {
                    const f32x4 v0 = acc[ai][bj][m][0] * rs, v1 = acc[ai][bj][m][1] * rs;
                    float v[8] = {v0[0], v0[1], v0[2], v0[3], v1[0], v1[1], v1[2], v1[3]};
                    const int c = cl + bj * HALF;
                    if (ct < 22) { *(u32x4*)(proj + (size_t)row * 6656 + ct * 256 + c) = pack8(v); }
                    else if (ct < 26) { const u32x4 w = pack8(v); bf16_t* p = vt + (size_t)((ct - 22) * 256 + c) * 8192 + row;
                        p[0] = (bf16_t)(w.x & 0xffffu); p[8192] = (bf16_t)(w.x >> 16); p[2 * 8192] = (bf16_t)(w.y & 0xffffu); p[3 * 8192] = (bf16_t)(w.y >> 16);
                        p[4 * 8192] = (bf16_t)(w.z & 0xffffu); p[5 * 8192] = (bf16_t)(w.z >> 16); p[6 * 8192] = (bf16_t)(w.w & 0xffffu); p[7 * 8192] = (bf16_t)(w.w >> 16); }
                    else if (ct < 30) {
#pragma unroll
                        for (int i = 0; i < 8; ++i) v[i] = v[i] * fsigmoid(v[i]);
                        *(u32x4*)(proj + (size_t)row * 6656 + (ct - 4) * 256 + c) = pack8(v); }
                    else { const int gc = (ct - 30) * 256 + c; const float bb[8] = {gb[bj][0][0], gb[bj][0][1], gb[bj][0][2], gb[bj][0][3], gb[bj][1][0], gb[bj][1][1], gb[bj][1][2], gb[bj][1][3]};
#pragma unroll
                        for (int i = 0; i < 8; ++i) v[i] = fsigmoid(v[i] + bb[i]);
                        __builtin_nontemporal_store(pack8(v), (u32x4*)(gates + (size_t)row * 2048 + gc)); }
                }
            }
    }
};
struct EpiBranch {
    static constexpr bool PERM = true, AFTER_DRAIN = false;
    bf16_t* mixed; const bf16_t* gates; int goff; int add;
    __device__ __forceinline__ void operator()(const f32x4 (&acc)[2][2][4][2], const Unit& u, int wr, int wc, int fr_in, int fq_in) const {
        int fr = fr_in, fq = fq_in; asm volatile("" : "+v"(fr), "+v"(fq));
        const int row0 = u.pm * BM + wr * 64 + fr; const int cl = u.pn * BM + wc * 32 + 8 * fq;
#pragma unroll
        for (int ai = 0; ai < 2; ++ai) {
            u32x4 gw[4][2], tw[4][2];
#pragma unroll
            for (int m = 0; m < 4; ++m)
#pragma unroll
                for (int bj = 0; bj < 2; ++bj) { const int row = row0 + ai * HALF + m * 16, c = cl + bj * HALF;
                    gw[m][bj] = __builtin_nontemporal_load((const u32x4*)(gates + (size_t)row * 2048 + goff + c));
                    tw[m][bj] = add ? *(const u32x4*)(mixed + (size_t)row * 1024 + c) : (u32x4){0u, 0u, 0u, 0u}; }
#pragma unroll
            for (int m = 0; m < 4; ++m)
#pragma unroll
                for (int bj = 0; bj < 2; ++bj) { const int row = row0 + ai * HALF + m * 16, c = cl + bj * HALF; float g[8], t[8], v[8];
                    unpack8(gw[m][bj], g); unpack8(tw[m][bj], t);
                    const f32x4 v0 = acc[ai][bj][m][0], v1 = acc[ai][bj][m][1];
                    v[0] = v0[0] * g[0] + t[0]; v[1] = v0[1] * g[1] + t[1]; v[2] = v0[2] * g[2] + t[2]; v[3] = v0[3] * g[3] + t[3];
                    v[4] = v1[0] * g[4] + t[4]; v[5] = v1[1] * g[5] + t[5]; v[6] = v1[2] * g[6] + t[6]; v[7] = v1[3] * g[7] + t[7];
                    *(u32x4*)(mixed + (size_t)row * 1024 + c) = pack8(v); }
        }
    }
};
struct EpiOut1 {
    static constexpr bool PERM = true, AFTER_DRAIN = false;
    const float* x; float* out; bf16_t* x1b; float* ss2;
    __device__ __forceinline__ void operator()(const f32x4 (&acc)[2][2][4][2], const Unit& u, int wr, int wc, int fr_in, int fq_in) const {
        int fr = fr_in, fq = fq_in; asm volatile("" : "+v"(fr), "+v"(fq));
        const int row0 = u.pm * BM + wr * 64 + fr; const int cl = u.pn * BM + wc * 32 + 8 * fq;
#pragma unroll
        for (int ai = 0; ai < 2; ++ai) {
            f32x4 xv[4][2][2];
#pragma unroll
            for (int m = 0; m < 4; ++m)
#pragma unroll
                for (int bj = 0; bj < 2; ++bj) { const size_t off = (size_t)(row0 + ai * HALF + m * 16) * 1024 + cl + bj * HALF; xv[m][bj][0] = __builtin_nontemporal_load((const f32x4*)(x + off)); xv[m][bj][1] = __builtin_nontemporal_load((const f32x4*)(x + off + 4)); }
#pragma unroll
            for (int m = 0; m < 4; ++m) {
                const int row = row0 + ai * HALF + m * 16; float ssq = 0.f;
#pragma unroll
                for (int bj = 0; bj < 2; ++bj) {
                    const size_t off = (size_t)row * 1024 + cl + bj * HALF;
                    const f32x4 o0 = xv[m][bj][0] + acc[ai][bj][m][0], o1 = xv[m][bj][1] + acc[ai][bj][m][1];
                    __builtin_nontemporal_store(o0, (f32x4*)(out + off)); __builtin_nontemporal_store(o1, (f32x4*)(out + off + 4));
                    const float v[8] = {o0[0], o0[1], o0[2], o0[3], o1[0], o1[1], o1[2], o1[3]};
                    *(u32x4*)(x1b + off) = pack8(v);
#pragma unroll
                    for (int i = 0; i < 8; ++i) ssq += v[i] * v[i];
                }
                ssq += __shfl_xor(ssq, 16); ssq += __shfl_xor(ssq, 32);
                if (fq == 0) ss2[(size_t)row * 16 + u.pn * 4 + wc] = ssq;
            }
        }
    }
};
struct EpiUp {
    static constexpr bool PERM = true, AFTER_DRAIN = false;
    bf16_t* U; const float* ss2;
    __device__ __forceinline__ void operator()(const f32x4 (&acc)[2][2][4][2], const Unit& u, int wr, int wc, int fr_in, int fq_in) const {
        int fr = fr_in, fq = fq_in; asm volatile("" : "+v"(fr), "+v"(fq));
        const int row0 = u.pm * BM + wr * 64 + fr; const int cl = u.pn * BM + wc * 32 + 8 * fq;
        float rsv[2][4];
#pragma unroll
        for (int ai = 0; ai < 2; ++ai) { f32x4 sv[4][4];
#pragma unroll
            for (int m = 0; m < 4; ++m) { const f32x4* sp = (const f32x4*)(ss2 + (size_t)(row0 + ai * HALF + m * 16) * 16); sv[m][0] = sp[0]; sv[m][1] = sp[1]; sv[m][2] = sp[2]; sv[m][3] = sp[3]; }
#pragma unroll
            for (int m = 0; m < 4; ++m) { const f32x4 t = (sv[m][0] + sv[m][1]) + (sv[m][2] + sv[m][3]); const float sum = (t[0] + t[1]) + (t[2] + t[3]);
                rsv[ai][m] = __builtin_amdgcn_rsqf(sum * (1.0f / 1024.0f) + 1e-6f); } }
#pragma unroll
        for (int ai = 0; ai < 2; ++ai)
#pragma unroll
            for (int m = 0; m < 4; ++m) {
                const int row = row0 + ai * HALF + m * 16; const float rs = rsv[ai][m];
#pragma unroll
                for (int bj = 0; bj < 2; ++bj) {
                    const f32x4 v0 = acc[ai][bj][m][0] * rs, v1 = acc[ai][bj][m][1] * rs;
                    float v[8] = {v0[0], v0[1], v0[2], v0[3], v1[0], v1[1], v1[2], v1[3]};
#pragma unroll
                    for (int i = 0; i < 8; ++i) { const float r = fmaxf(v[i], 0.f); v[i] = r * r; }
                    *(u32x4*)(U + (size_t)row * 4096 + cl + bj * HALF) = pack8(v);
                }
            }
    }
};
struct EpiDown {
    static constexpr bool PERM = true, AFTER_DRAIN = false;
    float* out; int store;
    __device__ __forceinline__ void operator()(const f32x4 (&acc)[2][2][4][2], const Unit& u, int wr, int wc, int fr_in, int fq_in) const {
        int fr = fr_in, fq = fq_in; asm volatile("" : "+v"(fr), "+v"(fq));
        const int row0 = u.pm * BM + wr * 64 + fr; const int cl = u.pn * BM + wc * 32 + 8 * fq;
#pragma unroll
        for (int ai = 0; ai < 2; ++ai) {
            f32x4 xv[4][2][2];
#pragma unroll
            for (int m = 0; m < 4; ++m)
#pragma unroll
                for (int bj = 0; bj < 2; ++bj) { const size_t off = (size_t)(row0 + ai * HALF + m * 16) * 1024 + cl + bj * HALF; xv[m][bj][0] = __builtin_nontemporal_load((const f32x4*)(out + off)); xv[m][bj][1] = __builtin_nontemporal_load((const f32x4*)(out + off + 4)); }
#pragma unroll
            for (int m = 0; m < 4; ++m)
#pragma unroll
                for (int bj = 0; bj < 2; ++bj) {
                    const size_t off = (size_t)(row0 + ai * HALF + m * 16) * 1024 + cl + bj * HALF;
                    const f32x4 o0 = xv[m][bj][0] + acc[ai][bj][m][0], o1 = xv[m][bj][1] + acc[ai][bj][m][1];
                    if (store) { __builtin_nontemporal_store(o0, (f32x4*)(out + off)); __builtin_nontemporal_store(o1, (f32x4*)(out + off + 4)); }
                }
        }
    }
};
template <class Epi, class Sched, bool ALIGN_EPI = false, bool SP2 = false>
__device__ __forceinline__ void gemm_phase(PG8_LAS unsigned char* lds, const Gemm g, const Sched& S, const Epi& E) {
    int tid_l = threadIdx.x; asm volatile("" : "+v"(tid_l));
    const int tid = tid_l, wid = __builtin_amdgcn_readfirstlane(tid >> 6), lane = tid & 63, wr = wid >> 2, wc = wid & 3, fr = lane & 15, fq = lane >> 4;
    const int K = g.K, nt = K / BK;
    unsigned voffA[2], voffB[2];
#pragma unroll
    for (int i = 0; i < 2; ++i) { int R, C; stage_rc(tid * 16 + i * 8192, R, C); const int Rb = Epi::PERM ? ((R & ~31) + perm32(R & 31)) : R;
        voffA[i] = (unsigned)(R * K + C) * 2u; voffB[i] = (unsigned)(Rb * K + C) * 2u; }
    const size_t kstep = (size_t)(BK * 2);
    const size_t hstep = (size_t)HALF * K * 2;
    const size_t tstep = 2 * hstep;
    const unsigned ldsw = (unsigned)wid * 1024u;
    const int aoff = lds_byte(wr * 64 + fr, fq * 8), boff = lds_byte(wc * 32 + fr, fq * 8);
#define PG8_SA(b, h) (((b) * 2 + (h)) * HTB)
#define PG8_SB(b, h) ((4 + (b) * 2 + (h)) * HTB)
#define PG8_STAGE(bufoff, gbase, voff) do { _Pragma("unroll") for (int _i = 0; _i < 2; ++_i) \
        __builtin_amdgcn_global_load_lds((const unsigned*)((const char*)(gbase) + (voff)[_i]), (PG8_LAS unsigned*)(lds + (bufoff) + ldsw + _i * 8192), 16, 0, 0); } while (0)
#define PG8_LDA(dst, b, h) do { _Pragma("unroll") for (int m = 0; m < 4; ++m) _Pragma("unroll") for (int k = 0; k < 2; ++k) dst[m][k] = *(const PG8_LAS bf16x8*)(lds + PG8_SA(b, h) + aoff + m * 2048 + k * 1024); } while (0)
#define PG8_LDB(dst, b, h) do { _Pragma("unroll") for (int n = 0; n < 2; ++n) _Pragma("unroll") for (int k = 0; k < 2; ++k) dst[n][k] = *(const PG8_LAS bf16x8*)(lds + PG8_SB(b, h) + boff + n * 2048 + k * 1024); } while (0)
#define PG8_MMA(ai, bj, At, Bt) do { __builtin_amdgcn_s_setprio(1); _Pragma("unroll") for (int m = 0; m < 4; ++m) _Pragma("unroll") for (int n = 0; n < 2; ++n) _Pragma("unroll") for (int k = 0; k < 2; ++k) \
        acc[ai][bj][m][n] = __builtin_amdgcn_mfma_f32_16x16x32_bf16(Bt[n][k], At[m][k], acc[ai][bj][m][n], 0, 0, 0); __builtin_amdgcn_s_setprio(0); } while (0)
#define PG8_WAIT_V(n) asm volatile("s_waitcnt vmcnt(" #n ")" ::: "memory")
#define PG8_WAIT_L(n) asm volatile("s_waitcnt lgkmcnt(" #n ")" ::: "memory")
#define PG8_BAR __builtin_amdgcn_s_barrier()
#define PG8_SCHED __builtin_amdgcn_sched_barrier(0)
    Unit cur, nxt; int ui = 0;
    if (!S.next(0, cur)) return;
    f32x4 acc[2][2][4][2];
#pragma unroll
    for (int a = 0; a < 2; ++a)
#pragma unroll
        for (int b = 0; b < 2; ++b)
#pragma unroll
            for (int m = 0; m < 4; ++m)
#pragma unroll
                for (int n = 0; n < 2; ++n) acc[a][b][m][n] = (f32x4){0.f, 0.f, 0.f, 0.f};
    bf16x8 At[4][2], B0[2][2], B1[2][2];
    const char* cA = (const char*)g.A + (size_t)cur.pm * tstep; const char* cB = (const char*)g.Bt + (size_t)cur.pn * tstep;
    S.a_ready(cur);
    if constexpr (SP2) {
        PG8_STAGE(PG8_SB(0, 0), cB, voffB); PG8_STAGE(PG8_SB(0, 1), cB + hstep, voffB); PG8_STAGE(PG8_SA(0, 0), cA, voffA); PG8_STAGE(PG8_SA(0, 1), cA + hstep, voffA);
        if (wr == 1) PG8_BAR;
        PG8_WAIT_V(2); PG8_BAR;
        PG8_STAGE(PG8_SB(1, 0), cB + kstep, voffB); PG8_STAGE(PG8_SA(1, 0), cA + kstep, voffA); PG8_STAGE(PG8_SB(1, 1), cB + hstep + kstep, voffB);
        PG8_WAIT_V(6); PG8_BAR;
    } else {
        PG8_STAGE(PG8_SB(0, 0), cB, voffB); PG8_STAGE(PG8_SA(0, 0), cA, voffA); PG8_STAGE(PG8_SB(0, 1), cB + hstep, voffB); PG8_STAGE(PG8_SA(0, 1), cA + hstep, voffA);
        if (wr == 1) PG8_BAR;
        PG8_WAIT_V(4); PG8_BAR;
        PG8_STAGE(PG8_SB(1, 0), cB + kstep, voffB); PG8_STAGE(PG8_SA(1, 0), cA + kstep, voffA); PG8_STAGE(PG8_SB(1, 1), cB + hstep + kstep, voffB);
        PG8_WAIT_V(6); PG8_BAR;
    }
    for (;;) {
        const bool has_next = S.next(ui + 1, nxt);
        const char* nA = has_next ? (const char*)g.A + (size_t)nxt.pm * tstep : cA; const char* nB = has_next ? (const char*)g.Bt + (size_t)nxt.pn * tstep : cB;
        for (int t = 0; t < nt; t += 2) {
            const bool last = (t == nt - 2);
            const char* a1 = cA + (size_t)(t + 1) * kstep;
            const char* a2 = last ? nA : cA + (size_t)(t + 2) * kstep; const char* b2 = last ? nB : cB + (size_t)(t + 2) * kstep;
            const char* a3 = a2 + kstep; const char* b3 = b2 + kstep;
            if (last && has_next) S.a_ready(nxt);
            if constexpr (SP2) {
            PG8_LDB(B0, 0, 0); PG8_LDB(B1, 0, 1); PG8_SCHED; PG8_LDA(At, 0, 0); PG8_STAGE(PG8_SA(1, 1), a1 + hstep, voffA);
            PG8_WAIT_V(8); PG8_WAIT_L(0); PG8_BAR; PG8_MMA(0, 0, At, B0); PG8_MMA(0, 1, At, B1); PG8_BAR; PG8_SCHED;
            PG8_LDA(At, 0, 1); PG8_STAGE(PG8_SB(0, 0), b2, voffB); PG8_STAGE(PG8_SB(0, 1), b2 + hstep, voffB); PG8_STAGE(PG8_SA(0, 0), a2, voffA);
            PG8_WAIT_V(8); PG8_WAIT_L(0); PG8_BAR; PG8_MMA(1, 0, At, B0); PG8_MMA(1, 1, At, B1); PG8_BAR; PG8_SCHED;
            PG8_LDB(B0, 1, 0); PG8_LDB(B1, 1, 1); PG8_SCHED; PG8_LDA(At, 1, 0); PG8_STAGE(PG8_SA(0, 1), a2 + hstep, voffA);
            PG8_WAIT_V(8); PG8_WAIT_L(0); PG8_BAR; PG8_MMA(0, 0, At, B0); PG8_MMA(0, 1, At, B1); PG8_BAR; PG8_SCHED;
            PG8_LDA(At, 1, 1); PG8_STAGE(PG8_SB(1, 0), b3, voffB); PG8_STAGE(PG8_SB(1, 1), b3 + hstep, voffB); PG8_STAGE(PG8_SA(1, 0), a3, voffA);
            PG8_WAIT_V(8); PG8_WAIT_L(0); PG8_BAR; PG8_MMA(1, 0, At, B0); PG8_MMA(1, 1, At, B1); PG8_BAR; PG8_SCHED;
            } else {
            PG8_LDB(B0, 0, 0); PG8_SCHED; PG8_LDA(At, 0, 0); PG8_STAGE(PG8_SA(1, 1), a1 + hstep, voffA);
            PG8_WAIT_L(8); PG8_BAR; PG8_WAIT_L(0); PG8_MMA(0, 0, At, B0); PG8_BAR; PG8_SCHED;
            PG8_LDB(B1, 0, 1); PG8_STAGE(PG8_SB(0, 0), b2, voffB);
            PG8_BAR; PG8_WAIT_L(0); PG8_MMA(0, 1, At, B1); PG8_BAR;
            PG8_LDA(At, 0, 1); PG8_STAGE(PG8_SA(0, 0), a2, voffA);
            PG8_BAR; PG8_WAIT_L(0); PG8_MMA(1, 0, At, B0); PG8_BAR; PG8_SCHED;
            PG8_STAGE(PG8_SB(0, 1), b2 + hstep, voffB);
            PG8_WAIT_V(6); PG8_BAR; PG8_MMA(1, 1, At, B1); PG8_BAR;
            PG8_LDB(B0, 1, 0); PG8_SCHED; PG8_LDA(At, 1, 0); PG8_STAGE(PG8_SA(0, 1), a2 + hstep, voffA);
            PG8_WAIT_L(8); PG8_BAR; PG8_WAIT_L(0); PG8_MMA(0, 0, At, B0); PG8_BAR; PG8_SCHED;
            PG8_LDB(B1, 1, 1); PG8_STAGE(PG8_SB(1, 0), b3, voffB);
            PG8_BAR; PG8_WAIT_L(0); PG8_MMA(0, 1, At, B1); PG8_BAR;
            PG8_LDA(At, 1, 1); PG8_STAGE(PG8_SA(1, 0), a3, voffA);
            PG8_BAR; PG8_WAIT_L(0); PG8_MMA(1, 0, At, B0); PG8_BAR; PG8_SCHED;
            PG8_STAGE(PG8_SB(1, 1), b3 + hstep, voffB);
            PG8_WAIT_V(6); PG8_BAR; PG8_MMA(1, 1, At, B1); PG8_BAR;
            }
        }
        if constexpr (ALIGN_EPI) { if (wr == 0) PG8_BAR; }
        if constexpr (!Epi::AFTER_DRAIN) { E(acc, cur, wr, wc, fr, fq); S.done(cur); }
        if (!has_next) break;
#pragma unroll
        for (int a = 0; a < 2; ++a)
#pragma unroll
            for (int b = 0; b < 2; ++b)
#pragma unroll
                for (int m = 0; m < 4; ++m)
#pragma unroll
                    for (int n = 0; n < 2; ++n) acc[a][b][m][n] = (f32x4){0.f, 0.f, 0.f, 0.f};
        cur = nxt; cA = nA; cB = nB; ++ui;
        if constexpr (ALIGN_EPI) { if (wr == 1) PG8_BAR; }
    }
    PG8_WAIT_V(0);
    if constexpr (!ALIGN_EPI) { if (wr == 0) PG8_BAR; }
    PG8_BAR;
    if constexpr (Epi::AFTER_DRAIN) { E.fused(acc, cur, wr, wc, fr, fq, lds, wid, lane); S.done(cur); }
#undef PG8_SA
#undef PG8_SB
#undef PG8_STAGE
#undef PG8_LDA
#undef PG8_LDB
#undef PG8_MMA
#undef PG8_WAIT_V
#undef PG8_WAIT_L
#undef PG8_BAR
#undef PG8_SCHED
}
}
#define LAS __attribute__((address_space(3)))
#define GAS __attribute__((address_space(1)))
#define LDS_BARRIER() do { asm volatile("s_waitcnt lgkmcnt(0)" ::: "memory"); __builtin_amdgcn_s_barrier(); asm volatile("" ::: "memory"); } while (0)
typedef unsigned short bf16;
typedef unsigned v4u __attribute__((ext_vector_type(4)));
typedef float f32x4 __attribute__((ext_vector_type(4)));
constexpr int NWAVES = 8, NTHREADS = 512;
constexpr int SEQ = 8192, DM = 1024, MTOK = 16384, DIN = 9744, N1 = 9728, PLD = 6656, FF = 4096;
constexpr float EPS = 1e-6f;
constexpr size_t MiB = 1u << 20;
constexpr size_t WS_WIN = 1 * MiB, WS_WA = 20 * MiB, WS_WB = 21 * MiB, WS_WO = 23 * MiB, WS_WUP = 25 * MiB, WS_WDN = 33 * MiB;
constexpr size_t WS_XB = 41 * MiB, WS_PROJ = 73 * MiB, WS_VT = 177 * MiB, WS_A1 = 193 * MiB, WS_A2 = 209 * MiB;
constexpr size_t WS_R1 = 241 * MiB, WS_PA = 242 * MiB, WS_SS2 = 243 * MiB, WS_MISC = 244 * MiB;
constexpr size_t WS_MIXED = 73 * MiB, WS_U = 73 * MiB, WS_END = 256 * MiB;
constexpr int LDS_BYTES = 155648, LDS_BARST = 155584;
constexpr size_t WS_BAR = 0;

__device__ __forceinline__ float bf2f(bf16 h) { return __uint_as_float(((unsigned)h) << 16); }
__device__ __forceinline__ unsigned f2bf(float f) { unsigned u = __builtin_bit_cast(unsigned, f); return (u + 0x7fffu + ((u >> 16) & 1u)) >> 16; }
__device__ __forceinline__ unsigned pk2(float lo, float hi) { return f2bf(lo) | (f2bf(hi) << 16); }
__device__ __forceinline__ float wave_sum(float v) {
#pragma unroll
    for (int o = 1; o < 64; o <<= 1) v += __shfl_xor(v, o);
    return v;
}
__device__ __forceinline__ float log_sigmoid(float x) { return fminf(x, 0.f) - log1pf(__expf(-fabsf(x))); }

#ifndef TPROBE
#define TPROBE -1
#endif
#ifndef TPBLK
#define TPBLK 0
#endif
#ifndef TPB
#define TPB (TPROBE + 1)
#endif
#ifndef REPMASK
#define REPMASK 0
#endif
struct Args { const float* in[15]; float* out; unsigned char* ws; int ph_lo, ph_hi, rep, pad; };

__device__ __forceinline__ void p0_transpose_item(const float* W, int ldw, int srccol0, const float* kscale, int kmask, float cscale,
                                                  bf16* WT, int K, int dstrow0, int k0, LAS float* scr, int lane) {
    float v[64];
    const GAS float* wp = (const GAS float*)W + (size_t)k0 * ldw + srccol0 + lane;
#pragma unroll
    for (int i = 0; i < 64; ++i) v[i] = __builtin_nontemporal_load(wp + (size_t)i * ldw);
    const int c = lane & 7;
    f32x4 s0 = (f32x4){cscale, cscale, cscale, cscale}, s1 = s0;
    if (kscale) { const int kb = (k0 + 8 * c) & kmask; s0 = *(const GAS f32x4*)((const GAS float*)kscale + kb) * cscale; s1 = *(const GAS f32x4*)((const GAS float*)kscale + kb + 4) * cscale; }
#pragma unroll
    for (int i = 0; i < 64; ++i) scr[i * 65 + lane] = v[i];
    asm volatile("s_waitcnt lgkmcnt(0)" ::: "memory");
#pragma unroll
    for (int j = 0; j < 8; ++j) { const int n = (lane >> 3) + 8 * j; const LAS float* s = scr + (8 * c) * 65 + n;
        v4u o; o.x = pk2(s[0 * 65] * s0[0], s[1 * 65] * s0[1]); o.y = pk2(s[2 * 65] * s0[2], s[3 * 65] * s0[3]); o.z = pk2(s[4 * 65] * s1[0], s[5 * 65] * s1[1]); o.w = pk2(s[6 * 65] * s1[2], s[7 * 65] * s1[3]);
        GAS v4u* dp = (GAS v4u*)((GAS bf16*)WT + (size_t)(dstrow0 + n) * K + k0 + 8 * c);
        if (ldw == DIN) *dp = o; else __builtin_nontemporal_store(o, dp); }
    asm volatile("s_waitcnt lgkmcnt(0)" ::: "memory");
}

#define XB_TMO      128
#define XB_XCNT(j)  (256  + 64 * (j))
#define XB_XSUB(j)  (1280 + 64 * (j))
#define XB_XGEN(j)  (2304 + 64 * (j))
#define XB_TOP      3328
#define XB_TOPGEN   3392
#define XCD_BAR_WORDS 3456
#define XB_SPIN_CAP (1u << 18)

__device__ __forceinline__ unsigned xb_ld(unsigned* p)              { return __hip_atomic_load(p, __ATOMIC_RELAXED, __HIP_MEMORY_SCOPE_AGENT); }
__device__ __forceinline__ unsigned xb_add(unsigned* p, unsigned v) { return __hip_atomic_fetch_add(p, v, __ATOMIC_RELAXED, __HIP_MEMORY_SCOPE_AGENT); }
__device__ __forceinline__ unsigned xb_xcc_id() { return (unsigned)__builtin_amdgcn_s_getreg((3 << 11) | 20) & 0xFu; }
#define XB_SPIN(cond, bar) do { unsigned _sp = 0; while (cond) { __builtin_amdgcn_s_sleep(1); \
    if ((++_sp & 255u) == 0u) { if (xb_ld(&(bar)[XB_TMO])) break; if (_sp > XB_SPIN_CAP) { atomicAdd(&(bar)[XB_TMO], 1u); break; } } } } while (0)

struct XcdBarrier {
    unsigned* bar; unsigned x;
    volatile LAS unsigned* st;
};

__device__ __forceinline__ XcdBarrier xcd_barrier_post(unsigned* bar, volatile LAS unsigned* st) {
    XcdBarrier b; b.bar = bar; b.x = xb_xcc_id(); b.st = st;
    if (threadIdx.x == 0) (void)xb_add(&bar[XB_XCNT(b.x)], 1u);
    return b;
}
__device__ __forceinline__ void xcd_barrier_complete(unsigned* bar, unsigned x, unsigned& nloc, unsigned& nx) {
    const unsigned G = gridDim.x * gridDim.y * gridDim.z;
    unsigned sum, cnt, mine, sp = 0u;
    for (;;) {
        sum = 0u; cnt = 0u; mine = 0u;
#pragma unroll
        for (unsigned j = 0; j < 16; ++j) { const unsigned c = xb_ld(&bar[XB_XCNT(j)]); sum += c; cnt += (c > 0u) ? 1u : 0u; mine = (j == x) ? c : mine; }
        if (sum == G) break;
        __builtin_amdgcn_s_sleep(1);
        if ((++sp & 255u) == 0u) { if (xb_ld(&bar[XB_TMO])) break; if (sp > XB_SPIN_CAP) { atomicAdd(&bar[XB_TMO], 1u); break; } }
    }
    nloc = mine > 0u ? mine : 1u; nx = cnt > 0u ? cnt : 1u;
}

__device__ __forceinline__ void xcd_barrier(const XcdBarrier& b) {
    asm volatile("s_waitcnt vmcnt(0)" ::: "memory");
    __syncthreads();
    if (threadIdx.x == 0) {
        unsigned* bar = b.bar;
        __builtin_amdgcn_s_waitcnt(0);
        unsigned nloc = b.st[0], nx = b.st[1];
        if (nloc == 0u) { xcd_barrier_complete(bar, b.x, nloc, nx); b.st[0] = nloc; b.st[1] = nx; }
        const unsigned old = xb_add(&bar[XB_XSUB(b.x)], 1u);
        const unsigned gen = old / nloc;
        if (old + 1u == (gen + 1u) * nloc) {
            __builtin_amdgcn_fence(__ATOMIC_RELEASE, "agent");
            asm volatile("s_waitcnt vmcnt(0)" ::: "memory");
            const unsigned og = xb_add(&bar[XB_TOP], 1u);
            const unsigned tg = og / nx;
            if (og + 1u == (tg + 1u) * nx) xb_add(&bar[XB_TOPGEN], 1u);
            else XB_SPIN(xb_ld(&bar[XB_TOPGEN]) == tg, bar);
            __builtin_amdgcn_fence(__ATOMIC_ACQUIRE, "agent");
            xb_add(&bar[XB_XGEN(b.x)], 1u);
            asm volatile("s_waitcnt vmcnt(0)" ::: "memory");
        } else {
            XB_SPIN(xb_ld(&bar[XB_XGEN(b.x)]) == gen, bar);
            __builtin_amdgcn_fence(__ATOMIC_ACQUIRE, "agent");
            asm volatile("s_waitcnt vmcnt(0)" ::: "memory");
        }
    }
    __syncthreads();
}

typedef short bf16x8_t __attribute__((ext_vector_type(8)));
typedef short s16x4_t __attribute__((ext_vector_type(4)));
constexpr int AT_PITCH = 144;
constexpr int AT_KL = 0, AT_VL = 384 * AT_PITCH;
constexpr int N_ATT_ITEMS = 768;
constexpr int AT_ROWS = 384;
struct AttnKQ { v4u k[6], q[4]; };
__device__ __forceinline__ void attn_decode(int it2, int& g, int& slot, int& d, int& r, int& n) {
    g = it2 >> 8; const int rem = it2 & 255; slot = rem & 7; const int rest = rem >> 3; const int sh = 2 * g; d = 1 << sh; r = rest >> (5 - sh); n = 2 * (rest & ((32 >> sh) - 1));
}
__device__ __forceinline__ bool it_first_block(int it2) { int g, slot, d, r, n; attn_decode(it2, g, slot, d, r, n); return n == 0; }
__device__ __forceinline__ void attn_load_kq(AttnKQ& R, const bf16* PROJ_, int it, int tid, int wave, int lane) {
    int g, slot, d, r, n; attn_decode(it, g, slot, d, r, n); const int hd = g * 8 + slot; const int c = tid & 7;
#pragma unroll
    for (int p = 0; p < 6; ++p) { const int row = p * 64 + (tid >> 3); const int sp = (n - 1) * 128 + row;
        if (n > 0 || p >= 2) R.k[p] = *(const GAS v4u*)((const GAS bf16*)PROJ_ + (size_t)(sp * d + r) * PLD + 1536 + hd * 64 + c * 8);
        else R.k[p] = (v4u){0u, 0u, 0u, 0u}; }
    const int fr = lane & 15, fq = lane >> 4; const GAS bf16* qb = (const GAS bf16*)PROJ_ + (size_t)((n * 128 + 16 * wave + fr) * d + r) * PLD + hd * 64 + 8 * fq;
    R.q[0] = *(const GAS v4u*)(qb); R.q[1] = *(const GAS v4u*)(qb + 32);
    const GAS bf16* qb2 = qb + (size_t)128 * d * PLD; R.q[2] = *(const GAS v4u*)(qb2); R.q[3] = *(const GAS v4u*)(qb2 + 32);
}
__device__ __forceinline__ void attn_load_v(v4u (&V)[6], const bf16* PROJ_, int it, int tid) {
    int g, slot, d, r, n; attn_decode(it, g, slot, d, r, n); const int hd = g * 8 + slot; const int c = tid & 7;
#pragma unroll
    for (int p = 0; p < 6; ++p) { const int row = p * 64 + (tid >> 3); const int sp = (n - 1) * 128 + row;
        if (n > 0 || p >= 2) V[p] = *(const GAS v4u*)((const GAS bf16*)PROJ_ + (size_t)(sp * d + r) * PLD + 3072 + hd * 64 + c * 8);
        else V[p] = (v4u){0u, 0u, 0u, 0u}; }
}
__device__ __forceinline__ void attn_stage_k(const AttnKQ& R, LAS unsigned char* lds, const float (&gkr)[8], int tid) {
    const int c = tid & 7;
#pragma unroll
    for (int p = 0; p < 6; ++p) { const int row = p * 64 + (tid >> 3); float f[8]; pg8::unpack8(R.k[p], f); float ss = 0.f;
#pragma unroll
        for (int i = 0; i < 8; ++i) ss += f[i] * f[i];
        ss += __shfl_xor(ss, 1); ss += __shfl_xor(ss, 2); ss += __shfl_xor(ss, 4);
        const float rs = __builtin_amdgcn_rsqf(ss * (1.0f / 64.0f) + EPS);
#pragma unroll
        for (int i = 0; i < 8; ++i) f[i] = f[i] * (rs * gkr[i]);
        *(LAS v4u*)(lds + AT_KL + row * AT_PITCH + c * 16) = pg8::pack8(f); }
}
__device__ __forceinline__ void attn_stage_v(const v4u (&V)[6], LAS unsigned char* lds, int tid) {
    const int c = tid & 7;
#pragma unroll
    for (int p = 0; p < 6; ++p) { const int row = p * 64 + (tid >> 3); *(LAS v4u*)(lds + AT_VL + row * AT_PITCH + c * 16) = V[p]; }
}
__device__ __forceinline__ void attn_scores(f32x4 (&sc)[9], float& mx, float& den, v4u q0, v4u q1, LAS unsigned char* lds, const float (&gqr)[16], int koff, bool firstblk, int wave, int lane) {
    const int fr = lane & 15, fq = lane >> 4, w = wave;
    float qf[16]; { float t0[8], t1[8]; pg8::unpack8(q0, t0); pg8::unpack8(q1, t1);
#pragma unroll
        for (int i = 0; i < 8; ++i) { qf[i] = t0[i]; qf[8 + i] = t1[i]; } }
    float ss = 0.f;
#pragma unroll
    for (int i = 0; i < 16; ++i) ss += qf[i] * qf[i];
    ss += __shfl_xor(ss, 16); ss += __shfl_xor(ss, 32);
    const float qs = __builtin_amdgcn_rsqf(ss * (1.0f / 64.0f) + EPS) * (0.125f * 1.4426950408889634f);
    bf16x8_t qa[2];
    { float t0[8], t1[8];
#pragma unroll
      for (int i = 0; i < 8; ++i) { t0[i] = qf[i] * (qs * gqr[i]); t1[i] = qf[8 + i] * (qs * gqr[8 + i]); }
      qa[0] = __builtin_bit_cast(bf16x8_t, pg8::pack8(t0)); qa[1] = __builtin_bit_cast(bf16x8_t, pg8::pack8(t1)); }
#pragma unroll
    for (int kti = 0; kti < 9; ++kti) { f32x4 acc = (f32x4){0.f, 0.f, 0.f, 0.f}; const LAS unsigned char* kp = lds + AT_KL + ((koff + w + kti) * 16 + fr) * AT_PITCH + fq * 16;
#pragma unroll
        for (int ks = 0; ks < 2; ++ks) { const bf16x8_t kf = *(const LAS bf16x8_t*)(kp + ks * 64); acc = __builtin_amdgcn_mfma_f32_16x16x32_bf16(kf, qa[ks], acc, 0, 0, 0); }
        sc[kti] = acc; if (kti % 3 == 2) __builtin_amdgcn_sched_barrier(0); }
    mx = -INFINITY;
#pragma unroll
    for (int j = 0; j < 4; ++j) { if (4 * fq + j < fr) sc[0][j] = -INFINITY; if (4 * fq + j > fr) sc[8][j] = -INFINITY; }
    if (firstblk) {
#pragma unroll
        for (int kti = 0; kti < 9; ++kti) if (w + kti < 8) sc[kti] = (f32x4){-INFINITY, -INFINITY, -INFINITY, -INFINITY}; }
#pragma unroll
    for (int kti = 0; kti < 9; ++kti)
#pragma unroll
        for (int j = 0; j < 4; ++j) mx = fmaxf(mx, sc[kti][j]);
    mx = fmaxf(mx, __shfl_xor(mx, 16)); mx = fmaxf(mx, __shfl_xor(mx, 32));
    den = 0.f;
#pragma unroll
    for (int kti = 0; kti < 9; ++kti)
#pragma unroll
        for (int j = 0; j < 4; ++j) { const float pv = __builtin_amdgcn_exp2f(sc[kti][j] - mx); sc[kti][j] = pv; den += pv; }
    den += __shfl_xor(den, 16); den += __shfl_xor(den, 32);
    __builtin_amdgcn_sched_barrier(0);
}
__device__ __forceinline__ void attn_pv(const f32x4 (&sc)[9], float mx, float den, LAS unsigned char* lds, bf16* PROJ_, float* ML_, int it, int koff, int wave, int lane, bool do_store) {
    int g, slot, d, r, n; attn_decode(it, g, slot, d, r, n); const int hd = g * 8 + slot; n += koff >> 3;
    const int fr = lane & 15, fq = lane >> 4, w = wave;
    f32x4 o[4];
#pragma unroll
    for (int et = 0; et < 4; ++et) o[et] = (f32x4){0.f, 0.f, 0.f, 0.f};
    const int q_ = (lane >> 2) & 3, p_ = lane & 3;
#pragma unroll
    for (int kk = 0; kk < 5; ++kk) { const int kt0 = koff + w + 2 * kk, kt1 = (kk < 4) ? kt0 + 1 : kt0;
        v4u aw; aw.x = pg8::cvt_pk_bf16(sc[2 * kk][0], sc[2 * kk][1]); aw.y = pg8::cvt_pk_bf16(sc[2 * kk][2], sc[2 * kk][3]);
        if (kk < 4) { aw.z = pg8::cvt_pk_bf16(sc[(kk < 4) ? 2 * kk + 1 : 0][0], sc[(kk < 4) ? 2 * kk + 1 : 0][1]); aw.w = pg8::cvt_pk_bf16(sc[(kk < 4) ? 2 * kk + 1 : 0][2], sc[(kk < 4) ? 2 * kk + 1 : 0][3]); } else { aw.z = 0u; aw.w = 0u; }
        const bf16x8_t af = __builtin_bit_cast(bf16x8_t, aw);
        const LAS unsigned char* v0 = lds + AT_VL + (kt0 * 16 + 4 * fq + q_) * AT_PITCH + p_ * 8; const LAS unsigned char* v1 = lds + AT_VL + (kt1 * 16 + 4 * fq + q_) * AT_PITCH + p_ * 8;
#pragma unroll
        for (int et = 0; et < 4; ++et) {
            const s16x4_t lo = __builtin_bit_cast(s16x4_t, __builtin_amdgcn_ds_read_tr16_b64_v4i16((LAS s16x4_t*)(v0 + et * 32)));
            const s16x4_t hi = __builtin_bit_cast(s16x4_t, __builtin_amdgcn_ds_read_tr16_b64_v4i16((LAS s16x4_t*)(v1 + et * 32)));
            const bf16x8_t bfr = (bf16x8_t){lo[0], lo[1], lo[2], lo[3], hi[0], hi[1], hi[2], hi[3]};
            o[et] = __builtin_amdgcn_mfma_f32_16x16x32_bf16(af, bfr, o[et], 0, 0, 0); }
        __builtin_amdgcn_sched_barrier(0); }
    if (do_store)
#pragma unroll
    for (int j = 0; j < 4; j += 2) { GAS bf16* op0 = (GAS bf16*)PROJ_ + (size_t)((n * 128 + 16 * w + 4 * fq + j) * d + r) * PLD + hd * 64 + fr; GAS bf16* op1 = op0 + (size_t)d * PLD;
#pragma unroll
        for (int et = 0; et < 4; ++et) { const unsigned wv = pg8::cvt_pk_bf16(o[et][j], o[et][j + 1]); op0[et * 16] = (bf16)(wv & 0xffffu); op1[et * 16] = (bf16)(wv >> 16); } }
    if (fq == 0) { GAS float* mp = (GAS float*)ML_ + (size_t)((n * 128 + 16 * w + fr) * d + r) * 48 + (g * 8 + slot) * 2; mp[0] = mx; mp[1] = den; }
}

constexpr int GL_QG = 0, GL_KG = 17408, GL_KDT = 34816, GL_VTL = 53248, GL_PL = 90112, GL_EB = 99328, GL_PAL = 99840, GL_GT = 103936, GL_SSQ = 105984, GL_RS = 108032, GL_QR = 108544, GL_KR = 124928, GL_UP = 141312;
typedef unsigned u32x2_t __attribute__((ext_vector_type(2)));
struct GlaLd { v4u vt[4], q[2], k[2]; float pa[2]; };
__device__ __forceinline__ void gla_load(GlaLd& L, int b, int h, int tok0, const bf16* PROJ_, const bf16* VT_, const float* PA_, int tid) {
    const GAS float* pap = (const GAS float*)PA_ + (size_t)(b * SEQ + tok0) * 16; L.pa[0] = pap[tid]; L.pa[1] = pap[tid + 512];
#pragma unroll
    for (int i = 0; i < 4; ++i) { const int piece = tid + 512 * i, v = piece >> 3, cc = piece & 7; L.vt[i] = *(const GAS v4u*)((const GAS bf16*)VT_ + (size_t)(h * 256 + v) * SEQ + tok0 + cc * 8); }
#pragma unroll
    for (int i = 0; i < 2; ++i) { const int piece = tid + 512 * i, row = piece >> 4, c16 = piece & 15; const GAS bf16* rp = (const GAS bf16*)PROJ_ + (size_t)(tok0 + row) * PLD + h * 128 + c16 * 8;
        L.k[i] = *(const GAS v4u*)(rp + 5120); L.q[i] = *(const GAS v4u*)(rp + 4608); }
}
__device__ __forceinline__ void gla_stage(const GlaLd& L, LAS unsigned char* lds, int tid) {
    LAS float* PAL = (LAS float*)(lds + GL_PAL); PAL[tid] = L.pa[0]; PAL[tid + 512] = L.pa[1];
#pragma unroll
    for (int i = 0; i < 4; ++i) { const int piece = tid + 512 * i, v = piece >> 3, cc = piece & 7; *(LAS v4u*)(lds + GL_VTL + v * 144 + cc * 16) = L.vt[i]; }
#pragma unroll
    for (int i = 0; i < 2; ++i) { const int piece = tid + 512 * i; *(LAS v4u*)(lds + GL_KR + piece * 16) = L.k[i]; *(LAS v4u*)(lds + GL_QR + piece * 16) = L.q[i]; }
}
__device__ __forceinline__ float fexp(float x) { return __builtin_amdgcn_exp2f(x * 1.4426950408889634f); }
__device__ __forceinline__ float log_sigmoid_fast(float x) { return fminf(x, 0.f) - 0.6931471805599453f * __builtin_amdgcn_logf(1.0f + __builtin_amdgcn_exp2f(fabsf(x) * -1.4426950408889634f)); }
__device__ __forceinline__ void gla_local(LAS unsigned char* lds, int b, int item, const bf16* PROJ_, const bf16* VT_, const float* PA_, const float* gate_up_, const float* gate_bias_,
                                          float* SBUF_, float* DBUF_, bf16* A2_, bf16* QGS_, int tid_in, int wave, int lane_in) {
    int tid = tid_in, lane = lane_in; asm volatile("" : "+v"(tid), "+v"(lane));
    const int h = item >> 5, seg = item & 31;
    const int w = wave;
    GlaLd L; gla_load(L, b, h, seg * 256, PROJ_, VT_, PA_, tid);
    { LAS float* UP = (LAS float*)(lds + GL_UP);
#pragma unroll
      for (int i = 0; i < 4; ++i) { const int idx = tid + 512 * i, r = idx >> 7, k2 = idx & 127; UP[k2 * 20 + r] = gate_up_[r * 512 + h * 128 + k2]; } }
    const float bk = gate_bias_[h * 128 + (tid & 127)];
    f32x4 S[8][2];
#pragma unroll
    for (int mtk = 0; mtk < 8; ++mtk) { S[mtk][0] = (f32x4){0.f, 0.f, 0.f, 0.f}; S[mtk][1] = (f32x4){0.f, 0.f, 0.f, 0.f}; }
    float segsum = 0.f;
    asm volatile("" :: "v"(bk), "v"(L.k[1]));
    const int tid_item = tid, lane_item = lane;
    for (int c = 0; c < 4; ++c) {
        const int tok0 = seg * 256 + c * 64;
        int tid = tid_item, lane = lane_item; asm volatile("" : "+v"(tid), "+v"(lane));
        const int kd = tid & 127, tq = tid >> 7, fr = lane & 15, fq = lane >> 4;
        gla_stage(L, lds, tid);
        LDS_BARRIER();
        if (c < 3) gla_load(L, b, h, tok0 + 64, PROJ_, VT_, PA_, tid);
        { const LAS float* pal = (const LAS float*)(lds + GL_PAL); const LAS float* upl = (const LAS float*)(lds + GL_UP) + (16 * w + fr) * 20 + fq;
          const float ub0 = upl[0], ub1 = upl[4], ub2 = upl[8], ub3 = upl[12];
#pragma unroll
          for (int mt = 0; mt < 4; ++mt) { const LAS float* pa4 = pal + (16 * mt + fr) * 16 + fq; f32x4 lacc = (f32x4){0.f, 0.f, 0.f, 0.f};
              lacc = __builtin_amdgcn_mfma_f32_16x16x4f32(pa4[0], ub0, lacc, 0, 0, 0); lacc = __builtin_amdgcn_mfma_f32_16x16x4f32(pa4[4], ub1, lacc, 0, 0, 0);
              lacc = __builtin_amdgcn_mfma_f32_16x16x4f32(pa4[8], ub2, lacc, 0, 0, 0); lacc = __builtin_amdgcn_mfma_f32_16x16x4f32(pa4[12], ub3, lacc, 0, 0, 0);
#pragma unroll
              for (int j = 0; j < 4; ++j) ((LAS float*)lds)[(16 * mt + 4 * fq + j) * 128 + 16 * w + fr] = lacc[j]; } }
        LDS_BARRIER();
        float cb[16];
        { float run = 0.f;
#pragma unroll
          for (int i = 0; i < 16; ++i) { const int t = 16 * tq + i; const float lg = bk + ((const LAS float*)lds)[t * 128 + kd];
              run += log_sigmoid_fast(lg) * (1.0f / 16.0f); cb[i] = run; } }
        { LAS float* GT = (LAS float*)(lds + GL_GT); GT[tq * 128 + kd] = cb[15]; }
        LDS_BARRIER();
        float off = 0.f, tot = 0.f;
        { const LAS float* GT = (const LAS float*)(lds + GL_GT);
#pragma unroll
          for (int q = 0; q < 4; ++q) { const float gv = GT[q * 128 + kd]; tot += gv; off += (q < tq) ? gv : 0.f; } }
        const float etot = fexp(tot), eseg = fexp(segsum);
        { float kdv[16];
          GAS bf16* qgs = (GAS bf16*)QGS_ + (size_t)(tok0 + 16 * tq) * 512 + h * 128 + kd;
#pragma unroll
          for (int i = 0; i < 16; i += 2) { const int t = 16 * tq + i; const float bc0 = cb[i] + off, bc1 = cb[i + 1] + off;
              const float kf0 = bf2f(*(const LAS unsigned short*)(lds + GL_KR + t * 256 + kd * 2)), kf1 = bf2f(*(const LAS unsigned short*)(lds + GL_KR + (t + 1) * 256 + kd * 2));
              const float en0 = fexp(-bc0), en1 = fexp(-bc1);
              const float kg0 = kf0 * en0, kg1 = kf1 * en1; kdv[i] = kg0 * etot; kdv[i + 1] = kg1 * etot;
              const float qf0 = bf2f(*(const LAS unsigned short*)(lds + GL_QR + t * 256 + kd * 2)), qf1 = bf2f(*(const LAS unsigned short*)(lds + GL_QR + (t + 1) * 256 + kd * 2));
              const float qg0 = qf0 * fexp(bc0), qg1 = qf1 * fexp(bc1);
              const unsigned qw = pg8::cvt_pk_bf16(qg0, qg1), kw = pg8::cvt_pk_bf16(kg0, kg1), sw = pg8::cvt_pk_bf16(qg0 * eseg, qg1 * eseg);
              *(LAS unsigned short*)(lds + GL_QG + t * 272 + kd * 2) = (unsigned short)(qw & 0xffffu); *(LAS unsigned short*)(lds + GL_QG + (t + 1) * 272 + kd * 2) = (unsigned short)(qw >> 16);
              *(LAS unsigned short*)(lds + GL_KG + t * 272 + kd * 2) = (unsigned short)(kw & 0xffffu); *(LAS unsigned short*)(lds + GL_KG + (t + 1) * 272 + kd * 2) = (unsigned short)(kw >> 16);
              qgs[(size_t)i * 512] = (bf16)(sw & 0xffffu); qgs[(size_t)(i + 1) * 512] = (bf16)(sw >> 16); }
          float lo8[8], hi8[8];
#pragma unroll
          for (int i = 0; i < 8; ++i) { lo8[i] = kdv[i]; hi8[i] = kdv[8 + i]; }
          *(LAS v4u*)(lds + GL_KDT + kd * 144 + tq * 32) = pg8::pack8(lo8); *(LAS v4u*)(lds + GL_KDT + kd * 144 + tq * 32 + 16) = pg8::pack8(hi8); }
        if (tq == 0) ((LAS float*)(lds + GL_EB))[kd] = etot;
        segsum += tot;
        LDS_BARRIER();
        {
            const int mt = w >> 1;
#pragma unroll
            for (int sti = 0; sti < 2; ++sti) { const int st = 2 * (w & 1) + sti; f32x4 acc = (f32x4){0.f, 0.f, 0.f, 0.f};
                if (st <= mt) {
#pragma unroll
                    for (int ks = 0; ks < 4; ++ks) { const bf16x8_t kf = *(const LAS bf16x8_t*)(lds + GL_KG + (16 * st + fr) * 272 + (32 * ks + 8 * fq) * 2);
                        const bf16x8_t qf = *(const LAS bf16x8_t*)(lds + GL_QG + (16 * mt + fr) * 272 + (32 * ks + 8 * fq) * 2);
                        acc = __builtin_amdgcn_mfma_f32_16x16x32_bf16(kf, qf, acc, 0, 0, 0); }
                    if (st == mt) {
#pragma unroll
                        for (int j = 0; j < 4; ++j) if (4 * fq + j > fr) acc[j] = 0.f; } }
                u32x2_t wv; wv.x = pg8::cvt_pk_bf16(acc[0], acc[1]); wv.y = pg8::cvt_pk_bf16(acc[2], acc[3]);
                *(LAS u32x2_t*)(lds + GL_PL + (16 * mt + fr) * 144 + (16 * st + 4 * fq) * 2) = wv; }
            LDS_BARRIER();
        }
        bf16x8_t vf[2][2];
#pragma unroll
        for (int ks2 = 0; ks2 < 2; ++ks2)
#pragma unroll
            for (int nt = 0; nt < 2; ++nt) vf[ks2][nt] = *(const LAS bf16x8_t*)(lds + GL_VTL + (32 * w + 16 * nt + fr) * 144 + (32 * ks2 + 8 * fq) * 2);
        f32x4 o[4][2];
#pragma unroll
        for (int mt = 0; mt < 4; ++mt) { o[mt][0] = (f32x4){0.f, 0.f, 0.f, 0.f}; o[mt][1] = (f32x4){0.f, 0.f, 0.f, 0.f}; }
#pragma unroll
        for (int ks = 0; ks < 4; ++ks) { bf16x8_t bfr[2];
#pragma unroll
            for (int nt = 0; nt < 2; ++nt) { v4u wv; wv.x = pg8::cvt_pk_bf16(S[2 * ks][nt][0], S[2 * ks][nt][1]); wv.y = pg8::cvt_pk_bf16(S[2 * ks][nt][2], S[2 * ks][nt][3]);
                wv.z = pg8::cvt_pk_bf16(S[2 * ks + 1][nt][0], S[2 * ks + 1][nt][1]); wv.w = pg8::cvt_pk_bf16(S[2 * ks + 1][nt][2], S[2 * ks + 1][nt][3]); bfr[nt] = __builtin_bit_cast(bf16x8_t, wv); }
#pragma unroll
            for (int mt = 0; mt < 4; ++mt) { const u32x2_t a0 = *(const LAS u32x2_t*)(lds + GL_QG + (16 * mt + fr) * 272 + (32 * ks + 4 * fq) * 2), a1 = *(const LAS u32x2_t*)(lds + GL_QG + (16 * mt + fr) * 272 + (32 * ks + 16 + 4 * fq) * 2);
                const v4u aw = (v4u){a0.x, a0.y, a1.x, a1.y}; const bf16x8_t af = __builtin_bit_cast(bf16x8_t, aw);
                o[mt][0] = __builtin_amdgcn_mfma_f32_16x16x32_bf16(bfr[0], af, o[mt][0], 0, 0, 0); o[mt][1] = __builtin_amdgcn_mfma_f32_16x16x32_bf16(bfr[1], af, o[mt][1], 0, 0, 0); } }
#pragma unroll
        for (int ks2 = 0; ks2 < 2; ++ks2)
#pragma unroll
            for (int mt = 0; mt < 4; ++mt) { const bf16x8_t pf = *(const LAS bf16x8_t*)(lds + GL_PL + (16 * mt + fr) * 144 + (32 * ks2 + 8 * fq) * 2);
                o[mt][0] = __builtin_amdgcn_mfma_f32_16x16x32_bf16(vf[ks2][0], pf, o[mt][0], 0, 0, 0); o[mt][1] = __builtin_amdgcn_mfma_f32_16x16x32_bf16(vf[ks2][1], pf, o[mt][1], 0, 0, 0); }
#pragma unroll
        for (int mtk = 0; mtk < 8; ++mtk) { const f32x4 eb = *(const LAS f32x4*)(lds + GL_EB + (16 * mtk + 4 * fq) * 4);
            S[mtk][0] = S[mtk][0] * eb; S[mtk][1] = S[mtk][1] * eb;
#pragma unroll
            for (int ks2 = 0; ks2 < 2; ++ks2) { const bf16x8_t kf = *(const LAS bf16x8_t*)(lds + GL_KDT + (16 * mtk + fr) * 144 + (32 * ks2 + 8 * fq) * 2);
                S[mtk][0] = __builtin_amdgcn_mfma_f32_16x16x32_bf16(kf, vf[ks2][0], S[mtk][0], 0, 0, 0); S[mtk][1] = __builtin_amdgcn_mfma_f32_16x16x32_bf16(kf, vf[ks2][1], S[mtk][1], 0, 0, 0); } }
        LDS_BARRIER();
#pragma unroll
        for (int mt = 0; mt < 4; ++mt)
#pragma unroll
            for (int nt = 0; nt < 2; ++nt) { u32x2_t wv; wv.x = pg8::cvt_pk_bf16(o[mt][nt][0], o[mt][nt][1]); wv.y = pg8::cvt_pk_bf16(o[mt][nt][2], o[mt][nt][3]);
                *(LAS u32x2_t*)(lds + (16 * mt + fr) * 528 + (32 * w + 16 * nt + 4 * fq) * 2) = wv; }
        LDS_BARRIER();
#pragma unroll
        for (int i = 0; i < 4; ++i) { const int piece = tid + 512 * i, t = piece >> 5, c8 = piece & 31;
            *(GAS v4u*)((GAS bf16*)A2_ + (size_t)(b * SEQ + tok0 + t) * DM + h * 256 + c8 * 8) = *(const LAS v4u*)(lds + t * 528 + c8 * 16); }
    }
#pragma unroll
    for (int mtk = 0; mtk < 8; ++mtk)
#pragma unroll
        for (int nt = 0; nt < 2; ++nt)
#pragma unroll
            for (int j = 0; j < 4; ++j) ((GAS float*)SBUF_)[((size_t)item * 64 + (mtk * 2 + nt) * 4 + j) * 512 + tid] = S[mtk][nt][j];
    if ((tid >> 7) == 0) ((GAS float*)DBUF_)[item * 128 + (tid & 127)] = fexp(segsum);
    LDS_BARRIER();
}
constexpr int GF_QG = 0, GF_OL = 17408, GF_SSQ = 51200, GF_RS = 53248;
__device__ __forceinline__ void gla_fix(LAS unsigned char* lds, int b, int unit, const bf16* PROJ_, const bf16* SB16_, bf16* A2_, const bf16* QGS_, int tid_in, int wave, int lane_in) {
    int tid = tid_in, lane = lane_in; asm volatile("" : "+v"(tid), "+v"(lane));
    const int item = unit >> 1, half = unit & 1, h = item >> 5, seg = item & 31, w = wave, fr = lane & 15, fq = lane >> 4;
    bf16x8_t bfr[4][2];
#pragma unroll
    for (int ks = 0; ks < 4; ++ks)
#pragma unroll
        for (int nt = 0; nt < 2; ++nt) { unsigned hv[8];
#pragma unroll
            for (int j = 0; j < 4; ++j) { hv[j] = ((const GAS unsigned short*)SB16_)[((size_t)item * 64 + ((2 * ks) * 2 + nt) * 4 + j) * 512 + tid]; hv[4 + j] = ((const GAS unsigned short*)SB16_)[((size_t)item * 64 + ((2 * ks + 1) * 2 + nt) * 4 + j) * 512 + tid]; }
            const v4u wv = (v4u){hv[0] | (hv[1] << 16), hv[2] | (hv[3] << 16), hv[4] | (hv[5] << 16), hv[6] | (hv[7] << 16)};
            bfr[ks][nt] = __builtin_bit_cast(bf16x8_t, wv); }
    for (int cc = 0; cc < 2; ++cc) {
        const int tok0 = seg * 256 + (2 * half + cc) * 64;
        v4u rg[4], ol[4], qg[2];
#pragma unroll
        for (int i = 0; i < 4; ++i) { const int piece = tid + 512 * i, t = piece >> 5, c8 = piece & 31;
            rg[i] = *(const GAS v4u*)((const GAS bf16*)PROJ_ + (size_t)(tok0 + t) * PLD + 5632 + h * 256 + c8 * 8);
            ol[i] = *(const GAS v4u*)((const GAS bf16*)A2_ + (size_t)(b * SEQ + tok0 + t) * DM + h * 256 + c8 * 8); }
#pragma unroll
        for (int i = 0; i < 2; ++i) { const int piece = tid + 512 * i, t = piece >> 4, c16 = piece & 15; qg[i] = *(const GAS v4u*)((const GAS bf16*)QGS_ + (size_t)(tok0 + t) * 512 + h * 128 + c16 * 8); }
        LDS_BARRIER();
#pragma unroll
        for (int i = 0; i < 4; ++i) { const int piece = tid + 512 * i, t = piece >> 5, c8 = piece & 31; *(LAS v4u*)(lds + GF_OL + t * 528 + c8 * 16) = ol[i]; }
#pragma unroll
        for (int i = 0; i < 2; ++i) { const int piece = tid + 512 * i, t = piece >> 4, c16 = piece & 15; *(LAS v4u*)(lds + GF_QG + t * 272 + c16 * 16) = qg[i]; }
        LDS_BARRIER();
        f32x4 o[4][2];
#pragma unroll
        for (int mt = 0; mt < 4; ++mt)
#pragma unroll
            for (int nt = 0; nt < 2; ++nt) { const u32x2_t wv = *(const LAS u32x2_t*)(lds + GF_OL + (16 * mt + fr) * 528 + (32 * w + 16 * nt + 4 * fq) * 2);
                o[mt][nt] = (f32x4){pg8::bflo(wv.x), pg8::bfhi(wv.x), pg8::bflo(wv.y), pg8::bfhi(wv.y)}; }
#pragma unroll
        for (int ks = 0; ks < 4; ++ks)
#pragma unroll
            for (int mt = 0; mt < 4; ++mt) { const u32x2_t a0 = *(const LAS u32x2_t*)(lds + GF_QG + (16 * mt + fr) * 272 + (32 * ks + 4 * fq) * 2), a1 = *(const LAS u32x2_t*)(lds + GF_QG + (16 * mt + fr) * 272 + (32 * ks + 16 + 4 * fq) * 2);
                const v4u aw = (v4u){a0.x, a0.y, a1.x, a1.y}; const bf16x8_t af = __builtin_bit_cast(bf16x8_t, aw);
                o[mt][0] = __builtin_amdgcn_mfma_f32_16x16x32_bf16(bfr[ks][0], af, o[mt][0], 0, 0, 0); o[mt][1] = __builtin_amdgcn_mfma_f32_16x16x32_bf16(bfr[ks][1], af, o[mt][1], 0, 0, 0); }
#pragma unroll
        for (int mt = 0; mt < 4; ++mt) { float sq = 0.f;
#pragma unroll
            for (int j = 0; j < 4; ++j) sq += o[mt][0][j] * o[mt][0][j] + o[mt][1][j] * o[mt][1][j];
            sq += __shfl_xor(sq, 16); sq += __shfl_xor(sq, 32);
            if (fq == 0) ((LAS float*)(lds + GF_SSQ))[w * 64 + 16 * mt + fr] = sq; }
        LDS_BARRIER();
        if (tid < 64) { const LAS float* sp = (const LAS float*)(lds + GF_SSQ); float tsum = 0.f;
#pragma unroll
            for (int q = 0; q < 8; ++q) tsum += sp[q * 64 + tid];
            ((LAS float*)(lds + GF_RS))[tid] = 1.0f / sqrtf(tsum * (1.0f / 256.0f) + EPS); }
        LDS_BARRIER();
#pragma unroll
        for (int mt = 0; mt < 4; ++mt) { const float rs = ((const LAS float*)(lds + GF_RS))[16 * mt + fr];
#pragma unroll
            for (int nt = 0; nt < 2; ++nt) { u32x2_t wv; wv.x = pg8::cvt_pk_bf16(o[mt][nt][0] * rs, o[mt][nt][1] * rs); wv.y = pg8::cvt_pk_bf16(o[mt][nt][2] * rs, o[mt][nt][3] * rs);
                *(LAS u32x2_t*)(lds + GF_OL + (16 * mt + fr) * 528 + (32 * w + 16 * nt + 4 * fq) * 2) = wv; } }
        LDS_BARRIER();
#pragma unroll
        for (int i = 0; i < 4; ++i) { const int piece = tid + 512 * i, t = piece >> 5, c8 = piece & 31; float ov[8], rv[8];
            pg8::unpack8(*(const LAS v4u*)(lds + GF_OL + t * 528 + c8 * 16), ov); pg8::unpack8(rg[i], rv);
#pragma unroll
            for (int e2 = 0; e2 < 8; ++e2) ov[e2] *= rv[e2];
            { GAS v4u* ap = (GAS v4u*)((GAS bf16*)A2_ + (size_t)(b * SEQ + tok0 + t) * DM + h * 256 + c8 * 8); if (b == 0) __builtin_nontemporal_store(pg8::pack8(ov), ap); else *ap = pg8::pack8(ov); } }
    }
    LDS_BARRIER();
}

__global__ void __launch_bounds__(NTHREADS, 2) fwd_kernel(Args a) {
    extern __shared__ __attribute__((aligned(16))) unsigned char lds_raw[];
    LAS unsigned char* lds = (LAS unsigned char*)lds_raw;
    cg::grid_group grid = cg::this_grid();
    const int tid = threadIdx.x, lane = tid & 63, wave = __builtin_amdgcn_readfirstlane(tid >> 6);
    const int G = gridDim.x, bx = blockIdx.x;
    const int gw = bx * NWAVES + wave, NGW = G * NWAVES;
    unsigned char* ws = a.ws;
    const float* x = a.in[0]; const float* g1 = a.in[1]; const float* w_in = a.in[2]; const float* gq = a.in[3]; const float* gk = a.in[4];
    const float* gate_up = a.in[5]; const float* gate_bias = a.in[6]; const float* gla_g = a.in[7]; const float* bgate_bias = a.in[8];
    const float* w_ab = a.in[9]; const float* w_gb = a.in[10]; const float* w_out = a.in[11]; const float* g2 = a.in[12]; const float* w_up = a.in[13]; const float* w_dn = a.in[14];
    bf16* WIN = (bf16*)(ws + WS_WIN); bf16* WA = (bf16*)(ws + WS_WA); bf16* WB = (bf16*)(ws + WS_WB); bf16* WO = (bf16*)(ws + WS_WO);
    bf16* WUP = (bf16*)(ws + WS_WUP); bf16* WDN = (bf16*)(ws + WS_WDN); bf16* XB = (bf16*)(ws + WS_XB); bf16* PROJ = (bf16*)(ws + WS_PROJ);
    bf16* VT = (bf16*)(ws + WS_VT); bf16* A1 = (bf16*)(ws + WS_A1); bf16* A2 = (bf16*)(ws + WS_A2);
    float* R1 = (float*)(ws + WS_R1); float* PA = (float*)(ws + WS_PA); float* SS2 = (float*)(ws + WS_SS2);
    bf16* MIXED = (bf16*)(ws + WS_MIXED); bf16* UB = (bf16*)(ws + WS_U); bf16* GATES = (bf16*)a.out;
    const int lo = a.ph_lo, hi = a.ph_hi; const int repm = a.rep;
    if (tid < 16) ((LAS unsigned*)(lds + LDS_BARST))[tid] = 0u;
    __syncthreads();
#define TS(i) do { if (TPROBE >= 0 && bx == TPBLK && tid == 0) ((LAS unsigned long long*)(lds + LDS_BARST + 16))[0 + ((i) == TPROBE ? 0 : ((i) == TPB ? 1 : 2))] = __builtin_amdgcn_s_memrealtime(); } while (0)
    TS(0);
    if (a.ph_lo < 0) grid.sync();
    if (a.ph_lo == 0) {
        unsigned* bw = (unsigned*)(ws + WS_BAR);
        if (bx == 0) { for (int i = tid; i < 4032; i += NTHREADS) bw[i] = 0u;
            asm volatile("s_waitcnt vmcnt(0)" ::: "memory"); __syncthreads();
            if (tid == 0) { __builtin_amdgcn_fence(__ATOMIC_RELEASE, "agent"); asm volatile("s_waitcnt vmcnt(0)" ::: "memory"); __hip_atomic_store(bw + 4064, 0x600DBA55u, __ATOMIC_RELAXED, __HIP_MEMORY_SCOPE_AGENT); } }
        if (tid == 0) { unsigned sp_ = 0; while (xb_ld(bw + 4064) != 0x600DBA55u) { __builtin_amdgcn_s_sleep(1); if (++sp_ > (1u << 22)) break; }
            __builtin_amdgcn_fence(__ATOMIC_ACQUIRE, "agent"); asm volatile("s_waitcnt vmcnt(0)" ::: "memory");
            (void)xb_add(bw + XB_XCNT(xb_xcc_id()), 1u); }
        __syncthreads();
    }
#define NREP(bit) (REPMASK ? (((repm >> (bit)) & 1) + 1) : 1)
#define IN(k) (lo <= (k) && (k) < hi)
#define LAUNDER(p) asm volatile("" : "+s"(p))
#define XBAR_OBJ(bb) XcdBarrier bb; bb.bar = (unsigned*)(ws + WS_BAR); bb.x = xb_xcc_id(); bb.st = (volatile LAS unsigned*)(lds + LDS_BARST)
#define SYNC(k) do { if (IN(k) && IN((k) + 1)) { asm volatile("s_waitcnt vmcnt(0) lgkmcnt(0)" ::: "memory"); \
        XBAR_OBJ(bb_); for (int rs_ = 0; rs_ < NREP(8); ++rs_) xcd_barrier(bb_); } } while (0)

    TS(39);
    if (IN(0)) for (int rep_ = 0; rep_ < NREP(0); ++rep_) {
        LAS float* scr = (LAS float*)(lds + wave * 16640);
        constexpr int I_IN = 16 * 152, I_A = 8 * 16, I_B = 16 * 16, I_O = 16 * 16, I_UP = 16 * 64, I_DN = 64 * 16;
        constexpr int NITEMS = I_IN + I_A + I_B + I_O + I_UP + I_DN;
        for (int it = wave * G + bx; it < NITEMS; it += NGW) {
            int r = it;
            if (r < I_IN) { const int kb = r / 152, nb = r % 152; const int n0 = nb * 64; const int src = n0 < 7680 ? n0 : n0 + 16;
                const float cs = (n0 >= 4608 && n0 < 5120) ? 0.08838834764831845f : 1.0f;
                p0_transpose_item(w_in, DIN, src, g1, 1023, cs, WIN, 1024, n0, kb * 64, scr, lane); continue; } r -= I_IN;
            if (r < I_A) { const int kb = r / 16, nb = r % 16; p0_transpose_item(w_ab, 1024, nb * 64, nullptr, 0, 1.0f, WA, 512, nb * 64, kb * 64, scr, lane); continue; } r -= I_A;
            if (r < I_B) { const int kb = r / 16, nb = r % 16; p0_transpose_item(w_gb, 1024, nb * 64, gla_g, 255, 1.0f, WB, 1024, nb * 64, kb * 64, scr, lane); continue; } r -= I_B;
            if (r < I_O) { const int kb = r / 16, nb = r % 16; p0_transpose_item(w_out, 1024, nb * 64, nullptr, 0, 1.0f, WO, 1024, nb * 64, kb * 64, scr, lane); continue; } r -= I_O;
            if (r < I_UP) { const int kb = r / 64, nb = r % 64; p0_transpose_item(w_up, 4096, nb * 64, g2, 1023, 1.0f, WUP, 1024, nb * 64, kb * 64, scr, lane); continue; } r -= I_UP;
            { const int kb = r / 16, nb = r % 16; p0_transpose_item(w_dn, 1024, nb * 64, nullptr, 0, 1.0f, WDN, 4096, nb * 64, kb * 64, scr, lane); }
        }
        __syncthreads();
        TS(40);
        LAS float* WAl = (LAS float*)lds;
        for (int idx = tid; idx < 1024 * 16; idx += NTHREADS) { const int k = idx >> 4, r = idx & 15; WAl[k * 20 + r] = w_in[(size_t)k * DIN + 7680 + r] * g1[k]; }
        __syncthreads();
        { const int fr = lane & 15, fq = lane >> 4, half = wave & 1; LAS float* xch = (LAS float*)(lds + 86016) + (wave >> 1) * 320;
          for (int tile = bx * 4 + (wave >> 1); tile < MTOK / 16; tile += G * 4) {
            asm volatile("" ::: "memory");
            const int row = tile * 16 + fr;
            const GAS f32x4* xr = (const GAS f32x4*)(x + (size_t)row * DM) + 2 * fq;
            GAS v4u* xo = (GAS v4u*)(XB + (size_t)row * DM) + fq;
            f32x4 acc = (f32x4){0.f, 0.f, 0.f, 0.f}; float ss = 0.f;
#pragma unroll 1
            for (int jb = 16 * half; jb < 16 * half + 16; jb += 8) {
                f32x4 v[8][2];
#pragma unroll
                for (int u = 0; u < 8; ++u) { v[u][0] = __builtin_nontemporal_load(xr + (jb + u) * 8); v[u][1] = __builtin_nontemporal_load(xr + (jb + u) * 8 + 1); }
#pragma unroll
                for (int u = 0; u < 8; ++u) { const int j = jb + u; const f32x4 a0 = v[u][0], a1 = v[u][1];
                    ss += ((a0[0] * a0[0] + a0[1] * a0[1]) + (a0[2] * a0[2] + a0[3] * a0[3])) + ((a1[0] * a1[0] + a1[1] * a1[1]) + (a1[2] * a1[2] + a1[3] * a1[3]));
                    v4u o; o.x = pk2(a0[0], a0[1]); o.y = pk2(a0[2], a0[3]); o.z = pk2(a1[0], a1[1]); o.w = pk2(a1[2], a1[3]); xo[j * 4] = o;
                    const LAS float* wp = WAl + (32 * j + 8 * fq) * 20 + fr;
                    acc = __builtin_amdgcn_mfma_f32_16x16x4f32(a0[0], wp[0], acc, 0, 0, 0); acc = __builtin_amdgcn_mfma_f32_16x16x4f32(a0[1], wp[20], acc, 0, 0, 0);
                    acc = __builtin_amdgcn_mfma_f32_16x16x4f32(a0[2], wp[40], acc, 0, 0, 0); acc = __builtin_amdgcn_mfma_f32_16x16x4f32(a0[3], wp[60], acc, 0, 0, 0);
                    acc = __builtin_amdgcn_mfma_f32_16x16x4f32(a1[0], wp[80], acc, 0, 0, 0); acc = __builtin_amdgcn_mfma_f32_16x16x4f32(a1[1], wp[100], acc, 0, 0, 0);
                    acc = __builtin_amdgcn_mfma_f32_16x16x4f32(a1[2], wp[120], acc, 0, 0, 0); acc = __builtin_amdgcn_mfma_f32_16x16x4f32(a1[3], wp[140], acc, 0, 0, 0); }
            }
            if (half == 1) { xch[lane] = acc[0]; xch[64 + lane] = acc[1]; xch[128 + lane] = acc[2]; xch[192 + lane] = acc[3]; xch[256 + lane] = ss; }
            __syncthreads();
            if (half == 0) { acc[0] += xch[lane]; acc[1] += xch[64 + lane]; acc[2] += xch[128 + lane]; acc[3] += xch[192 + lane]; ss += xch[256 + lane];
                ss += __shfl_xor(ss, 16); ss += __shfl_xor(ss, 32);
                const float r1 = 1.0f / sqrtf(ss * (1.0f / 1024.0f) + EPS);
#pragma unroll
                for (int j = 0; j < 4; ++j) { const float rr = __shfl(r1, 4 * fq + j); PA[(size_t)(tile * 16 + 4 * fq + j) * 16 + fr] = acc[j] * rr; }
                if (fq == 0) R1[row] = r1; }
            __syncthreads();
          } }
        __syncthreads();
    }
    TS(41);
    SYNC(0); TS(1);
    if (bx == 0 && tid == 0 && a.ph_lo == 0) __hip_atomic_store((unsigned*)(ws + WS_BAR) + 4064, 0u, __ATOMIC_RELAXED, __HIP_MEMORY_SCOPE_AGENT);

    for (int bq = 0; bq < 2; ++bq) {
        int b = bq; LAUNDER(b);
        const int p1 = 1 + 3 * b;
        if (IN(p1)) for (int rep_ = 0; rep_ < NREP(1); ++rep_) {
            pg8::Gemm g{XB + (size_t)b * SEQ * DM, WIN, SEQ, N1, DM}; pg8::StaticOrder S; S.init(SEQ, N1, G, bx);
            pg8::EpiProj E{PROJ, VT, GATES + (size_t)b * SEQ * 2048, R1 + b * SEQ, bgate_bias};
            pg8::gemm_phase<pg8::EpiProj, pg8::StaticOrder, true, true>(lds, g, S, E);
        }
        SYNC(p1); TS(p1 + 1);
        int tid_ = threadIdx.x; asm volatile("" : "+v"(tid_)); const int lane_ = tid_ & 63; const int wave_ = __builtin_amdgcn_readfirstlane(tid_ >> 6); int bx_ = bx; LAUNDER(bx_);
        const float* gate_up_ = gate_up; const float* gate_bias_ = gate_bias; const float* PA_ = PA; const bf16* PROJ_ = PROJ; const bf16* VT_ = VT; bf16* A1_ = A1; bf16* A2_ = A2; const float* gq_ = gq; const float* gk_ = gk;
        float* SBUF_ = (float*)(ws + WS_XB); float* DBUF_ = (float*)(ws + WS_MISC + 2 * MiB); float* ML_ = (float*)(ws + WS_MISC);
        bf16* SB16_ = (b == 0) ? (A2 + (size_t)SEQ * DM) : (XB + (size_t)SEQ * DM);
        LAUNDER(SB16_);
        bf16* QGS_ = (b == 0) ? (A1 + (size_t)SEQ * 512) : (bf16*)(ws + 247 * MiB);
        LAUNDER(QGS_);
        LAUNDER(gate_up_); LAUNDER(gate_bias_); LAUNDER(PA_); LAUNDER(PROJ_); LAUNDER(VT_); LAUNDER(A1_); LAUNDER(A2_); LAUNDER(gq_); LAUNDER(gk_); LAUNDER(SBUF_); LAUNDER(DBUF_); LAUNDER(ML_);
        if (IN(p1 + 1)) {
            if (bx_ < 128) { for (int rep_ = 0; rep_ < NREP(2); ++rep_) { gla_local(lds, b, bx_, PROJ_, VT_, PA_, gate_up_, gate_bias_, SBUF_, DBUF_, A2_, QGS_, tid_, wave_, lane_); }
                if (b == 0) TS(20);
                asm volatile("s_waitcnt vmcnt(0) lgkmcnt(0)" ::: "memory"); __syncthreads();
                if (tid_ == 0) { unsigned* cw = (unsigned*)(ws + WS_BAR) + 3520 + 64 * b;
                    __builtin_amdgcn_fence(__ATOMIC_RELEASE, "agent"); asm volatile("s_waitcnt vmcnt(0)" ::: "memory");
                    (void)xb_add(cw, 1u); }
            }
            if (b == 0) TS(21);
            {
                float gkr[8], gqr[16];
#pragma unroll
                for (int i = 0; i < 8; ++i) gkr[i] = gk_[(tid_ & 7) * 8 + i];
#pragma unroll
                for (int i = 0; i < 8; ++i) { gqr[i] = gq_[8 * (lane_ >> 4) + i]; gqr[8 + i] = gq_[32 + 8 * (lane_ >> 4) + i]; }
                bf16* PROJW = (bf16*)PROJ_;
                asm volatile("" :: "v"(gkr[7]), "v"(gqr[15]));
                const int first = bx_, cnt = bx_ < 128 ? 1 : 5;
                const int nrep_ = NREP(7);
                for (int rep_ = 0; rep_ < nrep_; ++rep_) {
                    AttnKQ R; v4u Vr[6]; attn_load_kq(R, PROJ_, first, tid_, wave_, lane_); attn_load_v(Vr, PROJ_, first, tid_);
                    for (int k = 0; k < cnt; ++k) { const int it = first + 128 * k;
                        LDS_BARRIER();
                        attn_stage_k(R, lds, gkr, tid_); attn_stage_v(Vr, lds, tid_);
                        const v4u q0 = R.q[0], q1 = R.q[1], q2 = R.q[2], q3 = R.q[3];
                        LDS_BARRIER();
                        if (k + 1 < cnt) { attn_load_kq(R, PROJ_, it + 128, tid_, wave_, lane_); attn_load_v(Vr, PROJ_, it + 128, tid_); }
                        { f32x4 sc[9]; float mx, den; attn_scores(sc, mx, den, q0, q1, lds, gqr, 0, it_first_block(it), wave_, lane_);
                          attn_pv(sc, mx, den, lds, PROJW, ML_, it, 0, wave_, lane_, rep_ == nrep_ - 1); }
                        { f32x4 sc[9]; float mx, den; attn_scores(sc, mx, den, q2, q3, lds, gqr, 8, false, wave_, lane_);
                          attn_pv(sc, mx, den, lds, PROJW, ML_, it, 8, wave_, lane_, rep_ == nrep_ - 1); }
                    }
                }
            }
        }
        if (IN(p1 + 1)) {
            if (tid_ == 0) { unsigned* cw = (unsigned*)(ws + WS_BAR) + 3520 + 64 * b; unsigned sp_ = 0;
                while (xb_ld(cw) < 128u) { __builtin_amdgcn_s_sleep(1); if (++sp_ > (1u << 22)) break; }
                __builtin_amdgcn_fence(__ATOMIC_ACQUIRE, "agent"); asm volatile("s_waitcnt vmcnt(0)" ::: "memory"); }
            __syncthreads();
            { const int gid = bx_ * NTHREADS + tid_; const int h = gid >> 15, r = (gid >> 9) & 63, tl = gid & 511; const int kdr = 16 * (r >> 3) + 4 * ((tl & 63) >> 4) + (r & 3);
              float loc[32], dec[32];
#pragma unroll
              for (int sg = 0; sg < 32; ++sg) { loc[sg] = ((const GAS float*)SBUF_)[((size_t)(h * 32 + sg) * 64 + r) * 512 + tl]; dec[sg] = ((const GAS float*)DBUF_)[(h * 32 + sg) * 128 + kdr]; }
              float cur = 0.f;
#pragma unroll
              for (int sg = 0; sg < 32; ++sg) { ((GAS unsigned short*)SB16_)[((size_t)(h * 32 + sg) * 64 + r) * 512 + tl] = (unsigned short)f2bf(cur); cur = dec[sg] * cur + loc[sg]; } }
        }
        SYNC(p1 + 1); TS(p1 + 2);
        if (IN(p1 + 2)) {
            for (int rep_ = 0; rep_ < NREP(3); ++rep_) { gla_fix(lds, b, bx_, PROJ_, SB16_, A2_, QGS_, tid_, wave_, lane_); }
            {
            for (int rep_ = 0; rep_ < NREP(9); ++rep_) {
                for (int idx = bx_ * NTHREADS + tid_; idx < SEQ * 64; idx += G * NTHREADS) {
                    const int t = idx >> 6, slot = (idx >> 3) & 7, c8 = idx & 7;
                    float m[3], dn[3];
#pragma unroll
                    for (int g = 0; g < 3; ++g) { const GAS float* mp = (const GAS float*)ML_ + (size_t)t * 48 + (g * 8 + slot) * 2; m[g] = mp[0]; dn[g] = mp[1]; }
                    const float M = fmaxf(m[0], fmaxf(m[1], m[2])); float D = 0.f; float acc[8];
#pragma unroll
                    for (int i = 0; i < 8; ++i) acc[i] = 0.f;
#pragma unroll
                    for (int g = 0; g < 3; ++g) { const float wg = __builtin_amdgcn_exp2f(m[g] - M); D += wg * dn[g]; float f[8];
                        pg8::unpack8(*(const GAS v4u*)((const GAS bf16*)PROJ_ + (size_t)t * PLD + (g * 8 + slot) * 64 + c8 * 8), f);
#pragma unroll
                        for (int i = 0; i < 8; ++i) acc[i] += wg * f[i]; }
                    const float inv = 1.0f / D;
#pragma unroll
                    for (int i = 0; i < 8; ++i) acc[i] *= inv;
                    { GAS v4u* ap = (GAS v4u*)((GAS bf16*)A1_ + (size_t)(b * SEQ + t) * 512 + slot * 64 + c8 * 8); if (b == 0) __builtin_nontemporal_store(pg8::pack8(acc), ap); else *ap = pg8::pack8(acc); }
                }
            }
            }
        }
        SYNC(p1 + 2); TS(p1 + 3);
    }
    if (IN(7)) for (int rep_ = 0; rep_ < NREP(4); ++rep_) {
#pragma unroll 1
        for (int pass = 0; pass < 2; ++pass) {
            const bool useB = (((bx & 1) != 0) != (pass == 1));
            pg8::Gemm g{useB ? A2 : A1, useB ? WB : WA, MTOK, DM, useB ? 1024 : 512}; pg8::StaticOrder S; S.init(MTOK, DM, G, bx); pg8::EpiBranch E{MIXED, GATES, useB ? 1024 : 0, pass};
            pg8::gemm_phase<pg8::EpiBranch, pg8::StaticOrder, true, true>(lds, g, S, E);
            __syncthreads();
        }
    }
    SYNC(7); TS(8);
    if (IN(8)) for (int rep_ = 0; rep_ < NREP(5); ++rep_) { pg8::Gemm g{MIXED, WO, MTOK, DM, 1024}; pg8::StaticOrder S; S.init(MTOK, DM, G, bx); pg8::EpiOut1 E{x, a.out, XB, SS2};
        pg8::gemm_phase<pg8::EpiOut1, pg8::StaticOrder, true, true>(lds, g, S, E); }
    SYNC(8); TS(9);
    if (IN(9)) for (int rep_ = 0; rep_ < NREP(6); ++rep_) { pg8::Gemm g{XB, WUP, MTOK, FF, 1024}; pg8::StaticOrder S; S.init(MTOK, FF, G, bx); pg8::EpiUp E{UB, SS2};
        pg8::gemm_phase<pg8::EpiUp, pg8::StaticOrder, true, true>(lds, g, S, E); }
    SYNC(9); TS(10);
    if (IN(10)) for (int rep_ = 0; rep_ < NREP(10); ++rep_) { pg8::Gemm g{UB, WDN, MTOK, DM, FF}; pg8::StaticOrder S; S.init(MTOK, DM, G, bx); pg8::EpiDown E{a.out, rep_ == NREP(10) - 1};
        pg8::gemm_phase<pg8::EpiDown, pg8::StaticOrder, true, true>(lds, g, S, E); }
    TS(11);
    if (TPROBE >= 0 && bx == TPBLK && tid == 0) { const LAS unsigned long long* tsp = (const LAS unsigned long long*)(lds + LDS_BARST + 16); const unsigned long long dt = tsp[1] - tsp[0];
        const unsigned long long tend = __builtin_amdgcn_s_memrealtime() + 4ull * dt; while (__builtin_amdgcn_s_memrealtime() < tend) __builtin_amdgcn_s_sleep(8); }
#undef IN
#undef SYNC
}

extern "C" void kernel_launch(void* const* d_in, const int* in_sizes, int n_in, void* d_out, int out_size, void* d_ws, size_t ws_size, hipStream_t stream) {
    static int grid = 0;
    if (grid == 0) {
        if (n_in != 15 || out_size != MTOK * DM || ws_size < WS_END) { fprintf(stderr, "kernel_launch: unexpected shapes (n_in %d, out %d, ws %zu)\n", n_in, out_size, ws_size); grid = -1; return; }
        int dev = 0, cus = 0, per_cu = 0;
        hipGetDevice(&dev); hipDeviceGetAttribute(&cus, hipDeviceAttributeMultiprocessorCount, dev);
        if (hipFuncSetAttribute((const void*)fwd_kernel, hipFuncAttributeMaxDynamicSharedMemorySize, LDS_BYTES) != hipSuccess) { fprintf(stderr, "kernel_launch: hipFuncSetAttribute failed\n"); grid = -1; return; }
        if (hipOccupancyMaxActiveBlocksPerMultiprocessor(&per_cu, (const void*)fwd_kernel, NTHREADS, LDS_BYTES) != hipSuccess || per_cu < 1) per_cu = 1;
        (void)hipGetLastError();
        grid = cus * per_cu;
        fprintf(stderr, "kernel_launch: grid %d (cus %d x %d)\n", grid, cus, per_cu);
    }
    if (grid < 0) return;
    Args a{};
    for (int i = 0; i < 15; ++i) a.in[i] = (const float*)d_in[i];
    a.out = (float*)d_out; a.ws = (unsigned char*)d_ws; a.ph_lo = 0; a.ph_hi = 11; a.rep = REPMASK; a.pad = 0;
    void* args[] = {&a};
    hipError_t e = hipLaunchCooperativeKernel((const void*)fwd_kernel, dim3(grid), dim3(NTHREADS), args, LDS_BYTES, stream);
    if (e != hipSuccess) fprintf(stderr, "cooperative launch failed: %s (grid %d)\n", hipGetErrorString(e), grid);
}
```
